# Optimizing an MI355X kernel written in HIP

```python
import math
import jax, jax.numpy as jnp
from jax import lax
import numpy as np

D_MODEL = 1024
BATCH = 4
SEQ = 8192
DEPTH = 1

CHUNK = 64
Q_BLOCK = 128
N_MEM = 256
HEAD_DIM = 64
SB_HEADS = 8
SB_WIDTH = SB_HEADS * HEAD_DIM
HG_HEADS = 4
HG_KEY_DIM = 128
HG_VAL_DIM = 64
HG_KWIDTH = HG_HEADS * HG_KEY_DIM
HG_VWIDTH = HG_HEADS * HG_VAL_DIM
MEM_HEADS = 4
MEM_WIDTH = MEM_HEADS * HEAD_DIM
MIX_WIDTH = SB_WIDTH + HG_VWIDTH + MEM_WIDTH
SPLIT_SIZES = (SB_WIDTH, SB_WIDTH, SB_WIDTH, HG_KWIDTH, HG_KWIDTH, HG_VWIDTH, HG_VWIDTH, MEM_WIDTH)
IN_WIDTH = 3 * SB_WIDTH + 2 * HG_KWIDTH + 2 * HG_VWIDTH + MEM_WIDTH
PEER_HEADS = 8
N_KEYS = 128
N_EXPERTS = N_KEYS * N_KEYS
PEER_TOPK = 16
D_KEY = 256
HALF_KEY = D_KEY // 2
PEER_TOKEN_BLOCK = 128
EPS = 1e-6

kernel_name = "hybrid_stickbreak_hgrn2_memattn_peer"


def rms_norm(x, gain):
    xf = x.astype(jnp.float32)
    y = xf * lax.rsqrt(jnp.mean(xf * xf, axis=-1, keepdims=True) + EPS)
    return (y * gain.astype(jnp.float32)).astype(x.dtype)


def stick_breaking_attention(q, k, v):
    b, s, h, d = q.shape
    nb = s // Q_BLOCK
    qb = q.reshape(b, nb, Q_BLOCK, h, d).transpose(1, 0, 3, 2, 4)
    kh = k.transpose(0, 2, 1, 3)
    vh = v.transpose(0, 2, 1, 3)
    key_pos = jnp.arange(s)
    scale = 1.0 / math.sqrt(d)

    def block(args):
        q_blk, i = args
        q_pos = i * Q_BLOCK + jnp.arange(Q_BLOCK)
        z = jnp.einsum('bhqd,bhkd->bhqk', q_blk, kh).astype(jnp.float32) * scale
        mask = key_pos[None, :] < q_pos[:, None]
        log_1m = jnp.where(mask, jax.nn.log_sigmoid(-z), 0.0)
        tail = lax.cumsum(log_1m, axis=3, reverse=True) - log_1m
        log_a = jax.nn.log_sigmoid(z) + tail
        a = jnp.where(mask, jnp.exp(log_a), 0.0)
        return jnp.einsum('bhqk,bhkd->bhqd', a.astype(vh.dtype), vh)

    out = lax.map(block, (qb, jnp.arange(nb)))
    return out.transpose(1, 0, 3, 2, 4).reshape(b, s, h, d)


def hgrn2_recurrence(q, f_logit, i, lower_bound):
    b, s, h, dk = q.shape
    dv = i.shape[-1]
    nc = s // CHUNK
    f = lower_bound + (1.0 - lower_bound) * jax.nn.sigmoid(f_logit.astype(jnp.float32))
    log_f = jnp.log(f)
    k = 1.0 - f
    qf = jax.nn.silu(q.astype(jnp.float32))
    vf = i.astype(jnp.float32)

    def to_chunks(t):
        return t.reshape(b, nc, CHUNK, h, t.shape[-1]).transpose(1, 0, 3, 2, 4)

    causal = jnp.tril(jnp.ones((CHUNK, CHUNK), dtype=bool))[:, :, None]

    def step(state, inp):
        qc, kc, vc, gc = inp
        bcum = jnp.cumsum(gc, axis=2)
        diff = bcum[:, :, :, None, :] - bcum[:, :, None, :, :]
        decay = jnp.where(causal, jnp.exp(jnp.where(causal, diff, 0.0)), 0.0)
        scores = jnp.einsum('bhtk,bhtsk,bhsk->bhts', qc, decay, kc)
        intra = jnp.einsum('bhts,bhsv->bhtv', scores, vc)
        inter = jnp.einsum('bhtk,bhkv->bhtv', qc * jnp.exp(bcum), state)
        last = bcum[:, :, -1:, :]
        new_state = (jnp.exp(last[:, :, 0, :])[..., None] * state
                     + jnp.einsum('bhsk,bhsv->bhkv', kc * jnp.exp(last - bcum), vc))
        return new_state, intra + inter

    state0 = jnp.zeros((b, h, dk, dv), jnp.float32)
    _, out = lax.scan(step, state0, (to_chunks(qf), to_chunks(k), to_chunks(vf), to_chunks(log_f)))
    return out.transpose(1, 0, 3, 2, 4).reshape(b, s, h, dv)


def memory_attention(q, mem_k, mem_v, q_gain, k_gain):
    qn = rms_norm(q, q_gain)
    kn = rms_norm(mem_k, k_gain)
    scale = 1.0 / math.sqrt(q.shape[-1])
    logits = jnp.einsum('bshd,bmhd->bhsm', qn, kn).astype(jnp.float32) * scale
    p = jax.nn.softmax(logits, axis=-1)
    return jnp.einsum('bhsm,bmhd->bshd', p.astype(mem_v.dtype), mem_v)


def peer_ffn(h, w_query, sub_keys, expert_u, expert_v):
    b, s, d = h.shape
    nb = s // PEER_TOKEN_BLOCK
    hb = h.reshape(b, nb, PEER_TOKEN_BLOCK, d).transpose(1, 0, 2, 3)

    def block(x_blk):
        t = x_blk.shape[1]
        q = (x_blk @ w_query).reshape(b, t, PEER_HEADS, 2, HALF_KEY)
        scores = jnp.einsum('bthcd,hcnd->bthcn', q, sub_keys).astype(jnp.float32)
        top_s, top_i = lax.top_k(scores, PEER_TOPK)
        cand_s = top_s[..., 0, :, None] + top_s[..., 1, None, :]
        cand_i = top_i[..., 0, :, None] * N_KEYS + top_i[..., 1, None, :]
        cand_s = cand_s.reshape(b, t, PEER_HEADS, PEER_TOPK * PEER_TOPK)
        cand_i = cand_i.reshape(b, t, PEER_HEADS, PEER_TOPK * PEER_TOPK)
        best_s, pos = lax.top_k(cand_s, PEER_TOPK)
        expert_idx = jnp.take_along_axis(cand_i, pos, axis=-1)
        gate = jax.nn.softmax(best_s, axis=-1)
        u = expert_u[expert_idx]
        v = expert_v[expert_idx]
        act = jax.nn.gelu(jnp.einsum('btd,bthkd->bthk', x_blk, u).astype(jnp.float32), approximate=False)
        return jnp.einsum('bthk,bthkd->btd', (gate * act).astype(v.dtype), v)

    out = lax.map(block, hb)
    return out.transpose(1, 0, 2, 3).reshape(b, s, d)


def setup_inputs(seed: int = 0) -> dict:
    key = jax.random.key(seed)
    ks = jax.random.split(key, 20)
    f32 = jnp.float32
    nrm = lambda k, shape, scale: jax.random.normal(k, shape, f32) * scale
    gain = lambda k, shape: 1.0 + 0.02 * jax.random.normal(k, shape, f32)
    return {
        "x": jax.random.normal(ks[0], (BATCH, SEQ, D_MODEL), f32),
        "mem": jax.random.normal(ks[1], (BATCH, N_MEM, D_MODEL), f32),
        "norm_mix_gain": gain(ks[2], (DEPTH, D_MODEL)),
        "w_in": nrm(ks[3], (DEPTH, D_MODEL, IN_WIDTH), D_MODEL ** -0.5),
        "gamma_lb": nrm(ks[4], (DEPTH + 1, HG_KWIDTH), 0.5),
        "sb_out_gain": gain(ks[5], (DEPTH, SB_HEADS, HEAD_DIM)),
        "hg_out_gain": gain(ks[6], (DEPTH, HG_HEADS, HG_VAL_DIM)),
        "mem_norm_gain": gain(ks[7], (D_MODEL,)),
        "w_mem_kv": nrm(ks[8], (DEPTH, D_MODEL, 2 * MEM_WIDTH), D_MODEL ** -0.5),
        "mem_q_gain": gain(ks[9], (DEPTH, HEAD_DIM)),
        "mem_k_gain": gain(ks[10], (DEPTH, HEAD_DIM)),
        "w_out": nrm(ks[11], (DEPTH, MIX_WIDTH, D_MODEL), MIX_WIDTH ** -0.5),
        "norm_ffn_gain": gain(ks[12], (DEPTH, D_MODEL)),
        "peer_w_query": nrm(ks[13], (DEPTH, D_MODEL, PEER_HEADS * D_KEY), D_MODEL ** -0.5),
        "peer_sub_keys": nrm(ks[14], (DEPTH, PEER_HEADS, 2, N_KEYS, HALF_KEY), HALF_KEY ** -0.5),
        "peer_u": nrm(ks[15], (DEPTH, N_EXPERTS, D_MODEL), D_MODEL ** -0.5),
        "peer_v": nrm(ks[16], (DEPTH, N_EXPERTS, D_MODEL), PEER_HEADS ** -0.5),
    }


def reference(x, mem, norm_mix_gain, w_in, gamma_lb, sb_out_gain, hg_out_gain, mem_norm_gain,
              w_mem_kv, mem_q_gain, mem_k_gain, w_out, norm_ffn_gain, peer_w_query,
              peer_sub_keys, peer_u, peer_v):
    b, s, _ = x.shape
    m = mem.shape[1]
    lb_all = jnp.cumsum(jax.nn.softmax(gamma_lb.astype(jnp.float32), axis=0), axis=0)
    mem_n = rms_norm(mem, mem_norm_gain)
    split_points = [int(v) for v in np.cumsum(SPLIT_SIZES)[:-1]]
    for l in range(DEPTH):
        h = rms_norm(x, norm_mix_gain[l])
        proj = h @ w_in[l]
        sb_q, sb_k, sb_v, hg_q, hg_f, hg_i, hg_g, mem_q = jnp.split(proj, split_points, axis=-1)

        sb_o = stick_breaking_attention(sb_q.reshape(b, s, SB_HEADS, HEAD_DIM),
                                        sb_k.reshape(b, s, SB_HEADS, HEAD_DIM),
                                        sb_v.reshape(b, s, SB_HEADS, HEAD_DIM))
        sb_o = rms_norm(sb_o, sb_out_gain[l]).reshape(b, s, SB_WIDTH)

        lb = lb_all[l].reshape(HG_HEADS, HG_KEY_DIM)
        hg_o = hgrn2_recurrence(hg_q.reshape(b, s, HG_HEADS, HG_KEY_DIM),
                                hg_f.reshape(b, s, HG_HEADS, HG_KEY_DIM),
                                hg_i.reshape(b, s, HG_HEADS, HG_VAL_DIM), lb).astype(x.dtype)
        hg_o = rms_norm(hg_o, hg_out_gain[l]).reshape(b, s, HG_VWIDTH) * jax.nn.silu(hg_g)

        mem_kv = mem_n @ w_mem_kv[l]
        mem_k, mem_v = jnp.split(mem_kv, 2, axis=-1)
        mem_o = memory_attention(mem_q.reshape(b, s, MEM_HEADS, HEAD_DIM),
                                 mem_k.reshape(b, m, MEM_HEADS, HEAD_DIM),
                                 mem_v.reshape(b, m, MEM_HEADS, HEAD_DIM),
                                 mem_q_gain[l], mem_k_gain[l]).reshape(b, s, MEM_WIDTH)

        mixed = jnp.concatenate([sb_o, hg_o, mem_o], axis=-1)
        x = x + mixed @ w_out[l]

        x = x + peer_ffn(rms_norm(x, norm_ffn_gain[l]), peer_w_query[l], peer_sub_keys[l],
                         peer_u[l], peer_v[l])
    return x
```

```cpp
#include <hip/hip_runtime.h>
#include <hip/hip_cooperative_groups.h>
#include <cstdio>
#include <cstdint>
namespace cg = cooperative_groups;

constexpr int NB = 4, SEQ = 8192, DM = 1024, T = NB * SEQ;
constexpr int NMEM = 256, INW = 3328;
constexpr int C_SBQ = 0, C_SBK = 512, C_SBV = 1024, C_HGQ = 1536, C_HGF = 2048, C_HGI = 2560, C_HGG = 2816, C_MQ = 3072;
constexpr int NEXP = 16384, PK = 128;
constexpr float EPS = 1e-6f;
constexpr float LOG2E = 1.4426950408889634f;
constexpr float C2 = 0.125f * LOG2E;

constexpr int NTHR = 512;
constexpr int LDS_BYTES = 147456;

constexpr size_t MiB = 1u << 20;
constexpr size_t WS_CTL = 0;
constexpr size_t WS_WIN_T = 1 * MiB;
constexpr size_t WS_WOUT_T = 8 * MiB;
constexpr size_t WS_WQ_T = 10 * MiB;
constexpr size_t WS_WMKV_T = 14 * MiB;
constexpr size_t WS_SKB = 15 * MiB;
constexpr size_t WS_LB = 15 * MiB + 512 * 1024;
constexpr size_t WS_MEMN = 16 * MiB;
constexpr size_t WS_MEMKV = 18 * MiB;
constexpr size_t WS_MEMK = 20 * MiB;
constexpr size_t WS_MEMV = 20 * MiB + 512 * 1024;
constexpr size_t WS_RSTD2 = 21 * MiB;
constexpr size_t WS_PIDX = 24 * MiB;
constexpr size_t WS_PG = 40 * MiB;
constexpr size_t WS_XB = 72 * MiB;
constexpr size_t WS_MIXED = 136 * MiB;
constexpr size_t WS_P = 200 * MiB;
constexpr size_t WS_Q = 200 * MiB;
constexpr size_t WS_HGRAW = 408 * MiB;
constexpr size_t WS_END = 512 * MiB;

typedef unsigned short bf16_t;
__device__ __forceinline__ float bf2f(bf16_t v) { return __uint_as_float(((unsigned)v) << 16); }
__device__ __forceinline__ float bflo(unsigned w) { return __uint_as_float(w << 16); }
__device__ __forceinline__ float bfhi(unsigned w) { return __uint_as_float(w & 0xffff0000u); }
__device__ __forceinline__ bf16_t f2bf(float f) { unsigned u = __float_as_uint(f); return (bf16_t)((u + 0x7fffu + ((u >> 16) & 1u)) >> 16); }
__device__ __forceinline__ unsigned pk2(float lo, float hi) { return (unsigned)f2bf(lo) | ((unsigned)f2bf(hi) << 16); }
__device__ __forceinline__ float wave_sum(float v) {
#pragma unroll
    for (int o = 1; o < 64; o <<= 1) v += __shfl_xor(v, o);
    return v;
}
__device__ __forceinline__ float silu(float v) { return v / (1.f + __expf(-v)); }

struct Params {
    const float *x, *mem, *g_mix, *w_in, *gamma_lb, *sb_gain, *hg_gain, *mem_gain, *w_mkv, *mq_gain, *mk_gain, *w_out, *g_ffn, *w_q, *sub_keys, *pu, *pv;
    float* out; unsigned char* ws;
};

__device__ __forceinline__ void transpose_item(const float* W, const float* gain, int K, int N, bf16_t* WT, float* scr, int item, int lane) {
    const int nblk = N / 32, kb = item / nblk, nb = item % nblk, k0 = 64 * kb, n0 = 32 * nb;
    for (int i = 0; i < 32; ++i) { const int kk = 2 * i + (lane >> 5); float g = gain ? gain[k0 + kk] : 1.f; scr[kk * 33 + (lane & 31)] = W[(size_t)(k0 + kk) * N + n0 + (lane & 31)] * g; }
    __builtin_amdgcn_s_waitcnt(0); __builtin_amdgcn_wave_barrier();
    const int c = lane & 7;
#pragma unroll
    for (int j = 0; j < 4; ++j) { const int n = (lane >> 3) + 8 * j; const float* s = scr + (8 * c) * 33 + n;
        uint4 o; o.x = pk2(s[0 * 33], s[1 * 33]); o.y = pk2(s[2 * 33], s[3 * 33]); o.z = pk2(s[4 * 33], s[5 * 33]); o.w = pk2(s[6 * 33], s[7 * 33]);
        *(uint4*)(WT + (size_t)(n0 + n) * K + k0 + 8 * c) = o; }
    __builtin_amdgcn_s_waitcnt(0); __builtin_amdgcn_wave_barrier();
}
__device__ __forceinline__ void norm_row_to_bf16(const float* xrow, bf16_t* orow, int lane) {
    const float4* xr = (const float4*)xrow + lane;
    float4 v[4]; float s = 0.f;
#pragma unroll
    for (int j = 0; j < 4; ++j) { v[j] = xr[64 * j]; s += (v[j].x * v[j].x + v[j].y * v[j].y) + (v[j].z * v[j].z + v[j].w * v[j].w); }
    const float rstd = rsqrtf(wave_sum(s) * (1.f / DM) + EPS);
    unsigned long long* o8 = (unsigned long long*)orow + lane;
#pragma unroll
    for (int j = 0; j < 4; ++j) o8[64 * j] = (unsigned long long)pk2(v[j].x * rstd, v[j].y * rstd) | ((unsigned long long)pk2(v[j].z * rstd, v[j].w * rstd) << 32);
}
__device__ __forceinline__ void phase_prep(const Params& p, unsigned char* lds) {
    const int tid = threadIdx.x, lane = tid & 63, wave = tid >> 6;
    const int gw = blockIdx.x * 8 + wave, NGW = gridDim.x * 8;
    const int gt = blockIdx.x * NTHR + tid, NGT = gridDim.x * NTHR;
    unsigned char* ws = p.ws;
    float* scr = (float*)lds + wave * (64 * 33);
    constexpr int I_IN = (DM / 64) * (INW / 32), I_OUT = (DM / 64) * (DM / 32), I_Q = (DM / 64) * (2048 / 32), I_MKV = (DM / 64) * (512 / 32);
    for (int it = gw; it < I_IN + I_OUT + I_Q + I_MKV; it += NGW) {
        int r = it;
        if (r < I_IN) { transpose_item(p.w_in, p.g_mix, DM, INW, (bf16_t*)(ws + WS_WIN_T), scr, r, lane); continue; } r -= I_IN;
        if (r < I_OUT) { transpose_item(p.w_out, nullptr, DM, DM, (bf16_t*)(ws + WS_WOUT_T), scr, r, lane); continue; } r -= I_OUT;
        if (r < I_Q) { transpose_item(p.w_q, p.g_ffn, DM, 2048, (bf16_t*)(ws + WS_WQ_T), scr, r, lane); continue; } r -= I_Q;
        transpose_item(p.w_mkv, p.mem_gain, DM, 512, (bf16_t*)(ws + WS_WMKV_T), scr, r, lane);
    }
    for (int m = gw; m < T; m += NGW) norm_row_to_bf16(p.x + (size_t)m * DM, (bf16_t*)(ws + WS_XB) + (size_t)m * DM, lane);
    for (int m = gw; m < NB * NMEM; m += NGW) norm_row_to_bf16(p.mem + (size_t)m * DM, (bf16_t*)(ws + WS_MEMN) + (size_t)m * DM, lane);
    for (int i = gt; i < 8 * 2 * 128 * 128; i += NGT) ((bf16_t*)(ws + WS_SKB))[i] = f2bf(p.sub_keys[i]);
    for (int i = gt; i < 512; i += NGT) ((float*)(ws + WS_LB))[i] = 1.f / (1.f + expf(p.gamma_lb[512 + i] - p.gamma_lb[i]));
}

template <class Epi>
__device__ __forceinline__ void gemm_naive(const bf16_t* A, const bf16_t* Bt, int M, int N, int K, unsigned char* ldsb, const Epi& epi) {
    float* As = (float*)ldsb;
    float* Bs = As + 32 * 132;
    const int tid = threadIdx.x, ty = tid >> 4, tx = tid & 15;
    const int ntm = M / 128, ntn = N / 64;
    for (int tile = blockIdx.x; tile < ntm * ntn; tile += gridDim.x) {
        const int tm = tile / ntn, tn = tile % ntn;
        float acc[4][4];
#pragma unroll
        for (int i = 0; i < 4; ++i)
#pragma unroll
            for (int j = 0; j < 4; ++j) acc[i][j] = 0.f;
        for (int k0 = 0; k0 < K; k0 += 32) {
            { const int r = tid >> 2, kq = (tid & 3) * 8;
              const uint4 v = *(const uint4*)(A + (size_t)(tm * 128 + r) * K + k0 + kq);
              As[(kq + 0) * 132 + r] = bflo(v.x); As[(kq + 1) * 132 + r] = bfhi(v.x); As[(kq + 2) * 132 + r] = bflo(v.y); As[(kq + 3) * 132 + r] = bfhi(v.y);
              As[(kq + 4) * 132 + r] = bflo(v.z); As[(kq + 5) * 132 + r] = bfhi(v.z); As[(kq + 6) * 132 + r] = bflo(v.w); As[(kq + 7) * 132 + r] = bfhi(v.w); }
            if (tid < 256) { const int r = tid >> 2, kq = (tid & 3) * 8;
              const uint4 v = *(const uint4*)(Bt + (size_t)(tn * 64 + r) * K + k0 + kq);
              Bs[(kq + 0) * 68 + r] = bflo(v.x); Bs[(kq + 1) * 68 + r] = bfhi(v.x); Bs[(kq + 2) * 68 + r] = bflo(v.y); Bs[(kq + 3) * 68 + r] = bfhi(v.y);
              Bs[(kq + 4) * 68 + r] = bflo(v.z); Bs[(kq + 5) * 68 + r] = bfhi(v.z); Bs[(kq + 6) * 68 + r] = bflo(v.w); Bs[(kq + 7) * 68 + r] = bfhi(v.w); }
            __syncthreads();
#pragma unroll 8
            for (int k = 0; k < 32; ++k) {
                const float4 a = *(const float4*)(As + k * 132 + ty * 4); const float4 b = *(const float4*)(Bs + k * 68 + tx * 4);
                const float av[4] = {a.x, a.y, a.z, a.w}, bv[4] = {b.x, b.y, b.z, b.w};
#pragma unroll
                for (int i = 0; i < 4; ++i)
#pragma unroll
                    for (int j = 0; j < 4; ++j) acc[i][j] = fmaf(av[i], bv[j], acc[i][j]);
            }
            __syncthreads();
        }
#pragma unroll
        for (int i = 0; i < 4; ++i)
#pragma unroll
            for (int j = 0; j < 4; ++j) epi(tm * 128 + ty * 4 + i, tn * 64 + tx * 4 + j, acc[i][j]);
    }
}

struct EpiProj {
    bf16_t* P;
    __device__ __forceinline__ void operator()(int row, int col, float v) const {
        if (col < C_SBK) v *= C2;
        else if (col >= C_HGQ && col < C_HGF) v = silu(v);
        else if (col >= C_HGG && col < C_MQ) v = silu(v);
        P[(size_t)row * INW + col] = f2bf(v);
    }
};
struct EpiF32 { float* O; int ld; __device__ __forceinline__ void operator()(int row, int col, float v) const { O[(size_t)row * ld + col] = v; } };
struct EpiWout { const float* x; float* out; bf16_t* xb;
    __device__ __forceinline__ void operator()(int row, int col, float v) const { const size_t i = (size_t)row * DM + col; const float r = x[i] + v; out[i] = r; xb[i] = f2bf(r); } };
struct EpiQ { const float* rstd; bf16_t* Q;
    __device__ __forceinline__ void operator()(int row, int col, float v) const { Q[(size_t)row * 2048 + col] = f2bf(v * rstd[row]); } };

#ifndef SB_EARLY
#define SB_EARLY 0
#endif
__device__ __forceinline__ void sb_naive(const Params& p) {
    const bf16_t* P = (const bf16_t*)(p.ws + WS_P);
    bf16_t* mixed = (bf16_t*)(p.ws + WS_MIXED);
    for (int row = blockIdx.x * NTHR + threadIdx.x; row < NB * 8 * SEQ; row += gridDim.x * NTHR) {
        const int t = row % SEQ, bh = row / SEQ, h = bh % 8, b = bh / 8;
        const size_t tok = (size_t)b * SEQ + t;
        float q[64], o[64];
        { const uint4* qp = (const uint4*)(P + tok * INW + C_SBQ + h * 64);
#pragma unroll
          for (int j = 0; j < 8; ++j) { const uint4 v = qp[j]; q[8 * j] = bflo(v.x); q[8 * j + 1] = bfhi(v.x); q[8 * j + 2] = bflo(v.y); q[8 * j + 3] = bfhi(v.y); q[8 * j + 4] = bflo(v.z); q[8 * j + 5] = bfhi(v.z); q[8 * j + 6] = bflo(v.w); q[8 * j + 7] = bfhi(v.w); } }
#pragma unroll
        for (int d = 0; d < 64; ++d) o[d] = 0.f;
        float R = 0.f;
        for (int s = t - 1; s >= 0; --s) {
            const uint4* kp = (const uint4*)(P + ((size_t)b * SEQ + s) * INW + C_SBK + h * 64);
            const uint4* vp = (const uint4*)(P + ((size_t)b * SEQ + s) * INW + C_SBV + h * 64);
            float z = 0.f;
#pragma unroll
            for (int j = 0; j < 8; ++j) { const uint4 v = kp[j];
                z = fmaf(q[8 * j], bflo(v.x), z); z = fmaf(q[8 * j + 1], bfhi(v.x), z); z = fmaf(q[8 * j + 2], bflo(v.y), z); z = fmaf(q[8 * j + 3], bfhi(v.y), z);
                z = fmaf(q[8 * j + 4], bflo(v.z), z); z = fmaf(q[8 * j + 5], bfhi(v.z), z); z = fmaf(q[8 * j + 6], bflo(v.w), z); z = fmaf(q[8 * j + 7], bfhi(v.w), z); }
            const float sp = fmaxf(z, 0.f) + log2f(1.f + exp2f(-fabsf(z)));
            const float a = exp2f(z - sp + R);
            R -= sp;
#pragma unroll
            for (int j = 0; j < 8; ++j) { const uint4 v = vp[j];
                o[8 * j] = fmaf(a, bflo(v.x), o[8 * j]); o[8 * j + 1] = fmaf(a, bfhi(v.x), o[8 * j + 1]); o[8 * j + 2] = fmaf(a, bflo(v.y), o[8 * j + 2]); o[8 * j + 3] = fmaf(a, bfhi(v.y), o[8 * j + 3]);
                o[8 * j + 4] = fmaf(a, bflo(v.z), o[8 * j + 4]); o[8 * j + 5] = fmaf(a, bfhi(v.z), o[8 * j + 5]); o[8 * j + 6] = fmaf(a, bflo(v.w), o[8 * j + 6]); o[8 * j + 7] = fmaf(a, bfhi(v.w), o[8 * j + 7]); }
#if SB_EARLY
            if (R < -150.f) break;
#endif
        }
        float ss = 0.f;
#pragma unroll
        for (int d = 0; d < 64; ++d) ss = fmaf(o[d], o[d], ss);
        const float r = rsqrtf(ss * (1.f / 64.f) + EPS);
        uint4* op = (uint4*)(mixed + tok * DM + h * 64);
        const float* g = p.sb_gain + h * 64;
#pragma unroll
        for (int j = 0; j < 8; ++j) { uint4 w; w.x = pk2(o[8 * j] * r * g[8 * j], o[8 * j + 1] * r * g[8 * j + 1]); w.y = pk2(o[8 * j + 2] * r * g[8 * j + 2], o[8 * j + 3] * r * g[8 * j + 3]);
            w.z = pk2(o[8 * j + 4] * r * g[8 * j + 4], o[8 * j + 5] * r * g[8 * j + 5]); w.w = pk2(o[8 * j + 6] * r * g[8 * j + 6], o[8 * j + 7] * r * g[8 * j + 7]); op[j] = w; }
    }
}

__device__ __forceinline__ void hg_naive(const Params& p, unsigned char* ldsb) {
    const bf16_t* P = (const bf16_t*)(p.ws + WS_P);
    float* raw = (float*)(p.ws + WS_HGRAW);
    const float* lbp = (const float*)(p.ws + WS_LB);
    float* red = (float*)ldsb;
    const int tid = threadIdx.x, jj = tid >> 7, k = tid & 127, wave = tid >> 6, lane = tid & 63;
    for (int unit = blockIdx.x; unit < NB * 4 * 16; unit += gridDim.x) {
        const int jg = unit & 15, h = (unit >> 4) & 3, b = unit >> 6;
        const float lb = lbp[h * 128 + k];
        float S = 0.f;
        for (int t0 = 0; t0 < SEQ; t0 += 64) {
            for (int tt = 0; tt < 64; tt += 8) {
                float fl[8], qv[8], iv[8];
#pragma unroll
                for (int u = 0; u < 8; ++u) { const bf16_t* pr = P + ((size_t)b * SEQ + t0 + tt + u) * INW;
                    fl[u] = bf2f(pr[C_HGF + h * 128 + k]); qv[u] = bf2f(pr[C_HGQ + h * 128 + k]); iv[u] = bf2f(pr[C_HGI + h * 64 + jg * 4 + jj]); }
#pragma unroll
                for (int u = 0; u < 8; ++u) {
                    const float f = lb + (1.f - lb) / (1.f + __expf(-fl[u]));
                    S = f * S + (1.f - f) * iv[u];
                    const float part = wave_sum(S * qv[u]);
                    if (lane == 0) red[(tt + u) * 8 + wave] = part;
                }
            }
            __syncthreads();
            if (tid < 256) { const int tt = tid >> 2, j2 = tid & 3;
                raw[((size_t)b * SEQ + t0 + tt) * 256 + h * 64 + jg * 4 + j2] = red[tt * 8 + 2 * j2] + red[tt * 8 + 2 * j2 + 1]; }
            __syncthreads();
        }
    }
}
__device__ __forceinline__ void hg_finish(const Params& p) {
    const bf16_t* P = (const bf16_t*)(p.ws + WS_P);
    const float* raw = (const float*)(p.ws + WS_HGRAW);
    bf16_t* mixed = (bf16_t*)(p.ws + WS_MIXED);
    const int lane = threadIdx.x & 63, wave = threadIdx.x >> 6;
    for (int it = blockIdx.x * 8 + wave; it < T * 4; it += gridDim.x * 8) {
        const int tok = it >> 2, h = it & 3;
        const float o = raw[(size_t)tok * 256 + h * 64 + lane];
        const float r = rsqrtf(wave_sum(o * o) * (1.f / 64.f) + EPS);
        const float g = bf2f(P[(size_t)tok * INW + C_HGG + h * 64 + lane]);
        mixed[(size_t)tok * DM + 512 + h * 64 + lane] = f2bf(o * r * p.hg_gain[h * 64 + lane] * g);
    }
}

__device__ __forceinline__ void mem_knorm(const Params& p) {
    const float* kv = (const float*)(p.ws + WS_MEMKV);
    bf16_t* mk = (bf16_t*)(p.ws + WS_MEMK); bf16_t* mv = (bf16_t*)(p.ws + WS_MEMV);
    const int lane = threadIdx.x & 63, wave = threadIdx.x >> 6;
    for (int it = blockIdx.x * 8 + wave; it < NB * NMEM * 4; it += gridDim.x * 8) {
        const int m = it >> 2, h = it & 3;
        const float kx = kv[(size_t)m * 512 + h * 64 + lane], vx = kv[(size_t)m * 512 + 256 + h * 64 + lane];
        const float r = rsqrtf(wave_sum(kx * kx) * (1.f / 64.f) + EPS);
        mk[(size_t)m * 256 + h * 64 + lane] = f2bf(kx * r * p.mk_gain[lane]);
        mv[(size_t)m * 256 + h * 64 + lane] = f2bf(vx);
    }
}
__device__ __forceinline__ void mem_attn_naive(const Params& p) {
    const bf16_t* P = (const bf16_t*)(p.ws + WS_P);
    const bf16_t* mk = (const bf16_t*)(p.ws + WS_MEMK); const bf16_t* mv = (const bf16_t*)(p.ws + WS_MEMV);
    bf16_t* mixed = (bf16_t*)(p.ws + WS_MIXED);
    for (int idx = blockIdx.x * NTHR + threadIdx.x; idx < 4 * T; idx += gridDim.x * NTHR) {
        const int h = idx / T, tok = idx % T, b = tok / SEQ;
        float q[64], o[64];
        { const uint4* qp = (const uint4*)(P + (size_t)tok * INW + C_MQ + h * 64);
#pragma unroll
          for (int j = 0; j < 8; ++j) { const uint4 v = qp[j]; q[8 * j] = bflo(v.x); q[8 * j + 1] = bfhi(v.x); q[8 * j + 2] = bflo(v.y); q[8 * j + 3] = bfhi(v.y); q[8 * j + 4] = bflo(v.z); q[8 * j + 5] = bfhi(v.z); q[8 * j + 6] = bflo(v.w); q[8 * j + 7] = bfhi(v.w); } }
        float ss = 0.f;
#pragma unroll
        for (int d = 0; d < 64; ++d) ss = fmaf(q[d], q[d], ss);
        const float r = rsqrtf(ss * (1.f / 64.f) + EPS) * 0.125f;
#pragma unroll
        for (int d = 0; d < 64; ++d) { q[d] *= r * p.mq_gain[d]; o[d] = 0.f; }
        float mx = -1e30f, l = 0.f;
        for (int m = 0; m < NMEM; ++m) {
            const uint4* kp = (const uint4*)(mk + ((size_t)b * NMEM + m) * 256 + h * 64);
            const uint4* vp = (const uint4*)(mv + ((size_t)b * NMEM + m) * 256 + h * 64);
            float z = 0.f;
#pragma unroll
            for (int j = 0; j < 8; ++j) { const uint4 v = kp[j];
                z = fmaf(q[8 * j], bflo(v.x), z); z = fmaf(q[8 * j + 1], bfhi(v.x), z); z = fmaf(q[8 * j + 2], bflo(v.y), z); z = fmaf(q[8 * j + 3], bfhi(v.y), z);
                z = fmaf(q[8 * j + 4], bflo(v.z), z); z = fmaf(q[8 * j + 5], bfhi(v.z), z); z = fmaf(q[8 * j + 6], bflo(v.w), z); z = fmaf(q[8 * j + 7], bfhi(v.w), z); }
            const float mn = fmaxf(mx, z), corr = __expf(mx - mn), pe = __expf(z - mn);
            mx = mn; l = l * corr + pe;
#pragma unroll
            for (int j = 0; j < 8; ++j) { const uint4 v = vp[j];
                o[8 * j] = fmaf(pe, bflo(v.x), o[8 * j] * corr); o[8 * j + 1] = fmaf(pe, bfhi(v.x), o[8 * j + 1] * corr); o[8 * j + 2] = fmaf(pe, bflo(v.y), o[8 * j + 2] * corr); o[8 * j + 3] = fmaf(pe, bfhi(v.y), o[8 * j + 3] * corr);
                o[8 * j + 4] = fmaf(pe, bflo(v.z), o[8 * j + 4] * corr); o[8 * j + 5] = fmaf(pe, bfhi(v.z), o[8 * j + 5] * corr); o[8 * j + 6] = fmaf(pe, bflo(v.w), o[8 * j + 6] * corr); o[8 * j + 7] = fmaf(pe, bfhi(v.w), o[8 * j + 7] * corr); }
        }
        const float il = 1.f / l;
        uint4* op = (uint4*)(mixed + (size_t)tok * DM + 768 + h * 64);
#pragma unroll
        for (int j = 0; j < 8; ++j) { uint4 w; w.x = pk2(o[8 * j] * il, o[8 * j + 1] * il); w.y = pk2(o[8 * j + 2] * il, o[8 * j + 3] * il); w.z = pk2(o[8 * j + 4] * il, o[8 * j + 5] * il); w.w = pk2(o[8 * j + 6] * il, o[8 * j + 7] * il); op[j] = w; }
    }
}

__device__ __forceinline__ void rstd2_rows(const Params& p) {
    float* rs = (float*)(p.ws + WS_RSTD2);
    const int lane = threadIdx.x & 63, wave = threadIdx.x >> 6;
    for (int m = blockIdx.x * 8 + wave; m < T; m += gridDim.x * 8) {
        const float4* xr = (const float4*)(p.out + (size_t)m * DM) + lane; float s = 0.f;
#pragma unroll
        for (int j = 0; j < 4; ++j) { const float4 v = xr[64 * j]; s += (v.x * v.x + v.y * v.y) + (v.z * v.z + v.w * v.w); }
        s = wave_sum(s);
        if (lane == 0) rs[m] = rsqrtf(s * (1.f / DM) + EPS);
    }
}

__device__ __forceinline__ void wave_argmax(float& v, int& i) {
#pragma unroll
    for (int o = 32; o >= 1; o >>= 1) { const float ov = __shfl_xor(v, o); const int oi = __shfl_xor(i, o); if (ov > v || (ov == v && oi < i)) { v = ov; i = oi; } }
}
__device__ __forceinline__ void topk_naive(const Params& p, unsigned char* ldsb) {
    const bf16_t* Q = (const bf16_t*)(p.ws + WS_Q);
    const bf16_t* SK = (const bf16_t*)(p.ws + WS_SKB);
    int* pidx = (int*)(p.ws + WS_PIDX); float* pg = (float*)(p.ws + WS_PG);
    const int lane = threadIdx.x & 63, wave = threadIdx.x >> 6;
    float* tsv = (float*)ldsb + wave * 128;
    int* tsi = (int*)tsv + 32;
    float* bsv = tsv + 64; int* bse = (int*)tsv + 80;
    for (int it = blockIdx.x * 8 + wave; it < T * 8; it += gridDim.x * 8) {
        const int tok = it >> 3, h = it & 7;
        for (int c = 0; c < 2; ++c) {
            const uint4* qp = (const uint4*)(Q + (size_t)tok * 2048 + h * 256 + c * 128);
            const uint4* k0 = (const uint4*)(SK + ((size_t)(h * 2 + c) * 128 + lane) * 128);
            const uint4* k1 = (const uint4*)(SK + ((size_t)(h * 2 + c) * 128 + lane + 64) * 128);
            float s0 = 0.f, s1 = 0.f;
            for (int j = 0; j < 16; ++j) { const uint4 qv = qp[j], a = k0[j], bq = k1[j];
                s0 = fmaf(bflo(qv.x), bflo(a.x), s0); s0 = fmaf(bfhi(qv.x), bfhi(a.x), s0); s0 = fmaf(bflo(qv.y), bflo(a.y), s0); s0 = fmaf(bfhi(qv.y), bfhi(a.y), s0);
                s0 = fmaf(bflo(qv.z), bflo(a.z), s0); s0 = fmaf(bfhi(qv.z), bfhi(a.z), s0); s0 = fmaf(bflo(qv.w), bflo(a.w), s0); s0 = fmaf(bfhi(qv.w), bfhi(a.w), s0);
                s1 = fmaf(bflo(qv.x), bflo(bq.x), s1); s1 = fmaf(bfhi(qv.x), bfhi(bq.x), s1); s1 = fmaf(bflo(qv.y), bflo(bq.y), s1); s1 = fmaf(bfhi(qv.y), bfhi(bq.y), s1);
                s1 = fmaf(bflo(qv.z), bflo(bq.z), s1); s1 = fmaf(bfhi(qv.z), bfhi(bq.z), s1); s1 = fmaf(bflo(qv.w), bflo(bq.w), s1); s1 = fmaf(bfhi(qv.w), bfhi(bq.w), s1); }
            for (int r = 0; r < 16; ++r) {
                float v = s0; int i = lane; if (s1 > s0) { v = s1; i = lane + 64; }
                wave_argmax(v, i);
                if (lane == 0) { tsv[c * 16 + r] = v; tsi[c * 16 + r] = i; }
                if (i == lane) s0 = -INFINITY; if (i == lane + 64) s1 = -INFINITY;
            }
        }
        __builtin_amdgcn_s_waitcnt(0); __builtin_amdgcn_wave_barrier();
        float cs[4];
#pragma unroll
        for (int u = 0; u < 4; ++u) { const int id = lane * 4 + u; cs[u] = tsv[id >> 4] + tsv[16 + (id & 15)]; }
        for (int r = 0; r < 16; ++r) {
            float v = cs[0]; int i = lane * 4;
#pragma unroll
            for (int u = 1; u < 4; ++u) if (cs[u] > v) { v = cs[u]; i = lane * 4 + u; }
            wave_argmax(v, i);
            if (lane == 0) { bsv[r] = v; bse[r] = tsi[i >> 4] * 128 + tsi[16 + (i & 15)]; }
#pragma unroll
            for (int u = 0; u < 4; ++u) if (i == lane * 4 + u) cs[u] = -INFINITY;
        }
        __builtin_amdgcn_s_waitcnt(0); __builtin_amdgcn_wave_barrier();
        { const float mxv = bsv[0]; float e = (lane < 16) ? __expf(bsv[lane & 15] - mxv) : 0.f;
          float s = e; s += __shfl_xor(s, 1); s += __shfl_xor(s, 2); s += __shfl_xor(s, 4); s += __shfl_xor(s, 8);
          if (lane < 16) { pidx[(size_t)tok * PK + h * 16 + lane] = bse[lane]; pg[(size_t)tok * PK + h * 16 + lane] = e / s; } }
        __builtin_amdgcn_s_waitcnt(0); __builtin_amdgcn_wave_barrier();
    }
}

__device__ __forceinline__ void peer_naive(const Params& p, unsigned char* ldsb) {
    const int* pidx = (const int*)(p.ws + WS_PIDX); const float* pg = (const float*)(p.ws + WS_PG);
    const float* rs = (const float*)(p.ws + WS_RSTD2);
    float* hs = (float*)ldsb;
    float* red = hs + 1024;
    const int tid = threadIdx.x, lane = tid & 63, wave = tid >> 6;
    for (int tok = blockIdx.x; tok < T; tok += gridDim.x) {
        const float r2 = rs[tok];
        for (int d = tid; d < DM; d += NTHR) hs[d] = p.out[(size_t)tok * DM + d] * r2 * p.g_ffn[d];
        __syncthreads();
        float4 hv[4];
#pragma unroll
        for (int j = 0; j < 4; ++j) hv[j] = *((const float4*)hs + lane + 64 * j);
        float4 acc[4];
#pragma unroll
        for (int j = 0; j < 4; ++j) acc[j] = make_float4(0.f, 0.f, 0.f, 0.f);
        for (int pi = wave; pi < PK; pi += 8) {
            const int e = pidx[(size_t)tok * PK + pi]; const float g = pg[(size_t)tok * PK + pi];
            const float4* up = (const float4*)(p.pu + (size_t)e * DM) + lane;
            const float4* vp = (const float4*)(p.pv + (size_t)e * DM) + lane;
            float s = 0.f;
#pragma unroll
            for (int j = 0; j < 4; ++j) { const float4 u = up[64 * j]; s += (hv[j].x * u.x + hv[j].y * u.y) + (hv[j].z * u.z + hv[j].w * u.w); }
            s = wave_sum(s);
            const float w = g * 0.5f * s * (1.f + erff(s * 0.70710678118654752f));
#pragma unroll
            for (int j = 0; j < 4; ++j) { const float4 v = vp[64 * j]; acc[j].x = fmaf(w, v.x, acc[j].x); acc[j].y = fmaf(w, v.y, acc[j].y); acc[j].z = fmaf(w, v.z, acc[j].z); acc[j].w = fmaf(w, v.w, acc[j].w); }
        }
#pragma unroll
        for (int j = 0; j < 4; ++j) *((float4*)(red + wave * 1024) + lane + 64 * j) = acc[j];
        __syncthreads();
        for (int d = tid; d < DM; d += NTHR) { float s = 0.f;
#pragma unroll
            for (int w = 0; w < 8; ++w) s += red[w * 1024 + d];
            p.out[(size_t)tok * DM + d] += s; }
        __syncthreads();
    }
}

__global__ void __launch_bounds__(NTHR, 2) fwd_kernel(Params p) {
    extern __shared__ __attribute__((aligned(16))) unsigned char lds[];
    cg::grid_group grid = cg::this_grid();
    unsigned char* ws = p.ws;
    phase_prep(p, lds);
    grid.sync();
    { EpiProj e{(bf16_t*)(ws + WS_P)}; gemm_naive((const bf16_t*)(ws + WS_XB), (const bf16_t*)(ws + WS_WIN_T), T, INW, DM, lds, e); }
    { EpiF32 e{(float*)(ws + WS_MEMKV), 512}; gemm_naive((const bf16_t*)(ws + WS_MEMN), (const bf16_t*)(ws + WS_WMKV_T), NB * NMEM, 512, DM, lds, e); }
    grid.sync();
    mem_knorm(p);
    sb_naive(p);
    hg_naive(p, lds);
    grid.sync();
    mem_attn_naive(p);
    hg_finish(p);
    grid.sync();
    { EpiWout e{p.x, p.out, (bf16_t*)(ws + WS_XB)}; gemm_naive((const bf16_t*)(ws + WS_MIXED), (const bf16_t*)(ws + WS_WOUT_T), T, DM, DM, lds, e); }
    grid.sync();
    rstd2_rows(p);
    grid.sync();
    { EpiQ e{(const float*)(ws + WS_RSTD2), (bf16_t*)(ws + WS_Q)}; gemm_naive((const bf16_t*)(ws + WS_XB), (const bf16_t*)(ws + WS_WQ_T), T, 2048, DM, lds, e); }
    grid.sync();
    topk_naive(p, lds);
    grid.sync();
    peer_naive(p, lds);
}

extern "C" void kernel_launch(void* const* d_in, const int* in_sizes, int n_in, void* d_out, int out_size, void* d_ws, size_t ws_size, hipStream_t stream) {
    static int grid_blocks = 0;
    if (grid_blocks == 0) {
        if (n_in != 17 || out_size != T * DM || ws_size < WS_END) { fprintf(stderr, "kernel_launch: unexpected shapes n_in %d out %d ws %zu\n", n_in, out_size, ws_size); grid_blocks = -1; return; }
        int dev = 0, cus = 0, per_cu = 0;
        (void)hipGetDevice(&dev);
        (void)hipDeviceGetAttribute(&cus, hipDeviceAttributeMultiprocessorCount, dev);
        (void)hipFuncSetAttribute((const void*)fwd_kernel, hipFuncAttributeMaxDynamicSharedMemorySize, LDS_BYTES);
        (void)hipOccupancyMaxActiveBlocksPerMultiprocessor(&per_cu, (const void*)fwd_kernel, NTHR, LDS_BYTES);
        if (per_cu < 1) { fprintf(stderr, "kernel_launch: occupancy query says %d blocks/CU\n", per_cu); per_cu = 1; }
        grid_blocks = cus * 1;
        (void)hipGetLastError();
    }
    if (grid_blocks < 0) return;
    Params p{};
    p.x = (const float*)d_in[0]; p.mem = (const float*)d_in[1]; p.g_mix = (const float*)d_in[2]; p.w_in = (const float*)d_in[3]; p.gamma_lb = (const float*)d_in[4];
    p.sb_gain = (const float*)d_in[5]; p.hg_gain = (const float*)d_in[6]; p.mem_gain = (const float*)d_in[7]; p.w_mkv = (const float*)d_in[8]; p.mq_gain = (const float*)d_in[9];
    p.mk_gain = (const float*)d_in[10]; p.w_out = (const float*)d_in[11]; p.g_ffn = (const float*)d_in[12]; p.w_q = (const float*)d_in[13]; p.sub_keys = (const float*)d_in[14];
    p.pu = (const float*)d_in[15]; p.pv = (const float*)d_in[16];
    p.out = (float*)d_out; p.ws = (unsigned char*)d_ws;
    void* args[] = {&p};
    hipError_t e = hipLaunchCooperativeKernel((const void*)fwd_kernel, dim3(grid_blocks), dim3(NTHR), args, LDS_BYTES, stream);
    if (e != hipSuccess) fprintf(stderr, "cooperative launch failed: %s (grid %d)\n", hipGetErrorString(e), grid_blocks);
}
```

```cpp
#include <hip/hip_runtime.h>
#include <hip/hip_cooperative_groups.h>
#include <cstdio>
#include <cstdint>
namespace cg = cooperative_groups;

constexpr int NB = 4, SEQ = 8192, DM = 1024, T = NB * SEQ;
constexpr int NMEM = 256, INW = 3328;
constexpr int C_SBQ = 0, C_SBK = 512, C_SBV = 1024, C_HGQ = 1536, C_HGF = 2048, C_HGI = 2560, C_HGG = 2816, C_MQ = 3072;
constexpr int NEXP = 16384, PK = 128;
constexpr float EPS = 1e-6f;
constexpr float LOG2E = 1.4426950408889634f;
constexpr float C2 = 0.125f * LOG2E;

constexpr int NTHR = 512;
constexpr int LDS_BYTES = 147456;

constexpr size_t MiB = 1u << 20;
constexpr size_t WS_CTL = 0;
constexpr size_t WS_WIN_T = 1 * MiB;
constexpr size_t WS_WOUT_T = 8 * MiB;
constexpr size_t WS_WQ_T = 10 * MiB;
constexpr size_t WS_WMKV_T = 14 * MiB;
constexpr size_t WS_SKB = 15 * MiB;
constexpr size_t WS_LB = 15 * MiB + 512 * 1024;
constexpr size_t WS_MEMN = 16 * MiB;
constexpr size_t WS_MEMKV = 18 * MiB;
constexpr size_t WS_MEMK = 20 * MiB;
constexpr size_t WS_MEMV = 20 * MiB + 512 * 1024;
constexpr size_t WS_RSTD2 = 21 * MiB;
constexpr size_t WS_PIDX = 24 * MiB;
constexpr size_t WS_PG = 40 * MiB;
constexpr size_t WS_XB = 72 * MiB;
constexpr size_t WS_MIXED = 136 * MiB;
constexpr size_t WS_P = 200 * MiB;
constexpr size_t WS_Q = 200 * MiB;
constexpr size_t WS_HGRAW = 408 * MiB;
constexpr size_t WS_PW = 56 * MiB;
constexpr size_t WS_PU = 200 * MiB;
constexpr size_t WS_U16 = 440 * MiB;
constexpr size_t WS_V16 = 472 * MiB;
constexpr size_t WS_END = 512 * MiB;

typedef unsigned short bf16_t;
__device__ __forceinline__ float bf2f(bf16_t v) { return __uint_as_float(((unsigned)v) << 16); }
__device__ __forceinline__ float bflo(unsigned w) { return __uint_as_float(w << 16); }
__device__ __forceinline__ float bfhi(unsigned w) { return __uint_as_float(w & 0xffff0000u); }
__device__ __forceinline__ bf16_t f2bf(float f) { unsigned u = __float_as_uint(f); return (bf16_t)((u + 0x7fffu + ((u >> 16) & 1u)) >> 16); }
__device__ __forceinline__ unsigned pk2(float lo, float hi) { return (unsigned)f2bf(lo) | ((unsigned)f2bf(hi) << 16); }
__device__ __forceinline__ float wave_sum(float v) {
#pragma unroll
    for (int o = 1; o < 64; o <<= 1) v += __shfl_xor(v, o);
    return v;
}
__device__ __forceinline__ float silu(float v) { return v / (1.f + __expf(-v)); }

typedef _Float16 h8_t __attribute__((ext_vector_type(8)));
typedef _Float16 h2_t __attribute__((ext_vector_type(2)));
typedef __bf16 bf16x2_v __attribute__((ext_vector_type(2)));
__device__ __forceinline__ float dot2bf(unsigned a, unsigned b, float c) { return __builtin_amdgcn_fdot2_f32_bf16(__builtin_bit_cast(bf16x2_v, a), __builtin_bit_cast(bf16x2_v, b), c, false); }

struct Params {
    const float *x, *mem, *g_mix, *w_in, *gamma_lb, *sb_gain, *hg_gain, *mem_gain, *w_mkv, *mq_gain, *mk_gain, *w_out, *g_ffn, *w_q, *sub_keys, *pu, *pv;
    float* out; unsigned char* ws;
};

namespace pg8 {
#define PG8_LAS __attribute__((address_space(3)))
typedef unsigned short bf16_t;
typedef short bf16x8 __attribute__((ext_vector_type(8)));
typedef float f32x4 __attribute__((ext_vector_type(4)));
typedef unsigned u32x4 __attribute__((ext_vector_type(4)));
constexpr int BM = 256, BK = 64, HALF = 128, HTB = HALF * BK * 2  , STAGE_BYTES = 8 * HTB, NXCD = 8, WGM = 8;

__host__ __device__ __forceinline__ int lds_byte(int r, int c) { const int st = (r >> 4) * 2 + (c >> 5), rr = r & 15, cc = c & 31, ob = rr * 64 + cc * 2; return st * 1024 + (ob ^ (((ob >> 9) & 1) << 5)); }
__host__ __device__ __forceinline__ void stage_rc(int b, int& R, int& C) { const int st = b / 1024, sb = b % 1024, swz = sb ^ (((sb >> 9) & 1) << 5); R = (st >> 1) * 16 + swz / 64; C = (st & 1) * 32 + (swz % 64) / 2; }
__host__ __device__ __forceinline__ int perm32(int rho) { const int n = rho >> 4, i = rho & 15; return 8 * (i >> 2) + 4 * n + (i & 3); }

struct Unit { int pm, pn; };
struct Gemm { const bf16_t* A; const bf16_t* Bt; int M, N, K; };

struct StaticOrder {
    int nM, nN, nwg, G, c;
    __host__ __device__ void init(int M, int N, int G_, int c_) { nM = M / BM; nN = N / BM; nwg = nM * nN; G = G_; c = c_; }
    __host__ __device__ bool next(int i, Unit& u) const {
        const long L = (long)i * G + c; if (L >= nwg) return false;
        int wgid = (int)L; { const int q = nwg / NXCD, r = nwg % NXCD, xcd = wgid % NXCD, off = wgid / NXCD; wgid = (xcd < r ? xcd * (q + 1) : r * (q + 1) + (xcd - r) * q) + off; }
        const int nig = WGM * nN, gid = wgid / nig, fm = gid * WGM, gsz = (nM - fm) < WGM ? (nM - fm) : WGM;
        u.pm = fm + ((wgid % nig) % gsz); u.pn = (wgid % nig) / gsz; return true;
    }
    __device__ __forceinline__ void a_ready(const Unit&) const {}
    __device__ __forceinline__ void done(const Unit&) const {}
};

__device__ __forceinline__ unsigned cvt_pk_bf16(float lo, float hi) { unsigned r; asm volatile("v_cvt_pk_bf16_f32 %0, %1, %2" : "=v"(r) : "v"(lo), "v"(hi)); return r; }
typedef float f32x2 __attribute__((ext_vector_type(2)));
template <class Epi, class Sched, bool ALIGN_EPI = false, bool SP2 = false>
__device__ __forceinline__ void gemm_phase(PG8_LAS unsigned char* lds, const Gemm g, const Sched& S, const Epi& E) {
    const int tid = threadIdx.x, wid = __builtin_amdgcn_readfirstlane(tid >> 6), lane = tid & 63, wr = wid >> 2, wc = wid & 3, fr = lane & 15, fq = lane >> 4;
    const int K = g.K, nt = K / BK;
    unsigned voffA[2], voffB[2];
#pragma unroll
    for (int i = 0; i < 2; ++i) { int R, C; stage_rc(tid * 16 + i * 8192, R, C); const int Rb = Epi::PERM ? ((R & ~31) + perm32(R & 31)) : R;
        voffA[i] = (unsigned)(R * K + C) * 2u; voffB[i] = (unsigned)(Rb * K + C) * 2u; }
    const size_t kstep = (size_t)(BK * 2);
    const size_t hstep = (size_t)HALF * K * 2;
    const size_t tstep = 2 * hstep;
    const unsigned ldsw = (unsigned)wid * 1024u;
    const int aoff = lds_byte(wr * 64 + fr, fq * 8), boff = lds_byte(wc * 32 + fr, fq * 8);
#define PG8_SA(b, h) (((b) * 2 + (h)) * HTB)
#define PG8_SB(b, h) ((4 + (b) * 2 + (h)) * HTB)
#define PG8_STAGE(bufoff, gbase, voff) do { _Pragma("unroll") for (int _i = 0; _i < 2; ++_i) \
        __builtin_amdgcn_global_load_lds((const unsigned*)((const char*)(gbase) + (voff)[_i]), (PG8_LAS unsigned*)(lds + (bufoff) + ldsw + _i * 8192), 16, 0, 0); } while (0)
#define PG8_LDA(dst, b, h) do { _Pragma("unroll") for (int m = 0; m < 4; ++m) _Pragma("unroll") for (int k = 0; k < 2; ++k) dst[m][k] = *(const PG8_LAS bf16x8*)(lds + PG8_SA(b, h) + aoff + m * 2048 + k * 1024); } while (0)
#define PG8_LDB(dst, b, h) do { _Pragma("unroll") for (int n = 0; n < 2; ++n) _Pragma("unroll") for (int k = 0; k < 2; ++k) dst[n][k] = *(const PG8_LAS bf16x8*)(lds + PG8_SB(b, h) + boff + n * 2048 + k * 1024); } while (0)
#define PG8_MMA(ai, bj, At, Bt) do { __builtin_amdgcn_s_setprio(1); _Pragma("unroll") for (int m = 0; m < 4; ++m) _Pragma("unroll") for (int n = 0; n < 2; ++n) _Pragma("unroll") for (int k = 0; k < 2; ++k) \
        acc[ai][bj][m][n] = __builtin_amdgcn_mfma_f32_16x16x32_bf16(Bt[n][k], At[m][k], acc[ai][bj][m][n], 0, 0, 0); __builtin_amdgcn_s_setprio(0); } while (0)
#define PG8_WAIT_V(n) asm volatile("s_waitcnt vmcnt(" #n ")" ::: "memory")
#define PG8_WAIT_L(n) asm volatile("s_waitcnt lgkmcnt(" #n ")" ::: "memory")
#define PG8_BAR __builtin_amdgcn_s_barrier()
#define PG8_SCHED __builtin_amdgcn_sched_barrier(0)
    Unit cur, nxt; int ui = 0;
    if (!S.next(0, cur)) return;
    f32x4 acc[2][2][4][2];
#pragma unroll
    for (int a = 0; a < 2; ++a)
#pragma unroll
        for (int b = 0; b < 2; ++b)
#pragma unroll
            for (int m = 0; m < 4; ++m)
#pragma unroll
                for (int n = 0; n < 2; ++n) acc[a][b][m][n] = (f32x4){0.f, 0.f, 0.f, 0.f};
    bf16x8 At[4][2], B0[2][2], B1[2][2];
    const char* cA = (const char*)g.A + (size_t)cur.pm * tstep; const char* cB = (const char*)g.Bt + (size_t)cur.pn * tstep;
    S.a_ready(cur);
    if constexpr (SP2) {
        PG8_STAGE(PG8_SB(0, 0), cB, voffB); PG8_STAGE(PG8_SB(0, 1), cB + hstep, voffB); PG8_STAGE(PG8_SA(0, 0), cA, voffA); PG8_STAGE(PG8_SA(0, 1), cA + hstep, voffA);
        if (wr == 1) PG8_BAR;
        PG8_WAIT_V(2); PG8_BAR;
        PG8_STAGE(PG8_SB(1, 0), cB + kstep, voffB); PG8_STAGE(PG8_SA(1, 0), cA + kstep, voffA); PG8_STAGE(PG8_SB(1, 1), cB + hstep + kstep, voffB);
        PG8_WAIT_V(6); PG8_BAR;
    } else {
        PG8_STAGE(PG8_SB(0, 0), cB, voffB); PG8_STAGE(PG8_SA(0, 0), cA, voffA); PG8_STAGE(PG8_SB(0, 1), cB + hstep, voffB); PG8_STAGE(PG8_SA(0, 1), cA + hstep, voffA);
        if (wr == 1) PG8_BAR;
        PG8_WAIT_V(4); PG8_BAR;
        PG8_STAGE(PG8_SB(1, 0), cB + kstep, voffB); PG8_STAGE(PG8_SA(1, 0), cA + kstep, voffA); PG8_STAGE(PG8_SB(1, 1), cB + hstep + kstep, voffB);
        PG8_WAIT_V(6); PG8_BAR;
    }
    for (;;) {
        const bool has_next = S.next(ui + 1, nxt);
        const char* nA = has_next ? (const char*)g.A + (size_t)nxt.pm * tstep : cA; const char* nB = has_next ? (const char*)g.Bt + (size_t)nxt.pn * tstep : cB;
        for (int t = 0; t < nt; t += 2) {
            const bool last = (t == nt - 2);
            const char* a1 = cA + (size_t)(t + 1) * kstep;
            const char* a2 = last ? nA : cA + (size_t)(t + 2) * kstep; const char* b2 = last ? nB : cB + (size_t)(t + 2) * kstep;
            const char* a3 = a2 + kstep; const char* b3 = b2 + kstep;
            if (last && has_next) S.a_ready(nxt);
            if constexpr (SP2) {
            PG8_LDB(B0, 0, 0); PG8_LDB(B1, 0, 1); PG8_SCHED; PG8_LDA(At, 0, 0); PG8_STAGE(PG8_SA(1, 1), a1 + hstep, voffA);
            PG8_WAIT_V(8); PG8_WAIT_L(0); PG8_BAR; PG8_MMA(0, 0, At, B0); PG8_MMA(0, 1, At, B1); PG8_BAR; PG8_SCHED;
            PG8_LDA(At, 0, 1); PG8_STAGE(PG8_SB(0, 0), b2, voffB); PG8_STAGE(PG8_SB(0, 1), b2 + hstep, voffB); PG8_STAGE(PG8_SA(0, 0), a2, voffA);
            PG8_WAIT_V(8); PG8_WAIT_L(0); PG8_BAR; PG8_MMA(1, 0, At, B0); PG8_MMA(1, 1, At, B1); PG8_BAR; PG8_SCHED;
            PG8_LDB(B0, 1, 0); PG8_LDB(B1, 1, 1); PG8_SCHED; PG8_LDA(At, 1, 0); PG8_STAGE(PG8_SA(0, 1), a2 + hstep, voffA);
            PG8_WAIT_V(8); PG8_WAIT_L(0); PG8_BAR; PG8_MMA(0, 0, At, B0); PG8_MMA(0, 1, At, B1); PG8_BAR; PG8_SCHED;
            PG8_LDA(At, 1, 1); PG8_STAGE(PG8_SB(1, 0), b3, voffB); PG8_STAGE(PG8_SB(1, 1), b3 + hstep, voffB); PG8_STAGE(PG8_SA(1, 0), a3, voffA);
            PG8_WAIT_V(8); PG8_WAIT_L(0); PG8_BAR; PG8_MMA(1, 0, At, B0); PG8_MMA(1, 1, At, B1); PG8_BAR; PG8_SCHED;
            } else {
            PG8_LDB(B0, 0, 0); PG8_SCHED; PG8_LDA(At, 0, 0); PG8_STAGE(PG8_SA(1, 1), a1 + hstep, voffA);
            PG8_WAIT_L(8); PG8_BAR; PG8_WAIT_L(0); PG8_MMA(0, 0, At, B0); PG8_BAR; PG8_SCHED;
            PG8_LDB(B1, 0, 1); PG8_STAGE(PG8_SB(0, 0), b2, voffB);
            PG8_BAR; PG8_WAIT_L(0); PG8_MMA(0, 1, At, B1); PG8_BAR;
            PG8_LDA(At, 0, 1); PG8_STAGE(PG8_SA(0, 0), a2, voffA);
            PG8_BAR; PG8_WAIT_L(0); PG8_MMA(1, 0, At, B0); PG8_BAR; PG8_SCHED;
            PG8_STAGE(PG8_SB(0, 1), b2 + hstep, voffB);
            PG8_WAIT_V(6); PG8_BAR; PG8_MMA(1, 1, At, B1); PG8_BAR;
            PG8_LDB(B0, 1, 0); PG8_SCHED; PG8_LDA(At, 1, 0); PG8_STAGE(PG8_SA(0, 1), a2 + hstep, voffA);
            PG8_WAIT_L(8); PG8_BAR; PG8_WAIT_L(0); PG8_MMA(0, 0, At, B0); PG8_BAR; PG8_SCHED;
            PG8_LDB(B1, 1, 1); PG8_STAGE(PG8_SB(1, 0), b3, voffB);
            PG8_BAR; PG8_WAIT_L(0); PG8_MMA(0, 1, At, B1); PG8_BAR;
            PG8_LDA(At, 1, 1); PG8_STAGE(PG8_SA(1, 0), a3, voffA);
            PG8_BAR; PG8_WAIT_L(0); PG8_MMA(1, 0, At, B0); PG8_BAR; PG8_SCHED;
            PG8_STAGE(PG8_SB(1, 1), b3 + hstep, voffB);
            PG8_WAIT_V(6); PG8_BAR; PG8_MMA(1, 1, At, B1); PG8_BAR;
            }
        }
        if constexpr (ALIGN_EPI) { if (wr == 0) PG8_BAR; }
        if constexpr (!Epi::AFTER_DRAIN) { E(acc, cur, wr, wc, fr, fq); S.done(cur); }
        if (!has_next) break;
#pragma unroll
        for (int a = 0; a < 2; ++a)
#pragma unroll
            for (int b = 0; b < 2; ++b)
#pragma unroll
                for (int m = 0; m < 4; ++m)
#pragma unroll
                    for (int n = 0; n < 2; ++n) acc[a][b][m][n] = (f32x4){0.f, 0.f, 0.f, 0.f};
        cur = nxt; cA = nA; cB = nB; ++ui;
        if constexpr (ALIGN_EPI) { if (wr == 1) PG8_BAR; }
    }
    PG8_WAIT_V(0);
    if constexpr (!ALIGN_EPI) { if (wr == 0) PG8_BAR; }
    PG8_BAR;
    if constexpr (Epi::AFTER_DRAIN) { E.fused(acc, cur, wr, wc, fr, fq, lds, wid, lane); S.done(cur); }
#undef PG8_SA
#undef PG8_SB
#undef PG8_STAGE
#undef PG8_LDA
#undef PG8_LDB
#undef PG8_MMA
#undef PG8_WAIT_V
#undef PG8_WAIT_L
#undef PG8_BAR
#undef PG8_SCHED
}
}


namespace pg8 {
typedef unsigned u32x4 __attribute__((ext_vector_type(4)));
struct EpiProjM {
    static constexpr bool PERM = true, AFTER_DRAIN = false;
    bf16_t* P;
    __device__ __forceinline__ void operator()(const f32x4 (&acc)[2][2][4][2], const Unit& u, int wr, int wc, int fr, int fq) const {
        const int row0 = u.pm * BM + wr * 64 + fr, col0 = u.pn * BM + wc * 32 + 8 * fq;
        const int pn = u.pn; const int mode = (pn < 2) ? 1 : ((pn == 6 || pn == 7 || pn == 11) ? 2 : 0);
#pragma unroll
        for (int ai = 0; ai < 2; ++ai)
#pragma unroll
            for (int m = 0; m < 4; ++m) { bf16_t* rowp = P + (size_t)(row0 + ai * HALF + m * 16) * INW + col0;
#pragma unroll
                for (int bj = 0; bj < 2; ++bj) { f32x4 v0 = acc[ai][bj][m][0], v1 = acc[ai][bj][m][1];
                    if (mode == 1) { v0 = v0 * C2; v1 = v1 * C2; }
                    else if (mode == 2) {
#pragma unroll
                        for (int e = 0; e < 4; ++e) { v0[e] = silu(v0[e]); v1[e] = silu(v1[e]); } }
                    u32x4 w; w.x = cvt_pk_bf16(v0[0], v0[1]); w.y = cvt_pk_bf16(v0[2], v0[3]); w.z = cvt_pk_bf16(v1[0], v1[1]); w.w = cvt_pk_bf16(v1[2], v1[3]);
                    *(u32x4*)(rowp + bj * HALF) = w; } }
    }
};
struct EpiF32M {
    static constexpr bool PERM = true, AFTER_DRAIN = false;
    float* O; int ld;
    __device__ __forceinline__ void operator()(const f32x4 (&acc)[2][2][4][2], const Unit& u, int wr, int wc, int fr, int fq) const {
        const int row0 = u.pm * BM + wr * 64 + fr, col0 = u.pn * BM + wc * 32 + 8 * fq;
#pragma unroll
        for (int ai = 0; ai < 2; ++ai)
#pragma unroll
            for (int m = 0; m < 4; ++m) { float* rowp = O + (size_t)(row0 + ai * HALF + m * 16) * ld + col0;
#pragma unroll
                for (int bj = 0; bj < 2; ++bj) { *(f32x4*)(rowp + bj * HALF) = acc[ai][bj][m][0]; *(f32x4*)(rowp + bj * HALF + 4) = acc[ai][bj][m][1]; } }
    }
};
struct EpiWoutM {
    static constexpr bool PERM = true, AFTER_DRAIN = false;
    const float* x; float* out; bf16_t* xb;
    __device__ __forceinline__ void operator()(const f32x4 (&acc)[2][2][4][2], const Unit& u, int wr, int wc, int fr, int fq) const {
        const int row0 = u.pm * BM + wr * 64 + fr, col0 = u.pn * BM + wc * 32 + 8 * fq;
#pragma unroll
        for (int ai = 0; ai < 2; ++ai)
#pragma unroll
            for (int m = 0; m < 4; ++m) { const size_t rb = (size_t)(row0 + ai * HALF + m * 16) * DM + col0;
#pragma unroll
                for (int bj = 0; bj < 2; ++bj) { const size_t i = rb + bj * HALF;
                    const f32x4 v0 = acc[ai][bj][m][0] + *(const f32x4*)(x + i), v1 = acc[ai][bj][m][1] + *(const f32x4*)(x + i + 4);
                    *(f32x4*)(out + i) = v0; *(f32x4*)(out + i + 4) = v1;
                    u32x4 w; w.x = cvt_pk_bf16(v0[0], v0[1]); w.y = cvt_pk_bf16(v0[2], v0[3]); w.z = cvt_pk_bf16(v1[0], v1[1]); w.w = cvt_pk_bf16(v1[2], v1[3]);
                    *(u32x4*)(xb + i) = w; } }
    }
};
struct EpiQM {
    static constexpr bool PERM = true, AFTER_DRAIN = false;
    const float* rstd; bf16_t* Q;
    __device__ __forceinline__ void operator()(const f32x4 (&acc)[2][2][4][2], const Unit& u, int wr, int wc, int fr, int fq) const {
        const int row0 = u.pm * BM + wr * 64 + fr, col0 = u.pn * BM + wc * 32 + 8 * fq;
#pragma unroll
        for (int ai = 0; ai < 2; ++ai)
#pragma unroll
            for (int m = 0; m < 4; ++m) { const int row = row0 + ai * HALF + m * 16; const float rs = rstd[row]; bf16_t* rowp = Q + (size_t)row * 2048 + col0;
#pragma unroll
                for (int bj = 0; bj < 2; ++bj) { const f32x4 v0 = acc[ai][bj][m][0] * rs, v1 = acc[ai][bj][m][1] * rs;
                    u32x4 w; w.x = cvt_pk_bf16(v0[0], v0[1]); w.y = cvt_pk_bf16(v0[2], v0[3]); w.z = cvt_pk_bf16(v1[0], v1[1]); w.w = cvt_pk_bf16(v1[2], v1[3]);
                    *(u32x4*)(rowp + bj * HALF) = w; } }
    }
};
}

__device__ __forceinline__ void transpose_item(const float* W, const float* gain, int K, int N, bf16_t* WT, float* scr, int item, int lane) {
    const int nblk = N / 32, kb = item / nblk, nb = item % nblk, k0 = 64 * kb, n0 = 32 * nb;
    for (int i = 0; i < 32; ++i) { const int kk = 2 * i + (lane >> 5); float g = gain ? gain[k0 + kk] : 1.f; scr[kk * 33 + (lane & 31)] = W[(size_t)(k0 + kk) * N + n0 + (lane & 31)] * g; }
    __builtin_amdgcn_s_waitcnt(0); __builtin_amdgcn_wave_barrier();
    const int c = lane & 7;
#pragma unroll
    for (int j = 0; j < 4; ++j) { const int n = (lane >> 3) + 8 * j; const float* s = scr + (8 * c) * 33 + n;
        uint4 o; o.x = pk2(s[0 * 33], s[1 * 33]); o.y = pk2(s[2 * 33], s[3 * 33]); o.z = pk2(s[4 * 33], s[5 * 33]); o.w = pk2(s[6 * 33], s[7 * 33]);
        *(uint4*)(WT + (size_t)(n0 + n) * K + k0 + 8 * c) = o; }
    __builtin_amdgcn_s_waitcnt(0); __builtin_amdgcn_wave_barrier();
}
__device__ __forceinline__ void norm_row_to_bf16(const float* xrow, bf16_t* orow, int lane) {
    const float4* xr = (const float4*)xrow + lane;
    float4 v[4]; float s = 0.f;
#pragma unroll
    for (int j = 0; j < 4; ++j) { v[j] = xr[64 * j]; s += (v[j].x * v[j].x + v[j].y * v[j].y) + (v[j].z * v[j].z + v[j].w * v[j].w); }
    const float rstd = rsqrtf(wave_sum(s) * (1.f / DM) + EPS);
    unsigned long long* o8 = (unsigned long long*)orow + lane;
#pragma unroll
    for (int j = 0; j < 4; ++j) o8[64 * j] = (unsigned long long)pk2(v[j].x * rstd, v[j].y * rstd) | ((unsigned long long)pk2(v[j].z * rstd, v[j].w * rstd) << 32);
}
__device__ __forceinline__ void phase_prep(const Params& p, unsigned char* lds) {
    const int tid = threadIdx.x, lane = tid & 63, wave = tid >> 6;
    const int gw = blockIdx.x * 8 + wave, NGW = gridDim.x * 8;
    const int gt = blockIdx.x * NTHR + tid, NGT = gridDim.x * NTHR;
    unsigned char* ws = p.ws;
    float* scr = (float*)lds + wave * (64 * 33);
    constexpr int I_IN = (DM / 64) * (INW / 32), I_OUT = (DM / 64) * (DM / 32), I_Q = (DM / 64) * (2048 / 32), I_MKV = (DM / 64) * (512 / 32);
    for (int it = gw; it < I_IN + I_OUT + I_Q + I_MKV; it += NGW) {
        int r = it;
        if (r < I_IN) { transpose_item(p.w_in, p.g_mix, DM, INW, (bf16_t*)(ws + WS_WIN_T), scr, r, lane); continue; } r -= I_IN;
        if (r < I_OUT) { transpose_item(p.w_out, nullptr, DM, DM, (bf16_t*)(ws + WS_WOUT_T), scr, r, lane); continue; } r -= I_OUT;
        if (r < I_Q) { transpose_item(p.w_q, p.g_ffn, DM, 2048, (bf16_t*)(ws + WS_WQ_T), scr, r, lane); continue; } r -= I_Q;
        transpose_item(p.w_mkv, p.mem_gain, DM, 512, (bf16_t*)(ws + WS_WMKV_T), scr, r, lane);
    }
    for (int m = gw; m < T; m += NGW) norm_row_to_bf16(p.x + (size_t)m * DM, (bf16_t*)(ws + WS_XB) + (size_t)m * DM, lane);
    for (int m = gw; m < NB * NMEM; m += NGW) norm_row_to_bf16(p.mem + (size_t)m * DM, (bf16_t*)(ws + WS_MEMN) + (size_t)m * DM, lane);
    for (int i = gt; i < 8 * 2 * 128 * 128; i += NGT) ((bf16_t*)(ws + WS_SKB))[i] = f2bf(p.sub_keys[i]);
    for (int i = gt; i < NEXP * DM / 8; i += NGT) {
        const int d0 = (i & 127) * 8;
        const float4 a = ((const float4*)p.pu)[2 * i], b = ((const float4*)p.pu)[2 * i + 1];
        const float4 ga = *(const float4*)(p.g_ffn + d0), gb = *(const float4*)(p.g_ffn + d0 + 4);
        uint4 o; o.x = pk2(a.x * ga.x, a.y * ga.y); o.y = pk2(a.z * ga.z, a.w * ga.w); o.z = pk2(b.x * gb.x, b.y * gb.y); o.w = pk2(b.z * gb.z, b.w * gb.w);
        ((uint4*)(ws + WS_U16))[i] = o;
        const float4 c = ((const float4*)p.pv)[2 * i], d = ((const float4*)p.pv)[2 * i + 1];
        h8_t hv; hv[0] = (_Float16)c.x; hv[1] = (_Float16)c.y; hv[2] = (_Float16)c.z; hv[3] = (_Float16)c.w; hv[4] = (_Float16)d.x; hv[5] = (_Float16)d.y; hv[6] = (_Float16)d.z; hv[7] = (_Float16)d.w;
        ((h8_t*)(ws + WS_V16))[i] = hv;
    }
    for (int i = gt; i < 512; i += NGT) ((float*)(ws + WS_LB))[i] = 1.f / (1.f + expf(p.gamma_lb[512 + i] - p.gamma_lb[i]));
}

template <class Epi>
__device__ __forceinline__ void gemm_naive(const bf16_t* A, const bf16_t* Bt, int M, int N, int K, unsigned char* ldsb, const Epi& epi) {
    float* As = (float*)ldsb;
    float* Bs = As + 32 * 132;
    const int tid = threadIdx.x, ty = tid >> 4, tx = tid & 15;
    const int ntm = M / 128, ntn = N / 64;
    for (int tile = blockIdx.x; tile < ntm * ntn; tile += gridDim.x) {
        const int tm = tile / ntn, tn = tile % ntn;
        float acc[4][4];
#pragma unroll
        for (int i = 0; i < 4; ++i)
#pragma unroll
            for (int j = 0; j < 4; ++j) acc[i][j] = 0.f;
        for (int k0 = 0; k0 < K; k0 += 32) {
            { const int r = tid >> 2, kq = (tid & 3) * 8;
              const uint4 v = *(const uint4*)(A + (size_t)(tm * 128 + r) * K + k0 + kq);
              As[(kq + 0) * 132 + r] = bflo(v.x); As[(kq + 1) * 132 + r] = bfhi(v.x); As[(kq + 2) * 132 + r] = bflo(v.y); As[(kq + 3) * 132 + r] = bfhi(v.y);
              As[(kq + 4) * 132 + r] = bflo(v.z); As[(kq + 5) * 132 + r] = bfhi(v.z); As[(kq + 6) * 132 + r] = bflo(v.w); As[(kq + 7) * 132 + r] = bfhi(v.w); }
            if (tid < 256) { const int r = tid >> 2, kq = (tid & 3) * 8;
              const uint4 v = *(const uint4*)(Bt + (size_t)(tn * 64 + r) * K + k0 + kq);
              Bs[(kq + 0) * 68 + r] = bflo(v.x); Bs[(kq + 1) * 68 + r] = bfhi(v.x); Bs[(kq + 2) * 68 + r] = bflo(v.y); Bs[(kq + 3) * 68 + r] = bfhi(v.y);
              Bs[(kq + 4) * 68 + r] = bflo(v.z); Bs[(kq + 5) * 68 + r] = bfhi(v.z); Bs[(kq + 6) * 68 + r] = bflo(v.w); Bs[(kq + 7) * 68 + r] = bfhi(v.w); }
            __syncthreads();
#pragma unroll 8
            for (int k = 0; k < 32; ++k) {
                const float4 a = *(const float4*)(As + k * 132 + ty * 4); const float4 b = *(const float4*)(Bs + k * 68 + tx * 4);
                const float av[4] = {a.x, a.y, a.z, a.w}, bv[4] = {b.x, b.y, b.z, b.w};
#pragma unroll
                for (int i = 0; i < 4; ++i)
#pragma unroll
                    for (int j = 0; j < 4; ++j) acc[i][j] = fmaf(av[i], bv[j], acc[i][j]);
            }
            __syncthreads();
        }
#pragma unroll
        for (int i = 0; i < 4; ++i)
#pragma unroll
            for (int j = 0; j < 4; ++j) epi(tm * 128 + ty * 4 + i, tn * 64 + tx * 4 + j, acc[i][j]);
    }
}

struct EpiProj {
    bf16_t* P;
    __device__ __forceinline__ void operator()(int row, int col, float v) const {
        if (col < C_SBK) v *= C2;
        else if (col >= C_HGQ && col < C_HGF) v = silu(v);
        else if (col >= C_HGG && col < C_MQ) v = silu(v);
        P[(size_t)row * INW + col] = f2bf(v);
    }
};
struct EpiF32 { float* O; int ld; __device__ __forceinline__ void operator()(int row, int col, float v) const { O[(size_t)row * ld + col] = v; } };
struct EpiWout { const float* x; float* out; bf16_t* xb;
    __device__ __forceinline__ void operator()(int row, int col, float v) const { const size_t i = (size_t)row * DM + col; const float r = x[i] + v; out[i] = r; xb[i] = f2bf(r); } };
struct EpiQ { const float* rstd; bf16_t* Q;
    __device__ __forceinline__ void operator()(int row, int col, float v) const { Q[(size_t)row * 2048 + col] = f2bf(v * rstd[row]); } };

#ifndef SB_EARLY
#define SB_EARLY 1
#endif
__device__ __forceinline__ void sb_naive(const Params& p) {
    const bf16_t* P = (const bf16_t*)(p.ws + WS_P);
    bf16_t* mixed = (bf16_t*)(p.ws + WS_MIXED);
    for (int row = blockIdx.x * NTHR + threadIdx.x; row < NB * 8 * SEQ; row += gridDim.x * NTHR) {
        const int t = row % SEQ, bh = row / SEQ, h = bh % 8, b = bh / 8;
        const size_t tok = (size_t)b * SEQ + t;
        float q[64], o[64];
        { const uint4* qp = (const uint4*)(P + tok * INW + C_SBQ + h * 64);
#pragma unroll
          for (int j = 0; j < 8; ++j) { const uint4 v = qp[j]; q[8 * j] = bflo(v.x); q[8 * j + 1] = bfhi(v.x); q[8 * j + 2] = bflo(v.y); q[8 * j + 3] = bfhi(v.y); q[8 * j + 4] = bflo(v.z); q[8 * j + 5] = bfhi(v.z); q[8 * j + 6] = bflo(v.w); q[8 * j + 7] = bfhi(v.w); } }
#pragma unroll
        for (int d = 0; d < 64; ++d) o[d] = 0.f;
        float R = 0.f;
        for (int s = t - 1; s >= 0; --s) {
            const uint4* kp = (const uint4*)(P + ((size_t)b * SEQ + s) * INW + C_SBK + h * 64);
            const uint4* vp = (const uint4*)(P + ((size_t)b * SEQ + s) * INW + C_SBV + h * 64);
            float z = 0.f;
#pragma unroll
            for (int j = 0; j < 8; ++j) { const uint4 v = kp[j];
                z = fmaf(q[8 * j], bflo(v.x), z); z = fmaf(q[8 * j + 1], bfhi(v.x), z); z = fmaf(q[8 * j + 2], bflo(v.y), z); z = fmaf(q[8 * j + 3], bfhi(v.y), z);
                z = fmaf(q[8 * j + 4], bflo(v.z), z); z = fmaf(q[8 * j + 5], bfhi(v.z), z); z = fmaf(q[8 * j + 6], bflo(v.w), z); z = fmaf(q[8 * j + 7], bfhi(v.w), z); }
            const float sp = fmaxf(z, 0.f) + log2f(1.f + exp2f(-fabsf(z)));
            const float a = exp2f(z - sp + R);
            R -= sp;
#pragma unroll
            for (int j = 0; j < 8; ++j) { const uint4 v = vp[j];
                o[8 * j] = fmaf(a, bflo(v.x), o[8 * j]); o[8 * j + 1] = fmaf(a, bfhi(v.x), o[8 * j + 1]); o[8 * j + 2] = fmaf(a, bflo(v.y), o[8 * j + 2]); o[8 * j + 3] = fmaf(a, bfhi(v.y), o[8 * j + 3]);
                o[8 * j + 4] = fmaf(a, bflo(v.z), o[8 * j + 4]); o[8 * j + 5] = fmaf(a, bfhi(v.z), o[8 * j + 5]); o[8 * j + 6] = fmaf(a, bflo(v.w), o[8 * j + 6]); o[8 * j + 7] = fmaf(a, bfhi(v.w), o[8 * j + 7]); }
#if SB_EARLY
            if (R < -150.f) break;
#endif
        }
        float ss = 0.f;
#pragma unroll
        for (int d = 0; d < 64; ++d) ss = fmaf(o[d], o[d], ss);
        const float r = rsqrtf(ss * (1.f / 64.f) + EPS);
        uint4* op = (uint4*)(mixed + tok * DM + h * 64);
        const float* g = p.sb_gain + h * 64;
#pragma unroll
        for (int j = 0; j < 8; ++j) { uint4 w; w.x = pk2(o[8 * j] * r * g[8 * j], o[8 * j + 1] * r * g[8 * j + 1]); w.y = pk2(o[8 * j + 2] * r * g[8 * j + 2], o[8 * j + 3] * r * g[8 * j + 3]);
            w.z = pk2(o[8 * j + 4] * r * g[8 * j + 4], o[8 * j + 5] * r * g[8 * j + 5]); w.w = pk2(o[8 * j + 6] * r * g[8 * j + 6], o[8 * j + 7] * r * g[8 * j + 7]); op[j] = w; }
    }
}

__device__ __forceinline__ void hg_naive(const Params& p, unsigned char* ldsb) {
    const bf16_t* P = (const bf16_t*)(p.ws + WS_P);
    float* raw = (float*)(p.ws + WS_HGRAW);
    const float* lbp = (const float*)(p.ws + WS_LB);
    float* red = (float*)ldsb;
    const int tid = threadIdx.x, jj = tid >> 7, k = tid & 127, wave = tid >> 6, lane = tid & 63;
    for (int unit = blockIdx.x; unit < NB * 4 * 16; unit += gridDim.x) {
        const int jg = unit & 15, h = (unit >> 4) & 3, b = unit >> 6;
        const float lb = lbp[h * 128 + k];
        float S = 0.f;
        for (int t0 = 0; t0 < SEQ; t0 += 64) {
            for (int tt = 0; tt < 64; tt += 8) {
                float fl[8], qv[8], iv[8];
#pragma unroll
                for (int u = 0; u < 8; ++u) { const bf16_t* pr = P + ((size_t)b * SEQ + t0 + tt + u) * INW;
                    fl[u] = bf2f(pr[C_HGF + h * 128 + k]); qv[u] = bf2f(pr[C_HGQ + h * 128 + k]); iv[u] = bf2f(pr[C_HGI + h * 64 + jg * 4 + jj]); }
#pragma unroll
                for (int u = 0; u < 8; ++u) {
                    const float f = lb + (1.f - lb) / (1.f + __expf(-fl[u]));
                    S = f * S + (1.f - f) * iv[u];
                    const float part = wave_sum(S * qv[u]);
                    if (lane == 0) red[(tt + u) * 8 + wave] = part;
                }
            }
            __syncthreads();
            if (tid < 256) { const int tt = tid >> 2, j2 = tid & 3;
                raw[((size_t)b * SEQ + t0 + tt) * 256 + h * 64 + jg * 4 + j2] = red[tt * 8 + 2 * j2] + red[tt * 8 + 2 * j2 + 1]; }
            __syncthreads();
        }
    }
}
__device__ __forceinline__ void hg_finish(const Params& p) {
    const bf16_t* P = (const bf16_t*)(p.ws + WS_P);
    const float* raw = (const float*)(p.ws + WS_HGRAW);
    bf16_t* mixed = (bf16_t*)(p.ws + WS_MIXED);
    const int lane = threadIdx.x & 63, wave = threadIdx.x >> 6;
    for (int it = blockIdx.x * 8 + wave; it < T * 4; it += gridDim.x * 8) {
        const int tok = it >> 2, h = it & 3;
        const float o = raw[(size_t)tok * 256 + h * 64 + lane];
        const float r = rsqrtf(wave_sum(o * o) * (1.f / 64.f) + EPS);
        const float g = bf2f(P[(size_t)tok * INW + C_HGG + h * 64 + lane]);
        mixed[(size_t)tok * DM + 512 + h * 64 + lane] = f2bf(o * r * p.hg_gain[h * 64 + lane] * g);
    }
}

__device__ __forceinline__ void mem_knorm(const Params& p) {
    const float* kv = (const float*)(p.ws + WS_MEMKV);
    bf16_t* mk = (bf16_t*)(p.ws + WS_MEMK); bf16_t* mv = (bf16_t*)(p.ws + WS_MEMV);
    const int lane = threadIdx.x & 63, wave = threadIdx.x >> 6;
    for (int it = blockIdx.x * 8 + wave; it < NB * NMEM * 4; it += gridDim.x * 8) {
        const int m = it >> 2, h = it & 3;
        const float kx = kv[(size_t)m * 512 + h * 64 + lane], vx = kv[(size_t)m * 512 + 256 + h * 64 + lane];
        const float r = rsqrtf(wave_sum(kx * kx) * (1.f / 64.f) + EPS);
        mk[(size_t)m * 256 + h * 64 + lane] = f2bf(kx * r * p.mk_gain[lane]);
        mv[(size_t)m * 256 + h * 64 + lane] = f2bf(vx);
    }
}
__device__ __forceinline__ void mem_attn_naive(const Params& p) {
    const bf16_t* P = (const bf16_t*)(p.ws + WS_P);
    const bf16_t* mk = (const bf16_t*)(p.ws + WS_MEMK); const bf16_t* mv = (const bf16_t*)(p.ws + WS_MEMV);
    bf16_t* mixed = (bf16_t*)(p.ws + WS_MIXED);
    for (int idx = blockIdx.x * NTHR + threadIdx.x; idx < 4 * T; idx += gridDim.x * NTHR) {
        const int h = idx / T, tok = idx % T, b = tok / SEQ;
        float q[64], o[64];
        { const uint4* qp = (const uint4*)(P + (size_t)tok * INW + C_MQ + h * 64);
#pragma unroll
          for (int j = 0; j < 8; ++j) { const uint4 v = qp[j]; q[8 * j] = bflo(v.x); q[8 * j + 1] = bfhi(v.x); q[8 * j + 2] = bflo(v.y); q[8 * j + 3] = bfhi(v.y); q[8 * j + 4] = bflo(v.z); q[8 * j + 5] = bfhi(v.z); q[8 * j + 6] = bflo(v.w); q[8 * j + 7] = bfhi(v.w); } }
        float ss = 0.f;
#pragma unroll
        for (int d = 0; d < 64; ++d) ss = fmaf(q[d], q[d], ss);
        const float r = rsqrtf(ss * (1.f / 64.f) + EPS) * 0.125f;
#pragma unroll
        for (int d = 0; d < 64; ++d) { q[d] *= r * p.mq_gain[d]; o[d] = 0.f; }
        float mx = -1e30f, l = 0.f;
        for (int m = 0; m < NMEM; ++m) {
            const uint4* kp = (const uint4*)(mk + ((size_t)b * NMEM + m) * 256 + h * 64);
            const uint4* vp = (const uint4*)(mv + ((size_t)b * NMEM + m) * 256 + h * 64);
            float z = 0.f;
#pragma unroll
            for (int j = 0; j < 8; ++j) { const uint4 v = kp[j];
                z = fmaf(q[8 * j], bflo(v.x), z); z = fmaf(q[8 * j + 1], bfhi(v.x), z); z = fmaf(q[8 * j + 2], bflo(v.y), z); z = fmaf(q[8 * j + 3], bfhi(v.y), z);
                z = fmaf(q[8 * j + 4], bflo(v.z), z); z = fmaf(q[8 * j + 5], bfhi(v.z), z); z = fmaf(q[8 * j + 6], bflo(v.w), z); z = fmaf(q[8 * j + 7], bfhi(v.w), z); }
            const float mn = fmaxf(mx, z), corr = __expf(mx - mn), pe = __expf(z - mn);
            mx = mn; l = l * corr + pe;
#pragma unroll
            for (int j = 0; j < 8; ++j) { const uint4 v = vp[j];
                o[8 * j] = fmaf(pe, bflo(v.x), o[8 * j] * corr); o[8 * j + 1] = fmaf(pe, bfhi(v.x), o[8 * j + 1] * corr); o[8 * j + 2] = fmaf(pe, bflo(v.y), o[8 * j + 2] * corr); o[8 * j + 3] = fmaf(pe, bfhi(v.y), o[8 * j + 3] * corr);
                o[8 * j + 4] = fmaf(pe, bflo(v.z), o[8 * j + 4] * corr); o[8 * j + 5] = fmaf(pe, bfhi(v.z), o[8 * j + 5] * corr); o[8 * j + 6] = fmaf(pe, bflo(v.w), o[8 * j + 6] * corr); o[8 * j + 7] = fmaf(pe, bfhi(v.w), o[8 * j + 7] * corr); }
        }
        const float il = 1.f / l;
        uint4* op = (uint4*)(mixed + (size_t)tok * DM + 768 + h * 64);
#pragma unroll
        for (int j = 0; j < 8; ++j) { uint4 w; w.x = pk2(o[8 * j] * il, o[8 * j + 1] * il); w.y = pk2(o[8 * j + 2] * il, o[8 * j + 3] * il); w.z = pk2(o[8 * j + 4] * il, o[8 * j + 5] * il); w.w = pk2(o[8 * j + 6] * il, o[8 * j + 7] * il); op[j] = w; }
    }
}

__device__ __forceinline__ void rstd2_rows(const Params& p) {
    float* rs = (float*)(p.ws + WS_RSTD2);
    const int lane = threadIdx.x & 63, wave = threadIdx.x >> 6;
    for (int m = blockIdx.x * 8 + wave; m < T; m += gridDim.x * 8) {
        const float4* xr = (const float4*)(p.out + (size_t)m * DM) + lane; float s = 0.f;
#pragma unroll
        for (int j = 0; j < 4; ++j) { const float4 v = xr[64 * j]; s += (v.x * v.x + v.y * v.y) + (v.z * v.z + v.w * v.w); }
        s = wave_sum(s);
        if (lane == 0) rs[m] = rsqrtf(s * (1.f / DM) + EPS);
    }
}

__device__ __forceinline__ void wave_argmax(float& v, int& i) {
#pragma unroll
    for (int o = 32; o >= 1; o >>= 1) { const float ov = __shfl_xor(v, o); const int oi = __shfl_xor(i, o); if (ov > v || (ov == v && oi < i)) { v = ov; i = oi; } }
}
__device__ __forceinline__ void topk_naive(const Params& p, unsigned char* ldsb) {
    const bf16_t* Q = (const bf16_t*)(p.ws + WS_Q);
    const bf16_t* SK = (const bf16_t*)(p.ws + WS_SKB);
    int* pidx = (int*)(p.ws + WS_PIDX); float* pg = (float*)(p.ws + WS_PG);
    const int lane = threadIdx.x & 63, wave = threadIdx.x >> 6;
    float* tsv = (float*)ldsb + wave * 128;
    int* tsi = (int*)tsv + 32;
    float* bsv = tsv + 64; int* bse = (int*)tsv + 80;
    for (int it = blockIdx.x * 8 + wave; it < T * 8; it += gridDim.x * 8) {
        const int tok = it >> 3, h = it & 7;
        for (int c = 0; c < 2; ++c) {
            const uint4* qp = (const uint4*)(Q + (size_t)tok * 2048 + h * 256 + c * 128);
            const uint4* k0 = (const uint4*)(SK + ((size_t)(h * 2 + c) * 128 + lane) * 128);
            const uint4* k1 = (const uint4*)(SK + ((size_t)(h * 2 + c) * 128 + lane + 64) * 128);
            float s0 = 0.f, s1 = 0.f;
            for (int j = 0; j < 16; ++j) { const uint4 qv = qp[j], a = k0[j], bq = k1[j];
                s0 = fmaf(bflo(qv.x), bflo(a.x), s0); s0 = fmaf(bfhi(qv.x), bfhi(a.x), s0); s0 = fmaf(bflo(qv.y), bflo(a.y), s0); s0 = fmaf(bfhi(qv.y), bfhi(a.y), s0);
                s0 = fmaf(bflo(qv.z), bflo(a.z), s0); s0 = fmaf(bfhi(qv.z), bfhi(a.z), s0); s0 = fmaf(bflo(qv.w), bflo(a.w), s0); s0 = fmaf(bfhi(qv.w), bfhi(a.w), s0);
                s1 = fmaf(bflo(qv.x), bflo(bq.x), s1); s1 = fmaf(bfhi(qv.x), bfhi(bq.x), s1); s1 = fmaf(bflo(qv.y), bflo(bq.y), s1); s1 = fmaf(bfhi(qv.y), bfhi(bq.y), s1);
                s1 = fmaf(bflo(qv.z), bflo(bq.z), s1); s1 = fmaf(bfhi(qv.z), bfhi(bq.z), s1); s1 = fmaf(bflo(qv.w), bflo(bq.w), s1); s1 = fmaf(bfhi(qv.w), bfhi(bq.w), s1); }
            for (int r = 0; r < 16; ++r) {
                float v = s0; int i = lane; if (s1 > s0) { v = s1; i = lane + 64; }
                wave_argmax(v, i);
                if (lane == 0) { tsv[c * 16 + r] = v; tsi[c * 16 + r] = i; }
                if (i == lane) s0 = -INFINITY; if (i == lane + 64) s1 = -INFINITY;
            }
        }
        __builtin_amdgcn_s_waitcnt(0); __builtin_amdgcn_wave_barrier();
        float cs[4];
#pragma unroll
        for (int u = 0; u < 4; ++u) { const int id = lane * 4 + u; cs[u] = tsv[id >> 4] + tsv[16 + (id & 15)]; }
        for (int r = 0; r < 16; ++r) {
            float v = cs[0]; int i = lane * 4;
#pragma unroll
            for (int u = 1; u < 4; ++u) if (cs[u] > v) { v = cs[u]; i = lane * 4 + u; }
            wave_argmax(v, i);
            if (lane == 0) { bsv[r] = v; bse[r] = tsi[i >> 4] * 128 + tsi[16 + (i & 15)]; }
#pragma unroll
            for (int u = 0; u < 4; ++u) if (i == lane * 4 + u) cs[u] = -INFINITY;
        }
        __builtin_amdgcn_s_waitcnt(0); __builtin_amdgcn_wave_barrier();
        { const float mxv = bsv[0]; float e = (lane < 16) ? __expf(bsv[lane & 15] - mxv) : 0.f;
          float s = e; s += __shfl_xor(s, 1); s += __shfl_xor(s, 2); s += __shfl_xor(s, 4); s += __shfl_xor(s, 8);
          if (lane < 16) { pidx[(size_t)tok * PK + h * 16 + lane] = bse[lane]; pg[(size_t)tok * PK + h * 16 + lane] = e / s; } }
        __builtin_amdgcn_s_waitcnt(0); __builtin_amdgcn_wave_barrier();
    }
}

__device__ __forceinline__ void peer_naive(const Params& p, unsigned char* ldsb) {
    const int* pidx = (const int*)(p.ws + WS_PIDX); const float* pg = (const float*)(p.ws + WS_PG);
    const float* rs = (const float*)(p.ws + WS_RSTD2);
    float* hs = (float*)ldsb;
    float* red = hs + 1024;
    const int tid = threadIdx.x, lane = tid & 63, wave = tid >> 6;
    for (int tok = blockIdx.x; tok < T; tok += gridDim.x) {
        const float r2 = rs[tok];
        for (int d = tid; d < DM; d += NTHR) hs[d] = p.out[(size_t)tok * DM + d] * r2 * p.g_ffn[d];
        __syncthreads();
        float4 hv[4];
#pragma unroll
        for (int j = 0; j < 4; ++j) hv[j] = *((const float4*)hs + lane + 64 * j);
        float4 acc[4];
#pragma unroll
        for (int j = 0; j < 4; ++j) acc[j] = make_float4(0.f, 0.f, 0.f, 0.f);
        for (int pi = wave; pi < PK; pi += 8) {
            const int e = pidx[(size_t)tok * PK + pi]; const float g = pg[(size_t)tok * PK + pi];
            const float4* up = (const float4*)(p.pu + (size_t)e * DM) + lane;
            const float4* vp = (const float4*)(p.pv + (size_t)e * DM) + lane;
            float s = 0.f;
#pragma unroll
            for (int j = 0; j < 4; ++j) { const float4 u = up[64 * j]; s += (hv[j].x * u.x + hv[j].y * u.y) + (hv[j].z * u.z + hv[j].w * u.w); }
            s = wave_sum(s);
            const float w = g * 0.5f * s * (1.f + erff(s * 0.70710678118654752f));
#pragma unroll
            for (int j = 0; j < 4; ++j) { const float4 v = vp[64 * j]; acc[j].x = fmaf(w, v.x, acc[j].x); acc[j].y = fmaf(w, v.y, acc[j].y); acc[j].z = fmaf(w, v.z, acc[j].z); acc[j].w = fmaf(w, v.w, acc[j].w); }
        }
#pragma unroll
        for (int j = 0; j < 4; ++j) *((float4*)(red + wave * 1024) + lane + 64 * j) = acc[j];
        __syncthreads();
        for (int d = tid; d < DM; d += NTHR) { float s = 0.f;
#pragma unroll
            for (int w = 0; w < 8; ++w) s += red[w * 1024 + d];
            p.out[(size_t)tok * DM + d] += s; }
        __syncthreads();
    }
}


__device__ __forceinline__ void peer_u_phase(const Params& p) {
    const int lane = threadIdx.x & 63, wave = threadIdx.x >> 6, g = lane >> 4, c = lane & 15;
    const int slice = blockIdx.x & 7, rank = blockIdx.x >> 3, nrank = gridDim.x >> 3;
    const bf16_t* xb = (const bf16_t*)(p.ws + WS_XB); const int* pidx = (const int*)(p.ws + WS_PIDX);
    const bf16_t* U = (const bf16_t*)(p.ws + WS_U16) + slice * 128 + c * 8;
    float* PU = (float*)(p.ws + WS_PU) + (size_t)slice * T * PK;
    for (int t = rank * 8 + wave; t < T; t += nrank * 8) {
        const uint4 hv = *(const uint4*)(xb + (size_t)t * DM + slice * 128 + c * 8);
        const uint4* ip = (const uint4*)(pidx + (size_t)t * PK + g * 32);
#pragma unroll 1
        for (int rd = 0; rd < 2; ++rd) {
            int e[16];
#pragma unroll
            for (int j = 0; j < 4; ++j) { const uint4 q = ip[rd * 4 + j]; e[4 * j] = q.x; e[4 * j + 1] = q.y; e[4 * j + 2] = q.z; e[4 * j + 3] = q.w; }
            float pr[16];
#pragma unroll
            for (int i = 0; i < 16; ++i) { const uint4 uv = *(const uint4*)(U + (size_t)e[i] * DM);
                float s = dot2bf(hv.x, uv.x, 0.f); s = dot2bf(hv.y, uv.y, s); s = dot2bf(hv.z, uv.z, s); s = dot2bf(hv.w, uv.w, s); pr[i] = s; }
#pragma unroll
            for (int s = 8; s >= 1; s >>= 1)
#pragma unroll
                for (int j = 0; j < s; ++j) { const bool up = (c & s) != 0; const float keep = up ? pr[j + s] : pr[j], send = up ? pr[j] : pr[j + s]; pr[j] = keep + __shfl_xor(send, s); }
            PU[(size_t)t * PK + g * 32 + rd * 16 + c] = pr[0];
        }
    }
}
__device__ __forceinline__ void peer_w_phase(const Params& p) {
    const float* PU = (const float*)(p.ws + WS_PU); const float* pg = (const float*)(p.ws + WS_PG); const float* rs = (const float*)(p.ws + WS_RSTD2);
    float* pw = (float*)(p.ws + WS_PW);
    for (int i = blockIdx.x * NTHR + threadIdx.x; i < T * PK; i += gridDim.x * NTHR) {
        float s = 0.f;
#pragma unroll
        for (int x = 0; x < 8; ++x) s += PU[(size_t)x * T * PK + i];
        s *= rs[i >> 7];
        pw[i] = pg[i] * 0.5f * s * (1.f + erff(s * 0.70710678118654752f));
    }
}
__device__ __forceinline__ void peer_v_phase(const Params& p) {
    const int lane = threadIdx.x & 63, wave = threadIdx.x >> 6, g = lane >> 4, c = lane & 15;
    const int slice = blockIdx.x & 7, rank = blockIdx.x >> 3, nrank = gridDim.x >> 3;
    const int* pidx = (const int*)(p.ws + WS_PIDX); const float* pw = (const float*)(p.ws + WS_PW);
    const _Float16* V = (const _Float16*)(p.ws + WS_V16) + slice * 128 + c * 8;
    for (int t = rank * 8 + wave; t < T; t += nrank * 8) {
        const uint4* ip = (const uint4*)(pidx + (size_t)t * PK + g * 32);
        const float4* wp = (const float4*)(pw + (size_t)t * PK + g * 32);
        float acc[8];
#pragma unroll
        for (int k = 0; k < 8; ++k) acc[k] = 0.f;
#pragma unroll 1
        for (int rd = 0; rd < 2; ++rd) {
            int e[16]; float w[16];
#pragma unroll
            for (int j = 0; j < 4; ++j) { const uint4 q = ip[rd * 4 + j]; e[4 * j] = q.x; e[4 * j + 1] = q.y; e[4 * j + 2] = q.z; e[4 * j + 3] = q.w;
                const float4 f = wp[rd * 4 + j]; w[4 * j] = f.x; w[4 * j + 1] = f.y; w[4 * j + 2] = f.z; w[4 * j + 3] = f.w; }
#pragma unroll
            for (int i = 0; i < 16; ++i) { const h8_t vv = *(const h8_t*)(V + (size_t)e[i] * DM);
#pragma unroll
                for (int k = 0; k < 8; ++k) acc[k] = fmaf((float)vv[k], w[i], acc[k]); }
        }
#pragma unroll
        for (int k = 0; k < 8; ++k) { acc[k] += __shfl_xor(acc[k], 16); acc[k] += __shfl_xor(acc[k], 32); }
        if (g == 0) { float4* op = (float4*)(p.out + (size_t)t * DM + slice * 128 + c * 8);
            float4 a = op[0], b = op[1];
            a.x += acc[0]; a.y += acc[1]; a.z += acc[2]; a.w += acc[3]; b.x += acc[4]; b.y += acc[5]; b.z += acc[6]; b.w += acc[7];
            op[0] = a; op[1] = b; }
    }
}

__global__ void __launch_bounds__(NTHR, 2) fwd_kernel(Params p) {
    extern __shared__ __attribute__((aligned(16))) unsigned char lds[];
    cg::grid_group grid = cg::this_grid();
    unsigned char* ws = p.ws;
    PG8_LAS unsigned char* ldsl = (PG8_LAS unsigned char*)lds;
    phase_prep(p, lds);
    grid.sync();
    { pg8::Gemm g{(const bf16_t*)(ws + WS_XB), (const bf16_t*)(ws + WS_WIN_T), T, INW, DM}; pg8::StaticOrder S; S.init(T, INW, gridDim.x, blockIdx.x); pg8::EpiProjM e{(bf16_t*)(ws + WS_P)};
      pg8::gemm_phase<pg8::EpiProjM, pg8::StaticOrder, true, true>(ldsl, g, S, e); }
    { pg8::Gemm g{(const bf16_t*)(ws + WS_MEMN), (const bf16_t*)(ws + WS_WMKV_T), NB * NMEM, 512, DM}; pg8::StaticOrder S; S.init(NB * NMEM, 512, gridDim.x, blockIdx.x); pg8::EpiF32M e{(float*)(ws + WS_MEMKV), 512};
      pg8::gemm_phase<pg8::EpiF32M, pg8::StaticOrder, true, true>(ldsl, g, S, e); }
    grid.sync();
    mem_knorm(p);
    sb_naive(p);
    hg_naive(p, lds);
    grid.sync();
    mem_attn_naive(p);
    hg_finish(p);
    grid.sync();
    { pg8::Gemm g{(const bf16_t*)(ws + WS_MIXED), (const bf16_t*)(ws + WS_WOUT_T), T, DM, DM}; pg8::StaticOrder S; S.init(T, DM, gridDim.x, blockIdx.x); pg8::EpiWoutM e{p.x, p.out, (bf16_t*)(ws + WS_XB)};
      pg8::gemm_phase<pg8::EpiWoutM, pg8::StaticOrder, true, true>(ldsl, g, S, e); }
    grid.sync();
    rstd2_rows(p);
    grid.sync();
    { pg8::Gemm g{(const bf16_t*)(ws + WS_XB), (const bf16_t*)(ws + WS_WQ_T), T, 2048, DM}; pg8::StaticOrder S; S.init(T, 2048, gridDim.x, blockIdx.x); pg8::EpiQM e{(const float*)(ws + WS_RSTD2), (bf16_t*)(ws + WS_Q)};
      pg8::gemm_phase<pg8::EpiQM, pg8::StaticOrder, true, true>(ldsl, g, S, e); }
    grid.sync();
    topk_naive(p, lds);
    grid.sync();
    peer_u_phase(p);
    grid.sync();
    peer_w_phase(p);
    grid.sync();
    peer_v_phase(p);
}

extern "C" void kernel_launch(void* const* d_in, const int* in_sizes, int n_in, void* d_out, int out_size, void* d_ws, size_t ws_size, hipStream_t stream) {
    static int grid_blocks = 0;
    if (grid_blocks == 0) {
        if (n_in != 17 || out_size != T * DM || ws_size < WS_END) { fprintf(stderr, "kernel_launch: unexpected shapes n_in %d out %d ws %zu\n", n_in, out_size, ws_size); grid_blocks = -1; return; }
        int dev = 0, cus = 0, per_cu = 0;
        (void)hipGetDevice(&dev);
        (void)hipDeviceGetAttribute(&cus, hipDeviceAttributeMultiprocessorCount, dev);
        (void)hipFuncSetAttribute((const void*)fwd_kernel, hipFuncAttributeMaxDynamicSharedMemorySize, LDS_BYTES);
        (void)hipOccupancyMaxActiveBlocksPerMultiprocessor(&per_cu, (const void*)fwd_kernel, NTHR, LDS_BYTES);
        if (per_cu < 1) { fprintf(stderr, "kernel_launch: occupancy query says %d blocks/CU\n", per_cu); per_cu = 1; }
        grid_blocks = cus * 1;
        (void)hipGetLastError();
    }
    if (grid_blocks < 0) return;
    Params p{};
    p.x = (const float*)d_in[0]; p.mem = (const float*)d_in[1]; p.g_mix = (const float*)d_in[2]; p.w_in = (const float*)d_in[3]; p.gamma_lb = (const float*)d_in[4];
    p.sb_gain = (const float*)d_in[5]; p.hg_gain = (const float*)d_in[6]; p.mem_gain = (const float*)d_in[7]; p.w_mkv = (const float*)d_in[8]; p.mq_gain = (const float*)d_in[9];
    p.mk_gain = (const float*)d_in[10]; p.w_out = (const float*)d_in[11]; p.g_ffn = (const float*)d_in[12]; p.w_q = (const float*)d_in[13]; p.sub_keys = (const float*)d_in[14];
    p.pu = (const float*)d_in[15]; p.pv = (const float*)d_in[16];
    p.out = (float*)d_out; p.ws = (unsigned char*)d_ws;
    void* args[] = {&p};
    hipError_t e = hipLaunchCooperativeKernel((const void*)fwd_kernel, dim3(grid_blocks), dim3(NTHR), args, LDS_BYTES, stream);
    if (e != hipSuccess) fprintf(stderr, "cooperative launch failed: %s (grid %d)\n", hipGetErrorString(e), grid_blocks);
}
```

```cpp
#include <hip/hip_runtime.h>
#include <hip/hip_cooperative_groups.h>
#include <cstdio>
#include <cstdint>
namespace cg = cooperative_groups;

constexpr int NB = 4, SEQ = 8192, DM = 1024, T = NB * SEQ;
constexpr int NMEM = 256, INW = 3328;
constexpr int C_SBQ = 0, C_SBK = 512, C_SBV = 1024, C_HGQ = 1536, C_HGF = 2048, C_HGI = 2560, C_HGG = 2816, C_MQ = 3072;
constexpr int NEXP = 16384, PK = 128;
constexpr float EPS = 1e-6f;
constexpr float LOG2E = 1.4426950408889634f;
constexpr float C2 = 0.125f * LOG2E;

constexpr int NTHR = 512;
constexpr int LDS_BYTES = 147456;

constexpr size_t MiB = 1u << 20;
constexpr size_t WS_CTL = 0;
constexpr size_t WS_WIN_T = 1 * MiB;
constexpr size_t WS_WOUT_T = 8 * MiB;
constexpr size_t WS_WQ_T = 10 * MiB;
constexpr size_t WS_WMKV_T = 14 * MiB;
constexpr size_t WS_SKB = 15 * MiB;
constexpr size_t WS_LB = 15 * MiB + 512 * 1024;
constexpr size_t WS_MEMN = 16 * MiB;
constexpr size_t WS_MEMKV = 18 * MiB;
constexpr size_t WS_MEMK = 20 * MiB;
constexpr size_t WS_MEMV = 20 * MiB + 512 * 1024;
constexpr size_t WS_RSTD2 = 21 * MiB;
constexpr size_t WS_PIDX = 24 * MiB;
constexpr size_t WS_PG = 40 * MiB;
constexpr size_t WS_XB = 72 * MiB;
constexpr size_t WS_MIXED = 136 * MiB;
constexpr size_t WS_P = 200 * MiB;
constexpr size_t WS_Q = 200 * MiB;
constexpr size_t WS_HGRAW = 408 * MiB;
constexpr size_t WS_PW = 56 * MiB;
constexpr size_t WS_PU = 200 * MiB;
constexpr size_t WS_U16 = 440 * MiB;
constexpr size_t WS_V16 = 472 * MiB;
constexpr size_t WS_END = 512 * MiB;

typedef unsigned short bf16_t;
__device__ __forceinline__ float bf2f(bf16_t v) { return __uint_as_float(((unsigned)v) << 16); }
__device__ __forceinline__ float bflo(unsigned w) { return __uint_as_float(w << 16); }
__device__ __forceinline__ float bfhi(unsigned w) { return __uint_as_float(w & 0xffff0000u); }
__device__ __forceinline__ bf16_t f2bf(float f) { unsigned u = __float_as_uint(f); return (bf16_t)((u + 0x7fffu + ((u >> 16) & 1u)) >> 16); }
__device__ __forceinline__ unsigned pk2(float lo, float hi) { return (unsigned)f2bf(lo) | ((unsigned)f2bf(hi) << 16); }
__device__ __forceinline__ float wave_sum(float v) {
#pragma unroll
    for (int o = 1; o < 64; o <<= 1) v += __shfl_xor(v, o);
    return v;
}
__device__ __forceinline__ float silu(float v) { return v / (1.f + __expf(-v)); }

typedef _Float16 h8_t __attribute__((ext_vector_type(8)));
typedef _Float16 h2_t __attribute__((ext_vector_type(2)));
typedef __bf16 bf16x2_v __attribute__((ext_vector_type(2)));
__device__ __forceinline__ float dot2bf(unsigned a, unsigned b, float c) { return __builtin_amdgcn_fdot2_f32_bf16(__builtin_bit_cast(bf16x2_v, a), __builtin_bit_cast(bf16x2_v, b), c, false); }

struct Params {
    const float *x, *mem, *g_mix, *w_in, *gamma_lb, *sb_gain, *hg_gain, *mem_gain, *w_mkv, *mq_gain, *mk_gain, *w_out, *g_ffn, *w_q, *sub_keys, *pu, *pv;
    float* out; unsigned char* ws;
};

namespace pg8 {
#define PG8_LAS __attribute__((address_space(3)))
typedef unsigned short bf16_t;
typedef short bf16x8 __attribute__((ext_vector_type(8)));
typedef float f32x4 __attribute__((ext_vector_type(4)));
typedef unsigned u32x4 __attribute__((ext_vector_type(4)));
constexpr int BM = 256, BK = 64, HALF = 128, HTB = HALF * BK * 2  , STAGE_BYTES = 8 * HTB, NXCD = 8, WGM = 8;

__host__ __device__ __forceinline__ int lds_byte(int r, int c) { const int st = (r >> 4) * 2 + (c >> 5), rr = r & 15, cc = c & 31, ob = rr * 64 + cc * 2; return st * 1024 + (ob ^ (((ob >> 9) & 1) << 5)); }
__host__ __device__ __forceinline__ void stage_rc(int b, int& R, int& C) { const int st = b / 1024, sb = b % 1024, swz = sb ^ (((sb >> 9) & 1) << 5); R = (st >> 1) * 16 + swz / 64; C = (st & 1) * 32 + (swz % 64) / 2; }
__host__ __device__ __forceinline__ int perm32(int rho) { const int n = rho >> 4, i = rho & 15; return 8 * (i >> 2) + 4 * n + (i & 3); }

struct Unit { int pm, pn; };
struct Gemm { const bf16_t* A; const bf16_t* Bt; int M, N, K; };

struct StaticOrder {
    int nM, nN, nwg, G, c;
    __host__ __device__ void init(int M, int N, int G_, int c_) { nM = M / BM; nN = N / BM; nwg = nM * nN; G = G_; c = c_; }
    __host__ __device__ bool next(int i, Unit& u) const {
        const long L = (long)i * G + c; if (L >= nwg) return false;
        int wgid = (int)L; { const int q = nwg / NXCD, r = nwg % NXCD, xcd = wgid % NXCD, off = wgid / NXCD; wgid = (xcd < r ? xcd * (q + 1) : r * (q + 1) + (xcd - r) * q) + off; }
        const int nig = WGM * nN, gid = wgid / nig, fm = gid * WGM, gsz = (nM - fm) < WGM ? (nM - fm) : WGM;
        u.pm = fm + ((wgid % nig) % gsz); u.pn = (wgid % nig) / gsz; return true;
    }
    __device__ __forceinline__ void a_ready(const Unit&) const {}
    __device__ __forceinline__ void done(const Unit&) const {}
};

__device__ __forceinline__ unsigned cvt_pk_bf16(float lo, float hi) { unsigned r; asm volatile("v_cvt_pk_bf16_f32 %0, %1, %2" : "=v"(r) : "v"(lo), "v"(hi)); return r; }
typedef float f32x2 __attribute__((ext_vector_type(2)));
template <class Epi, class Sched, bool ALIGN_EPI = false, bool SP2 = false>
__device__ __forceinline__ void gemm_phase(PG8_LAS unsigned char* lds, const Gemm g, const Sched& S, const Epi& E) {
    const int tid = threadIdx.x, wid = __builtin_amdgcn_readfirstlane(tid >> 6), lane = tid & 63, wr = wid >> 2, wc = wid & 3, fr = lane & 15, fq = lane >> 4;
    const int K = g.K, nt = K / BK;
    unsigned voffA[2], voffB[2];
#pragma unroll
    for (int i = 0; i < 2; ++i) { int R, C; stage_rc(tid * 16 + i * 8192, R, C); const int Rb = Epi::PERM ? ((R & ~31) + perm32(R & 31)) : R;
        voffA[i] = (unsigned)(R * K + C) * 2u; voffB[i] = (unsigned)(Rb * K + C) * 2u; }
    const size_t kstep = (size_t)(BK * 2);
    const size_t hstep = (size_t)HALF * K * 2;
    const size_t tstep = 2 * hstep;
    const unsigned ldsw = (unsigned)wid * 1024u;
    const int aoff = lds_byte(wr * 64 + fr, fq * 8), boff = lds_byte(wc * 32 + fr, fq * 8);
#define PG8_SA(b, h) (((b) * 2 + (h)) * HTB)
#define PG8_SB(b, h) ((4 + (b) * 2 + (h)) * HTB)
#define PG8_STAGE(bufoff, gbase, voff) do { _Pragma("unroll") for (int _i = 0; _i < 2; ++_i) \
        __builtin_amdgcn_global_load_lds((const unsigned*)((const char*)(gbase) + (voff)[_i]), (PG8_LAS unsigned*)(lds + (bufoff) + ldsw + _i * 8192), 16, 0, 0); } while (0)
#define PG8_LDA(dst, b, h) do { _Pragma("unroll") for (int m = 0; m < 4; ++m) _Pragma("unroll") for (int k = 0; k < 2; ++k) dst[m][k] = *(const PG8_LAS bf16x8*)(lds + PG8_SA(b, h) + aoff + m * 2048 + k * 1024); } while (0)
#define PG8_LDB(dst, b, h) do { _Pragma("unroll") for (int n = 0; n < 2; ++n) _Pragma("unroll") for (int k = 0; k < 2; ++k) dst[n][k] = *(const PG8_LAS bf16x8*)(lds + PG8_SB(b, h) + boff + n * 2048 + k * 1024); } while (0)
#define PG8_MMA(ai, bj, At, Bt) do { __builtin_amdgcn_s_setprio(1); _Pragma("unroll") for (int m = 0; m < 4; ++m) _Pragma("unroll") for (int n = 0; n < 2; ++n) _Pragma("unroll") for (int k = 0; k < 2; ++k) \
        acc[ai][bj][m][n] = __builtin_amdgcn_mfma_f32_16x16x32_bf16(Bt[n][k], At[m][k], acc[ai][bj][m][n], 0, 0, 0); __builtin_amdgcn_s_setprio(0); } while (0)
#define PG8_WAIT_V(n) asm volatile("s_waitcnt vmcnt(" #n ")" ::: "memory")
#define PG8_WAIT_L(n) asm volatile("s_waitcnt lgkmcnt(" #n ")" ::: "memory")
#define PG8_BAR __builtin_amdgcn_s_barrier()
#define PG8_SCHED __builtin_amdgcn_sched_barrier(0)
    Unit cur, nxt; int ui = 0;
    if (!S.next(0, cur)) return;
    f32x4 acc[2][2][4][2];
#pragma unroll
    for (int a = 0; a < 2; ++a)
#pragma unroll
        for (int b = 0; b < 2; ++b)
#pragma unroll
            for (int m = 0; m < 4; ++m)
#pragma unroll
                for (int n = 0; n < 2; ++n) acc[a][b][m][n] = (f32x4){0.f, 0.f, 0.f, 0.f};
    bf16x8 At[4][2], B0[2][2], B1[2][2];
    const char* cA = (const char*)g.A + (size_t)cur.pm * tstep; const char* cB = (const char*)g.Bt + (size_t)cur.pn * tstep;
    S.a_ready(cur);
    if constexpr (SP2) {
        PG8_STAGE(PG8_SB(0, 0), cB, voffB); PG8_STAGE(PG8_SB(0, 1), cB + hstep, voffB); PG8_STAGE(PG8_SA(0, 0), cA, voffA); PG8_STAGE(PG8_SA(0, 1), cA + hstep, voffA);
        if (wr == 1) PG8_BAR;
        PG8_WAIT_V(2); PG8_BAR;
        PG8_STAGE(PG8_SB(1, 0), cB + kstep, voffB); PG8_STAGE(PG8_SA(1, 0), cA + kstep, voffA); PG8_STAGE(PG8_SB(1, 1), cB + hstep + kstep, voffB);
        PG8_WAIT_V(6); PG8_BAR;
    } else {
        PG8_STAGE(PG8_SB(0, 0), cB, voffB); PG8_STAGE(PG8_SA(0, 0), cA, voffA); PG8_STAGE(PG8_SB(0, 1), cB + hstep, voffB); PG8_STAGE(PG8_SA(0, 1), cA + hstep, voffA);
        if (wr == 1) PG8_BAR;
        PG8_WAIT_V(4); PG8_BAR;
        PG8_STAGE(PG8_SB(1, 0), cB + kstep, voffB); PG8_STAGE(PG8_SA(1, 0), cA + kstep, voffA); PG8_STAGE(PG8_SB(1, 1), cB + hstep + kstep, voffB);
        PG8_WAIT_V(6); PG8_BAR;
    }
    for (;;) {
        const bool has_next = S.next(ui + 1, nxt);
        const char* nA = has_next ? (const char*)g.A + (size_t)nxt.pm * tstep : cA; const char* nB = has_next ? (const char*)g.Bt + (size_t)nxt.pn * tstep : cB;
        for (int t = 0; t < nt; t += 2) {
            const bool last = (t == nt - 2);
            const char* a1 = cA + (size_t)(t + 1) * kstep;
            const char* a2 = last ? nA : cA + (size_t)(t + 2) * kstep; const char* b2 = last ? nB : cB + (size_t)(t + 2) * kstep;
            const char* a3 = a2 + kstep; const char* b3 = b2 + kstep;
            if (last && has_next) S.a_ready(nxt);
            if constexpr (SP2) {
            PG8_LDB(B0, 0, 0); PG8_LDB(B1, 0, 1); PG8_SCHED; PG8_LDA(At, 0, 0); PG8_STAGE(PG8_SA(1, 1), a1 + hstep, voffA);
            PG8_WAIT_V(8); PG8_WAIT_L(0); PG8_BAR; PG8_MMA(0, 0, At, B0); PG8_MMA(0, 1, At, B1); PG8_BAR; PG8_SCHED;
            PG8_LDA(At, 0, 1); PG8_STAGE(PG8_SB(0, 0), b2, voffB); PG8_STAGE(PG8_SB(0, 1), b2 + hstep, voffB); PG8_STAGE(PG8_SA(0, 0), a2, voffA);
            PG8_WAIT_V(8); PG8_WAIT_L(0); PG8_BAR; PG8_MMA(1, 0, At, B0); PG8_MMA(1, 1, At, B1); PG8_BAR; PG8_SCHED;
            PG8_LDB(B0, 1, 0); PG8_LDB(B1, 1, 1); PG8_SCHED; PG8_LDA(At, 1, 0); PG8_STAGE(PG8_SA(0, 1), a2 + hstep, voffA);
            PG8_WAIT_V(8); PG8_WAIT_L(0); PG8_BAR; PG8_MMA(0, 0, At, B0); PG8_MMA(0, 1, At, B1); PG8_BAR; PG8_SCHED;
            PG8_LDA(At, 1, 1); PG8_STAGE(PG8_SB(1, 0), b3, voffB); PG8_STAGE(PG8_SB(1, 1), b3 + hstep, voffB); PG8_STAGE(PG8_SA(1, 0), a3, voffA);
            PG8_WAIT_V(8); PG8_WAIT_L(0); PG8_BAR; PG8_MMA(1, 0, At, B0); PG8_MMA(1, 1, At, B1); PG8_BAR; PG8_SCHED;
            } else {
            PG8_LDB(B0, 0, 0); PG8_SCHED; PG8_LDA(At, 0, 0); PG8_STAGE(PG8_SA(1, 1), a1 + hstep, voffA);
            PG8_WAIT_L(8); PG8_BAR; PG8_WAIT_L(0); PG8_MMA(0, 0, At, B0); PG8_BAR; PG8_SCHED;
            PG8_LDB(B1, 0, 1); PG8_STAGE(PG8_SB(0, 0), b2, voffB);
            PG8_BAR; PG8_WAIT_L(0); PG8_MMA(0, 1, At, B1); PG8_BAR;
            PG8_LDA(At, 0, 1); PG8_STAGE(PG8_SA(0, 0), a2, voffA);
            PG8_BAR; PG8_WAIT_L(0); PG8_MMA(1, 0, At, B0); PG8_BAR; PG8_SCHED;
            PG8_STAGE(PG8_SB(0, 1), b2 + hstep, voffB);
            PG8_WAIT_V(6); PG8_BAR; PG8_MMA(1, 1, At, B1); PG8_BAR;
            PG8_LDB(B0, 1, 0); PG8_SCHED; PG8_LDA(At, 1, 0); PG8_STAGE(PG8_SA(0, 1), a2 + hstep, voffA);
            PG8_WAIT_L(8); PG8_BAR; PG8_WAIT_L(0); PG8_MMA(0, 0, At, B0); PG8_BAR; PG8_SCHED;
            PG8_LDB(B1, 1, 1); PG8_STAGE(PG8_SB(1, 0), b3, voffB);
            PG8_BAR; PG8_WAIT_L(0); PG8_MMA(0, 1, At, B1); PG8_BAR;
            PG8_LDA(At, 1, 1); PG8_STAGE(PG8_SA(1, 0), a3, voffA);
            PG8_BAR; PG8_WAIT_L(0); PG8_MMA(1, 0, At, B0); PG8_BAR; PG8_SCHED;
            PG8_STAGE(PG8_SB(1, 1), b3 + hstep, voffB);
            PG8_WAIT_V(6); PG8_BAR; PG8_MMA(1, 1, At, B1); PG8_BAR;
            }
        }
        if constexpr (ALIGN_EPI) { if (wr == 0) PG8_BAR; }
        if constexpr (!Epi::AFTER_DRAIN) { E(acc, cur, wr, wc, fr, fq); S.done(cur); }
        if (!has_next) break;
#pragma unroll
        for (int a = 0; a < 2; ++a)
#pragma unroll
            for (int b = 0; b < 2; ++b)
#pragma unroll
                for (int m = 0; m < 4; ++m)
#pragma unroll
                    for (int n = 0; n < 2; ++n) acc[a][b][m][n] = (f32x4){0.f, 0.f, 0.f, 0.f};
        cur = nxt; cA = nA; cB = nB; ++ui;
        if constexpr (ALIGN_EPI) { if (wr == 1) PG8_BAR; }
    }
    PG8_WAIT_V(0);
    if constexpr (!ALIGN_EPI) { if (wr == 0) PG8_BAR; }
    PG8_BAR;
    if constexpr (Epi::AFTER_DRAIN) { E.fused(acc, cur, wr, wc, fr, fq, lds, wid, lane); S.done(cur); }
#undef PG8_SA
#undef PG8_SB
#undef PG8_STAGE
#undef PG8_LDA
#undef PG8_LDB
#undef PG8_MMA
#undef PG8_WAIT_V
#undef PG8_WAIT_L
#undef PG8_BAR
#undef PG8_SCHED
}
}


namespace pg8 {
typedef unsigned u32x4 __attribute__((ext_vector_type(4)));
struct EpiProjM {
    static constexpr bool PERM = true, AFTER_DRAIN = false;
    bf16_t* P;
    __device__ __forceinline__ void operator()(const f32x4 (&acc)[2][2][4][2], const Unit& u, int wr, int wc, int fr, int fq) const {
        const int row0 = u.pm * BM + wr * 64 + fr, col0 = u.pn * BM + wc * 32 + 8 * fq;
        const int pn = u.pn; const int mode = (pn < 2) ? 1 : ((pn == 6 || pn == 7 || pn == 11) ? 2 : 0);
#pragma unroll
        for (int ai = 0; ai < 2; ++ai)
#pragma unroll
            for (int m = 0; m < 4; ++m) { bf16_t* rowp = P + (size_t)(row0 + ai * HALF + m * 16) * INW + col0;
#pragma unroll
                for (int bj = 0; bj < 2; ++bj) { f32x4 v0 = acc[ai][bj][m][0], v1 = acc[ai][bj][m][1];
                    if (mode == 1) { v0 = v0 * C2; v1 = v1 * C2; }
                    else if (mode == 2) {
#pragma unroll
                        for (int e = 0; e < 4; ++e) { v0[e] = silu(v0[e]); v1[e] = silu(v1[e]); } }
                    u32x4 w; w.x = cvt_pk_bf16(v0[0], v0[1]); w.y = cvt_pk_bf16(v0[2], v0[3]); w.z = cvt_pk_bf16(v1[0], v1[1]); w.w = cvt_pk_bf16(v1[2], v1[3]);
                    *(u32x4*)(rowp + bj * HALF) = w; } }
    }
};
struct EpiF32M {
    static constexpr bool PERM = true, AFTER_DRAIN = false;
    float* O; int ld;
    __device__ __forceinline__ void operator()(const f32x4 (&acc)[2][2][4][2], const Unit& u, int wr, int wc, int fr, int fq) const {
        const int row0 = u.pm * BM + wr * 64 + fr, col0 = u.pn * BM + wc * 32 + 8 * fq;
#pragma unroll
        for (int ai = 0; ai < 2; ++ai)
#pragma unroll
            for (int m = 0; m < 4; ++m) { float* rowp = O + (size_t)(row0 + ai * HALF + m * 16) * ld + col0;
#pragma unroll
                for (int bj = 0; bj < 2; ++bj) { *(f32x4*)(rowp + bj * HALF) = acc[ai][bj][m][0]; *(f32x4*)(rowp + bj * HALF + 4) = acc[ai][bj][m][1]; } }
    }
};
struct EpiWoutM {
    static constexpr bool PERM = true, AFTER_DRAIN = false;
    const float* x; float* out; bf16_t* xb;
    __device__ __forceinline__ void operator()(const f32x4 (&acc)[2][2][4][2], const Unit& u, int wr, int wc, int fr, int fq) const {
        const int row0 = u.pm * BM + wr * 64 + fr, col0 = u.pn * BM + wc * 32 + 8 * fq;
#pragma unroll
        for (int ai = 0; ai < 2; ++ai)
#pragma unroll
            for (int m = 0; m < 4; ++m) { const size_t rb = (size_t)(row0 + ai * HALF + m * 16) * DM + col0;
#pragma unroll
                for (int bj = 0; bj < 2; ++bj) { const size_t i = rb + bj * HALF;
                    const f32x4 v0 = acc[ai][bj][m][0] + *(const f32x4*)(x + i), v1 = acc[ai][bj][m][1] + *(const f32x4*)(x + i + 4);
                    *(f32x4*)(out + i) = v0; *(f32x4*)(out + i + 4) = v1;
                    u32x4 w; w.x = cvt_pk_bf16(v0[0], v0[1]); w.y = cvt_pk_bf16(v0[2], v0[3]); w.z = cvt_pk_bf16(v1[0], v1[1]); w.w = cvt_pk_bf16(v1[2], v1[3]);
                    *(u32x4*)(xb + i) = w; } }
    }
};
struct EpiQM {
    static constexpr bool PERM = true, AFTER_DRAIN = false;
    const float* rstd; bf16_t* Q;
    __device__ __forceinline__ void operator()(const f32x4 (&acc)[2][2][4][2], const Unit& u, int wr, int wc, int fr, int fq) const {
        const int row0 = u.pm * BM + wr * 64 + fr, col0 = u.pn * BM + wc * 32 + 8 * fq;
#pragma unroll
        for (int ai = 0; ai < 2; ++ai)
#pragma unroll
            for (int m = 0; m < 4; ++m) { const int row = row0 + ai * HALF + m * 16; const float rs = rstd[row]; bf16_t* rowp = Q + (size_t)row * 2048 + col0;
#pragma unroll
                for (int bj = 0; bj < 2; ++bj) { const f32x4 v0 = acc[ai][bj][m][0] * rs, v1 = acc[ai][bj][m][1] * rs;
                    u32x4 w; w.x = cvt_pk_bf16(v0[0], v0[1]); w.y = cvt_pk_bf16(v0[2], v0[3]); w.z = cvt_pk_bf16(v1[0], v1[1]); w.w = cvt_pk_bf16(v1[2], v1[3]);
                    *(u32x4*)(rowp + bj * HALF) = w; } }
    }
};
}

__device__ __forceinline__ void transpose_item(const float* W, const float* gain, int K, int N, bf16_t* WT, float* scr, int item, int lane) {
    const int nblk = N / 32, kb = item / nblk, nb = item % nblk, k0 = 64 * kb, n0 = 32 * nb;
    for (int i = 0; i < 32; ++i) { const int kk = 2 * i + (lane >> 5); float g = gain ? gain[k0 + kk] : 1.f; scr[kk * 33 + (lane & 31)] = W[(size_t)(k0 + kk) * N + n0 + (lane & 31)] * g; }
    __builtin_amdgcn_s_waitcnt(0); __builtin_amdgcn_wave_barrier();
    const int c = lane & 7;
#pragma unroll
    for (int j = 0; j < 4; ++j) { const int n = (lane >> 3) + 8 * j; const float* s = scr + (8 * c) * 33 + n;
        uint4 o; o.x = pk2(s[0 * 33], s[1 * 33]); o.y = pk2(s[2 * 33], s[3 * 33]); o.z = pk2(s[4 * 33], s[5 * 33]); o.w = pk2(s[6 * 33], s[7 * 33]);
        *(uint4*)(WT + (size_t)(n0 + n) * K + k0 + 8 * c) = o; }
    __builtin_amdgcn_s_waitcnt(0); __builtin_amdgcn_wave_barrier();
}
__device__ __forceinline__ void norm_row_to_bf16(const float* xrow, bf16_t* orow, int lane) {
    const float4* xr = (const float4*)xrow + lane;
    float4 v[4]; float s = 0.f;
#pragma unroll
    for (int j = 0; j < 4; ++j) { v[j] = xr[64 * j]; s += (v[j].x * v[j].x + v[j].y * v[j].y) + (v[j].z * v[j].z + v[j].w * v[j].w); }
    const float rstd = rsqrtf(wave_sum(s) * (1.f / DM) + EPS);
    unsigned long long* o8 = (unsigned long long*)orow + lane;
#pragma unroll
    for (int j = 0; j < 4; ++j) o8[64 * j] = (unsigned long long)pk2(v[j].x * rstd, v[j].y * rstd) | ((unsigned long long)pk2(v[j].z * rstd, v[j].w * rstd) << 32);
}
__device__ __forceinline__ void phase_prep(const Params& p, unsigned char* lds) {
    const int tid = threadIdx.x, lane = tid & 63, wave = tid >> 6;
    const int gw = blockIdx.x * 8 + wave, NGW = gridDim.x * 8;
    const int gt = blockIdx.x * NTHR + tid, NGT = gridDim.x * NTHR;
    unsigned char* ws = p.ws;
    float* scr = (float*)lds + wave * (64 * 33);
    constexpr int I_IN = (DM / 64) * (INW / 32), I_OUT = (DM / 64) * (DM / 32), I_Q = (DM / 64) * (2048 / 32), I_MKV = (DM / 64) * (512 / 32);
    for (int it = gw; it < I_IN + I_OUT + I_Q + I_MKV; it += NGW) {
        int r = it;
        if (r < I_IN) { transpose_item(p.w_in, p.g_mix, DM, INW, (bf16_t*)(ws + WS_WIN_T), scr, r, lane); continue; } r -= I_IN;
        if (r < I_OUT) { transpose_item(p.w_out, nullptr, DM, DM, (bf16_t*)(ws + WS_WOUT_T), scr, r, lane); continue; } r -= I_OUT;
        if (r < I_Q) { transpose_item(p.w_q, p.g_ffn, DM, 2048, (bf16_t*)(ws + WS_WQ_T), scr, r, lane); continue; } r -= I_Q;
        transpose_item(p.w_mkv, p.mem_gain, DM, 512, (bf16_t*)(ws + WS_WMKV_T), scr, r, lane);
    }
    for (int m = gw; m < T; m += NGW) norm_row_to_bf16(p.x + (size_t)m * DM, (bf16_t*)(ws + WS_XB) + (size_t)m * DM, lane);
    for (int m = gw; m < NB * NMEM; m += NGW) norm_row_to_bf16(p.mem + (size_t)m * DM, (bf16_t*)(ws + WS_MEMN) + (size_t)m * DM, lane);
    for (int i = gt; i < 8 * 2 * 128 * 128; i += NGT) ((bf16_t*)(ws + WS_SKB))[i] = f2bf(p.sub_keys[i]);
    for (int i = gt; i < NEXP * DM / 8; i += NGT) {
        const int d0 = (i & 127) * 8;
        const float4 a = ((const float4*)p.pu)[2 * i], b = ((const float4*)p.pu)[2 * i + 1];
        const float4 ga = *(const float4*)(p.g_ffn + d0), gb = *(const float4*)(p.g_ffn + d0 + 4);
        uint4 o; o.x = pk2(a.x * ga.x, a.y * ga.y); o.y = pk2(a.z * ga.z, a.w * ga.w); o.z = pk2(b.x * gb.x, b.y * gb.y); o.w = pk2(b.z * gb.z, b.w * gb.w);
        ((uint4*)(ws + WS_U16))[i] = o;
        const float4 c = ((const float4*)p.pv)[2 * i], d = ((const float4*)p.pv)[2 * i + 1];
        h8_t hv; hv[0] = (_Float16)c.x; hv[1] = (_Float16)c.y; hv[2] = (_Float16)c.z; hv[3] = (_Float16)c.w; hv[4] = (_Float16)d.x; hv[5] = (_Float16)d.y; hv[6] = (_Float16)d.z; hv[7] = (_Float16)d.w;
        ((h8_t*)(ws + WS_V16))[i] = hv;
    }
    for (int i = gt; i < 512; i += NGT) ((float*)(ws + WS_LB))[i] = 1.f / (1.f + expf(p.gamma_lb[512 + i] - p.gamma_lb[i]));
}

template <class Epi>
__device__ __forceinline__ void gemm_naive(const bf16_t* A, const bf16_t* Bt, int M, int N, int K, unsigned char* ldsb, const Epi& epi) {
    float* As = (float*)ldsb;
    float* Bs = As + 32 * 132;
    const int tid = threadIdx.x, ty = tid >> 4, tx = tid & 15;
    const int ntm = M / 128, ntn = N / 64;
    for (int tile = blockIdx.x; tile < ntm * ntn; tile += gridDim.x) {
        const int tm = tile / ntn, tn = tile % ntn;
        float acc[4][4];
#pragma unroll
        for (int i = 0; i < 4; ++i)
#pragma unroll
            for (int j = 0; j < 4; ++j) acc[i][j] = 0.f;
        for (int k0 = 0; k0 < K; k0 += 32) {
            { const int r = tid >> 2, kq = (tid & 3) * 8;
              const uint4 v = *(const uint4*)(A + (size_t)(tm * 128 + r) * K + k0 + kq);
              As[(kq + 0) * 132 + r] = bflo(v.x); As[(kq + 1) * 132 + r] = bfhi(v.x); As[(kq + 2) * 132 + r] = bflo(v.y); As[(kq + 3) * 132 + r] = bfhi(v.y);
              As[(kq + 4) * 132 + r] = bflo(v.z); As[(kq + 5) * 132 + r] = bfhi(v.z); As[(kq + 6) * 132 + r] = bflo(v.w); As[(kq + 7) * 132 + r] = bfhi(v.w); }
            if (tid < 256) { const int r = tid >> 2, kq = (tid & 3) * 8;
              const uint4 v = *(const uint4*)(Bt + (size_t)(tn * 64 + r) * K + k0 + kq);
              Bs[(kq + 0) * 68 + r] = bflo(v.x); Bs[(kq + 1) * 68 + r] = bfhi(v.x); Bs[(kq + 2) * 68 + r] = bflo(v.y); Bs[(kq + 3) * 68 + r] = bfhi(v.y);
              Bs[(kq + 4) * 68 + r] = bflo(v.z); Bs[(kq + 5) * 68 + r] = bfhi(v.z); Bs[(kq + 6) * 68 + r] = bflo(v.w); Bs[(kq + 7) * 68 + r] = bfhi(v.w); }
            __syncthreads();
#pragma unroll 8
            for (int k = 0; k < 32; ++k) {
                const float4 a = *(const float4*)(As + k * 132 + ty * 4); const float4 b = *(const float4*)(Bs + k * 68 + tx * 4);
                const float av[4] = {a.x, a.y, a.z, a.w}, bv[4] = {b.x, b.y, b.z, b.w};
#pragma unroll
                for (int i = 0; i < 4; ++i)
#pragma unroll
                    for (int j = 0; j < 4; ++j) acc[i][j] = fmaf(av[i], bv[j], acc[i][j]);
            }
            __syncthreads();
        }
#pragma unroll
        for (int i = 0; i < 4; ++i)
#pragma unroll
            for (int j = 0; j < 4; ++j) epi(tm * 128 + ty * 4 + i, tn * 64 + tx * 4 + j, acc[i][j]);
    }
}

struct EpiProj {
    bf16_t* P;
    __device__ __forceinline__ void operator()(int row, int col, float v) const {
        if (col < C_SBK) v *= C2;
        else if (col >= C_HGQ && col < C_HGF) v = silu(v);
        else if (col >= C_HGG && col < C_MQ) v = silu(v);
        P[(size_t)row * INW + col] = f2bf(v);
    }
};
struct EpiF32 { float* O; int ld; __device__ __forceinline__ void operator()(int row, int col, float v) const { O[(size_t)row * ld + col] = v; } };
struct EpiWout { const float* x; float* out; bf16_t* xb;
    __device__ __forceinline__ void operator()(int row, int col, float v) const { const size_t i = (size_t)row * DM + col; const float r = x[i] + v; out[i] = r; xb[i] = f2bf(r); } };
struct EpiQ { const float* rstd; bf16_t* Q;
    __device__ __forceinline__ void operator()(int row, int col, float v) const { Q[(size_t)row * 2048 + col] = f2bf(v * rstd[row]); } };

#ifndef SB_EARLY
#define SB_EARLY 1
#endif
__device__ __forceinline__ void sb_naive(const Params& p) {
    const bf16_t* P = (const bf16_t*)(p.ws + WS_P);
    bf16_t* mixed = (bf16_t*)(p.ws + WS_MIXED);
    for (int row = blockIdx.x * NTHR + threadIdx.x; row < NB * 8 * SEQ; row += gridDim.x * NTHR) {
        const int t = row % SEQ, bh = row / SEQ, h = bh % 8, b = bh / 8;
        const size_t tok = (size_t)b * SEQ + t;
        float q[64], o[64];
        { const uint4* qp = (const uint4*)(P + tok * INW + C_SBQ + h * 64);
#pragma unroll
          for (int j = 0; j < 8; ++j) { const uint4 v = qp[j]; q[8 * j] = bflo(v.x); q[8 * j + 1] = bfhi(v.x); q[8 * j + 2] = bflo(v.y); q[8 * j + 3] = bfhi(v.y); q[8 * j + 4] = bflo(v.z); q[8 * j + 5] = bfhi(v.z); q[8 * j + 6] = bflo(v.w); q[8 * j + 7] = bfhi(v.w); } }
#pragma unroll
        for (int d = 0; d < 64; ++d) o[d] = 0.f;
        float R = 0.f;
        for (int s = t - 1; s >= 0; --s) {
            const uint4* kp = (const uint4*)(P + ((size_t)b * SEQ + s) * INW + C_SBK + h * 64);
            const uint4* vp = (const uint4*)(P + ((size_t)b * SEQ + s) * INW + C_SBV + h * 64);
            float z = 0.f;
#pragma unroll
            for (int j = 0; j < 8; ++j) { const uint4 v = kp[j];
                z = fmaf(q[8 * j], bflo(v.x), z); z = fmaf(q[8 * j + 1], bfhi(v.x), z); z = fmaf(q[8 * j + 2], bflo(v.y), z); z = fmaf(q[8 * j + 3], bfhi(v.y), z);
                z = fmaf(q[8 * j + 4], bflo(v.z), z); z = fmaf(q[8 * j + 5], bfhi(v.z), z); z = fmaf(q[8 * j + 6], bflo(v.w), z); z = fmaf(q[8 * j + 7], bfhi(v.w), z); }
            const float sp = fmaxf(z, 0.f) + log2f(1.f + exp2f(-fabsf(z)));
            const float a = exp2f(z - sp + R);
            R -= sp;
#pragma unroll
            for (int j = 0; j < 8; ++j) { const uint4 v = vp[j];
                o[8 * j] = fmaf(a, bflo(v.x), o[8 * j]); o[8 * j + 1] = fmaf(a, bfhi(v.x), o[8 * j + 1]); o[8 * j + 2] = fmaf(a, bflo(v.y), o[8 * j + 2]); o[8 * j + 3] = fmaf(a, bfhi(v.y), o[8 * j + 3]);
                o[8 * j + 4] = fmaf(a, bflo(v.z), o[8 * j + 4]); o[8 * j + 5] = fmaf(a, bfhi(v.z), o[8 * j + 5]); o[8 * j + 6] = fmaf(a, bflo(v.w), o[8 * j + 6]); o[8 * j + 7] = fmaf(a, bfhi(v.w), o[8 * j + 7]); }
#if SB_EARLY
            if (R < -150.f) break;
#endif
        }
        float ss = 0.f;
#pragma unroll
        for (int d = 0; d < 64; ++d) ss = fmaf(o[d], o[d], ss);
        const float r = rsqrtf(ss * (1.f / 64.f) + EPS);
        uint4* op = (uint4*)(mixed + tok * DM + h * 64);
        const float* g = p.sb_gain + h * 64;
#pragma unroll
        for (int j = 0; j < 8; ++j) { uint4 w; w.x = pk2(o[8 * j] * r * g[8 * j], o[8 * j + 1] * r * g[8 * j + 1]); w.y = pk2(o[8 * j + 2] * r * g[8 * j + 2], o[8 * j + 3] * r * g[8 * j + 3]);
            w.z = pk2(o[8 * j + 4] * r * g[8 * j + 4], o[8 * j + 5] * r * g[8 * j + 5]); w.w = pk2(o[8 * j + 6] * r * g[8 * j + 6], o[8 * j + 7] * r * g[8 * j + 7]); op[j] = w; }
    }
}

__device__ __forceinline__ void hg_naive(const Params& p, unsigned char* ldsb) {
    const bf16_t* P = (const bf16_t*)(p.ws + WS_P);
    float* raw = (float*)(p.ws + WS_HGRAW);
    const float* lbp = (const float*)(p.ws + WS_LB);
    float* red = (float*)ldsb;
    const int tid = threadIdx.x, jj = tid >> 7, k = tid & 127, wave = tid >> 6, lane = tid & 63;
    for (int unit = blockIdx.x; unit < NB * 4 * 16; unit += gridDim.x) {
        const int jg = unit & 15, h = (unit >> 4) & 3, b = unit >> 6;
        const float lb = lbp[h * 128 + k];
        float S = 0.f;
        for (int t0 = 0; t0 < SEQ; t0 += 64) {
            for (int tt = 0; tt < 64; tt += 8) {
                float fl[8], qv[8], iv[8];
#pragma unroll
                for (int u = 0; u < 8; ++u) { const bf16_t* pr = P + ((size_t)b * SEQ + t0 + tt + u) * INW;
                    fl[u] = bf2f(pr[C_HGF + h * 128 + k]); qv[u] = bf2f(pr[C_HGQ + h * 128 + k]); iv[u] = bf2f(pr[C_HGI + h * 64 + jg * 4 + jj]); }
#pragma unroll
                for (int u = 0; u < 8; ++u) {
                    const float f = lb + (1.f - lb) / (1.f + __expf(-fl[u]));
                    S = f * S + (1.f - f) * iv[u];
                    const float part = wave_sum(S * qv[u]);
                    if (lane == 0) red[(tt + u) * 8 + wave] = part;
                }
            }
            __syncthreads();
            if (tid < 256) { const int tt = tid >> 2, j2 = tid & 3;
                raw[((size_t)b * SEQ + t0 + tt) * 256 + h * 64 + jg * 4 + j2] = red[tt * 8 + 2 * j2] + red[tt * 8 + 2 * j2 + 1]; }
            __syncthreads();
        }
    }
}
__device__ __forceinline__ void hg_finish(const Params& p) {
    const bf16_t* P = (const bf16_t*)(p.ws + WS_P);
    const float* raw = (const float*)(p.ws + WS_HGRAW);
    bf16_t* mixed = (bf16_t*)(p.ws + WS_MIXED);
    const int lane = threadIdx.x & 63, wave = threadIdx.x >> 6;
    for (int it = blockIdx.x * 8 + wave; it < T * 4; it += gridDim.x * 8) {
        const int tok = it >> 2, h = it & 3;
        const float o = raw[(size_t)tok * 256 + h * 64 + lane];
        const float r = rsqrtf(wave_sum(o * o) * (1.f / 64.f) + EPS);
        const float g = bf2f(P[(size_t)tok * INW + C_HGG + h * 64 + lane]);
        mixed[(size_t)tok * DM + 512 + h * 64 + lane] = f2bf(o * r * p.hg_gain[h * 64 + lane] * g);
    }
}


#define LAS __attribute__((address_space(3)))
typedef float f32x16 __attribute__((ext_vector_type(16)));
typedef short sh8_t __attribute__((ext_vector_type(8)));
typedef unsigned u4_t __attribute__((ext_vector_type(4)));
__device__ __forceinline__ void mma32(f32x16& acc, const LAS bf16_t* A, int lda, const LAS bf16_t* Bt, int ldb, int K, int lane) {
    const int r = lane & 31, h = lane >> 5;
    const LAS bf16_t* ap = A + r * lda + 8 * h; const LAS bf16_t* bp = Bt + r * ldb + 8 * h;
    for (int k0 = 0; k0 < K; k0 += 16) {
        const sh8_t a = *(const LAS sh8_t*)(ap + k0), b = *(const LAS sh8_t*)(bp + k0);
        acc = __builtin_amdgcn_mfma_f32_32x32x16_bf16(a, b, acc, 0, 0, 0);
    }
}
__device__ __forceinline__ int crow(int r, int hh) { return (r & 3) + 8 * (r >> 2) + 4 * hh; }
constexpr size_t HG_LT = 0;
constexpr size_t HG_SB = 64 * MiB;
constexpr size_t HG_DD = 96 * MiB;
__device__ __forceinline__ void hg_cols(const bf16_t* P, const float* lbp, int b_, int h, int c, LAS float* gs, int tid, float (&kk)[16], float (&bc)[16], float& bmid, float& blast) {
    const int rg = tid >> 7, k = tid & 127;
    const float lb = lbp[h * 128 + k];
    const bf16_t* pr = P + ((size_t)b_ * SEQ + c * 64 + rg * 16) * INW + C_HGF + h * 128 + k;
    float run = 0.f;
#pragma unroll
    for (int i = 0; i < 16; ++i) { const float fl = bf2f(pr[(size_t)i * INW]); const float kv = (1.f - lb) / (1.f + __expf(fl)); kk[i] = kv; run += __logf(1.f - kv); bc[i] = run; }
    gs[rg * 128 + k] = run;
    __syncthreads();
    const float g0 = gs[k], g1 = gs[128 + k], g2 = gs[256 + k], g3 = gs[384 + k];
    const float off = (rg > 0 ? g0 : 0.f) + (rg > 1 ? g1 : 0.f) + (rg > 2 ? g2 : 0.f);
#pragma unroll
    for (int i = 0; i < 16; ++i) bc[i] += off;
    bmid = g0 + g1; blast = (g0 + g1) + (g2 + g3);
}
__device__ __forceinline__ void hg_load_vt(const bf16_t* P, int b_, int h, int c, LAS bf16_t* VT, int tid) {
    const int s = tid >> 3, jq = tid & 7;
    const uint4 v = *(const uint4*)(P + ((size_t)b_ * SEQ + c * 64 + s) * INW + C_HGI + h * 64 + jq * 8);
    LAS bf16_t* d = VT + (jq * 8) * 72 + s;
    d[0 * 72] = (bf16_t)(v.x & 0xffff); d[1 * 72] = (bf16_t)(v.x >> 16); d[2 * 72] = (bf16_t)(v.y & 0xffff); d[3 * 72] = (bf16_t)(v.y >> 16);
    d[4 * 72] = (bf16_t)(v.z & 0xffff); d[5 * 72] = (bf16_t)(v.z >> 16); d[6 * 72] = (bf16_t)(v.w & 0xffff); d[7 * 72] = (bf16_t)(v.w >> 16);
}
__device__ __forceinline__ void hg_local(const Params& p, unsigned char* ldsb) {
    const bf16_t* P = (const bf16_t*)(p.ws + WS_P); const float* lbp = (const float*)(p.ws + WS_LB);
    float* LT = (float*)((unsigned char*)p.out + HG_LT); float* DD = (float*)((unsigned char*)p.out + HG_DD);
    LAS unsigned char* l = (LAS unsigned char*)ldsb;
    LAS float* gs = (LAS float*)l; LAS bf16_t* KST = (LAS bf16_t*)(l + 2048); LAS bf16_t* VT = (LAS bf16_t*)(l + 20480);
    const int tid = threadIdx.x, lane = tid & 63, wave = tid >> 6, rg = tid >> 7, k = tid & 127;
    for (int unit = blockIdx.x; unit < 2048; unit += gridDim.x) {
        const int bh = unit >> 7, c = unit & 127, b_ = bh >> 2, h = bh & 3;
        float kk[16], bc[16], bmid, blast;
        hg_cols(P, lbp, b_, h, c, gs, tid, kk, bc, bmid, blast);
        { unsigned w[8];
#pragma unroll
          for (int i = 0; i < 8; ++i) w[i] = pk2(kk[2 * i] * __expf(blast - bc[2 * i]), kk[2 * i + 1] * __expf(blast - bc[2 * i + 1]));
          LAS u4_t* d = (LAS u4_t*)(KST + k * 72 + rg * 16);
          d[0] = (u4_t){w[0], w[1], w[2], w[3]}; d[1] = (u4_t){w[4], w[5], w[6], w[7]}; }
        hg_load_vt(P, b_, h, c, VT, tid);
        if (tid < 128) DD[(size_t)unit * 128 + tid] = __expf(blast);
        __syncthreads();
        { const int ji = wave >> 2, ki = wave & 3;
          f32x16 acc;
#pragma unroll
          for (int r = 0; r < 16; ++r) acc[r] = 0.f;
          mma32(acc, VT + 32 * ji * 72, 72, KST + 32 * ki * 72, 72, 64, lane);
          float* o = LT + (size_t)unit * 8192 + 32 * ki + (lane & 31);
#pragma unroll
          for (int r = 0; r < 16; ++r) o[(size_t)(32 * ji + crow(r, lane >> 5)) * 128] = acc[r]; }
        __syncthreads();
    }
}
__device__ __forceinline__ void hg_scan(const Params& p) {
    const float* LT = (const float*)((unsigned char*)p.out + HG_LT); const float* DD = (const float*)((unsigned char*)p.out + HG_DD);
    bf16_t* SB = (bf16_t*)((unsigned char*)p.out + HG_SB);
    for (int gt = blockIdx.x * NTHR + threadIdx.x; gt < 16 * 8192; gt += gridDim.x * NTHR) {
        const int bh = gt >> 13, e = gt & 8191, k = e & 127;
        float S = 0.f;
#pragma unroll 8
        for (int c = 0; c < 128; ++c) { const size_t u = (size_t)bh * 128 + c;
            const float L = LT[u * 8192 + e], D = DD[u * 128 + k];
            SB[u * 8192 + e] = f2bf(S); S = fmaf(D, S, L); }
    }
}
__device__ __forceinline__ void hg_out(const Params& p, unsigned char* ldsb) {
    const bf16_t* P = (const bf16_t*)(p.ws + WS_P); const float* lbp = (const float*)(p.ws + WS_LB);
    const bf16_t* SB = (const bf16_t*)((unsigned char*)p.out + HG_SB);
    bf16_t* mixed = (bf16_t*)(p.ws + WS_MIXED);
    LAS unsigned char* l = (LAS unsigned char*)ldsb;
    LAS float* gs = (LAS float*)l;
    LAS bf16_t* QT = (LAS bf16_t*)(l + 2048); LAS bf16_t* KT = (LAS bf16_t*)(l + 19456); LAS bf16_t* QI = (LAS bf16_t*)(l + 36864);
    LAS bf16_t* VT = (LAS bf16_t*)(l + 54272); LAS bf16_t* SC = (LAS bf16_t*)(l + 63488); LAS bf16_t* ST = (LAS bf16_t*)(l + 72704);
    LAS float* OB = (LAS float*)(l + 90112);
    const int tid = threadIdx.x, lane = tid & 63, wave = tid >> 6, rg = tid >> 7, k = tid & 127;
    for (int unit = blockIdx.x; unit < 2048; unit += gridDim.x) {
        const int bh = unit >> 7, c = unit & 127, b_ = bh >> 2, h = bh & 3;
        const size_t tok0 = (size_t)b_ * SEQ + c * 64;
        float kk[16], bc[16], bmid, blast;
        hg_cols(P, lbp, b_, h, c, gs, tid, kk, bc, bmid, blast);
        { const bf16_t* qp = P + (tok0 + rg * 16) * INW + C_HGQ + h * 128 + k;
#pragma unroll
          for (int i = 0; i < 16; ++i) { const float q = bf2f(qp[(size_t)i * INW]); const int o = (rg * 16 + i) * 136 + k;
              QT[o] = f2bf(q * __expf(fminf(bc[i] - bmid, 40.f))); KT[o] = f2bf(kk[i] * __expf(fminf(bmid - bc[i], 40.f))); QI[o] = f2bf(q * __expf(bc[i])); } }
        hg_load_vt(P, b_, h, c, VT, tid);
#pragma unroll
        for (int i = 0; i < 2; ++i) { const int idx = tid * 8 + i * 4096, j = idx >> 7, kq = idx & 127;
            *(LAS u4_t*)(ST + j * 136 + kq) = *(const u4_t*)(SB + (size_t)unit * 8192 + idx); }
        __syncthreads();
        if (wave < 4) { const int ti = wave >> 1, si = wave & 1;
            f32x16 acc;
#pragma unroll
            for (int r = 0; r < 16; ++r) acc[r] = 0.f;
            if (si <= ti) mma32(acc, QT + 32 * ti * 136, 136, KT + 32 * si * 136, 136, 128, lane);
            const int s = 32 * si + (lane & 31);
#pragma unroll
            for (int r = 0; r < 16; ++r) { const int t = 32 * ti + crow(r, lane >> 5); SC[t * 72 + s] = f2bf((s <= t) ? acc[r] : 0.f); } }
        __syncthreads();
        if (wave < 4) { const int ti = wave >> 1, ji = wave & 1;
            f32x16 acc;
#pragma unroll
            for (int r = 0; r < 16; ++r) acc[r] = 0.f;
            mma32(acc, SC + 32 * ti * 72, 72, VT + 32 * ji * 72, 72, 64, lane);
            mma32(acc, QI + 32 * ti * 136, 136, ST + 32 * ji * 136, 136, 128, lane);
            const int j = 32 * ji + (lane & 31);
#pragma unroll
            for (int r = 0; r < 16; ++r) OB[(32 * ti + crow(r, lane >> 5)) * 65 + j] = acc[r]; }
        __syncthreads();
        { const int t = tid >> 3, jq = tid & 7;
          float o[8]; float ss = 0.f;
#pragma unroll
          for (int e = 0; e < 8; ++e) { o[e] = OB[t * 65 + jq * 8 + e]; ss = fmaf(o[e], o[e], ss); }
          ss += __shfl_xor(ss, 1); ss += __shfl_xor(ss, 2); ss += __shfl_xor(ss, 4);
          const float r = rsqrtf(ss * (1.f / 64.f) + EPS);
          const uint4 gv = *(const uint4*)(P + (tok0 + t) * INW + C_HGG + h * 64 + jq * 8);
          const float* gn = p.hg_gain + h * 64 + jq * 8;
          uint4 w; w.x = pk2(o[0] * r * gn[0] * bflo(gv.x), o[1] * r * gn[1] * bfhi(gv.x)); w.y = pk2(o[2] * r * gn[2] * bflo(gv.y), o[3] * r * gn[3] * bfhi(gv.y));
          w.z = pk2(o[4] * r * gn[4] * bflo(gv.z), o[5] * r * gn[5] * bfhi(gv.z)); w.w = pk2(o[6] * r * gn[6] * bflo(gv.w), o[7] * r * gn[7] * bfhi(gv.w));
          *(uint4*)(mixed + (tok0 + t) * DM + 512 + h * 64 + jq * 8) = w; }
        __syncthreads();
    }
}

__device__ __forceinline__ void mem_knorm(const Params& p) {
    const float* kv = (const float*)(p.ws + WS_MEMKV);
    bf16_t* mk = (bf16_t*)(p.ws + WS_MEMK); bf16_t* mv = (bf16_t*)(p.ws + WS_MEMV);
    const int lane = threadIdx.x & 63, wave = threadIdx.x >> 6;
    for (int it = blockIdx.x * 8 + wave; it < NB * NMEM * 4; it += gridDim.x * 8) {
        const int m = it >> 2, h = it & 3;
        const float kx = kv[(size_t)m * 512 + h * 64 + lane], vx = kv[(size_t)m * 512 + 256 + h * 64 + lane];
        const float r = rsqrtf(wave_sum(kx * kx) * (1.f / 64.f) + EPS);
        mk[(size_t)m * 256 + h * 64 + lane] = f2bf(kx * r * p.mk_gain[lane]);
        mv[(size_t)m * 256 + h * 64 + lane] = f2bf(vx);
    }
}
__device__ __forceinline__ void mem_attn_naive(const Params& p) {
    const bf16_t* P = (const bf16_t*)(p.ws + WS_P);
    const bf16_t* mk = (const bf16_t*)(p.ws + WS_MEMK); const bf16_t* mv = (const bf16_t*)(p.ws + WS_MEMV);
    bf16_t* mixed = (bf16_t*)(p.ws + WS_MIXED);
    for (int idx = blockIdx.x * NTHR + threadIdx.x; idx < 4 * T; idx += gridDim.x * NTHR) {
        const int h = idx / T, tok = idx % T, b = tok / SEQ;
        float q[64], o[64];
        { const uint4* qp = (const uint4*)(P + (size_t)tok * INW + C_MQ + h * 64);
#pragma unroll
          for (int j = 0; j < 8; ++j) { const uint4 v = qp[j]; q[8 * j] = bflo(v.x); q[8 * j + 1] = bfhi(v.x); q[8 * j + 2] = bflo(v.y); q[8 * j + 3] = bfhi(v.y); q[8 * j + 4] = bflo(v.z); q[8 * j + 5] = bfhi(v.z); q[8 * j + 6] = bflo(v.w); q[8 * j + 7] = bfhi(v.w); } }
        float ss = 0.f;
#pragma unroll
        for (int d = 0; d < 64; ++d) ss = fmaf(q[d], q[d], ss);
        const float r = rsqrtf(ss * (1.f / 64.f) + EPS) * 0.125f;
#pragma unroll
        for (int d = 0; d < 64; ++d) { q[d] *= r * p.mq_gain[d]; o[d] = 0.f; }
        float mx = -1e30f, l = 0.f;
        for (int m = 0; m < NMEM; ++m) {
            const uint4* kp = (const uint4*)(mk + ((size_t)b * NMEM + m) * 256 + h * 64);
            const uint4* vp = (const uint4*)(mv + ((size_t)b * NMEM + m) * 256 + h * 64);
            float z = 0.f;
#pragma unroll
            for (int j = 0; j < 8; ++j) { const uint4 v = kp[j];
                z = fmaf(q[8 * j], bflo(v.x), z); z = fmaf(q[8 * j + 1], bfhi(v.x), z); z = fmaf(q[8 * j + 2], bflo(v.y), z); z = fmaf(q[8 * j + 3], bfhi(v.y), z);
                z = fmaf(q[8 * j + 4], bflo(v.z), z); z = fmaf(q[8 * j + 5], bfhi(v.z), z); z = fmaf(q[8 * j + 6], bflo(v.w), z); z = fmaf(q[8 * j + 7], bfhi(v.w), z); }
            const float mn = fmaxf(mx, z), corr = __expf(mx - mn), pe = __expf(z - mn);
            mx = mn; l = l * corr + pe;
#pragma unroll
            for (int j = 0; j < 8; ++j) { const uint4 v = vp[j];
                o[8 * j] = fmaf(pe, bflo(v.x), o[8 * j] * corr); o[8 * j + 1] = fmaf(pe, bfhi(v.x), o[8 * j + 1] * corr); o[8 * j + 2] = fmaf(pe, bflo(v.y), o[8 * j + 2] * corr); o[8 * j + 3] = fmaf(pe, bfhi(v.y), o[8 * j + 3] * corr);
                o[8 * j + 4] = fmaf(pe, bflo(v.z), o[8 * j + 4] * corr); o[8 * j + 5] = fmaf(pe, bfhi(v.z), o[8 * j + 5] * corr); o[8 * j + 6] = fmaf(pe, bflo(v.w), o[8 * j + 6] * corr); o[8 * j + 7] = fmaf(pe, bfhi(v.w), o[8 * j + 7] * corr); }
        }
        const float il = 1.f / l;
        uint4* op = (uint4*)(mixed + (size_t)tok * DM + 768 + h * 64);
#pragma unroll
        for (int j = 0; j < 8; ++j) { uint4 w; w.x = pk2(o[8 * j] * il, o[8 * j + 1] * il); w.y = pk2(o[8 * j + 2] * il, o[8 * j + 3] * il); w.z = pk2(o[8 * j + 4] * il, o[8 * j + 5] * il); w.w = pk2(o[8 * j + 6] * il, o[8 * j + 7] * il); op[j] = w; }
    }
}


__device__ __forceinline__ unsigned cvtpk(float lo, float hi) { unsigned r; asm("v_cvt_pk_bf16_f32 %0, %1, %2" : "=v"(r) : "v"(lo), "v"(hi)); return r; }
__device__ __forceinline__ sh8_t frag8(const float (&x)[8]) { const u4_t w = {cvtpk(x[0], x[1]), cvtpk(x[2], x[3]), cvtpk(x[4], x[5]), cvtpk(x[6], x[7])}; return __builtin_bit_cast(sh8_t, w); }
__device__ __forceinline__ int kperm(int key) { return (key & 16) | ((key & 4) << 1) | ((key & 8) >> 1) | (key & 3); }
__device__ __forceinline__ void vt_store(LAS bf16_t* VT, int pitch, int d0, int pos, const u4_t v) {
    LAS bf16_t* d = VT + d0 * pitch + pos;
    d[0 * pitch] = (bf16_t)(v.x & 0xffff); d[1 * pitch] = (bf16_t)(v.x >> 16); d[2 * pitch] = (bf16_t)(v.y & 0xffff); d[3 * pitch] = (bf16_t)(v.y >> 16);
    d[4 * pitch] = (bf16_t)(v.z & 0xffff); d[5 * pitch] = (bf16_t)(v.z >> 16); d[6 * pitch] = (bf16_t)(v.w & 0xffff); d[7 * pitch] = (bf16_t)(v.w >> 16);
}
__device__ __forceinline__ void sb_mfma(const Params& p, unsigned char* ldsb) {
    const bf16_t* P = (const bf16_t*)(p.ws + WS_P);
    bf16_t* mixed = (bf16_t*)(p.ws + WS_MIXED);
    const int tid = threadIdx.x, lane = tid & 63, wave = tid >> 6, r = lane & 31, hh = lane >> 5;
    LAS bf16_t* VT = (LAS bf16_t*)ldsb + wave * (64 * 40);
    sh8_t mf[2];
#pragma unroll
    for (int ks = 0; ks < 2; ++ks)
#pragma unroll
        for (int e = 0; e < 8; ++e) { const int j = 16 * ks + 8 * (e >> 2) + 4 * hh + (e & 3); mf[ks][e] = (j > r) ? (short)0x3F80 : (short)0; }
    for (int u = blockIdx.x * 8 + wave; u < 32 * 256; u += gridDim.x * 8) {
        const int bh = u >> 8, qt = u & 255, b = bh >> 3, h = bh & 7;
        const size_t tok0 = (size_t)b * SEQ + qt * 32;
        sh8_t qf[4];
        { const bf16_t* qp = P + (tok0 + r) * INW + C_SBQ + h * 64 + 8 * hh;
#pragma unroll
          for (int ks = 0; ks < 4; ++ks) qf[ks] = *(const sh8_t*)(qp + 16 * ks); }
        f32x16 o0, o1;
#pragma unroll
        for (int i = 0; i < 16; ++i) { o0[i] = 0.f; o1[i] = 0.f; }
        float R = 0.f;
        for (int kt = qt; kt >= 0; --kt) {
            const size_t ktok0 = (size_t)b * SEQ + kt * 32;
            f32x16 z;
#pragma unroll
            for (int i = 0; i < 16; ++i) z[i] = 0.f;
            { const bf16_t* kp = P + (ktok0 + r) * INW + C_SBK + h * 64 + 8 * hh;
#pragma unroll
              for (int ks = 0; ks < 4; ++ks) z = __builtin_amdgcn_mfma_f32_32x32x16_bf16(*(const sh8_t*)(kp + 16 * ks), qf[ks], z, 0, 0, 0); }
#pragma unroll
            for (int i = 0; i < 4; ++i) { const int idx = lane + 64 * i, key = idx >> 3, dq = idx & 7;
                const u4_t v = *(const u4_t*)(P + (ktok0 + key) * INW + C_SBV + h * 64 + dq * 8);
                vt_store(VT, 40, dq * 8, kperm(key), v); }
            const bool diag = (kt == qt);
            float sp[16]; f32x16 la; float tot = 0.f;
#pragma unroll
            for (int i = 0; i < 16; ++i) { const float zz = z[i];
                float s = fmaxf(zz, 0.f) + __builtin_amdgcn_logf(1.f + __builtin_amdgcn_exp2f(-fabsf(zz)));
                const bool valid = !diag || (crow(i, hh) < r);
                la[i] = zz - s + R; s = valid ? s : 0.f; sp[i] = s; tot += s; }
            tot += __shfl_xor(tot, 32);
#pragma unroll
            for (int ks = 0; ks < 2; ++ks) {
                unsigned hi[4], lo[4];
#pragma unroll
                for (int e = 0; e < 4; ++e) { const float x0 = -sp[8 * ks + 2 * e], x1 = -sp[8 * ks + 2 * e + 1]; hi[e] = cvtpk(x0, x1); lo[e] = cvtpk(x0 - bflo(hi[e]), x1 - bfhi(hi[e])); }
                const u4_t hv = {hi[0], hi[1], hi[2], hi[3]}, lv = {lo[0], lo[1], lo[2], lo[3]};
                la = __builtin_amdgcn_mfma_f32_32x32x16_bf16(mf[ks], __builtin_bit_cast(sh8_t, hv), la, 0, 0, 0);
                la = __builtin_amdgcn_mfma_f32_32x32x16_bf16(mf[ks], __builtin_bit_cast(sh8_t, lv), la, 0, 0, 0);
            }
            sh8_t af[2];
#pragma unroll
            for (int ks = 0; ks < 2; ++ks) { float a[8];
#pragma unroll
                for (int e = 0; e < 8; ++e) { const int i = 8 * ks + e; const bool valid = !diag || (crow(i, hh) < r); a[e] = valid ? __builtin_amdgcn_exp2f(la[i]) : 0.f; }
                af[ks] = frag8(a); }
            R -= tot;
#pragma unroll
            for (int ks = 0; ks < 2; ++ks) {
                o0 = __builtin_amdgcn_mfma_f32_32x32x16_bf16(*(const LAS sh8_t*)(VT + r * 40 + 16 * ks + 8 * hh), af[ks], o0, 0, 0, 0);
                o1 = __builtin_amdgcn_mfma_f32_32x32x16_bf16(*(const LAS sh8_t*)(VT + (32 + r) * 40 + 16 * ks + 8 * hh), af[ks], o1, 0, 0, 0);
            }
            if (__all(R < -160.f)) break;
        }
        float ss = 0.f;
#pragma unroll
        for (int i = 0; i < 16; ++i) { ss = fmaf(o0[i], o0[i], ss); ss = fmaf(o1[i], o1[i], ss); }
        ss += __shfl_xor(ss, 32);
        const float rn = rsqrtf(ss * (1.f / 64.f) + EPS);
        bf16_t* op = mixed + (tok0 + r) * DM + h * 64 + 4 * hh;
        const float* gp = p.sb_gain + h * 64 + 4 * hh;
#pragma unroll
        for (int q4 = 0; q4 < 4; ++q4) {
            const float4 g0 = *(const float4*)(gp + 8 * q4), g1 = *(const float4*)(gp + 32 + 8 * q4);
            uint2 w0, w1;
            w0.x = cvtpk(o0[4 * q4] * rn * g0.x, o0[4 * q4 + 1] * rn * g0.y); w0.y = cvtpk(o0[4 * q4 + 2] * rn * g0.z, o0[4 * q4 + 3] * rn * g0.w);
            w1.x = cvtpk(o1[4 * q4] * rn * g1.x, o1[4 * q4 + 1] * rn * g1.y); w1.y = cvtpk(o1[4 * q4 + 2] * rn * g1.z, o1[4 * q4 + 3] * rn * g1.w);
            *(uint2*)(op + 8 * q4) = w0; *(uint2*)(op + 32 + 8 * q4) = w1;
        }
    }
}
__device__ __forceinline__ void mem_attn_mfma(const Params& p, unsigned char* ldsb) {
    const bf16_t* P = (const bf16_t*)(p.ws + WS_P);
    const bf16_t* mk = (const bf16_t*)(p.ws + WS_MEMK); const bf16_t* mv = (const bf16_t*)(p.ws + WS_MEMV);
    bf16_t* mixed = (bf16_t*)(p.ws + WS_MIXED);
    const int tid = threadIdx.x, lane = tid & 63, wave = tid >> 6, r = lane & 31, hh = lane >> 5;
    LAS bf16_t* VT = (LAS bf16_t*)ldsb;
    for (int unit = blockIdx.x; unit < NB * 4 * (SEQ / 256); unit += gridDim.x) {
        const int tb = unit & 31, hd = (unit >> 5) & 3, b = unit >> 7;
        __syncthreads();
#pragma unroll
        for (int i = 0; i < 4; ++i) { const int idx = tid + 512 * i, key = idx >> 3, dq = idx & 7;
            const u4_t v = *(const u4_t*)(mv + ((size_t)b * NMEM + key) * 256 + hd * 64 + dq * 8);
            vt_store(VT, 264, dq * 8, (key & ~31) | kperm(key & 31), v); }
        __syncthreads();
        const size_t tok = (size_t)b * SEQ + tb * 256 + wave * 32 + r;
        sh8_t qf[4];
        { const bf16_t* qp = P + tok * INW + C_MQ + hd * 64 + 8 * hh;
          float qv[32]; float ss = 0.f;
#pragma unroll
          for (int ks = 0; ks < 4; ++ks) { const u4_t w = *(const u4_t*)(qp + 16 * ks);
              qv[8 * ks] = bflo(w.x); qv[8 * ks + 1] = bfhi(w.x); qv[8 * ks + 2] = bflo(w.y); qv[8 * ks + 3] = bfhi(w.y); qv[8 * ks + 4] = bflo(w.z); qv[8 * ks + 5] = bfhi(w.z); qv[8 * ks + 6] = bflo(w.w); qv[8 * ks + 7] = bfhi(w.w); }
#pragma unroll
          for (int i = 0; i < 32; ++i) ss = fmaf(qv[i], qv[i], ss);
          ss += __shfl_xor(ss, 32);
          const float rq = rsqrtf(ss * (1.f / 64.f) + EPS) * (0.125f * LOG2E);
#pragma unroll
          for (int ks = 0; ks < 4; ++ks) { float t8[8];
#pragma unroll
              for (int e = 0; e < 8; ++e) t8[e] = qv[8 * ks + e] * rq * p.mq_gain[16 * ks + 8 * hh + e];
              qf[ks] = frag8(t8); } }
        f32x16 s[8];
#pragma unroll
        for (int kt = 0; kt < 8; ++kt) {
#pragma unroll
            for (int i = 0; i < 16; ++i) s[kt][i] = 0.f;
            const bf16_t* kp = mk + ((size_t)b * NMEM + kt * 32 + r) * 256 + hd * 64 + 8 * hh;
#pragma unroll
            for (int ks = 0; ks < 4; ++ks) s[kt] = __builtin_amdgcn_mfma_f32_32x32x16_bf16(*(const sh8_t*)(kp + 16 * ks), qf[ks], s[kt], 0, 0, 0);
        }
        float mx = -1e30f;
#pragma unroll
        for (int kt = 0; kt < 8; ++kt)
#pragma unroll
            for (int i = 0; i < 16; ++i) mx = fmaxf(mx, s[kt][i]);
        mx = fmaxf(mx, __shfl_xor(mx, 32));
        float lsum = 0.f;
        f32x16 o0, o1;
#pragma unroll
        for (int i = 0; i < 16; ++i) { o0[i] = 0.f; o1[i] = 0.f; }
#pragma unroll
        for (int kt = 0; kt < 8; ++kt)
#pragma unroll
            for (int ks = 0; ks < 2; ++ks) { float a[8];
#pragma unroll
                for (int e = 0; e < 8; ++e) { a[e] = __builtin_amdgcn_exp2f(s[kt][8 * ks + e] - mx); lsum += a[e]; }
                const sh8_t af = frag8(a);
                o0 = __builtin_amdgcn_mfma_f32_32x32x16_bf16(*(const LAS sh8_t*)(VT + r * 264 + 32 * kt + 16 * ks + 8 * hh), af, o0, 0, 0, 0);
                o1 = __builtin_amdgcn_mfma_f32_32x32x16_bf16(*(const LAS sh8_t*)(VT + (32 + r) * 264 + 32 * kt + 16 * ks + 8 * hh), af, o1, 0, 0, 0); }
        lsum += __shfl_xor(lsum, 32);
        const float il = 1.f / lsum;
        bf16_t* op = mixed + tok * DM + 768 + hd * 64 + 4 * hh;
#pragma unroll
        for (int q4 = 0; q4 < 4; ++q4) {
            uint2 w0, w1;
            w0.x = cvtpk(o0[4 * q4] * il, o0[4 * q4 + 1] * il); w0.y = cvtpk(o0[4 * q4 + 2] * il, o0[4 * q4 + 3] * il);
            w1.x = cvtpk(o1[4 * q4] * il, o1[4 * q4 + 1] * il); w1.y = cvtpk(o1[4 * q4 + 2] * il, o1[4 * q4 + 3] * il);
            *(uint2*)(op + 8 * q4) = w0; *(uint2*)(op + 32 + 8 * q4) = w1;
        }
    }
}

__device__ __forceinline__ void rstd2_rows(const Params& p) {
    float* rs = (float*)(p.ws + WS_RSTD2);
    const int lane = threadIdx.x & 63, wave = threadIdx.x >> 6;
    for (int m = blockIdx.x * 8 + wave; m < T; m += gridDim.x * 8) {
        const float4* xr = (const float4*)(p.out + (size_t)m * DM) + lane; float s = 0.f;
#pragma unroll
        for (int j = 0; j < 4; ++j) { const float4 v = xr[64 * j]; s += (v.x * v.x + v.y * v.y) + (v.z * v.z + v.w * v.w); }
        s = wave_sum(s);
        if (lane == 0) rs[m] = rsqrtf(s * (1.f / DM) + EPS);
    }
}

__device__ __forceinline__ void wave_argmax(float& v, int& i) {
#pragma unroll
    for (int o = 32; o >= 1; o >>= 1) { const float ov = __shfl_xor(v, o); const int oi = __shfl_xor(i, o); if (ov > v || (ov == v && oi < i)) { v = ov; i = oi; } }
}
__device__ __forceinline__ void topk_naive(const Params& p, unsigned char* ldsb) {
    const bf16_t* Q = (const bf16_t*)(p.ws + WS_Q);
    const bf16_t* SK = (const bf16_t*)(p.ws + WS_SKB);
    int* pidx = (int*)(p.ws + WS_PIDX); float* pg = (float*)(p.ws + WS_PG);
    const int lane = threadIdx.x & 63, wave = threadIdx.x >> 6;
    float* tsv = (float*)ldsb + wave * 128;
    int* tsi = (int*)tsv + 32;
    float* bsv = tsv + 64; int* bse = (int*)tsv + 80;
    for (int it = blockIdx.x * 8 + wave; it < T * 8; it += gridDim.x * 8) {
        const int tok = it >> 3, h = it & 7;
        for (int c = 0; c < 2; ++c) {
            const uint4* qp = (const uint4*)(Q + (size_t)tok * 2048 + h * 256 + c * 128);
            const uint4* k0 = (const uint4*)(SK + ((size_t)(h * 2 + c) * 128 + lane) * 128);
            const uint4* k1 = (const uint4*)(SK + ((size_t)(h * 2 + c) * 128 + lane + 64) * 128);
            float s0 = 0.f, s1 = 0.f;
            for (int j = 0; j < 16; ++j) { const uint4 qv = qp[j], a = k0[j], bq = k1[j];
                s0 = fmaf(bflo(qv.x), bflo(a.x), s0); s0 = fmaf(bfhi(qv.x), bfhi(a.x), s0); s0 = fmaf(bflo(qv.y), bflo(a.y), s0); s0 = fmaf(bfhi(qv.y), bfhi(a.y), s0);
                s0 = fmaf(bflo(qv.z), bflo(a.z), s0); s0 = fmaf(bfhi(qv.z), bfhi(a.z), s0); s0 = fmaf(bflo(qv.w), bflo(a.w), s0); s0 = fmaf(bfhi(qv.w), bfhi(a.w), s0);
                s1 = fmaf(bflo(qv.x), bflo(bq.x), s1); s1 = fmaf(bfhi(qv.x), bfhi(bq.x), s1); s1 = fmaf(bflo(qv.y), bflo(bq.y), s1); s1 = fmaf(bfhi(qv.y), bfhi(bq.y), s1);
                s1 = fmaf(bflo(qv.z), bflo(bq.z), s1); s1 = fmaf(bfhi(qv.z), bfhi(bq.z), s1); s1 = fmaf(bflo(qv.w), bflo(bq.w), s1); s1 = fmaf(bfhi(qv.w), bfhi(bq.w), s1); }
            for (int r = 0; r < 16; ++r) {
                float v = s0; int i = lane; if (s1 > s0) { v = s1; i = lane + 64; }
                wave_argmax(v, i);
                if (lane == 0) { tsv[c * 16 + r] = v; tsi[c * 16 + r] = i; }
                if (i == lane) s0 = -INFINITY; if (i == lane + 64) s1 = -INFINITY;
            }
        }
        __builtin_amdgcn_s_waitcnt(0); __builtin_amdgcn_wave_barrier();
        float cs[4];
#pragma unroll
        for (int u = 0; u < 4; ++u) { const int id = lane * 4 + u; cs[u] = tsv[id >> 4] + tsv[16 + (id & 15)]; }
        for (int r = 0; r < 16; ++r) {
            float v = cs[0]; int i = lane * 4;
#pragma unroll
            for (int u = 1; u < 4; ++u) if (cs[u] > v) { v = cs[u]; i = lane * 4 + u; }
            wave_argmax(v, i);
            if (lane == 0) { bsv[r] = v; bse[r] = tsi[i >> 4] * 128 + tsi[16 + (i & 15)]; }
#pragma unroll
            for (int u = 0; u < 4; ++u) if (i == lane * 4 + u) cs[u] = -INFINITY;
        }
        __builtin_amdgcn_s_waitcnt(0); __builtin_amdgcn_wave_barrier();
        { const float mxv = bsv[0]; float e = (lane < 16) ? __expf(bsv[lane & 15] - mxv) : 0.f;
          float s = e; s += __shfl_xor(s, 1); s += __shfl_xor(s, 2); s += __shfl_xor(s, 4); s += __shfl_xor(s, 8);
          if (lane < 16) { pidx[(size_t)tok * PK + h * 16 + lane] = bse[lane]; pg[(size_t)tok * PK + h * 16 + lane] = e / s; } }
        __builtin_amdgcn_s_waitcnt(0); __builtin_amdgcn_wave_barrier();
    }
}

__device__ __forceinline__ void peer_naive(const Params& p, unsigned char* ldsb) {
    const int* pidx = (const int*)(p.ws + WS_PIDX); const float* pg = (const float*)(p.ws + WS_PG);
    const float* rs = (const float*)(p.ws + WS_RSTD2);
    float* hs = (float*)ldsb;
    float* red = hs + 1024;
    const int tid = threadIdx.x, lane = tid & 63, wave = tid >> 6;
    for (int tok = blockIdx.x; tok < T; tok += gridDim.x) {
        const float r2 = rs[tok];
        for (int d = tid; d < DM; d += NTHR) hs[d] = p.out[(size_t)tok * DM + d] * r2 * p.g_ffn[d];
        __syncthreads();
        float4 hv[4];
#pragma unroll
        for (int j = 0; j < 4; ++j) hv[j] = *((const float4*)hs + lane + 64 * j);
        float4 acc[4];
#pragma unroll
        for (int j = 0; j < 4; ++j) acc[j] = make_float4(0.f, 0.f, 0.f, 0.f);
        for (int pi = wave; pi < PK; pi += 8) {
            const int e = pidx[(size_t)tok * PK + pi]; const float g = pg[(size_t)tok * PK + pi];
            const float4* up = (const float4*)(p.pu + (size_t)e * DM) + lane;
            const float4* vp = (const float4*)(p.pv + (size_t)e * DM) + lane;
            float s = 0.f;
#pragma unroll
            for (int j = 0; j < 4; ++j) { const float4 u = up[64 * j]; s += (hv[j].x * u.x + hv[j].y * u.y) + (hv[j].z * u.z + hv[j].w * u.w); }
            s = wave_sum(s);
            const float w = g * 0.5f * s * (1.f + erff(s * 0.70710678118654752f));
#pragma unroll
            for (int j = 0; j < 4; ++j) { const float4 v = vp[64 * j]; acc[j].x = fmaf(w, v.x, acc[j].x); acc[j].y = fmaf(w, v.y, acc[j].y); acc[j].z = fmaf(w, v.z, acc[j].z); acc[j].w = fmaf(w, v.w, acc[j].w); }
        }
#pragma unroll
        for (int j = 0; j < 4; ++j) *((float4*)(red + wave * 1024) + lane + 64 * j) = acc[j];
        __syncthreads();
        for (int d = tid; d < DM; d += NTHR) { float s = 0.f;
#pragma unroll
            for (int w = 0; w < 8; ++w) s += red[w * 1024 + d];
            p.out[(size_t)tok * DM + d] += s; }
        __syncthreads();
    }
}


__device__ __forceinline__ int tk_pack(float s, int payload, int mask) { const int b = __float_as_int(s); const int m = b ^ ((b >> 31) & 0x7fffffff); return (m & ~mask) | payload; }
__device__ __forceinline__ float tk_unpack(int key, int mask) { const int m = key & ~mask; return __int_as_float(m ^ ((m >> 31) & 0x7fffffff)); }
template <int N> __device__ __forceinline__ void bitonic_sort_desc(int (&v)[N]) {
#pragma unroll
    for (int k = 2; k <= N; k <<= 1)
#pragma unroll
        for (int j = k >> 1; j > 0; j >>= 1)
#pragma unroll
            for (int i = 0; i < N; ++i) { const int l = i ^ j; if (l > i) { const bool desc = ((i & k) == 0); const int a = v[i], b = v[l]; const int hi = max(a, b), lo = min(a, b); v[i] = desc ? hi : lo; v[l] = desc ? lo : hi; } }
}
__device__ __forceinline__ void merge_top16(int (&A)[16], const int (&B)[16]) {
#pragma unroll
    for (int i = 0; i < 16; ++i) A[i] = max(A[i], B[15 - i]);
#pragma unroll
    for (int j = 8; j > 0; j >>= 1)
#pragma unroll
        for (int i = 0; i < 16; ++i) { const int l = i ^ j; if (l > i) { const int a = A[i], b = A[l]; A[i] = max(a, b); A[l] = min(a, b); } }
}
__device__ __forceinline__ void top16_of_64(int (&g0)[16], int (&g1)[16], int (&g2)[16], int (&g3)[16]) {
    bitonic_sort_desc<16>(g0); bitonic_sort_desc<16>(g1); bitonic_sort_desc<16>(g2); bitonic_sort_desc<16>(g3);
    merge_top16(g0, g1); merge_top16(g2, g3); merge_top16(g0, g2);
}
__device__ __forceinline__ void topk_mfma(const Params& p, unsigned char* ldsb) {
    const bf16_t* Q = (const bf16_t*)(p.ws + WS_Q);
    const bf16_t* SK = (const bf16_t*)(p.ws + WS_SKB);
    int* pidx = (int*)(p.ws + WS_PIDX); float* pg = (float*)(p.ws + WS_PG);
    LAS unsigned char* l = (LAS unsigned char*)ldsb;
    LAS bf16_t* SKL = (LAS bf16_t*)l;
    const int tid = threadIdx.x, lane = tid & 63, wave = tid >> 6, r = lane & 31, hh = lane >> 5;
    LAS unsigned char* ib = l + 69632 + (wave * 64 + lane) * 36;
    int cur_h = -1;
    for (int unit = blockIdx.x; unit < 8 * (T / 256); unit += gridDim.x) {
        const int h = unit & 7, tb = unit >> 3;
        if (h != cur_h) {
            __syncthreads();
#pragma unroll
            for (int it = 0; it < 8; ++it) { const int idx = tid + 512 * it, row = idx >> 4, cq = idx & 15;
                *(LAS u4_t*)(SKL + row * 136 + cq * 8) = *(const u4_t*)(SK + ((size_t)h * 256 + row) * 128 + cq * 8); }
            __syncthreads();
            cur_h = h;
        }
        const int tok = tb * 256 + wave * 32 + r;
        int sorted[2][16];
#pragma unroll
        for (int c = 0; c < 2; ++c) {
            sh8_t qf[8];
            { const sh8_t* qp = (const sh8_t*)(Q + (size_t)tok * 2048 + h * 256 + c * 128 + 8 * hh);
#pragma unroll
              for (int ks = 0; ks < 8; ++ks) qf[ks] = qp[2 * ks]; }
            int g[4][16];
#pragma unroll
            for (int mt = 0; mt < 4; ++mt) {
                f32x16 acc;
#pragma unroll
                for (int i = 0; i < 16; ++i) acc[i] = 0.f;
                const LAS bf16_t* ap = SKL + (c * 128 + 32 * mt + r) * 136 + 8 * hh;
#pragma unroll
                for (int ks = 0; ks < 8; ++ks) acc = __builtin_amdgcn_mfma_f32_32x32x16_bf16(*(const LAS sh8_t*)(ap + 16 * ks), qf[ks], acc, 0, 0, 0);
#pragma unroll
                for (int i = 0; i < 16; ++i) g[mt][i] = tk_pack(acc[i], (32 * mt + (i & 3) + 8 * (i >> 2)) | (hh << 2), 127);
            }
            top16_of_64(g[0], g[1], g[2], g[3]);
            int o[16];
#pragma unroll
            for (int i = 0; i < 16; ++i) o[i] = __shfl_xor(g[0][i], 32);
            merge_top16(g[0], o);
#pragma unroll
            for (int i = 0; i < 16; ++i) sorted[c][i] = g[0][i];
        }
#pragma unroll
        for (int c = 0; c < 2; ++c)
#pragma unroll
            for (int w = 0; w < 4; ++w)
                *(LAS unsigned*)(ib + c * 16 + w * 4) = (unsigned)(sorted[c][4 * w] & 127) | ((unsigned)(sorted[c][4 * w + 1] & 127) << 8) | ((unsigned)(sorted[c][4 * w + 2] & 127) << 16) | ((unsigned)(sorted[c][4 * w + 3] & 127) << 24);
        float av[16], bv[16];
#pragma unroll
        for (int i = 0; i < 16; ++i) { av[i] = tk_unpack(sorted[0][i], 127); bv[i] = tk_unpack(sorted[1][i], 127); }
        int cd[4][16];
        {
            int n = 0;
#pragma unroll
            for (int i = 0; i < 16; ++i)
#pragma unroll
                for (int j = 0; j < 16; ++j)
                    if ((i + 1) * (j + 1) <= 16) { cd[n >> 4][n & 15] = tk_pack(av[i] + bv[j], i * 16 + j, 255); ++n; }
#pragma unroll
            for (; n < 64; ++n) cd[n >> 4][n & 15] = (int)0x80000000;
        }
        top16_of_64(cd[0], cd[1], cd[2], cd[3]);
        float sv[16]; int ex[16];
        const float s0 = tk_unpack(cd[0][0], 255);
        float sum = 0.f;
#pragma unroll
        for (int q = 0; q < 16; ++q) { const int key = cd[0][q]; const int id = key & 255;
            const int ia = ib[id >> 4], ibx = ib[16 + (id & 15)];
            ex[q] = ia * 128 + ibx; sv[q] = __expf(tk_unpack(key, 255) - s0); sum += sv[q]; }
        const float inv = 1.f / sum;
        if (hh == 0) { u4_t* d = (u4_t*)(pidx + (size_t)tok * PK + h * 16);
#pragma unroll
            for (int w = 0; w < 4; ++w) d[w] = (u4_t){(unsigned)ex[4 * w], (unsigned)ex[4 * w + 1], (unsigned)ex[4 * w + 2], (unsigned)ex[4 * w + 3]}; }
        else { float4* d = (float4*)(pg + (size_t)tok * PK + h * 16);
#pragma unroll
            for (int w = 0; w < 4; ++w) d[w] = make_float4(sv[4 * w] * inv, sv[4 * w + 1] * inv, sv[4 * w + 2] * inv, sv[4 * w + 3] * inv); }
    }
}

__device__ __forceinline__ void peer_u_phase(const Params& p) {
    const int lane = threadIdx.x & 63, wave = threadIdx.x >> 6, g = lane >> 4, c = lane & 15;
    const int slice = blockIdx.x & 7, rank = blockIdx.x >> 3, nrank = gridDim.x >> 3;
    const bf16_t* xb = (const bf16_t*)(p.ws + WS_XB); const int* pidx = (const int*)(p.ws + WS_PIDX);
    const bf16_t* U = (const bf16_t*)(p.ws + WS_U16) + slice * 128 + c * 8;
    float* PU = (float*)(p.ws + WS_PU) + (size_t)slice * T * PK;
    for (int t = rank * 8 + wave; t < T; t += nrank * 8) {
        const uint4 hv = *(const uint4*)(xb + (size_t)t * DM + slice * 128 + c * 8);
        const uint4* ip = (const uint4*)(pidx + (size_t)t * PK + g * 32);
#pragma unroll 1
        for (int rd = 0; rd < 2; ++rd) {
            int e[16];
#pragma unroll
            for (int j = 0; j < 4; ++j) { const uint4 q = ip[rd * 4 + j]; e[4 * j] = q.x; e[4 * j + 1] = q.y; e[4 * j + 2] = q.z; e[4 * j + 3] = q.w; }
            float pr[16];
#pragma unroll
            for (int i = 0; i < 16; ++i) { const uint4 uv = *(const uint4*)(U + (size_t)e[i] * DM);
                float s = dot2bf(hv.x, uv.x, 0.f); s = dot2bf(hv.y, uv.y, s); s = dot2bf(hv.z, uv.z, s); s = dot2bf(hv.w, uv.w, s); pr[i] = s; }
#pragma unroll
            for (int s = 8; s >= 1; s >>= 1)
#pragma unroll
                for (int j = 0; j < s; ++j) { const bool up = (c & s) != 0; const float keep = up ? pr[j + s] : pr[j], send = up ? pr[j] : pr[j + s]; pr[j] = keep + __shfl_xor(send, s); }
            PU[(size_t)t * PK + g * 32 + rd * 16 + c] = pr[0];
        }
    }
}
__device__ __forceinline__ void peer_w_phase(const Params& p) {
    const float* PU = (const float*)(p.ws + WS_PU); const float* pg = (const float*)(p.ws + WS_PG); const float* rs = (const float*)(p.ws + WS_RSTD2);
    float* pw = (float*)(p.ws + WS_PW);
    for (int i = blockIdx.x * NTHR + threadIdx.x; i < T * PK; i += gridDim.x * NTHR) {
        float s = 0.f;
#pragma unroll
        for (int x = 0; x < 8; ++x) s += PU[(size_t)x * T * PK + i];
        s *= rs[i >> 7];
        pw[i] = pg[i] * 0.5f * s * (1.f + erff(s * 0.70710678118654752f));
    }
}
__device__ __forceinline__ void peer_v_phase(const Params& p) {
    const int lane = threadIdx.x & 63, wave = threadIdx.x >> 6, g = lane >> 4, c = lane & 15;
    const int slice = blockIdx.x & 7, rank = blockIdx.x >> 3, nrank = gridDim.x >> 3;
    const int* pidx = (const int*)(p.ws + WS_PIDX); const float* pw = (const float*)(p.ws + WS_PW);
    const _Float16* V = (const _Float16*)(p.ws + WS_V16) + slice * 128 + c * 8;
    for (int t = rank * 8 + wave; t < T; t += nrank * 8) {
        const uint4* ip = (const uint4*)(pidx + (size_t)t * PK + g * 32);
        const float4* wp = (const float4*)(pw + (size_t)t * PK + g * 32);
        float acc[8];
#pragma unroll
        for (int k = 0; k < 8; ++k) acc[k] = 0.f;
#pragma unroll 1
        for (int rd = 0; rd < 2; ++rd) {
            int e[16]; float w[16];
#pragma unroll
            for (int j = 0; j < 4; ++j) { const uint4 q = ip[rd * 4 + j]; e[4 * j] = q.x; e[4 * j + 1] = q.y; e[4 * j + 2] = q.z; e[4 * j + 3] = q.w;
                const float4 f = wp[rd * 4 + j]; w[4 * j] = f.x; w[4 * j + 1] = f.y; w[4 * j + 2] = f.z; w[4 * j + 3] = f.w; }
#pragma unroll
            for (int i = 0; i < 16; ++i) { const h8_t vv = *(const h8_t*)(V + (size_t)e[i] * DM);
#pragma unroll
                for (int k = 0; k < 8; ++k) acc[k] = fmaf((float)vv[k], w[i], acc[k]); }
        }
#pragma unroll
        for (int k = 0; k < 8; ++k) { acc[k] += __shfl_xor(acc[k], 16); acc[k] += __shfl_xor(acc[k], 32); }
        if (g == 0) { float4* op = (float4*)(p.out + (size_t)t * DM + slice * 128 + c * 8);
            float4 a = op[0], b = op[1];
            a.x += acc[0]; a.y += acc[1]; a.z += acc[2]; a.w += acc[3]; b.x += acc[4]; b.y += acc[5]; b.z += acc[6]; b.w += acc[7];
            op[0] = a; op[1] = b; }
    }
}

__global__ void __launch_bounds__(NTHR, 2) fwd_kernel(Params p) {
    extern __shared__ __attribute__((aligned(16))) unsigned char lds[];
    cg::grid_group grid = cg::this_grid();
    unsigned char* ws = p.ws;
    PG8_LAS unsigned char* ldsl = (PG8_LAS unsigned char*)lds;
    phase_prep(p, lds);
    grid.sync();
    { pg8::Gemm g{(const bf16_t*)(ws + WS_XB), (const bf16_t*)(ws + WS_WIN_T), T, INW, DM}; pg8::StaticOrder S; S.init(T, INW, gridDim.x, blockIdx.x); pg8::EpiProjM e{(bf16_t*)(ws + WS_P)};
      pg8::gemm_phase<pg8::EpiProjM, pg8::StaticOrder, true, true>(ldsl, g, S, e); }
    { pg8::Gemm g{(const bf16_t*)(ws + WS_MEMN), (const bf16_t*)(ws + WS_WMKV_T), NB * NMEM, 512, DM}; pg8::StaticOrder S; S.init(NB * NMEM, 512, gridDim.x, blockIdx.x); pg8::EpiF32M e{(float*)(ws + WS_MEMKV), 512};
      pg8::gemm_phase<pg8::EpiF32M, pg8::StaticOrder, true, true>(ldsl, g, S, e); }
    grid.sync();
    mem_knorm(p);
    sb_mfma(p, lds);
    __syncthreads();
    hg_local(p, lds);
    grid.sync();
    hg_scan(p);
    mem_attn_mfma(p, lds);
    grid.sync();
    hg_out(p, lds);
    grid.sync();
    { pg8::Gemm g{(const bf16_t*)(ws + WS_MIXED), (const bf16_t*)(ws + WS_WOUT_T), T, DM, DM}; pg8::StaticOrder S; S.init(T, DM, gridDim.x, blockIdx.x); pg8::EpiWoutM e{p.x, p.out, (bf16_t*)(ws + WS_XB)};
      pg8::gemm_phase<pg8::EpiWoutM, pg8::StaticOrder, true, true>(ldsl, g, S, e); }
    grid.sync();
    rstd2_rows(p);
    grid.sync();
    { pg8::Gemm g{(const bf16_t*)(ws + WS_XB), (const bf16_t*)(ws + WS_WQ_T), T, 2048, DM}; pg8::StaticOrder S; S.init(T, 2048, gridDim.x, blockIdx.x); pg8::EpiQM e{(const float*)(ws + WS_RSTD2), (bf16_t*)(ws + WS_Q)};
      pg8::gemm_phase<pg8::EpiQM, pg8::StaticOrder, true, true>(ldsl, g, S, e); }
    grid.sync();
    topk_mfma(p, lds);
    grid.sync();
    peer_u_phase(p);
    grid.sync();
    peer_w_phase(p);
    grid.sync();
    peer_v_phase(p);
}

extern "C" void kernel_launch(void* const* d_in, const int* in_sizes, int n_in, void* d_out, int out_size, void* d_ws, size_t ws_size, hipStream_t stream) {
    static int grid_blocks = 0;
    if (grid_blocks == 0) {
        if (n_in != 17 || out_size != T * DM || ws_size < WS_END) { fprintf(stderr, "kernel_launch: unexpected shapes n_in %d out %d ws %zu\n", n_in, out_size, ws_size); grid_blocks = -1; return; }
        int dev = 0, cus = 0, per_cu = 0;
        (void)hipGetDevice(&dev);
        (void)hipDeviceGetAttribute(&cus, hipDeviceAttributeMultiprocessorCount, dev);
        (void)hipFuncSetAttribute((const void*)fwd_kernel, hipFuncAttributeMaxDynamicSharedMemorySize, LDS_BYTES);
        (void)hipOccupancyMaxActiveBlocksPerMultiprocessor(&per_cu, (const void*)fwd_kernel, NTHR, LDS_BYTES);
        if (per_cu < 1) { fprintf(stderr, "kernel_launch: occupancy query says %d blocks/CU\n", per_cu); per_cu = 1; }
        grid_blocks = cus * 1;
        (void)hipGetLastError();
    }
    if (grid_blocks < 0) return;
    Params p{};
    p.x = (const float*)d_in[0]; p.mem = (const float*)d_in[1]; p.g_mix = (const float*)d_in[2]; p.w_in = (const float*)d_in[3]; p.gamma_lb = (const float*)d_in[4];
    p.sb_gain = (const float*)d_in[5]; p.hg_gain = (const float*)d_in[6]; p.mem_gain = (const float*)d_in[7]; p.w_mkv = (const float*)d_in[8]; p.mq_gain = (const float*)d_in[9];
    p.mk_gain = (const float*)d_in[10]; p.w_out = (const float*)d_in[11]; p.g_ffn = (const float*)d_in[12]; p.w_q = (const float*)d_in[13]; p.sub_keys = (const float*)d_in[14];
    p.pu = (const float*)d_in[15]; p.pv = (const float*)d_in[16];
    p.out = (float*)d_out; p.ws = (unsigned char*)d_ws;
    void* args[] = {&p};
    hipError_t e = hipLaunchCooperativeKernel((const void*)fwd_kernel, dim3(grid_blocks), dim3(NTHR), args, LDS_BYTES, stream);
    if (e != hipSuccess) fprintf(stderr, "cooperative launch failed: %s (grid %d)\n", hipGetErrorString(e), grid_blocks);
}
```

```cpp
#include <hip/hip_runtime.h>
#include <hip/hip_cooperative_groups.h>
#include <cstdio>
#include <cstdint>
namespace cg = cooperative_groups;

constexpr int NB = 4, SEQ = 8192, DM = 1024, T = NB * SEQ;
constexpr int NMEM = 256, INW = 3328;
constexpr int C_SBQ = 0, C_SBK = 512, C_SBV = 1024, C_HGQ = 1536, C_HGF = 2048, C_HGI = 2560, C_HGG = 2816, C_MQ = 3072;
constexpr int NEXP = 16384, PK = 128;
constexpr float EPS = 1e-6f;
constexpr float LOG2E = 1.4426950408889634f;
constexpr float C2 = 0.125f * LOG2E;

constexpr int NTHR = 512;
constexpr int LDS_BYTES = 147456;

constexpr size_t MiB = 1u << 20;
constexpr size_t WS_CTL = 0;
constexpr size_t WS_WIN_T = 1 * MiB;
constexpr size_t WS_WOUT_T = 8 * MiB;
constexpr size_t WS_WQ_T = 10 * MiB;
constexpr size_t WS_WMKV_T = 14 * MiB;
constexpr size_t WS_SKB = 15 * MiB;
constexpr size_t WS_LB = 15 * MiB + 512 * 1024;
constexpr size_t WS_MEMN = 16 * MiB;
constexpr size_t WS_MEMKV = 18 * MiB;
constexpr size_t WS_MEMK = 20 * MiB;
constexpr size_t WS_MEMV = 20 * MiB + 512 * 1024;
constexpr size_t WS_RSTD2 = 21 * MiB;
constexpr size_t WS_PIDX = 24 * MiB;
constexpr size_t WS_PG = 40 * MiB;
constexpr size_t WS_XB = 72 * MiB;
constexpr size_t WS_MIXED = 136 * MiB;
constexpr size_t WS_P = 200 * MiB;
constexpr size_t WS_Q = 200 * MiB;
constexpr size_t WS_HGRAW = 408 * MiB;
constexpr size_t WS_PW = 56 * MiB;
constexpr size_t WS_PU = 136 * MiB;
constexpr size_t WS_U16 = 440 * MiB;
constexpr size_t WS_V16 = 472 * MiB;
constexpr size_t WS_END = 512 * MiB;

typedef unsigned short bf16_t;
__device__ __forceinline__ float bf2f(bf16_t v) { return __uint_as_float(((unsigned)v) << 16); }
__device__ __forceinline__ float bflo(unsigned w) { return __uint_as_float(w << 16); }
__device__ __forceinline__ float bfhi(unsigned w) { return __uint_as_float(w & 0xffff0000u); }
__device__ __forceinline__ bf16_t f2bf(float f) { unsigned u = __float_as_uint(f); return (bf16_t)((u + 0x7fffu + ((u >> 16) & 1u)) >> 16); }
__device__ __forceinline__ unsigned pk2(float lo, float hi) { return (unsigned)f2bf(lo) | ((unsigned)f2bf(hi) << 16); }
__device__ __forceinline__ float wave_sum(float v) {
#pragma unroll
    for (int o = 1; o < 64; o <<= 1) v += __shfl_xor(v, o);
    return v;
}
__device__ __forceinline__ float silu(float v) { return v / (1.f + __expf(-v)); }

typedef _Float16 h8_t __attribute__((ext_vector_type(8)));
typedef _Float16 h2_t __attribute__((ext_vector_type(2)));
typedef _Float16 h4_t __attribute__((ext_vector_type(4)));
typedef unsigned u2_t __attribute__((ext_vector_type(2)));
typedef __bf16 bf16x2_v __attribute__((ext_vector_type(2)));
__device__ __forceinline__ float dot2bf(unsigned a, unsigned b, float c) { return __builtin_amdgcn_fdot2_f32_bf16(__builtin_bit_cast(bf16x2_v, a), __builtin_bit_cast(bf16x2_v, b), c, false); }

struct Params {
    const float *x, *mem, *g_mix, *w_in, *gamma_lb, *sb_gain, *hg_gain, *mem_gain, *w_mkv, *mq_gain, *mk_gain, *w_out, *g_ffn, *w_q, *sub_keys, *pu, *pv;
    float* out; unsigned char* ws;
};

namespace pg8 {
#define PG8_LAS __attribute__((address_space(3)))
typedef unsigned short bf16_t;
typedef short bf16x8 __attribute__((ext_vector_type(8)));
typedef float f32x4 __attribute__((ext_vector_type(4)));
typedef unsigned u32x4 __attribute__((ext_vector_type(4)));
constexpr int BM = 256, BK = 64, HALF = 128, HTB = HALF * BK * 2  , STAGE_BYTES = 8 * HTB, NXCD = 8, WGM = 8;

__host__ __device__ __forceinline__ int lds_byte(int r, int c) { const int st = (r >> 4) * 2 + (c >> 5), rr = r & 15, cc = c & 31, ob = rr * 64 + cc * 2; return st * 1024 + (ob ^ (((ob >> 9) & 1) << 5)); }
__host__ __device__ __forceinline__ void stage_rc(int b, int& R, int& C) { const int st = b / 1024, sb = b % 1024, swz = sb ^ (((sb >> 9) & 1) << 5); R = (st >> 1) * 16 + swz / 64; C = (st & 1) * 32 + (swz % 64) / 2; }
__host__ __device__ __forceinline__ int perm32(int rho) { const int n = rho >> 4, i = rho & 15; return 8 * (i >> 2) + 4 * n + (i & 3); }

struct Unit { int pm, pn; };
struct Gemm { const bf16_t* A; const bf16_t* Bt; int M, N, K; };

struct StaticOrder {
    int nM, nN, nwg, G, c;
    __host__ __device__ void init(int M, int N, int G_, int c_) { nM = M / BM; nN = N / BM; nwg = nM * nN; G = G_; c = c_; }
    __host__ __device__ bool next(int i, Unit& u) const {
        const long L = (long)i * G + c; if (L >= nwg) return false;
        int wgid = (int)L; { const int q = nwg / NXCD, r = nwg % NXCD, xcd = wgid % NXCD, off = wgid / NXCD; wgid = (xcd < r ? xcd * (q + 1) : r * (q + 1) + (xcd - r) * q) + off; }
        const int nig = WGM * nN, gid = wgid / nig, fm = gid * WGM, gsz = (nM - fm) < WGM ? (nM - fm) : WGM;
        u.pm = fm + ((wgid % nig) % gsz); u.pn = (wgid % nig) / gsz; return true;
    }
    __device__ __forceinline__ void a_ready(const Unit&) const {}
    __device__ __forceinline__ void done(const Unit&) const {}
};

__device__ __forceinline__ unsigned cvt_pk_bf16(float lo, float hi) { unsigned r; asm volatile("v_cvt_pk_bf16_f32 %0, %1, %2" : "=v"(r) : "v"(lo), "v"(hi)); return r; }
typedef float f32x2 __attribute__((ext_vector_type(2)));
template <class Epi, class Sched, bool ALIGN_EPI = false, bool SP2 = false>
__device__ __forceinline__ void gemm_phase(PG8_LAS unsigned char* lds, const Gemm g, const Sched& S, const Epi& E) {
    const int tid = threadIdx.x, wid = __builtin_amdgcn_readfirstlane(tid >> 6), lane = tid & 63, wr = wid >> 2, wc = wid & 3, fr = lane & 15, fq = lane >> 4;
    const int K = g.K, nt = K / BK;
    unsigned voffA[2], voffB[2];
#pragma unroll
    for (int i = 0; i < 2; ++i) { int R, C; stage_rc(tid * 16 + i * 8192, R, C); const int Rb = Epi::PERM ? ((R & ~31) + perm32(R & 31)) : R;
        voffA[i] = (unsigned)(R * K + C) * 2u; voffB[i] = (unsigned)(Rb * K + C) * 2u; }
    const size_t kstep = (size_t)(BK * 2);
    const size_t hstep = (size_t)HALF * K * 2;
    const size_t tstep = 2 * hstep;
    const unsigned ldsw = (unsigned)wid * 1024u;
    const int aoff = lds_byte(wr * 64 + fr, fq * 8), boff = lds_byte(wc * 32 + fr, fq * 8);
#define PG8_SA(b, h) (((b) * 2 + (h)) * HTB)
#define PG8_SB(b, h) ((4 + (b) * 2 + (h)) * HTB)
#define PG8_STAGE(bufoff, gbase, voff) do { _Pragma("unroll") for (int _i = 0; _i < 2; ++_i) \
        __builtin_amdgcn_global_load_lds((const unsigned*)((const char*)(gbase) + (voff)[_i]), (PG8_LAS unsigned*)(lds + (bufoff) + ldsw + _i * 8192), 16, 0, 0); } while (0)
#define PG8_LDA(dst, b, h) do { _Pragma("unroll") for (int m = 0; m < 4; ++m) _Pragma("unroll") for (int k = 0; k < 2; ++k) dst[m][k] = *(const PG8_LAS bf16x8*)(lds + PG8_SA(b, h) + aoff + m * 2048 + k * 1024); } while (0)
#define PG8_LDB(dst, b, h) do { _Pragma("unroll") for (int n = 0; n < 2; ++n) _Pragma("unroll") for (int k = 0; k < 2; ++k) dst[n][k] = *(const PG8_LAS bf16x8*)(lds + PG8_SB(b, h) + boff + n * 2048 + k * 1024); } while (0)
#define PG8_MMA(ai, bj, At, Bt) do { __builtin_amdgcn_s_setprio(1); _Pragma("unroll") for (int m = 0; m < 4; ++m) _Pragma("unroll") for (int n = 0; n < 2; ++n) _Pragma("unroll") for (int k = 0; k < 2; ++k) \
        acc[ai][bj][m][n] = __builtin_amdgcn_mfma_f32_16x16x32_bf16(Bt[n][k], At[m][k], acc[ai][bj][m][n], 0, 0, 0); __builtin_amdgcn_s_setprio(0); } while (0)
#define PG8_WAIT_V(n) asm volatile("s_waitcnt vmcnt(" #n ")" ::: "memory")
#define PG8_WAIT_L(n) asm volatile("s_waitcnt lgkmcnt(" #n ")" ::: "memory")
#define PG8_BAR __builtin_amdgcn_s_barrier()
#define PG8_SCHED __builtin_amdgcn_sched_barrier(0)
    Unit cur, nxt; int ui = 0;
    if (!S.next(0, cur)) return;
    f32x4 acc[2][2][4][2];
#pragma unroll
    for (int a = 0; a < 2; ++a)
#pragma unroll
        for (int b = 0; b < 2; ++b)
#pragma unroll
            for (int m = 0; m < 4; ++m)
#pragma unroll
                for (int n = 0; n < 2; ++n) acc[a][b][m][n] = (f32x4){0.f, 0.f, 0.f, 0.f};
    bf16x8 At[4][2], B0[2][2], B1[2][2];
    const char* cA = (const char*)g.A + (size_t)cur.pm * tstep; const char* cB = (const char*)g.Bt + (size_t)cur.pn * tstep;
    S.a_ready(cur);
    if constexpr (SP2) {
        PG8_STAGE(PG8_SB(0, 0), cB, voffB); PG8_STAGE(PG8_SB(0, 1), cB + hstep, voffB); PG8_STAGE(PG8_SA(0, 0), cA, voffA); PG8_STAGE(PG8_SA(0, 1), cA + hstep, voffA);
        if (wr == 1) PG8_BAR;
        PG8_WAIT_V(2); PG8_BAR;
        PG8_STAGE(PG8_SB(1, 0), cB + kstep, voffB); PG8_STAGE(PG8_SA(1, 0), cA + kstep, voffA); PG8_STAGE(PG8_SB(1, 1), cB + hstep + kstep, voffB);
        PG8_WAIT_V(6); PG8_BAR;
    } else {
        PG8_STAGE(PG8_SB(0, 0), cB, voffB); PG8_STAGE(PG8_SA(0, 0), cA, voffA); PG8_STAGE(PG8_SB(0, 1), cB + hstep, voffB); PG8_STAGE(PG8_SA(0, 1), cA + hstep, voffA);
        if (wr == 1) PG8_BAR;
        PG8_WAIT_V(4); PG8_BAR;
        PG8_STAGE(PG8_SB(1, 0), cB + kstep, voffB); PG8_STAGE(PG8_SA(1, 0), cA + kstep, voffA); PG8_STAGE(PG8_SB(1, 1), cB + hstep + kstep, voffB);
        PG8_WAIT_V(6); PG8_BAR;
    }
    for (;;) {
        const bool has_next = S.next(ui + 1, nxt);
        const char* nA = has_next ? (const char*)g.A + (size_t)nxt.pm * tstep : cA; const char* nB = has_next ? (const char*)g.Bt + (size_t)nxt.pn * tstep : cB;
        for (int t = 0; t < nt; t += 2) {
            const bool last = (t == nt - 2);
            const char* a1 = cA + (size_t)(t + 1) * kstep;
            const char* a2 = last ? nA : cA + (size_t)(t + 2) * kstep; const char* b2 = last ? nB : cB + (size_t)(t + 2) * kstep;
            const char* a3 = a2 + kstep; const char* b3 = b2 + kstep;
            if (last && has_next) S.a_ready(nxt);
            if constexpr (SP2) {
            PG8_LDB(B0, 0, 0); PG8_LDB(B1, 0, 1); PG8_SCHED; PG8_LDA(At, 0, 0); PG8_STAGE(PG8_SA(1, 1), a1 + hstep, voffA);
            PG8_WAIT_V(8); PG8_WAIT_L(0); PG8_BAR; PG8_MMA(0, 0, At, B0); PG8_MMA(0, 1, At, B1); PG8_BAR; PG8_SCHED;
            PG8_LDA(At, 0, 1); PG8_STAGE(PG8_SB(0, 0), b2, voffB); PG8_STAGE(PG8_SB(0, 1), b2 + hstep, voffB); PG8_STAGE(PG8_SA(0, 0), a2, voffA);
            PG8_WAIT_V(8); PG8_WAIT_L(0); PG8_BAR; PG8_MMA(1, 0, At, B0); PG8_MMA(1, 1, At, B1); PG8_BAR; PG8_SCHED;
            PG8_LDB(B0, 1, 0); PG8_LDB(B1, 1, 1); PG8_SCHED; PG8_LDA(At, 1, 0); PG8_STAGE(PG8_SA(0, 1), a2 + hstep, voffA);
            PG8_WAIT_V(8); PG8_WAIT_L(0); PG8_BAR; PG8_MMA(0, 0, At, B0); PG8_MMA(0, 1, At, B1); PG8_BAR; PG8_SCHED;
            PG8_LDA(At, 1, 1); PG8_STAGE(PG8_SB(1, 0), b3, voffB); PG8_STAGE(PG8_SB(1, 1), b3 + hstep, voffB); PG8_STAGE(PG8_SA(1, 0), a3, voffA);
            PG8_WAIT_V(8); PG8_WAIT_L(0); PG8_BAR; PG8_MMA(1, 0, At, B0); PG8_MMA(1, 1, At, B1); PG8_BAR; PG8_SCHED;
            } else {
            PG8_LDB(B0, 0, 0); PG8_SCHED; PG8_LDA(At, 0, 0); PG8_STAGE(PG8_SA(1, 1), a1 + hstep, voffA);
            PG8_WAIT_L(8); PG8_BAR; PG8_WAIT_L(0); PG8_MMA(0, 0, At, B0); PG8_BAR; PG8_SCHED;
            PG8_LDB(B1, 0, 1); PG8_STAGE(PG8_SB(0, 0), b2, voffB);
            PG8_BAR; PG8_WAIT_L(0); PG8_MMA(0, 1, At, B1); PG8_BAR;
            PG8_LDA(At, 0, 1); PG8_STAGE(PG8_SA(0, 0), a2, voffA);
            PG8_BAR; PG8_WAIT_L(0); PG8_MMA(1, 0, At, B0); PG8_BAR; PG8_SCHED;
            PG8_STAGE(PG8_SB(0, 1), b2 + hstep, voffB);
            PG8_WAIT_V(6); PG8_BAR; PG8_MMA(1, 1, At, B1); PG8_BAR;
            PG8_LDB(B0, 1, 0); PG8_SCHED; PG8_LDA(At, 1, 0); PG8_STAGE(PG8_SA(0, 1), a2 + hstep, voffA);
            PG8_WAIT_L(8); PG8_BAR; PG8_WAIT_L(0); PG8_MMA(0, 0, At, B0); PG8_BAR; PG8_SCHED;
            PG8_LDB(B1, 1, 1); PG8_STAGE(PG8_SB(1, 0), b3, voffB);
            PG8_BAR; PG8_WAIT_L(0); PG8_MMA(0, 1, At, B1); PG8_BAR;
            PG8_LDA(At, 1, 1); PG8_STAGE(PG8_SA(1, 0), a3, voffA);
            PG8_BAR; PG8_WAIT_L(0); PG8_MMA(1, 0, At, B0); PG8_BAR; PG8_SCHED;
            PG8_STAGE(PG8_SB(1, 1), b3 + hstep, voffB);
            PG8_WAIT_V(6); PG8_BAR; PG8_MMA(1, 1, At, B1); PG8_BAR;
            }
        }
        if constexpr (ALIGN_EPI) { if (wr == 0) PG8_BAR; }
        if constexpr (!Epi::AFTER_DRAIN) { E(acc, cur, wr, wc, fr, fq); S.done(cur); }
        if (!has_next) break;
#pragma unroll
        for (int a = 0; a < 2; ++a)
#pragma unroll
            for (int b = 0; b < 2; ++b)
#pragma unroll
                for (int m = 0; m < 4; ++m)
#pragma unroll
                    for (int n = 0; n < 2; ++n) acc[a][b][m][n] = (f32x4){0.f, 0.f, 0.f, 0.f};
        cur = nxt; cA = nA; cB = nB; ++ui;
        if constexpr (ALIGN_EPI) { if (wr == 1) PG8_BAR; }
    }
    PG8_WAIT_V(0);
    if constexpr (!ALIGN_EPI) { if (wr == 0) PG8_BAR; }
    PG8_BAR;
    if constexpr (Epi::AFTER_DRAIN) { E.fused(acc, cur, wr, wc, fr, fq, lds, wid, lane); S.done(cur); }
#undef PG8_SA
#undef PG8_SB
#undef PG8_STAGE
#undef PG8_LDA
#undef PG8_LDB
#undef PG8_MMA
#undef PG8_WAIT_V
#undef PG8_WAIT_L
#undef PG8_BAR
#undef PG8_SCHED
}
}


namespace pg8 {
typedef unsigned u32x4 __attribute__((ext_vector_type(4)));
struct EpiProjM {
    static constexpr bool PERM = true, AFTER_DRAIN = false;
    bf16_t* P;
    __device__ __forceinline__ void operator()(const f32x4 (&acc)[2][2][4][2], const Unit& u, int wr, int wc, int fr, int fq) const {
        const int row0 = u.pm * BM + wr * 64 + fr, col0 = u.pn * BM + wc * 32 + 8 * fq;
        const int pn = u.pn; const int mode = (pn < 2) ? 1 : ((pn == 6 || pn == 7 || pn == 11) ? 2 : 0);
#pragma unroll
        for (int ai = 0; ai < 2; ++ai)
#pragma unroll
            for (int m = 0; m < 4; ++m) { bf16_t* rowp = P + (size_t)(row0 + ai * HALF + m * 16) * INW + col0;
#pragma unroll
                for (int bj = 0; bj < 2; ++bj) { f32x4 v0 = acc[ai][bj][m][0], v1 = acc[ai][bj][m][1];
                    if (mode == 1) { v0 = v0 * C2; v1 = v1 * C2; }
                    else if (mode == 2) {
#pragma unroll
                        for (int e = 0; e < 4; ++e) { v0[e] = silu(v0[e]); v1[e] = silu(v1[e]); } }
                    u32x4 w; w.x = cvt_pk_bf16(v0[0], v0[1]); w.y = cvt_pk_bf16(v0[2], v0[3]); w.z = cvt_pk_bf16(v1[0], v1[1]); w.w = cvt_pk_bf16(v1[2], v1[3]);
                    *(u32x4*)(rowp + bj * HALF) = w; } }
    }
};
struct EpiF32M {
    static constexpr bool PERM = true, AFTER_DRAIN = false;
    float* O; int ld;
    __device__ __forceinline__ void operator()(const f32x4 (&acc)[2][2][4][2], const Unit& u, int wr, int wc, int fr, int fq) const {
        const int row0 = u.pm * BM + wr * 64 + fr, col0 = u.pn * BM + wc * 32 + 8 * fq;
#pragma unroll
        for (int ai = 0; ai < 2; ++ai)
#pragma unroll
            for (int m = 0; m < 4; ++m) { float* rowp = O + (size_t)(row0 + ai * HALF + m * 16) * ld + col0;
#pragma unroll
                for (int bj = 0; bj < 2; ++bj) { *(f32x4*)(rowp + bj * HALF) = acc[ai][bj][m][0]; *(f32x4*)(rowp + bj * HALF + 4) = acc[ai][bj][m][1]; } }
    }
};
struct EpiWoutM {
    static constexpr bool PERM = true, AFTER_DRAIN = false;
    const float* x; float* out; bf16_t* xb;
    __device__ __forceinline__ void operator()(const f32x4 (&acc)[2][2][4][2], const Unit& u, int wr, int wc, int fr, int fq) const {
        const int row0 = u.pm * BM + wr * 64 + fr, col0 = u.pn * BM + wc * 32 + 8 * fq;
#pragma unroll
        for (int ai = 0; ai < 2; ++ai)
#pragma unroll
            for (int m = 0; m < 4; ++m) { const size_t rb = (size_t)(row0 + ai * HALF + m * 16) * DM + col0;
#pragma unroll
                for (int bj = 0; bj < 2; ++bj) { const size_t i = rb + bj * HALF;
                    const f32x4 v0 = acc[ai][bj][m][0] + *(const f32x4*)(x + i), v1 = acc[ai][bj][m][1] + *(const f32x4*)(x + i + 4);
                    *(f32x4*)(out + i) = v0; *(f32x4*)(out + i + 4) = v1;
                    u32x4 w; w.x = cvt_pk_bf16(v0[0], v0[1]); w.y = cvt_pk_bf16(v0[2], v0[3]); w.z = cvt_pk_bf16(v1[0], v1[1]); w.w = cvt_pk_bf16(v1[2], v1[3]);
                    *(u32x4*)(xb + i) = w; } }
    }
};
struct EpiQM {
    static constexpr bool PERM = true, AFTER_DRAIN = false;
    const float* rstd; bf16_t* Q;
    __device__ __forceinline__ void operator()(const f32x4 (&acc)[2][2][4][2], const Unit& u, int wr, int wc, int fr, int fq) const {
        const int row0 = u.pm * BM + wr * 64 + fr, col0 = u.pn * BM + wc * 32 + 8 * fq;
#pragma unroll
        for (int ai = 0; ai < 2; ++ai)
#pragma unroll
            for (int m = 0; m < 4; ++m) { const int row = row0 + ai * HALF + m * 16; const float rs = rstd[row]; bf16_t* rowp = Q + (size_t)row * 2048 + col0;
#pragma unroll
                for (int bj = 0; bj < 2; ++bj) { const f32x4 v0 = acc[ai][bj][m][0] * rs, v1 = acc[ai][bj][m][1] * rs;
                    u32x4 w; w.x = cvt_pk_bf16(v0[0], v0[1]); w.y = cvt_pk_bf16(v0[2], v0[3]); w.z = cvt_pk_bf16(v1[0], v1[1]); w.w = cvt_pk_bf16(v1[2], v1[3]);
                    *(u32x4*)(rowp + bj * HALF) = w; } }
    }
};
}

#define LAS __attribute__((address_space(3)))
#define XB_TMO      128
#define XB_XCNT(j)  (256  + 64 * (j))
#define XB_XSUB(j)  (1280 + 64 * (j))
#define XB_XGEN(j)  (2304 + 64 * (j))
#define XB_TOP      3328
#define XB_TOPGEN   3392
#define XCD_BAR_WORDS 3456
#define XB_SPIN_CAP (1u << 18)

__device__ __forceinline__ unsigned xb_ld(unsigned* p)              { return __hip_atomic_load(p, __ATOMIC_RELAXED, __HIP_MEMORY_SCOPE_AGENT); }
__device__ __forceinline__ unsigned xb_add(unsigned* p, unsigned v) { return __hip_atomic_fetch_add(p, v, __ATOMIC_RELAXED, __HIP_MEMORY_SCOPE_AGENT); }
__device__ __forceinline__ unsigned xb_xcc_id() { return (unsigned)__builtin_amdgcn_s_getreg((3 << 11) | 20) & 0xFu; }
#define XB_SPIN(cond, bar) do { unsigned _sp = 0; while (cond) { __builtin_amdgcn_s_sleep(1); \
    if ((++_sp & 255u) == 0u) { if (xb_ld(&(bar)[XB_TMO])) break; if (_sp > XB_SPIN_CAP) { atomicAdd(&(bar)[XB_TMO], 1u); break; } } } } while (0)

struct XcdBarrier {
    unsigned* bar; unsigned x;
    volatile LAS unsigned* st;
};

__device__ __forceinline__ XcdBarrier xcd_barrier_post(unsigned* bar, volatile LAS unsigned* st) {
    XcdBarrier b; b.bar = bar; b.x = xb_xcc_id(); b.st = st;
    if (threadIdx.x == 0) (void)xb_add(&bar[XB_XCNT(b.x)], 1u);
    return b;
}
__device__ __forceinline__ void xcd_barrier_complete(unsigned* bar, unsigned x, unsigned& nloc, unsigned& nx) {
    const unsigned G = gridDim.x * gridDim.y * gridDim.z;
    unsigned sum, cnt, mine, sp = 0u;
    for (;;) {
        sum = 0u; cnt = 0u; mine = 0u;
#pragma unroll
        for (unsigned j = 0; j < 16; ++j) { const unsigned c = xb_ld(&bar[XB_XCNT(j)]); sum += c; cnt += (c > 0u) ? 1u : 0u; mine = (j == x) ? c : mine; }
        if (sum == G) break;
        __builtin_amdgcn_s_sleep(1);
        if ((++sp & 255u) == 0u) { if (xb_ld(&bar[XB_TMO])) break; if (sp > XB_SPIN_CAP) { atomicAdd(&bar[XB_TMO], 1u); break; } }
    }
    nloc = mine > 0u ? mine : 1u; nx = cnt > 0u ? cnt : 1u;
}

__device__ __forceinline__ void xcd_barrier(const XcdBarrier& b) {
    asm volatile("s_waitcnt vmcnt(0)" ::: "memory");
    __syncthreads();
    if (threadIdx.x == 0) {
        unsigned* bar = b.bar;
        __builtin_amdgcn_s_waitcnt(0);
        unsigned nloc = b.st[0], nx = b.st[1];
        if (nloc == 0u) { xcd_barrier_complete(bar, b.x, nloc, nx); b.st[0] = nloc; b.st[1] = nx; }
        const unsigned old = xb_add(&bar[XB_XSUB(b.x)], 1u);
        const unsigned gen = old / nloc;
        if (old + 1u == (gen + 1u) * nloc) {
            __builtin_amdgcn_fence(__ATOMIC_RELEASE, "agent");
            asm volatile("s_waitcnt vmcnt(0)" ::: "memory");
            const unsigned og = xb_add(&bar[XB_TOP], 1u);
            const unsigned tg = og / nx;
            if (og + 1u == (tg + 1u) * nx) xb_add(&bar[XB_TOPGEN], 1u);
            else XB_SPIN(xb_ld(&bar[XB_TOPGEN]) == tg, bar);
            __builtin_amdgcn_fence(__ATOMIC_ACQUIRE, "agent");
            xb_add(&bar[XB_XGEN(b.x)], 1u);
            asm volatile("s_waitcnt vmcnt(0)" ::: "memory");
        } else {
            XB_SPIN(xb_ld(&bar[XB_XGEN(b.x)]) == gen, bar);
            __builtin_amdgcn_fence(__ATOMIC_ACQUIRE, "agent");
            asm volatile("s_waitcnt vmcnt(0)" ::: "memory");
        }
    }
    __syncthreads();
}

__device__ __forceinline__ void transpose_item(const float* W, const float* gain, int K, int N, bf16_t* WT, float* scr, int item, int lane) {
    const int nblk = N / 32, kb = item / nblk, nb = item % nblk, k0 = 64 * kb, n0 = 32 * nb;
    for (int i = 0; i < 32; ++i) { const int kk = 2 * i + (lane >> 5); float g = gain ? gain[k0 + kk] : 1.f; scr[kk * 33 + (lane & 31)] = W[(size_t)(k0 + kk) * N + n0 + (lane & 31)] * g; }
    __builtin_amdgcn_s_waitcnt(0); __builtin_amdgcn_wave_barrier();
    const int c = lane & 7;
#pragma unroll
    for (int j = 0; j < 4; ++j) { const int n = (lane >> 3) + 8 * j; const float* s = scr + (8 * c) * 33 + n;
        uint4 o; o.x = pk2(s[0 * 33], s[1 * 33]); o.y = pk2(s[2 * 33], s[3 * 33]); o.z = pk2(s[4 * 33], s[5 * 33]); o.w = pk2(s[6 * 33], s[7 * 33]);
        *(uint4*)(WT + (size_t)(n0 + n) * K + k0 + 8 * c) = o; }
    __builtin_amdgcn_s_waitcnt(0); __builtin_amdgcn_wave_barrier();
}
__device__ __forceinline__ void norm_row_to_bf16(const float* xrow, bf16_t* orow, int lane) {
    const float4* xr = (const float4*)xrow + lane;
    float4 v[4]; float s = 0.f;
#pragma unroll
    for (int j = 0; j < 4; ++j) { v[j] = xr[64 * j]; s += (v[j].x * v[j].x + v[j].y * v[j].y) + (v[j].z * v[j].z + v[j].w * v[j].w); }
    const float rstd = rsqrtf(wave_sum(s) * (1.f / DM) + EPS);
    unsigned long long* o8 = (unsigned long long*)orow + lane;
#pragma unroll
    for (int j = 0; j < 4; ++j) o8[64 * j] = (unsigned long long)pk2(v[j].x * rstd, v[j].y * rstd) | ((unsigned long long)pk2(v[j].z * rstd, v[j].w * rstd) << 32);
}
__device__ __forceinline__ void phase_prep(const Params& p, unsigned char* lds) {
    const int tid = threadIdx.x, lane = tid & 63, wave = tid >> 6;
    const int gw = blockIdx.x * 8 + wave, NGW = gridDim.x * 8;
    const int gt = blockIdx.x * NTHR + tid, NGT = gridDim.x * NTHR;
    unsigned char* ws = p.ws;
    float* scr = (float*)lds + wave * (64 * 33);
    constexpr int I_IN = (DM / 64) * (INW / 32), I_OUT = (DM / 64) * (DM / 32), I_Q = (DM / 64) * (2048 / 32), I_MKV = (DM / 64) * (512 / 32);
    for (int it = gw; it < I_IN + I_OUT + I_Q + I_MKV; it += NGW) {
        int r = it;
        if (r < I_IN) { transpose_item(p.w_in, p.g_mix, DM, INW, (bf16_t*)(ws + WS_WIN_T), scr, r, lane); continue; } r -= I_IN;
        if (r < I_OUT) { transpose_item(p.w_out, nullptr, DM, DM, (bf16_t*)(ws + WS_WOUT_T), scr, r, lane); continue; } r -= I_OUT;
        if (r < I_Q) { transpose_item(p.w_q, p.g_ffn, DM, 2048, (bf16_t*)(ws + WS_WQ_T), scr, r, lane); continue; } r -= I_Q;
        transpose_item(p.w_mkv, p.mem_gain, DM, 512, (bf16_t*)(ws + WS_WMKV_T), scr, r, lane);
    }
    for (int m = gw; m < T; m += NGW) norm_row_to_bf16(p.x + (size_t)m * DM, (bf16_t*)(ws + WS_XB) + (size_t)m * DM, lane);
    for (int m = gw; m < NB * NMEM; m += NGW) norm_row_to_bf16(p.mem + (size_t)m * DM, (bf16_t*)(ws + WS_MEMN) + (size_t)m * DM, lane);
    for (int i = gt; i < 8 * 2 * 128 * 128; i += NGT) ((bf16_t*)(ws + WS_SKB))[i] = f2bf(p.sub_keys[i]);
    for (int i = gt; i < NEXP * DM / 8; i += NGT) {
        const int d0 = (i & 127) * 8, e = i >> 7, s0 = (d0 >> 2) & 15, j0 = (d0 >> 6) * 4;
        const float4 a = ((const float4*)p.pu)[2 * i], b = ((const float4*)p.pu)[2 * i + 1];
        const float4 ga = *(const float4*)(p.g_ffn + d0), gb = *(const float4*)(p.g_ffn + d0 + 4);
        uint2 o0, o1; o0.x = pk2(a.x * ga.x, a.y * ga.y); o0.y = pk2(a.z * ga.z, a.w * ga.w); o1.x = pk2(b.x * gb.x, b.y * gb.y); o1.y = pk2(b.z * gb.z, b.w * gb.w);
        bf16_t* ub = (bf16_t*)(ws + WS_U16);
        *(uint2*)(ub + ((size_t)s0 * NEXP + e) * 64 + j0) = o0; *(uint2*)(ub + ((size_t)(s0 + 1) * NEXP + e) * 64 + j0) = o1;
        const float4 c = ((const float4*)p.pv)[2 * i], d = ((const float4*)p.pv)[2 * i + 1];
        h4_t h0, h1; h0[0] = (_Float16)c.x; h0[1] = (_Float16)c.y; h0[2] = (_Float16)c.z; h0[3] = (_Float16)c.w; h1[0] = (_Float16)d.x; h1[1] = (_Float16)d.y; h1[2] = (_Float16)d.z; h1[3] = (_Float16)d.w;
        _Float16* vb = (_Float16*)(ws + WS_V16);
        *(h4_t*)(vb + ((size_t)s0 * NEXP + e) * 64 + j0) = h0; *(h4_t*)(vb + ((size_t)(s0 + 1) * NEXP + e) * 64 + j0) = h1;
    }
    for (int i = gt; i < 512; i += NGT) ((float*)(ws + WS_LB))[i] = 1.f / (1.f + expf(p.gamma_lb[512 + i] - p.gamma_lb[i]));
}

template <class Epi>
__device__ __forceinline__ void gemm_naive(const bf16_t* A, const bf16_t* Bt, int M, int N, int K, unsigned char* ldsb, const Epi& epi) {
    float* As = (float*)ldsb;
    float* Bs = As + 32 * 132;
    const int tid = threadIdx.x, ty = tid >> 4, tx = tid & 15;
    const int ntm = M / 128, ntn = N / 64;
    for (int tile = blockIdx.x; tile < ntm * ntn; tile += gridDim.x) {
        const int tm = tile / ntn, tn = tile % ntn;
        float acc[4][4];
#pragma unroll
        for (int i = 0; i < 4; ++i)
#pragma unroll
            for (int j = 0; j < 4; ++j) acc[i][j] = 0.f;
        for (int k0 = 0; k0 < K; k0 += 32) {
            { const int r = tid >> 2, kq = (tid & 3) * 8;
              const uint4 v = *(const uint4*)(A + (size_t)(tm * 128 + r) * K + k0 + kq);
              As[(kq + 0) * 132 + r] = bflo(v.x); As[(kq + 1) * 132 + r] = bfhi(v.x); As[(kq + 2) * 132 + r] = bflo(v.y); As[(kq + 3) * 132 + r] = bfhi(v.y);
              As[(kq + 4) * 132 + r] = bflo(v.z); As[(kq + 5) * 132 + r] = bfhi(v.z); As[(kq + 6) * 132 + r] = bflo(v.w); As[(kq + 7) * 132 + r] = bfhi(v.w); }
            if (tid < 256) { const int r = tid >> 2, kq = (tid & 3) * 8;
              const uint4 v = *(const uint4*)(Bt + (size_t)(tn * 64 + r) * K + k0 + kq);
              Bs[(kq + 0) * 68 + r] = bflo(v.x); Bs[(kq + 1) * 68 + r] = bfhi(v.x); Bs[(kq + 2) * 68 + r] = bflo(v.y); Bs[(kq + 3) * 68 + r] = bfhi(v.y);
              Bs[(kq + 4) * 68 + r] = bflo(v.z); Bs[(kq + 5) * 68 + r] = bfhi(v.z); Bs[(kq + 6) * 68 + r] = bflo(v.w); Bs[(kq + 7) * 68 + r] = bfhi(v.w); }
            __syncthreads();
#pragma unroll 8
            for (int k = 0; k < 32; ++k) {
                const float4 a = *(const float4*)(As + k * 132 + ty * 4); const float4 b = *(const float4*)(Bs + k * 68 + tx * 4);
                const float av[4] = {a.x, a.y, a.z, a.w}, bv[4] = {b.x, b.y, b.z, b.w};
#pragma unroll
                for (int i = 0; i < 4; ++i)
#pragma unroll
                    for (int j = 0; j < 4; ++j) acc[i][j] = fmaf(av[i], bv[j], acc[i][j]);
            }
            __syncthreads();
        }
#pragma unroll
        for (int i = 0; i < 4; ++i)
#pragma unroll
            for (int j = 0; j < 4; ++j) epi(tm * 128 + ty * 4 + i, tn * 64 + tx * 4 + j, acc[i][j]);
    }
}

struct EpiProj {
    bf16_t* P;
    __device__ __forceinline__ void operator()(int row, int col, float v) const {
        if (col < C_SBK) v *= C2;
        else if (col >= C_HGQ && col < C_HGF) v = silu(v);
        else if (col >= C_HGG && col < C_MQ) v = silu(v);
        P[(size_t)row * INW + col] = f2bf(v);
    }
};
struct EpiF32 { float* O; int ld; __device__ __forceinline__ void operator()(int row, int col, float v) const { O[(size_t)row * ld + col] = v; } };
struct EpiWout { const float* x; float* out; bf16_t* xb;
    __device__ __forceinline__ void operator()(int row, int col, float v) const { const size_t i = (size_t)row * DM + col; const float r = x[i] + v; out[i] = r; xb[i] = f2bf(r); } };
struct EpiQ { const float* rstd; bf16_t* Q;
    __device__ __forceinline__ void operator()(int row, int col, float v) const { Q[(size_t)row * 2048 + col] = f2bf(v * rstd[row]); } };

#ifndef SB_EARLY
#define SB_EARLY 1
#endif
__device__ __forceinline__ void sb_naive(const Params& p) {
    const bf16_t* P = (const bf16_t*)(p.ws + WS_P);
    bf16_t* mixed = (bf16_t*)(p.ws + WS_MIXED);
    for (int row = blockIdx.x * NTHR + threadIdx.x; row < NB * 8 * SEQ; row += gridDim.x * NTHR) {
        const int t = row % SEQ, bh = row / SEQ, h = bh % 8, b = bh / 8;
        const size_t tok = (size_t)b * SEQ + t;
        float q[64], o[64];
        { const uint4* qp = (const uint4*)(P + tok * INW + C_SBQ + h * 64);
#pragma unroll
          for (int j = 0; j < 8; ++j) { const uint4 v = qp[j]; q[8 * j] = bflo(v.x); q[8 * j + 1] = bfhi(v.x); q[8 * j + 2] = bflo(v.y); q[8 * j + 3] = bfhi(v.y); q[8 * j + 4] = bflo(v.z); q[8 * j + 5] = bfhi(v.z); q[8 * j + 6] = bflo(v.w); q[8 * j + 7] = bfhi(v.w); } }
#pragma unroll
        for (int d = 0; d < 64; ++d) o[d] = 0.f;
        float R = 0.f;
        for (int s = t - 1; s >= 0; --s) {
            const uint4* kp = (const uint4*)(P + ((size_t)b * SEQ + s) * INW + C_SBK + h * 64);
            const uint4* vp = (const uint4*)(P + ((size_t)b * SEQ + s) * INW + C_SBV + h * 64);
            float z = 0.f;
#pragma unroll
            for (int j = 0; j < 8; ++j) { const uint4 v = kp[j];
                z = fmaf(q[8 * j], bflo(v.x), z); z = fmaf(q[8 * j + 1], bfhi(v.x), z); z = fmaf(q[8 * j + 2], bflo(v.y), z); z = fmaf(q[8 * j + 3], bfhi(v.y), z);
                z = fmaf(q[8 * j + 4], bflo(v.z), z); z = fmaf(q[8 * j + 5], bfhi(v.z), z); z = fmaf(q[8 * j + 6], bflo(v.w), z); z = fmaf(q[8 * j + 7], bfhi(v.w), z); }
            const float sp = fmaxf(z, 0.f) + log2f(1.f + exp2f(-fabsf(z)));
            const float a = exp2f(z - sp + R);
            R -= sp;
#pragma unroll
            for (int j = 0; j < 8; ++j) { const uint4 v = vp[j];
                o[8 * j] = fmaf(a, bflo(v.x), o[8 * j]); o[8 * j + 1] = fmaf(a, bfhi(v.x), o[8 * j + 1]); o[8 * j + 2] = fmaf(a, bflo(v.y), o[8 * j + 2]); o[8 * j + 3] = fmaf(a, bfhi(v.y), o[8 * j + 3]);
                o[8 * j + 4] = fmaf(a, bflo(v.z), o[8 * j + 4]); o[8 * j + 5] = fmaf(a, bfhi(v.z), o[8 * j + 5]); o[8 * j + 6] = fmaf(a, bflo(v.w), o[8 * j + 6]); o[8 * j + 7] = fmaf(a, bfhi(v.w), o[8 * j + 7]); }
#if SB_EARLY
            if (R < -150.f) break;
#endif
        }
        float ss = 0.f;
#pragma unroll
        for (int d = 0; d < 64; ++d) ss = fmaf(o[d], o[d], ss);
        const float r = rsqrtf(ss * (1.f / 64.f) + EPS);
        uint4* op = (uint4*)(mixed + tok * DM + h * 64);
        const float* g = p.sb_gain + h * 64;
#pragma unroll
        for (int j = 0; j < 8; ++j) { uint4 w; w.x = pk2(o[8 * j] * r * g[8 * j], o[8 * j + 1] * r * g[8 * j + 1]); w.y = pk2(o[8 * j + 2] * r * g[8 * j + 2], o[8 * j + 3] * r * g[8 * j + 3]);
            w.z = pk2(o[8 * j + 4] * r * g[8 * j + 4], o[8 * j + 5] * r * g[8 * j + 5]); w.w = pk2(o[8 * j + 6] * r * g[8 * j + 6], o[8 * j + 7] * r * g[8 * j + 7]); op[j] = w; }
    }
}

__device__ __forceinline__ void hg_naive(const Params& p, unsigned char* ldsb) {
    const bf16_t* P = (const bf16_t*)(p.ws + WS_P);
    float* raw = (float*)(p.ws + WS_HGRAW);
    const float* lbp = (const float*)(p.ws + WS_LB);
    float* red = (float*)ldsb;
    const int tid = threadIdx.x, jj = tid >> 7, k = tid & 127, wave = tid >> 6, lane = tid & 63;
    for (int unit = blockIdx.x; unit < NB * 4 * 16; unit += gridDim.x) {
        const int jg = unit & 15, h = (unit >> 4) & 3, b = unit >> 6;
        const float lb = lbp[h * 128 + k];
        float S = 0.f;
        for (int t0 = 0; t0 < SEQ; t0 += 64) {
            for (int tt = 0; tt < 64; tt += 8) {
                float fl[8], qv[8], iv[8];
#pragma unroll
                for (int u = 0; u < 8; ++u) { const bf16_t* pr = P + ((size_t)b * SEQ + t0 + tt + u) * INW;
                    fl[u] = bf2f(pr[C_HGF + h * 128 + k]); qv[u] = bf2f(pr[C_HGQ + h * 128 + k]); iv[u] = bf2f(pr[C_HGI + h * 64 + jg * 4 + jj]); }
#pragma unroll
                for (int u = 0; u < 8; ++u) {
                    const float f = lb + (1.f - lb) / (1.f + __expf(-fl[u]));
                    S = f * S + (1.f - f) * iv[u];
                    const float part = wave_sum(S * qv[u]);
                    if (lane == 0) red[(tt + u) * 8 + wave] = part;
                }
            }
            __syncthreads();
            if (tid < 256) { const int tt = tid >> 2, j2 = tid & 3;
                raw[((size_t)b * SEQ + t0 + tt) * 256 + h * 64 + jg * 4 + j2] = red[tt * 8 + 2 * j2] + red[tt * 8 + 2 * j2 + 1]; }
            __syncthreads();
        }
    }
}
__device__ __forceinline__ void hg_finish(const Params& p) {
    const bf16_t* P = (const bf16_t*)(p.ws + WS_P);
    const float* raw = (const float*)(p.ws + WS_HGRAW);
    bf16_t* mixed = (bf16_t*)(p.ws + WS_MIXED);
    const int lane = threadIdx.x & 63, wave = threadIdx.x >> 6;
    for (int it = blockIdx.x * 8 + wave; it < T * 4; it += gridDim.x * 8) {
        const int tok = it >> 2, h = it & 3;
        const float o = raw[(size_t)tok * 256 + h * 64 + lane];
        const float r = rsqrtf(wave_sum(o * o) * (1.f / 64.f) + EPS);
        const float g = bf2f(P[(size_t)tok * INW + C_HGG + h * 64 + lane]);
        mixed[(size_t)tok * DM + 512 + h * 64 + lane] = f2bf(o * r * p.hg_gain[h * 64 + lane] * g);
    }
}


typedef float f32x16 __attribute__((ext_vector_type(16)));
typedef short sh8_t __attribute__((ext_vector_type(8)));
typedef unsigned u4_t __attribute__((ext_vector_type(4)));
typedef float f32x4_t __attribute__((ext_vector_type(4)));
typedef float float2_t __attribute__((ext_vector_type(2)));
__device__ __forceinline__ void mma32(f32x16& acc, const LAS bf16_t* A, int lda, const LAS bf16_t* Bt, int ldb, int K, int lane) {
    const int r = lane & 31, h = lane >> 5;
    const LAS bf16_t* ap = A + r * lda + 8 * h; const LAS bf16_t* bp = Bt + r * ldb + 8 * h;
    for (int k0 = 0; k0 < K; k0 += 16) {
        const sh8_t a = *(const LAS sh8_t*)(ap + k0), b = *(const LAS sh8_t*)(bp + k0);
        acc = __builtin_amdgcn_mfma_f32_32x32x16_bf16(a, b, acc, 0, 0, 0);
    }
}
__device__ __forceinline__ int crow(int r, int hh) { return (r & 3) + 8 * (r >> 2) + 4 * hh; }
constexpr size_t HG_LT = 0;
constexpr size_t HG_SB = 64 * MiB;
constexpr size_t HG_DD = 96 * MiB;
__device__ __forceinline__ void hg_cols(const bf16_t* P, const float* lbp, int b_, int h, int c, LAS float* gs, int tid, float (&kk)[16], float (&bc)[16], float& bmid, float& blast) {
    const int rg = tid >> 7, k = tid & 127;
    const float lb = lbp[h * 128 + k];
    const bf16_t* pr = P + ((size_t)b_ * SEQ + c * 64 + rg * 16) * INW + C_HGF + h * 128 + k;
    float run = 0.f;
#pragma unroll
    for (int i = 0; i < 16; ++i) { const float fl = bf2f(pr[(size_t)i * INW]); const float kv = (1.f - lb) / (1.f + __expf(fl)); kk[i] = kv; run += __logf(1.f - kv); bc[i] = run; }
    gs[rg * 128 + k] = run;
    __syncthreads();
    const float g0 = gs[k], g1 = gs[128 + k], g2 = gs[256 + k], g3 = gs[384 + k];
    const float off = (rg > 0 ? g0 : 0.f) + (rg > 1 ? g1 : 0.f) + (rg > 2 ? g2 : 0.f);
#pragma unroll
    for (int i = 0; i < 16; ++i) bc[i] += off;
    bmid = g0 + g1; blast = (g0 + g1) + (g2 + g3);
}
__device__ __forceinline__ void hg_load_vt(const bf16_t* P, int b_, int h, int c, LAS bf16_t* VT, int tid) {
    const int s = tid >> 3, jq = tid & 7;
    const uint4 v = *(const uint4*)(P + ((size_t)b_ * SEQ + c * 64 + s) * INW + C_HGI + h * 64 + jq * 8);
    LAS bf16_t* d = VT + (jq * 8) * 72 + s;
    d[0 * 72] = (bf16_t)(v.x & 0xffff); d[1 * 72] = (bf16_t)(v.x >> 16); d[2 * 72] = (bf16_t)(v.y & 0xffff); d[3 * 72] = (bf16_t)(v.y >> 16);
    d[4 * 72] = (bf16_t)(v.z & 0xffff); d[5 * 72] = (bf16_t)(v.z >> 16); d[6 * 72] = (bf16_t)(v.w & 0xffff); d[7 * 72] = (bf16_t)(v.w >> 16);
}
__device__ __forceinline__ void hg_local(const Params& p, unsigned char* ldsb) {
    const bf16_t* P = (const bf16_t*)(p.ws + WS_P); const float* lbp = (const float*)(p.ws + WS_LB);
    float* LT = (float*)((unsigned char*)p.out + HG_LT); float* DD = (float*)((unsigned char*)p.out + HG_DD);
    LAS unsigned char* l = (LAS unsigned char*)ldsb;
    LAS float* gs = (LAS float*)l; LAS bf16_t* KST = (LAS bf16_t*)(l + 2048); LAS bf16_t* VT = (LAS bf16_t*)(l + 20480);
    const int tid = threadIdx.x, lane = tid & 63, wave = tid >> 6, rg = tid >> 7, k = tid & 127;
    for (int unit = blockIdx.x; unit < 2048; unit += gridDim.x) {
        const int bh = unit >> 7, c = unit & 127, b_ = bh >> 2, h = bh & 3;
        float kk[16], bc[16], bmid, blast;
        hg_cols(P, lbp, b_, h, c, gs, tid, kk, bc, bmid, blast);
        { unsigned w[8];
#pragma unroll
          for (int i = 0; i < 8; ++i) w[i] = pk2(kk[2 * i] * __expf(blast - bc[2 * i]), kk[2 * i + 1] * __expf(blast - bc[2 * i + 1]));
          LAS u4_t* d = (LAS u4_t*)(KST + k * 72 + rg * 16);
          d[0] = (u4_t){w[0], w[1], w[2], w[3]}; d[1] = (u4_t){w[4], w[5], w[6], w[7]}; }
        hg_load_vt(P, b_, h, c, VT, tid);
        if (tid < 128) DD[(size_t)unit * 128 + tid] = __expf(blast);
        __syncthreads();
        { const int ji = wave >> 2, ki = wave & 3;
          f32x16 acc;
#pragma unroll
          for (int r = 0; r < 16; ++r) acc[r] = 0.f;
          mma32(acc, VT + 32 * ji * 72, 72, KST + 32 * ki * 72, 72, 64, lane);
          float* o = LT + (size_t)unit * 8192 + 32 * ki + (lane & 31);
#pragma unroll
          for (int r = 0; r < 16; ++r) o[(size_t)(32 * ji + crow(r, lane >> 5)) * 128] = acc[r]; }
        __syncthreads();
    }
}
__device__ __forceinline__ void hg_scan(const Params& p) {
    const float* LT = (const float*)((unsigned char*)p.out + HG_LT); const float* DD = (const float*)((unsigned char*)p.out + HG_DD);
    bf16_t* SB = (bf16_t*)((unsigned char*)p.out + HG_SB);
    for (int gt = blockIdx.x * NTHR + threadIdx.x; gt < 16 * 8192; gt += gridDim.x * NTHR) {
        const int bh = gt >> 13, e = gt & 8191, k = e & 127;
        float S = 0.f;
#pragma unroll 8
        for (int c = 0; c < 128; ++c) { const size_t u = (size_t)bh * 128 + c;
            const float L = LT[u * 8192 + e], D = DD[u * 128 + k];
            SB[u * 8192 + e] = f2bf(S); S = fmaf(D, S, L); }
    }
}
__device__ __forceinline__ void hg_out(const Params& p, unsigned char* ldsb) {
    const bf16_t* P = (const bf16_t*)(p.ws + WS_P); const float* lbp = (const float*)(p.ws + WS_LB);
    const bf16_t* SB = (const bf16_t*)((unsigned char*)p.out + HG_SB);
    bf16_t* mixed = (bf16_t*)(p.ws + WS_MIXED);
    LAS unsigned char* l = (LAS unsigned char*)ldsb;
    LAS float* gs = (LAS float*)l;
    LAS bf16_t* QT = (LAS bf16_t*)(l + 2048); LAS bf16_t* KT = (LAS bf16_t*)(l + 19456); LAS bf16_t* QI = (LAS bf16_t*)(l + 36864);
    LAS bf16_t* VT = (LAS bf16_t*)(l + 54272); LAS bf16_t* SC = (LAS bf16_t*)(l + 63488); LAS bf16_t* ST = (LAS bf16_t*)(l + 72704);
    LAS float* OB = (LAS float*)(l + 90112);
    const int tid = threadIdx.x, lane = tid & 63, wave = tid >> 6, rg = tid >> 7, k = tid & 127;
    for (int unit = blockIdx.x; unit < 2048; unit += gridDim.x) {
        const int bh = unit >> 7, c = unit & 127, b_ = bh >> 2, h = bh & 3;
        const size_t tok0 = (size_t)b_ * SEQ + c * 64;
        float kk[16], bc[16], bmid, blast;
        hg_cols(P, lbp, b_, h, c, gs, tid, kk, bc, bmid, blast);
        { const bf16_t* qp = P + (tok0 + rg * 16) * INW + C_HGQ + h * 128 + k;
#pragma unroll
          for (int i = 0; i < 16; ++i) { const float q = bf2f(qp[(size_t)i * INW]); const int o = (rg * 16 + i) * 136 + k;
              QT[o] = f2bf(q * __expf(fminf(bc[i] - bmid, 40.f))); KT[o] = f2bf(kk[i] * __expf(fminf(bmid - bc[i], 40.f))); QI[o] = f2bf(q * __expf(bc[i])); } }
        hg_load_vt(P, b_, h, c, VT, tid);
#pragma unroll
        for (int i = 0; i < 2; ++i) { const int idx = tid * 8 + i * 4096, j = idx >> 7, kq = idx & 127;
            *(LAS u4_t*)(ST + j * 136 + kq) = *(const u4_t*)(SB + (size_t)unit * 8192 + idx); }
        __syncthreads();
        if (wave < 4) { const int ti = wave >> 1, si = wave & 1;
            f32x16 acc;
#pragma unroll
            for (int r = 0; r < 16; ++r) acc[r] = 0.f;
            if (si <= ti) mma32(acc, QT + 32 * ti * 136, 136, KT + 32 * si * 136, 136, 128, lane);
            const int s = 32 * si + (lane & 31);
#pragma unroll
            for (int r = 0; r < 16; ++r) { const int t = 32 * ti + crow(r, lane >> 5); SC[t * 72 + s] = f2bf((s <= t) ? acc[r] : 0.f); } }
        __syncthreads();
        if (wave < 4) { const int ti = wave >> 1, ji = wave & 1;
            f32x16 acc;
#pragma unroll
            for (int r = 0; r < 16; ++r) acc[r] = 0.f;
            mma32(acc, SC + 32 * ti * 72, 72, VT + 32 * ji * 72, 72, 64, lane);
            mma32(acc, QI + 32 * ti * 136, 136, ST + 32 * ji * 136, 136, 128, lane);
            const int j = 32 * ji + (lane & 31);
#pragma unroll
            for (int r = 0; r < 16; ++r) OB[(32 * ti + crow(r, lane >> 5)) * 65 + j] = acc[r]; }
        __syncthreads();
        { const int t = tid >> 3, jq = tid & 7;
          float o[8]; float ss = 0.f;
#pragma unroll
          for (int e = 0; e < 8; ++e) { o[e] = OB[t * 65 + jq * 8 + e]; ss = fmaf(o[e], o[e], ss); }
          ss += __shfl_xor(ss, 1); ss += __shfl_xor(ss, 2); ss += __shfl_xor(ss, 4);
          const float r = rsqrtf(ss * (1.f / 64.f) + EPS);
          const uint4 gv = *(const uint4*)(P + (tok0 + t) * INW + C_HGG + h * 64 + jq * 8);
          const float* gn = p.hg_gain + h * 64 + jq * 8;
          uint4 w; w.x = pk2(o[0] * r * gn[0] * bflo(gv.x), o[1] * r * gn[1] * bfhi(gv.x)); w.y = pk2(o[2] * r * gn[2] * bflo(gv.y), o[3] * r * gn[3] * bfhi(gv.y));
          w.z = pk2(o[4] * r * gn[4] * bflo(gv.z), o[5] * r * gn[5] * bfhi(gv.z)); w.w = pk2(o[6] * r * gn[6] * bflo(gv.w), o[7] * r * gn[7] * bfhi(gv.w));
          *(uint4*)(mixed + (tok0 + t) * DM + 512 + h * 64 + jq * 8) = w; }
        __syncthreads();
    }
}

__device__ __forceinline__ void mem_knorm(const Params& p) {
    const float* kv = (const float*)(p.ws + WS_MEMKV);
    bf16_t* mk = (bf16_t*)(p.ws + WS_MEMK); bf16_t* mv = (bf16_t*)(p.ws + WS_MEMV);
    const int lane = threadIdx.x & 63, wave = threadIdx.x >> 6;
    for (int it = blockIdx.x * 8 + wave; it < NB * NMEM * 4; it += gridDim.x * 8) {
        const int m = it >> 2, h = it & 3;
        const float kx = kv[(size_t)m * 512 + h * 64 + lane], vx = kv[(size_t)m * 512 + 256 + h * 64 + lane];
        const float r = rsqrtf(wave_sum(kx * kx) * (1.f / 64.f) + EPS);
        mk[(size_t)m * 256 + h * 64 + lane] = f2bf(kx * r * p.mk_gain[lane]);
        mv[(size_t)m * 256 + h * 64 + lane] = f2bf(vx);
    }
}
__device__ __forceinline__ void mem_attn_naive(const Params& p) {
    const bf16_t* P = (const bf16_t*)(p.ws + WS_P);
    const bf16_t* mk = (const bf16_t*)(p.ws + WS_MEMK); const bf16_t* mv = (const bf16_t*)(p.ws + WS_MEMV);
    bf16_t* mixed = (bf16_t*)(p.ws + WS_MIXED);
    for (int idx = blockIdx.x * NTHR + threadIdx.x; idx < 4 * T; idx += gridDim.x * NTHR) {
        const int h = idx / T, tok = idx % T, b = tok / SEQ;
        float q[64], o[64];
        { const uint4* qp = (const uint4*)(P + (size_t)tok * INW + C_MQ + h * 64);
#pragma unroll
          for (int j = 0; j < 8; ++j) { const uint4 v = qp[j]; q[8 * j] = bflo(v.x); q[8 * j + 1] = bfhi(v.x); q[8 * j + 2] = bflo(v.y); q[8 * j + 3] = bfhi(v.y); q[8 * j + 4] = bflo(v.z); q[8 * j + 5] = bfhi(v.z); q[8 * j + 6] = bflo(v.w); q[8 * j + 7] = bfhi(v.w); } }
        float ss = 0.f;
#pragma unroll
        for (int d = 0; d < 64; ++d) ss = fmaf(q[d], q[d], ss);
        const float r = rsqrtf(ss * (1.f / 64.f) + EPS) * 0.125f;
#pragma unroll
        for (int d = 0; d < 64; ++d) { q[d] *= r * p.mq_gain[d]; o[d] = 0.f; }
        float mx = -1e30f, l = 0.f;
        for (int m = 0; m < NMEM; ++m) {
            const uint4* kp = (const uint4*)(mk + ((size_t)b * NMEM + m) * 256 + h * 64);
            const uint4* vp = (const uint4*)(mv + ((size_t)b * NMEM + m) * 256 + h * 64);
            float z = 0.f;
#pragma unroll
            for (int j = 0; j < 8; ++j) { const uint4 v = kp[j];
                z = fmaf(q[8 * j], bflo(v.x), z); z = fmaf(q[8 * j + 1], bfhi(v.x), z); z = fmaf(q[8 * j + 2], bflo(v.y), z); z = fmaf(q[8 * j + 3], bfhi(v.y), z);
                z = fmaf(q[8 * j + 4], bflo(v.z), z); z = fmaf(q[8 * j + 5], bfhi(v.z), z); z = fmaf(q[8 * j + 6], bflo(v.w), z); z = fmaf(q[8 * j + 7], bfhi(v.w), z); }
            const float mn = fmaxf(mx, z), corr = __expf(mx - mn), pe = __expf(z - mn);
            mx = mn; l = l * corr + pe;
#pragma unroll
            for (int j = 0; j < 8; ++j) { const uint4 v = vp[j];
                o[8 * j] = fmaf(pe, bflo(v.x), o[8 * j] * corr); o[8 * j + 1] = fmaf(pe, bfhi(v.x), o[8 * j + 1] * corr); o[8 * j + 2] = fmaf(pe, bflo(v.y), o[8 * j + 2] * corr); o[8 * j + 3] = fmaf(pe, bfhi(v.y), o[8 * j + 3] * corr);
                o[8 * j + 4] = fmaf(pe, bflo(v.z), o[8 * j + 4] * corr); o[8 * j + 5] = fmaf(pe, bfhi(v.z), o[8 * j + 5] * corr); o[8 * j + 6] = fmaf(pe, bflo(v.w), o[8 * j + 6] * corr); o[8 * j + 7] = fmaf(pe, bfhi(v.w), o[8 * j + 7] * corr); }
        }
        const float il = 1.f / l;
        uint4* op = (uint4*)(mixed + (size_t)tok * DM + 768 + h * 64);
#pragma unroll
        for (int j = 0; j < 8; ++j) { uint4 w; w.x = pk2(o[8 * j] * il, o[8 * j + 1] * il); w.y = pk2(o[8 * j + 2] * il, o[8 * j + 3] * il); w.z = pk2(o[8 * j + 4] * il, o[8 * j + 5] * il); w.w = pk2(o[8 * j + 6] * il, o[8 * j + 7] * il); op[j] = w; }
    }
}


__device__ __forceinline__ unsigned cvtpk(float lo, float hi) { unsigned r; asm("v_cvt_pk_bf16_f32 %0, %1, %2" : "=v"(r) : "v"(lo), "v"(hi)); return r; }
__device__ __forceinline__ sh8_t frag8(const float (&x)[8]) { const u4_t w = {cvtpk(x[0], x[1]), cvtpk(x[2], x[3]), cvtpk(x[4], x[5]), cvtpk(x[6], x[7])}; return __builtin_bit_cast(sh8_t, w); }
__device__ __forceinline__ int kperm(int key) { return (key & 16) | ((key & 4) << 1) | ((key & 8) >> 1) | (key & 3); }
__device__ __forceinline__ void vt_store(LAS bf16_t* VT, int pitch, int d0, int pos, const u4_t v) {
    LAS bf16_t* d = VT + d0 * pitch + pos;
    d[0 * pitch] = (bf16_t)(v.x & 0xffff); d[1 * pitch] = (bf16_t)(v.x >> 16); d[2 * pitch] = (bf16_t)(v.y & 0xffff); d[3 * pitch] = (bf16_t)(v.y >> 16);
    d[4 * pitch] = (bf16_t)(v.z & 0xffff); d[5 * pitch] = (bf16_t)(v.z >> 16); d[6 * pitch] = (bf16_t)(v.w & 0xffff); d[7 * pitch] = (bf16_t)(v.w >> 16);
}
__device__ __forceinline__ void sb_mfma(const Params& p, unsigned char* ldsb) {
    const bf16_t* P = (const bf16_t*)(p.ws + WS_P);
    bf16_t* mixed = (bf16_t*)(p.ws + WS_MIXED);
    const int tid = threadIdx.x, lane = tid & 63, wave = tid >> 6, r = lane & 31, hh = lane >> 5;
    LAS bf16_t* VT = (LAS bf16_t*)ldsb + wave * (64 * 40);
    sh8_t mf[2];
#pragma unroll
    for (int ks = 0; ks < 2; ++ks)
#pragma unroll
        for (int e = 0; e < 8; ++e) { const int j = 16 * ks + 8 * (e >> 2) + 4 * hh + (e & 3); mf[ks][e] = (j > r) ? (short)0x3F80 : (short)0; }
    for (int u = blockIdx.x * 8 + wave; u < 32 * 256; u += gridDim.x * 8) {
        const int bh = u >> 8, qt = u & 255, b = bh >> 3, h = bh & 7;
        const size_t tok0 = (size_t)b * SEQ + qt * 32;
        sh8_t qf[4];
        { const bf16_t* qp = P + (tok0 + r) * INW + C_SBQ + h * 64 + 8 * hh;
#pragma unroll
          for (int ks = 0; ks < 4; ++ks) qf[ks] = *(const sh8_t*)(qp + 16 * ks); }
        f32x16 o0, o1;
#pragma unroll
        for (int i = 0; i < 16; ++i) { o0[i] = 0.f; o1[i] = 0.f; }
        float R = 0.f;
        for (int kt = qt; kt >= 0; --kt) {
            const size_t ktok0 = (size_t)b * SEQ + kt * 32;
            f32x16 z;
#pragma unroll
            for (int i = 0; i < 16; ++i) z[i] = 0.f;
            { const bf16_t* kp = P + (ktok0 + r) * INW + C_SBK + h * 64 + 8 * hh;
#pragma unroll
              for (int ks = 0; ks < 4; ++ks) z = __builtin_amdgcn_mfma_f32_32x32x16_bf16(*(const sh8_t*)(kp + 16 * ks), qf[ks], z, 0, 0, 0); }
#pragma unroll
            for (int i = 0; i < 4; ++i) { const int idx = lane + 64 * i, key = idx >> 3, dq = idx & 7;
                const u4_t v = *(const u4_t*)(P + (ktok0 + key) * INW + C_SBV + h * 64 + dq * 8);
                vt_store(VT, 40, dq * 8, kperm(key), v); }
            const bool diag = (kt == qt);
            float sp[16]; f32x16 la; float tot = 0.f;
#pragma unroll
            for (int i = 0; i < 16; ++i) { const float zz = z[i];
                float s = fmaxf(zz, 0.f) + __builtin_amdgcn_logf(1.f + __builtin_amdgcn_exp2f(-fabsf(zz)));
                const bool valid = !diag || (crow(i, hh) < r);
                la[i] = zz - s + R; s = valid ? s : 0.f; sp[i] = s; tot += s; }
            tot += __shfl_xor(tot, 32);
#pragma unroll
            for (int ks = 0; ks < 2; ++ks) {
                unsigned hi[4], lo[4];
#pragma unroll
                for (int e = 0; e < 4; ++e) { const float x0 = -sp[8 * ks + 2 * e], x1 = -sp[8 * ks + 2 * e + 1]; hi[e] = cvtpk(x0, x1); lo[e] = cvtpk(x0 - bflo(hi[e]), x1 - bfhi(hi[e])); }
                const u4_t hv = {hi[0], hi[1], hi[2], hi[3]}, lv = {lo[0], lo[1], lo[2], lo[3]};
                la = __builtin_amdgcn_mfma_f32_32x32x16_bf16(mf[ks], __builtin_bit_cast(sh8_t, hv), la, 0, 0, 0);
                la = __builtin_amdgcn_mfma_f32_32x32x16_bf16(mf[ks], __builtin_bit_cast(sh8_t, lv), la, 0, 0, 0);
            }
            sh8_t af[2];
#pragma unroll
            for (int ks = 0; ks < 2; ++ks) { float a[8];
#pragma unroll
                for (int e = 0; e < 8; ++e) { const int i = 8 * ks + e; const bool valid = !diag || (crow(i, hh) < r); a[e] = valid ? __builtin_amdgcn_exp2f(la[i]) : 0.f; }
                af[ks] = frag8(a); }
            R -= tot;
#pragma unroll
            for (int ks = 0; ks < 2; ++ks) {
                o0 = __builtin_amdgcn_mfma_f32_32x32x16_bf16(*(const LAS sh8_t*)(VT + r * 40 + 16 * ks + 8 * hh), af[ks], o0, 0, 0, 0);
                o1 = __builtin_amdgcn_mfma_f32_32x32x16_bf16(*(const LAS sh8_t*)(VT + (32 + r) * 40 + 16 * ks + 8 * hh), af[ks], o1, 0, 0, 0);
            }
            if (__all(R < -160.f)) break;
        }
        float ss = 0.f;
#pragma unroll
        for (int i = 0; i < 16; ++i) { ss = fmaf(o0[i], o0[i], ss); ss = fmaf(o1[i], o1[i], ss); }
        ss += __shfl_xor(ss, 32);
        const float rn = rsqrtf(ss * (1.f / 64.f) + EPS);
        bf16_t* op = mixed + (tok0 + r) * DM + h * 64 + 4 * hh;
        const float* gp = p.sb_gain + h * 64 + 4 * hh;
#pragma unroll
        for (int q4 = 0; q4 < 4; ++q4) {
            const float4 g0 = *(const float4*)(gp + 8 * q4), g1 = *(const float4*)(gp + 32 + 8 * q4);
            uint2 w0, w1;
            w0.x = cvtpk(o0[4 * q4] * rn * g0.x, o0[4 * q4 + 1] * rn * g0.y); w0.y = cvtpk(o0[4 * q4 + 2] * rn * g0.z, o0[4 * q4 + 3] * rn * g0.w);
            w1.x = cvtpk(o1[4 * q4] * rn * g1.x, o1[4 * q4 + 1] * rn * g1.y); w1.y = cvtpk(o1[4 * q4 + 2] * rn * g1.z, o1[4 * q4 + 3] * rn * g1.w);
            *(uint2*)(op + 8 * q4) = w0; *(uint2*)(op + 32 + 8 * q4) = w1;
        }
    }
}
__device__ __forceinline__ void mem_attn_mfma(const Params& p, unsigned char* ldsb) {
    const bf16_t* P = (const bf16_t*)(p.ws + WS_P);
    const bf16_t* mk = (const bf16_t*)(p.ws + WS_MEMK); const bf16_t* mv = (const bf16_t*)(p.ws + WS_MEMV);
    bf16_t* mixed = (bf16_t*)(p.ws + WS_MIXED);
    const int tid = threadIdx.x, lane = tid & 63, wave = tid >> 6, r = lane & 31, hh = lane >> 5;
    LAS bf16_t* VT = (LAS bf16_t*)ldsb;
    for (int unit = blockIdx.x; unit < NB * 4 * (SEQ / 256); unit += gridDim.x) {
        const int tb = unit & 31, hd = (unit >> 5) & 3, b = unit >> 7;
        __syncthreads();
#pragma unroll
        for (int i = 0; i < 4; ++i) { const int idx = tid + 512 * i, key = idx >> 3, dq = idx & 7;
            const u4_t v = *(const u4_t*)(mv + ((size_t)b * NMEM + key) * 256 + hd * 64 + dq * 8);
            vt_store(VT, 264, dq * 8, (key & ~31) | kperm(key & 31), v); }
        __syncthreads();
        const size_t tok = (size_t)b * SEQ + tb * 256 + wave * 32 + r;
        sh8_t qf[4];
        { const bf16_t* qp = P + tok * INW + C_MQ + hd * 64 + 8 * hh;
          float qv[32]; float ss = 0.f;
#pragma unroll
          for (int ks = 0; ks < 4; ++ks) { const u4_t w = *(const u4_t*)(qp + 16 * ks);
              qv[8 * ks] = bflo(w.x); qv[8 * ks + 1] = bfhi(w.x); qv[8 * ks + 2] = bflo(w.y); qv[8 * ks + 3] = bfhi(w.y); qv[8 * ks + 4] = bflo(w.z); qv[8 * ks + 5] = bfhi(w.z); qv[8 * ks + 6] = bflo(w.w); qv[8 * ks + 7] = bfhi(w.w); }
#pragma unroll
          for (int i = 0; i < 32; ++i) ss = fmaf(qv[i], qv[i], ss);
          ss += __shfl_xor(ss, 32);
          const float rq = rsqrtf(ss * (1.f / 64.f) + EPS) * (0.125f * LOG2E);
#pragma unroll
          for (int ks = 0; ks < 4; ++ks) { float t8[8];
#pragma unroll
              for (int e = 0; e < 8; ++e) t8[e] = qv[8 * ks + e] * rq * p.mq_gain[16 * ks + 8 * hh + e];
              qf[ks] = frag8(t8); } }
        f32x16 s[8];
#pragma unroll
        for (int kt = 0; kt < 8; ++kt) {
#pragma unroll
            for (int i = 0; i < 16; ++i) s[kt][i] = 0.f;
            const bf16_t* kp = mk + ((size_t)b * NMEM + kt * 32 + r) * 256 + hd * 64 + 8 * hh;
#pragma unroll
            for (int ks = 0; ks < 4; ++ks) s[kt] = __builtin_amdgcn_mfma_f32_32x32x16_bf16(*(const sh8_t*)(kp + 16 * ks), qf[ks], s[kt], 0, 0, 0);
        }
        float mx = -1e30f;
#pragma unroll
        for (int kt = 0; kt < 8; ++kt)
#pragma unroll
            for (int i = 0; i < 16; ++i) mx = fmaxf(mx, s[kt][i]);
        mx = fmaxf(mx, __shfl_xor(mx, 32));
        float lsum = 0.f;
        f32x16 o0, o1;
#pragma unroll
        for (int i = 0; i < 16; ++i) { o0[i] = 0.f; o1[i] = 0.f; }
#pragma unroll
        for (int kt = 0; kt < 8; ++kt)
#pragma unroll
            for (int ks = 0; ks < 2; ++ks) { float a[8];
#pragma unroll
                for (int e = 0; e < 8; ++e) { a[e] = __builtin_amdgcn_exp2f(s[kt][8 * ks + e] - mx); lsum += a[e]; }
                const sh8_t af = frag8(a);
                o0 = __builtin_amdgcn_mfma_f32_32x32x16_bf16(*(const LAS sh8_t*)(VT + r * 264 + 32 * kt + 16 * ks + 8 * hh), af, o0, 0, 0, 0);
                o1 = __builtin_amdgcn_mfma_f32_32x32x16_bf16(*(const LAS sh8_t*)(VT + (32 + r) * 264 + 32 * kt + 16 * ks + 8 * hh), af, o1, 0, 0, 0); }
        lsum += __shfl_xor(lsum, 32);
        const float il = 1.f / lsum;
        bf16_t* op = mixed + tok * DM + 768 + hd * 64 + 4 * hh;
#pragma unroll
        for (int q4 = 0; q4 < 4; ++q4) {
            uint2 w0, w1;
            w0.x = cvtpk(o0[4 * q4] * il, o0[4 * q4 + 1] * il); w0.y = cvtpk(o0[4 * q4 + 2] * il, o0[4 * q4 + 3] * il);
            w1.x = cvtpk(o1[4 * q4] * il, o1[4 * q4 + 1] * il); w1.y = cvtpk(o1[4 * q4 + 2] * il, o1[4 * q4 + 3] * il);
            *(uint2*)(op + 8 * q4) = w0; *(uint2*)(op + 32 + 8 * q4) = w1;
        }
    }
}

__device__ __forceinline__ void rstd2_rows(const Params& p) {
    float* rs = (float*)(p.ws + WS_RSTD2);
    const int lane = threadIdx.x & 63, wave = threadIdx.x >> 6;
    for (int m = blockIdx.x * 8 + wave; m < T; m += gridDim.x * 8) {
        const float4* xr = (const float4*)(p.out + (size_t)m * DM) + lane; float s = 0.f;
#pragma unroll
        for (int j = 0; j < 4; ++j) { const float4 v = xr[64 * j]; s += (v.x * v.x + v.y * v.y) + (v.z * v.z + v.w * v.w); }
        s = wave_sum(s);
        if (lane == 0) rs[m] = rsqrtf(s * (1.f / DM) + EPS);
    }
}

__device__ __forceinline__ void wave_argmax(float& v, int& i) {
#pragma unroll
    for (int o = 32; o >= 1; o >>= 1) { const float ov = __shfl_xor(v, o); const int oi = __shfl_xor(i, o); if (ov > v || (ov == v && oi < i)) { v = ov; i = oi; } }
}
__device__ __forceinline__ void topk_naive(const Params& p, unsigned char* ldsb) {
    const bf16_t* Q = (const bf16_t*)(p.ws + WS_Q);
    const bf16_t* SK = (const bf16_t*)(p.ws + WS_SKB);
    int* pidx = (int*)(p.ws + WS_PIDX); float* pg = (float*)(p.ws + WS_PG);
    const int lane = threadIdx.x & 63, wave = threadIdx.x >> 6;
    float* tsv = (float*)ldsb + wave * 128;
    int* tsi = (int*)tsv + 32;
    float* bsv = tsv + 64; int* bse = (int*)tsv + 80;
    for (int it = blockIdx.x * 8 + wave; it < T * 8; it += gridDim.x * 8) {
        const int tok = it >> 3, h = it & 7;
        for (int c = 0; c < 2; ++c) {
            const uint4* qp = (const uint4*)(Q + (size_t)tok * 2048 + h * 256 + c * 128);
            const uint4* k0 = (const uint4*)(SK + ((size_t)(h * 2 + c) * 128 + lane) * 128);
            const uint4* k1 = (const uint4*)(SK + ((size_t)(h * 2 + c) * 128 + lane + 64) * 128);
            float s0 = 0.f, s1 = 0.f;
            for (int j = 0; j < 16; ++j) { const uint4 qv = qp[j], a = k0[j], bq = k1[j];
                s0 = fmaf(bflo(qv.x), bflo(a.x), s0); s0 = fmaf(bfhi(qv.x), bfhi(a.x), s0); s0 = fmaf(bflo(qv.y), bflo(a.y), s0); s0 = fmaf(bfhi(qv.y), bfhi(a.y), s0);
                s0 = fmaf(bflo(qv.z), bflo(a.z), s0); s0 = fmaf(bfhi(qv.z), bfhi(a.z), s0); s0 = fmaf(bflo(qv.w), bflo(a.w), s0); s0 = fmaf(bfhi(qv.w), bfhi(a.w), s0);
                s1 = fmaf(bflo(qv.x), bflo(bq.x), s1); s1 = fmaf(bfhi(qv.x), bfhi(bq.x), s1); s1 = fmaf(bflo(qv.y), bflo(bq.y), s1); s1 = fmaf(bfhi(qv.y), bfhi(bq.y), s1);
                s1 = fmaf(bflo(qv.z), bflo(bq.z), s1); s1 = fmaf(bfhi(qv.z), bfhi(bq.z), s1); s1 = fmaf(bflo(qv.w), bflo(bq.w), s1); s1 = fmaf(bfhi(qv.w), bfhi(bq.w), s1); }
            for (int r = 0; r < 16; ++r) {
                float v = s0; int i = lane; if (s1 > s0) { v = s1; i = lane + 64; }
                wave_argmax(v, i);
                if (lane == 0) { tsv[c * 16 + r] = v; tsi[c * 16 + r] = i; }
                if (i == lane) s0 = -INFINITY; if (i == lane + 64) s1 = -INFINITY;
            }
        }
        __builtin_amdgcn_s_waitcnt(0); __builtin_amdgcn_wave_barrier();
        float cs[4];
#pragma unroll
        for (int u = 0; u < 4; ++u) { const int id = lane * 4 + u; cs[u] = tsv[id >> 4] + tsv[16 + (id & 15)]; }
        for (int r = 0; r < 16; ++r) {
            float v = cs[0]; int i = lane * 4;
#pragma unroll
            for (int u = 1; u < 4; ++u) if (cs[u] > v) { v = cs[u]; i = lane * 4 + u; }
            wave_argmax(v, i);
            if (lane == 0) { bsv[r] = v; bse[r] = tsi[i >> 4] * 128 + tsi[16 + (i & 15)]; }
#pragma unroll
            for (int u = 0; u < 4; ++u) if (i == lane * 4 + u) cs[u] = -INFINITY;
        }
        __builtin_amdgcn_s_waitcnt(0); __builtin_amdgcn_wave_barrier();
        { const float mxv = bsv[0]; float e = (lane < 16) ? __expf(bsv[lane & 15] - mxv) : 0.f;
          float s = e; s += __shfl_xor(s, 1); s += __shfl_xor(s, 2); s += __shfl_xor(s, 4); s += __shfl_xor(s, 8);
          if (lane < 16) { pidx[(size_t)tok * PK + h * 16 + lane] = bse[lane]; pg[(size_t)tok * PK + h * 16 + lane] = e / s; } }
        __builtin_amdgcn_s_waitcnt(0); __builtin_amdgcn_wave_barrier();
    }
}

__device__ __forceinline__ void peer_naive(const Params& p, unsigned char* ldsb) {
    const int* pidx = (const int*)(p.ws + WS_PIDX); const float* pg = (const float*)(p.ws + WS_PG);
    const float* rs = (const float*)(p.ws + WS_RSTD2);
    float* hs = (float*)ldsb;
    float* red = hs + 1024;
    const int tid = threadIdx.x, lane = tid & 63, wave = tid >> 6;
    for (int tok = blockIdx.x; tok < T; tok += gridDim.x) {
        const float r2 = rs[tok];
        for (int d = tid; d < DM; d += NTHR) hs[d] = p.out[(size_t)tok * DM + d] * r2 * p.g_ffn[d];
        __syncthreads();
        float4 hv[4];
#pragma unroll
        for (int j = 0; j < 4; ++j) hv[j] = *((const float4*)hs + lane + 64 * j);
        float4 acc[4];
#pragma unroll
        for (int j = 0; j < 4; ++j) acc[j] = make_float4(0.f, 0.f, 0.f, 0.f);
        for (int pi = wave; pi < PK; pi += 8) {
            const int e = pidx[(size_t)tok * PK + pi]; const float g = pg[(size_t)tok * PK + pi];
            const float4* up = (const float4*)(p.pu + (size_t)e * DM) + lane;
            const float4* vp = (const float4*)(p.pv + (size_t)e * DM) + lane;
            float s = 0.f;
#pragma unroll
            for (int j = 0; j < 4; ++j) { const float4 u = up[64 * j]; s += (hv[j].x * u.x + hv[j].y * u.y) + (hv[j].z * u.z + hv[j].w * u.w); }
            s = wave_sum(s);
            const float w = g * 0.5f * s * (1.f + erff(s * 0.70710678118654752f));
#pragma unroll
            for (int j = 0; j < 4; ++j) { const float4 v = vp[64 * j]; acc[j].x = fmaf(w, v.x, acc[j].x); acc[j].y = fmaf(w, v.y, acc[j].y); acc[j].z = fmaf(w, v.z, acc[j].z); acc[j].w = fmaf(w, v.w, acc[j].w); }
        }
#pragma unroll
        for (int j = 0; j < 4; ++j) *((float4*)(red + wave * 1024) + lane + 64 * j) = acc[j];
        __syncthreads();
        for (int d = tid; d < DM; d += NTHR) { float s = 0.f;
#pragma unroll
            for (int w = 0; w < 8; ++w) s += red[w * 1024 + d];
            p.out[(size_t)tok * DM + d] += s; }
        __syncthreads();
    }
}


__device__ __forceinline__ int tk_pack(float s, int payload, int mask) { const int b = __float_as_int(s); const int m = b ^ ((b >> 31) & 0x7fffffff); return (m & ~mask) | payload; }
__device__ __forceinline__ float tk_unpack(int key, int mask) { const int m = key & ~mask; return __int_as_float(m ^ ((m >> 31) & 0x7fffffff)); }
template <int N> __device__ __forceinline__ void bitonic_sort_desc(int (&v)[N]) {
#pragma unroll
    for (int k = 2; k <= N; k <<= 1)
#pragma unroll
        for (int j = k >> 1; j > 0; j >>= 1)
#pragma unroll
            for (int i = 0; i < N; ++i) { const int l = i ^ j; if (l > i) { const bool desc = ((i & k) == 0); const int a = v[i], b = v[l]; const int hi = max(a, b), lo = min(a, b); v[i] = desc ? hi : lo; v[l] = desc ? lo : hi; } }
}
__device__ __forceinline__ void merge_top16(int (&A)[16], const int (&B)[16]) {
#pragma unroll
    for (int i = 0; i < 16; ++i) A[i] = max(A[i], B[15 - i]);
#pragma unroll
    for (int j = 8; j > 0; j >>= 1)
#pragma unroll
        for (int i = 0; i < 16; ++i) { const int l = i ^ j; if (l > i) { const int a = A[i], b = A[l]; A[i] = max(a, b); A[l] = min(a, b); } }
}
__device__ __forceinline__ void top16_of_64(int (&g0)[16], int (&g1)[16], int (&g2)[16], int (&g3)[16]) {
    bitonic_sort_desc<16>(g0); bitonic_sort_desc<16>(g1); bitonic_sort_desc<16>(g2); bitonic_sort_desc<16>(g3);
    merge_top16(g0, g1); merge_top16(g2, g3); merge_top16(g0, g2);
}
__device__ __forceinline__ void topk_mfma(const Params& p, unsigned char* ldsb) {
    const bf16_t* Q = (const bf16_t*)(p.ws + WS_Q);
    const bf16_t* SK = (const bf16_t*)(p.ws + WS_SKB);
    unsigned short* pidx16 = (unsigned short*)(p.ws + WS_PIDX); float* pg = (float*)(p.ws + WS_PG);
    LAS unsigned char* l = (LAS unsigned char*)ldsb;
    LAS bf16_t* SKL = (LAS bf16_t*)l;
    const int tid = threadIdx.x, lane = tid & 63, wave = tid >> 6, r = lane & 31, hh = lane >> 5;
    LAS unsigned char* ib = l + 69632 + (wave * 64 + lane) * 36;
    int cur_h = -1;
    for (int unit = blockIdx.x; unit < 8 * (T / 256); unit += gridDim.x) {
        const int h = unit & 7, tb = unit >> 3;
        if (h != cur_h) {
            __syncthreads();
#pragma unroll
            for (int it = 0; it < 8; ++it) { const int idx = tid + 512 * it, row = idx >> 4, cq = idx & 15;
                *(LAS u4_t*)(SKL + row * 136 + cq * 8) = *(const u4_t*)(SK + ((size_t)h * 256 + row) * 128 + cq * 8); }
            __syncthreads();
            cur_h = h;
        }
        const int tok = tb * 256 + wave * 32 + r;
        int sorted[2][16];
#pragma unroll
        for (int c = 0; c < 2; ++c) {
            sh8_t qf[8];
            { const sh8_t* qp = (const sh8_t*)(Q + (size_t)tok * 2048 + h * 256 + c * 128 + 8 * hh);
#pragma unroll
              for (int ks = 0; ks < 8; ++ks) qf[ks] = qp[2 * ks]; }
            int g[4][16];
#pragma unroll
            for (int mt = 0; mt < 4; ++mt) {
                f32x16 acc;
#pragma unroll
                for (int i = 0; i < 16; ++i) acc[i] = 0.f;
                const LAS bf16_t* ap = SKL + (c * 128 + 32 * mt + r) * 136 + 8 * hh;
#pragma unroll
                for (int ks = 0; ks < 8; ++ks) acc = __builtin_amdgcn_mfma_f32_32x32x16_bf16(*(const LAS sh8_t*)(ap + 16 * ks), qf[ks], acc, 0, 0, 0);
#pragma unroll
                for (int i = 0; i < 16; ++i) g[mt][i] = tk_pack(acc[i], (32 * mt + (i & 3) + 8 * (i >> 2)) | (hh << 2), 127);
            }
            top16_of_64(g[0], g[1], g[2], g[3]);
            int o[16];
#pragma unroll
            for (int i = 0; i < 16; ++i) o[i] = __shfl_xor(g[0][i], 32);
            merge_top16(g[0], o);
#pragma unroll
            for (int i = 0; i < 16; ++i) sorted[c][i] = g[0][i];
        }
#pragma unroll
        for (int c = 0; c < 2; ++c)
#pragma unroll
            for (int w = 0; w < 4; ++w)
                *(LAS unsigned*)(ib + c * 16 + w * 4) = (unsigned)(sorted[c][4 * w] & 127) | ((unsigned)(sorted[c][4 * w + 1] & 127) << 8) | ((unsigned)(sorted[c][4 * w + 2] & 127) << 16) | ((unsigned)(sorted[c][4 * w + 3] & 127) << 24);
        float av[16], bv[16];
#pragma unroll
        for (int i = 0; i < 16; ++i) { av[i] = tk_unpack(sorted[0][i], 127); bv[i] = tk_unpack(sorted[1][i], 127); }
        int cd[4][16];
        {
            int n = 0;
#pragma unroll
            for (int i = 0; i < 16; ++i)
#pragma unroll
                for (int j = 0; j < 16; ++j)
                    if ((i + 1) * (j + 1) <= 16) { cd[n >> 4][n & 15] = tk_pack(av[i] + bv[j], i * 16 + j, 255); ++n; }
#pragma unroll
            for (; n < 64; ++n) cd[n >> 4][n & 15] = (int)0x80000000;
        }
        top16_of_64(cd[0], cd[1], cd[2], cd[3]);
        float sv[16]; int ex[16];
        const float s0 = tk_unpack(cd[0][0], 255);
        float sum = 0.f;
#pragma unroll
        for (int q = 0; q < 16; ++q) { const int key = cd[0][q]; const int id = key & 255;
            const int ia = ib[id >> 4], ibx = ib[16 + (id & 15)];
            ex[q] = ia * 128 + ibx; sv[q] = __expf(tk_unpack(key, 255) - s0); sum += sv[q]; }
        const float inv = 1.f / sum;
        if (hh == 0) { u4_t* d = (u4_t*)(pidx16 + (size_t)tok * PK + h * 16);
#pragma unroll
            for (int w = 0; w < 2; ++w) d[w] = (u4_t){(unsigned)ex[8 * w] | ((unsigned)ex[8 * w + 1] << 16), (unsigned)ex[8 * w + 2] | ((unsigned)ex[8 * w + 3] << 16), (unsigned)ex[8 * w + 4] | ((unsigned)ex[8 * w + 5] << 16), (unsigned)ex[8 * w + 6] | ((unsigned)ex[8 * w + 7] << 16)}; }
        else { float4* d = (float4*)(pg + (size_t)tok * PK + h * 16);
#pragma unroll
            for (int w = 0; w < 4; ++w) d[w] = make_float4(sv[4 * w] * inv, sv[4 * w + 1] * inv, sv[4 * w + 2] * inv, sv[4 * w + 3] * inv); }
    }
}

struct Sl { int vx, rank, nrank; };
__device__ __forceinline__ float dpp_xor1(float x) { return __int_as_float(__builtin_amdgcn_mov_dpp(__float_as_int(x), 0xB1, 0xF, 0xF, true)); }
__device__ __forceinline__ float dpp_xor2(float x) { return __int_as_float(__builtin_amdgcn_mov_dpp(__float_as_int(x), 0x4E, 0xF, 0xF, true)); }
__device__ __forceinline__ float dpp_hmir(float x) { return __int_as_float(__builtin_amdgcn_mov_dpp(__float_as_int(x), 0x141, 0xF, 0xF, true)); }
__device__ __forceinline__ void peer_u_phase(const Params& p, const Sl sl) {
    const int lane = threadIdx.x & 63, wave = threadIdx.x >> 6, g8 = lane >> 3, c = lane & 7;
    const unsigned short* pidx = (const unsigned short*)(p.ws + WS_PIDX);
    const int tbase = sl.rank * 8 + wave, stride = sl.nrank * 8;
    const int nk = (tbase < T) ? (T - tbase + stride - 1) / stride : 0;
#define TK(k) (tbase + ((k) < nk ? (k) : nk - 1) * stride)
#define U_LOAD_IDX(I, t) { const u4_t* ip_ = (const u4_t*)(pidx + (size_t)(t) * PK + g8 * 16); I[0] = __builtin_nontemporal_load(ip_); I[1] = __builtin_nontemporal_load(ip_ + 1); }
#define U_LOAD_H(H, t) { const u2_t h0_ = __builtin_nontemporal_load((const u2_t*)(xbb + (size_t)(t) * DM)), h1_ = __builtin_nontemporal_load((const u2_t*)(xbb + (size_t)(t) * DM + 64)); H = (u4_t){h0_.x, h0_.y, h1_.x, h1_.y}; }
#define U_ISSUE(G, I) { const unsigned w0_ = I[(G) >> 1][(2 * (G)) & 3], w1_ = I[(G) >> 1][(2 * (G) + 1) & 3]; \
        rr[4 * (G)] = *(const u4_t*)(Ub + (size_t)(w0_ & 0xffffu) * 64); rr[4 * (G) + 1] = *(const u4_t*)(Ub + (size_t)(w0_ >> 16) * 64); \
        rr[4 * (G) + 2] = *(const u4_t*)(Ub + (size_t)(w1_ & 0xffffu) * 64); rr[4 * (G) + 3] = *(const u4_t*)(Ub + (size_t)(w1_ >> 16) * 64); }
#define U_DOT(G, H) { _Pragma("unroll") for (int i_ = 4 * (G); i_ < 4 * (G) + 4; ++i_) { float s_ = dot2bf(H.x, rr[i_].x, 0.f); s_ = dot2bf(H.y, rr[i_].y, s_); s_ = dot2bf(H.z, rr[i_].z, s_); pr[i_] = dot2bf(H.w, rr[i_].w, s_); } }
#define U_STEP(k, I1, I2, Hc, Hn) { float pr[16]; \
        U_LOAD_IDX(I2, TK((k) + 2)); U_LOAD_H(Hn, TK((k) + 1)); __builtin_amdgcn_sched_barrier(0); \
        U_DOT(0, Hc); __builtin_amdgcn_sched_barrier(0); U_ISSUE(0, I1); __builtin_amdgcn_sched_barrier(0); U_DOT(1, Hc); __builtin_amdgcn_sched_barrier(0); U_ISSUE(1, I1); __builtin_amdgcn_sched_barrier(0); U_DOT(2, Hc); __builtin_amdgcn_sched_barrier(0); U_ISSUE(2, I1); __builtin_amdgcn_sched_barrier(0); U_DOT(3, Hc); __builtin_amdgcn_sched_barrier(0); U_ISSUE(3, I1); __builtin_amdgcn_sched_barrier(0); \
        _Pragma("unroll") for (int j_ = 0; j_ < 8; ++j_) { const float keep_ = (c & 4) ? pr[j_ + 8] : pr[j_], send_ = (c & 4) ? pr[j_] : pr[j_ + 8]; pr[j_] = keep_ + dpp_hmir(send_); } \
        _Pragma("unroll") for (int j_ = 0; j_ < 4; ++j_) { const float keep_ = (c & 2) ? pr[j_ + 4] : pr[j_], send_ = (c & 2) ? pr[j_] : pr[j_ + 4]; pr[j_] = keep_ + dpp_xor2(send_); } \
        _Pragma("unroll") for (int j_ = 0; j_ < 2; ++j_) { const float keep_ = (c & 1) ? pr[j_ + 2] : pr[j_], send_ = (c & 1) ? pr[j_] : pr[j_ + 2]; pr[j_] = keep_ + dpp_xor1(send_); } \
        __builtin_nontemporal_store((float2_t){pr[0], pr[1]}, (float2_t*)(PUs + (size_t)TK(k) * PK + g8 * 16 + 2 * c)); }
    for (int rd = 0; rd < 2; ++rd) {
        const int s = sl.vx + 8 * rd;
        const bf16_t* Ub = (const bf16_t*)(p.ws + WS_U16) + (size_t)s * NEXP * 64 + c * 8;
        const bf16_t* xbb = (const bf16_t*)(p.ws + WS_XB) + (2 * c) * 64 + s * 4;
        float* PUs = (float*)(p.ws + WS_PU) + (size_t)s * T * PK;
        if (nk == 0) continue;
        u4_t iA[2], iB[2], rr[16], hA, hB;
        U_LOAD_IDX(iA, TK(0)); U_LOAD_IDX(iB, TK(1)); U_LOAD_H(hA, TK(0)); __builtin_amdgcn_sched_barrier(0);
        U_ISSUE(0, iA); __builtin_amdgcn_sched_barrier(0); U_ISSUE(1, iA); __builtin_amdgcn_sched_barrier(0); U_ISSUE(2, iA); __builtin_amdgcn_sched_barrier(0); U_ISSUE(3, iA); __builtin_amdgcn_sched_barrier(0);
        for (int k = 0; k < nk; k += 2) {
            U_STEP(k, iB, iA, hA, hB);
            if (k + 1 < nk) U_STEP(k + 1, iA, iB, hB, hA);
        }
    }
#undef U_LOAD_IDX
#undef U_LOAD_H
#undef U_ISSUE
#undef U_DOT
#undef U_STEP
}
__device__ __forceinline__ void peer_w_phase(const Params& p) {
    const float* PU = (const float*)(p.ws + WS_PU); const float* pg = (const float*)(p.ws + WS_PG); const float* rs = (const float*)(p.ws + WS_RSTD2);
    float* pw = (float*)(p.ws + WS_PW);
    for (int i = blockIdx.x * NTHR + threadIdx.x; i < T * PK / 4; i += gridDim.x * NTHR) {
        f32x4_t s = {0.f, 0.f, 0.f, 0.f};
#pragma unroll
        for (int x = 0; x < 16; ++x) s += __builtin_nontemporal_load((const f32x4_t*)(PU + (size_t)x * T * PK) + i);
        s *= rs[i >> 5];
        const f32x4_t g = *((const f32x4_t*)pg + i);
        f32x4_t w;
#pragma unroll
        for (int e = 0; e < 4; ++e) w[e] = g[e] * 0.5f * s[e] * (1.f + erff(s[e] * 0.70710678118654752f));
        *((f32x4_t*)pw + i) = w;
    }
}
__device__ __forceinline__ void peer_v_phase(const Params& p, const Sl sl) {
    const int lane = threadIdx.x & 63, wave = threadIdx.x >> 6, g8 = lane & 7, c = lane >> 3;
    const unsigned short* pidx = (const unsigned short*)(p.ws + WS_PIDX); const float* pw = (const float*)(p.ws + WS_PW);
    const int tbase = sl.rank * 8 + wave, stride = sl.nrank * 8;
    const int nk = (tbase < T) ? (T - tbase + stride - 1) / stride : 0;
#define V_LOAD_IDX(I, t) { const u4_t* ip_ = (const u4_t*)(pidx + (size_t)(t) * PK + g8 * 16); I[0] = __builtin_nontemporal_load(ip_); I[1] = __builtin_nontemporal_load(ip_ + 1); }
#define V_LOAD_W(W, t) { const f32x4_t* wp_ = (const f32x4_t*)(pw + (size_t)(t) * PK + g8 * 16); W[0] = __builtin_nontemporal_load(wp_); W[1] = __builtin_nontemporal_load(wp_ + 1); W[2] = __builtin_nontemporal_load(wp_ + 2); W[3] = __builtin_nontemporal_load(wp_ + 3); }
#define V_ISSUE(G, I) { const unsigned w0_ = I[(G) >> 1][(2 * (G)) & 3], w1_ = I[(G) >> 1][(2 * (G) + 1) & 3]; \
        rr[4 * (G)] = *(const h8_t*)(Vb + (size_t)(w0_ & 0xffffu) * 64); rr[4 * (G) + 1] = *(const h8_t*)(Vb + (size_t)(w0_ >> 16) * 64); \
        rr[4 * (G) + 2] = *(const h8_t*)(Vb + (size_t)(w1_ & 0xffffu) * 64); rr[4 * (G) + 3] = *(const h8_t*)(Vb + (size_t)(w1_ >> 16) * 64); }
#define V_FMA(G, W) { _Pragma("unroll") for (int i_ = 4 * (G); i_ < 4 * (G) + 4; ++i_) { const float wv_ = W[G][i_ & 3]; \
            _Pragma("unroll") for (int k_ = 0; k_ < 8; ++k_) acc[k_] = fmaf((float)rr[i_][k_], wv_, acc[k_]); } }
#define V_STEP(k, I1, I2, Wc, Wn) { float acc[8]; \
        _Pragma("unroll") for (int k_ = 0; k_ < 8; ++k_) acc[k_] = 0.f; \
        float* op_ = ob + (size_t)TK(k) * DM; const float oold_ = *op_; \
        V_LOAD_IDX(I2, TK((k) + 2)); V_LOAD_W(Wn, TK((k) + 1)); __builtin_amdgcn_sched_barrier(0); \
        V_FMA(0, Wc); __builtin_amdgcn_sched_barrier(0); V_ISSUE(0, I1); __builtin_amdgcn_sched_barrier(0); V_FMA(1, Wc); __builtin_amdgcn_sched_barrier(0); V_ISSUE(1, I1); __builtin_amdgcn_sched_barrier(0); V_FMA(2, Wc); __builtin_amdgcn_sched_barrier(0); V_ISSUE(2, I1); __builtin_amdgcn_sched_barrier(0); V_FMA(3, Wc); __builtin_amdgcn_sched_barrier(0); V_ISSUE(3, I1); __builtin_amdgcn_sched_barrier(0); \
        _Pragma("unroll") for (int j_ = 0; j_ < 4; ++j_) { const float keep_ = (g8 & 4) ? acc[j_ + 4] : acc[j_], send_ = (g8 & 4) ? acc[j_] : acc[j_ + 4]; acc[j_] = keep_ + dpp_hmir(send_); } \
        _Pragma("unroll") for (int j_ = 0; j_ < 2; ++j_) { const float keep_ = (g8 & 2) ? acc[j_ + 2] : acc[j_], send_ = (g8 & 2) ? acc[j_] : acc[j_ + 2]; acc[j_] = keep_ + dpp_xor2(send_); } \
        { const float keep_ = (g8 & 1) ? acc[1] : acc[0], send_ = (g8 & 1) ? acc[0] : acc[1]; acc[0] = keep_ + dpp_xor1(send_); } \
        *op_ = oold_ + acc[0]; }
    for (int rd = 0; rd < 2; ++rd) {
        const int s = sl.vx + 8 * rd;
        const _Float16* Vb = (const _Float16*)(p.ws + WS_V16) + (size_t)s * NEXP * 64 + c * 8;
        float* ob = p.out + (lane >> 2) * 64 + s * 4 + (lane & 3);
        if (nk == 0) continue;
        u4_t iA[2], iB[2]; f32x4_t wA[4], wB[4]; h8_t rr[16];
        V_LOAD_IDX(iA, TK(0)); V_LOAD_IDX(iB, TK(1)); V_LOAD_W(wA, TK(0)); __builtin_amdgcn_sched_barrier(0);
        V_ISSUE(0, iA); __builtin_amdgcn_sched_barrier(0); V_ISSUE(1, iA); __builtin_amdgcn_sched_barrier(0); V_ISSUE(2, iA); __builtin_amdgcn_sched_barrier(0); V_ISSUE(3, iA); __builtin_amdgcn_sched_barrier(0);
        for (int k = 0; k < nk; k += 2) {
            V_STEP(k, iB, iA, wA, wB);
            if (k + 1 < nk) V_STEP(k + 1, iA, iB, wB, wA);
        }
    }
#undef V_LOAD_IDX
#undef V_LOAD_W
#undef V_ISSUE
#undef V_FMA
#undef V_STEP
#undef TK
}

__global__ void __launch_bounds__(NTHR, 2) fwd_kernel(Params p) {
    extern __shared__ __attribute__((aligned(16))) unsigned char lds[];
    cg::grid_group grid = cg::this_grid();
    unsigned char* ws = p.ws;
    PG8_LAS unsigned char* ldsl = (PG8_LAS unsigned char*)lds;
    if (threadIdx.x == 0) { unsigned* ctl0 = (unsigned*)(ws + WS_CTL); const unsigned xcc0 = (unsigned)__builtin_amdgcn_s_getreg((3 << 11) | 20) & 7u;
        ((volatile unsigned*)lds)[36860] = __hip_atomic_fetch_add(&ctl0[64 * xcc0], 1u, __ATOMIC_RELAXED, __HIP_MEMORY_SCOPE_AGENT); ((volatile unsigned*)lds)[36861] = xcc0; }
    if (threadIdx.x < 2) ((volatile LAS unsigned*)(LAS unsigned char*)lds)[36862 + threadIdx.x] = 0u;
    __syncthreads();
    const XcdBarrier xbar = xcd_barrier_post((unsigned*)(ws + WS_CTL) + 4096, (volatile LAS unsigned*)(LAS unsigned char*)lds + 36862);
#ifndef PROBE_DBL
#define PROBE_DBL -1
#endif
#define REP(k) for (int rep_ = 0; rep_ < ((PROBE_DBL == (k)) ? 2 : 1); ++rep_)
    REP(0) phase_prep(p, lds);
    grid.sync();
    {
    { pg8::Gemm g{(const bf16_t*)(ws + WS_XB), (const bf16_t*)(ws + WS_WIN_T), T, INW, DM}; pg8::StaticOrder S; S.init(T, INW, gridDim.x, blockIdx.x); pg8::EpiProjM e{(bf16_t*)(ws + WS_P)};
      pg8::gemm_phase<pg8::EpiProjM, pg8::StaticOrder, true, true>(ldsl, g, S, e); }
#if PROBE_DBL == 1
    { pg8::Gemm g{(const bf16_t*)(ws + WS_XB), (const bf16_t*)(ws + WS_WIN_T), T, INW, DM}; pg8::StaticOrder S; S.init(T, INW, gridDim.x, blockIdx.x); pg8::EpiProjM e{(bf16_t*)(ws + WS_P)};
      pg8::gemm_phase<pg8::EpiProjM, pg8::StaticOrder, true, true>(ldsl, g, S, e); }
#endif
    { pg8::Gemm g{(const bf16_t*)(ws + WS_MEMN), (const bf16_t*)(ws + WS_WMKV_T), NB * NMEM, 512, DM}; pg8::StaticOrder S; S.init(NB * NMEM, 512, gridDim.x, blockIdx.x); pg8::EpiF32M e{(float*)(ws + WS_MEMKV), 512};
      pg8::gemm_phase<pg8::EpiF32M, pg8::StaticOrder, true, true>(ldsl, g, S, e); }
    }
    xcd_barrier(xbar);
    mem_knorm(p);
    REP(2) { sb_mfma(p, lds); __syncthreads(); }
    REP(3) { hg_local(p, lds); }
    xcd_barrier(xbar);
    REP(4) hg_scan(p);
    REP(5) mem_attn_mfma(p, lds);
    xcd_barrier(xbar);
    REP(6) hg_out(p, lds);
    xcd_barrier(xbar);
    { pg8::Gemm g{(const bf16_t*)(ws + WS_MIXED), (const bf16_t*)(ws + WS_WOUT_T), T, DM, DM}; pg8::StaticOrder S; S.init(T, DM, gridDim.x, blockIdx.x); pg8::EpiWoutM e{p.x, p.out, (bf16_t*)(ws + WS_XB)};
      pg8::gemm_phase<pg8::EpiWoutM, pg8::StaticOrder, true, true>(ldsl, g, S, e); }
#if PROBE_DBL == 7
    { pg8::Gemm g{(const bf16_t*)(ws + WS_MIXED), (const bf16_t*)(ws + WS_WOUT_T), T, DM, DM}; pg8::StaticOrder S; S.init(T, DM, gridDim.x, blockIdx.x); pg8::EpiWoutM e{p.x, p.out, (bf16_t*)(ws + WS_XB)};
      pg8::gemm_phase<pg8::EpiWoutM, pg8::StaticOrder, true, true>(ldsl, g, S, e); }
#endif
    xcd_barrier(xbar);
    REP(8) rstd2_rows(p);
    xcd_barrier(xbar);
    { pg8::Gemm g{(const bf16_t*)(ws + WS_XB), (const bf16_t*)(ws + WS_WQ_T), T, 2048, DM}; pg8::StaticOrder S; S.init(T, 2048, gridDim.x, blockIdx.x); pg8::EpiQM e{(const float*)(ws + WS_RSTD2), (bf16_t*)(ws + WS_Q)};
      pg8::gemm_phase<pg8::EpiQM, pg8::StaticOrder, true, true>(ldsl, g, S, e); }
#if PROBE_DBL == 9
    { pg8::Gemm g{(const bf16_t*)(ws + WS_XB), (const bf16_t*)(ws + WS_WQ_T), T, 2048, DM}; pg8::StaticOrder S; S.init(T, 2048, gridDim.x, blockIdx.x); pg8::EpiQM e{(const float*)(ws + WS_RSTD2), (bf16_t*)(ws + WS_Q)};
      pg8::gemm_phase<pg8::EpiQM, pg8::StaticOrder, true, true>(ldsl, g, S, e); }
#endif
    xcd_barrier(xbar);
    REP(10) topk_mfma(p, lds);
    xcd_barrier(xbar);
    Sl sl;
    { const unsigned* ctl = (const unsigned*)(ws + WS_CTL); const int myrank = (int)((volatile unsigned*)lds)[36860]; const unsigned xcc = ((volatile unsigned*)lds)[36861];
      bool good = (gridDim.x % 8u) == 0u;
      for (int j = 0; j < 8; ++j) good = good && (__hip_atomic_load(&ctl[64 * j], __ATOMIC_RELAXED, __HIP_MEMORY_SCOPE_AGENT) == gridDim.x / 8u);
      if (good) { sl.vx = (int)xcc; sl.rank = myrank; sl.nrank = (int)(gridDim.x / 8u); }
      else { sl.vx = (int)(blockIdx.x & 7u); sl.rank = (int)(blockIdx.x >> 3); sl.nrank = (int)((gridDim.x - (blockIdx.x & 7u) + 7u) / 8u); } }
    REP(11) peer_u_phase(p, sl);
    xcd_barrier(xbar);
    REP(12) peer_w_phase(p);
    xcd_barrier(xbar);
    if (PROBE_DBL == 100) { for (int i = 0; i < 10; ++i) xcd_barrier(xbar); }
    peer_v_phase(p, sl);
}

extern "C" void kernel_launch(void* const* d_in, const int* in_sizes, int n_in, void* d_out, int out_size, void* d_ws, size_t ws_size, hipStream_t stream) {
    static int grid_blocks = 0;
    if (grid_blocks == 0) {
        if (n_in != 17 || out_size != T * DM || ws_size < WS_END) { fprintf(stderr, "kernel_launch: unexpected shapes n_in %d out %d ws %zu\n", n_in, out_size, ws_size); grid_blocks = -1; return; }
        int dev = 0, cus = 0, per_cu = 0;
        (void)hipGetDevice(&dev);
        (void)hipDeviceGetAttribute(&cus, hipDeviceAttributeMultiprocessorCount, dev);
        (void)hipFuncSetAttribute((const void*)fwd_kernel, hipFuncAttributeMaxDynamicSharedMemorySize, LDS_BYTES);
        (void)hipOccupancyMaxActiveBlocksPerMultiprocessor(&per_cu, (const void*)fwd_kernel, NTHR, LDS_BYTES);
        if (per_cu < 1) { fprintf(stderr, "kernel_launch: occupancy query says %d blocks/CU\n", per_cu); per_cu = 1; }
        grid_blocks = cus * 1;
        (void)hipGetLastError();
    }
    if (grid_blocks < 0) return;
    Params p{};
    p.x = (const float*)d_in[0]; p.mem = (const float*)d_in[1]; p.g_mix = (const float*)d_in[2]; p.w_in = (const float*)d_in[3]; p.gamma_lb = (const float*)d_in[4];
    p.sb_gain = (const float*)d_in[5]; p.hg_gain = (const float*)d_in[6]; p.mem_gain = (const float*)d_in[7]; p.w_mkv = (const float*)d_in[8]; p.mq_gain = (const float*)d_in[9];
    p.mk_gain = (const float*)d_in[10]; p.w_out = (const float*)d_in[11]; p.g_ffn = (const float*)d_in[12]; p.w_q = (const float*)d_in[13]; p.sub_keys = (const float*)d_in[14];
    p.pu = (const float*)d_in[15]; p.pv = (const float*)d_in[16];
    p.out = (float*)d_out; p.ws = (unsigned char*)d_ws;
    (void)hipMemsetAsync((char*)d_ws + WS_CTL, 0, 65536, stream);
    void* args[] = {&p};
    hipError_t e = hipLaunchCooperativeKernel((const void*)fwd_kernel, dim3(grid_blocks), dim3(NTHR), args, LDS_BYTES, stream);
    if (e != hipSuccess) fprintf(stderr, "cooperative launch failed: %s (grid %d)\n", hipGetErrorString(e), grid_blocks);
}
```

```cpp
#include <hip/hip_runtime.h>
#include <hip/hip_cooperative_groups.h>
#include <cstdio>
#include <cstdint>
namespace cg = cooperative_groups;

constexpr int NB = 4, SEQ = 8192, DM = 1024, T = NB * SEQ;
constexpr int NMEM = 256, INW = 3328;
constexpr int C_SBQ = 0, C_SBK = 512, C_SBV = 1024, C_HGQ = 1536, C_HGF = 2048, C_HGI = 2560, C_HGG = 2816, C_MQ = 3072;
constexpr int NEXP = 16384, PK = 128;
constexpr float EPS = 1e-6f;
constexpr float LOG2E = 1.4426950408889634f;
constexpr float C2 = 0.125f * LOG2E;

constexpr float PEER_US = 64.f, PEER_VS = 8.f;
constexpr int NTHR = 512;
constexpr int LDS_BYTES = 147456;

constexpr size_t MiB = 1u << 20;
constexpr size_t WS_CTL = 0;
constexpr size_t WS_WIN_T = 1 * MiB;
constexpr size_t WS_WOUT_T = 8 * MiB;
constexpr size_t WS_WQ_T = 10 * MiB;
constexpr size_t WS_WMKV_T = 14 * MiB;
constexpr size_t WS_SKB = 15 * MiB;
constexpr size_t WS_LB = 15 * MiB + 512 * 1024;
constexpr size_t WS_MEMN = 16 * MiB;
constexpr size_t WS_MEMKV = 18 * MiB;
constexpr size_t WS_MEMK = 20 * MiB;
constexpr size_t WS_MEMV = 20 * MiB + 512 * 1024;
constexpr size_t WS_RSTD2 = 21 * MiB;
constexpr size_t WS_PIDX = 24 * MiB;
constexpr size_t WS_PG = 40 * MiB;
constexpr size_t WS_XB = 72 * MiB;
constexpr size_t WS_MIXED = 136 * MiB;
constexpr size_t WS_P = 200 * MiB;
constexpr size_t WS_Q = 136 * MiB;
constexpr size_t WS_X1S = 270 * MiB;
constexpr size_t WS_SSQ = 22 * MiB;
constexpr size_t WS_HGRAW = 408 * MiB;
constexpr size_t WS_PW = 56 * MiB;
constexpr size_t WS_PU = 136 * MiB;
constexpr size_t WS_U16 = 440 * MiB;
constexpr size_t WS_V16 = 472 * MiB;
constexpr size_t WS_END = 512 * MiB;

typedef unsigned short bf16_t;
__device__ __forceinline__ float bf2f(bf16_t v) { return __uint_as_float(((unsigned)v) << 16); }
__device__ __forceinline__ float bflo(unsigned w) { return __uint_as_float(w << 16); }
__device__ __forceinline__ float bfhi(unsigned w) { return __uint_as_float(w & 0xffff0000u); }
__device__ __forceinline__ bf16_t f2bf(float f) { unsigned u = __float_as_uint(f); return (bf16_t)((u + 0x7fffu + ((u >> 16) & 1u)) >> 16); }
__device__ __forceinline__ unsigned pk2(float lo, float hi) { return (unsigned)f2bf(lo) | ((unsigned)f2bf(hi) << 16); }
__device__ __forceinline__ float wave_sum(float v) {
#pragma unroll
    for (int o = 1; o < 64; o <<= 1) v += __shfl_xor(v, o);
    return v;
}
__device__ __forceinline__ float silu(float v) { return v / (1.f + __expf(-v)); }

typedef _Float16 h8_t __attribute__((ext_vector_type(8)));
typedef _Float16 h2_t __attribute__((ext_vector_type(2)));
typedef _Float16 h4_t __attribute__((ext_vector_type(4)));
typedef unsigned u2_t __attribute__((ext_vector_type(2)));
typedef __bf16 bf16x2_v __attribute__((ext_vector_type(2)));
__device__ __forceinline__ float dot2bf(unsigned a, unsigned b, float c) { return __builtin_amdgcn_fdot2_f32_bf16(__builtin_bit_cast(bf16x2_v, a), __builtin_bit_cast(bf16x2_v, b), c, false); }

struct Params {
    const float *x, *mem, *g_mix, *w_in, *gamma_lb, *sb_gain, *hg_gain, *mem_gain, *w_mkv, *mq_gain, *mk_gain, *w_out, *g_ffn, *w_q, *sub_keys, *pu, *pv;
    float* out; unsigned char* ws;
};

namespace pg8 {
#define PG8_LAS __attribute__((address_space(3)))
typedef unsigned short bf16_t;
typedef short bf16x8 __attribute__((ext_vector_type(8)));
typedef float f32x4 __attribute__((ext_vector_type(4)));
typedef unsigned u32x4 __attribute__((ext_vector_type(4)));
constexpr int BM = 256, BK = 64, HALF = 128, HTB = HALF * BK * 2  , STAGE_BYTES = 8 * HTB, NXCD = 8, WGM = 8;

__host__ __device__ __forceinline__ int lds_byte(int r, int c) { const int st = (r >> 4) * 2 + (c >> 5), rr = r & 15, cc = c & 31, ob = rr * 64 + cc * 2; return st * 1024 + (ob ^ (((ob >> 9) & 1) << 5)); }
__host__ __device__ __forceinline__ void stage_rc(int b, int& R, int& C) { const int st = b / 1024, sb = b % 1024, swz = sb ^ (((sb >> 9) & 1) << 5); R = (st >> 1) * 16 + swz / 64; C = (st & 1) * 32 + (swz % 64) / 2; }
__host__ __device__ __forceinline__ int perm32(int rho) { const int n = rho >> 4, i = rho & 15; return 8 * (i >> 2) + 4 * n + (i & 3); }

struct Unit { int pm, pn; };
struct Gemm { const bf16_t* A; const bf16_t* Bt; int M, N, K; int lda; size_t kstepA; };

struct StaticOrder {
    int nM, nN, nwg, G, c;
    __host__ __device__ void init(int M, int N, int G_, int c_) { nM = M / BM; nN = N / BM; nwg = nM * nN; G = G_; c = c_; }
    __host__ __device__ bool next(int i, Unit& u) const {
        const long L = (long)i * G + c; if (L >= nwg) return false;
        int wgid = (int)L; { const int q = nwg / NXCD, r = nwg % NXCD, xcd = wgid % NXCD, off = wgid / NXCD; wgid = (xcd < r ? xcd * (q + 1) : r * (q + 1) + (xcd - r) * q) + off; }
        const int nig = WGM * nN, gid = wgid / nig, fm = gid * WGM, gsz = (nM - fm) < WGM ? (nM - fm) : WGM;
        u.pm = fm + ((wgid % nig) % gsz); u.pn = (wgid % nig) / gsz; return true;
    }
    __device__ __forceinline__ void a_ready(const Unit&) const {}
    __device__ __forceinline__ void done(const Unit&) const {}
};

__device__ __forceinline__ unsigned cvt_pk_bf16(float lo, float hi) { unsigned r; asm volatile("v_cvt_pk_bf16_f32 %0, %1, %2" : "=v"(r) : "v"(lo), "v"(hi)); return r; }
typedef float f32x2 __attribute__((ext_vector_type(2)));
template <class Epi, class Sched, bool ALIGN_EPI = false, bool SP2 = false>
__device__ __forceinline__ void gemm_phase(PG8_LAS unsigned char* lds, const Gemm g, const Sched& S, const Epi& E) {
    int tid_ = threadIdx.x; asm volatile("" : "+v"(tid_));
    const int tid = tid_, wid = __builtin_amdgcn_readfirstlane(tid >> 6), lane = tid & 63, wr = wid >> 2, wc = wid & 3, fr = lane & 15, fq = lane >> 4;
    const int K = g.K, nt = K / BK;
    unsigned voffA[2], voffB[2];
#pragma unroll
    for (int i = 0; i < 2; ++i) { int R, C; stage_rc(tid * 16 + i * 8192, R, C); const int Rb = Epi::PERM ? ((R & ~31) + perm32(R & 31)) : R;
        voffA[i] = (unsigned)(R * g.lda + C) * 2u; voffB[i] = (unsigned)(Rb * K + C) * 2u; }
    const size_t kstep = (size_t)(BK * 2);
    const size_t hstep = (size_t)HALF * K * 2;
    const size_t tstep = 2 * hstep;
    const size_t kstepA = g.kstepA, hstepA = (size_t)HALF * g.lda * 2, tstepA = 2 * hstepA;
    const unsigned ldsw = (unsigned)wid * 1024u;
    const int aoff = lds_byte(wr * 64 + fr, fq * 8), boff = lds_byte(wc * 32 + fr, fq * 8);
#define PG8_SA(b, h) (((b) * 2 + (h)) * HTB)
#define PG8_SB(b, h) ((4 + (b) * 2 + (h)) * HTB)
#define PG8_STAGE(bufoff, gbase, voff) do { _Pragma("unroll") for (int _i = 0; _i < 2; ++_i) \
        __builtin_amdgcn_global_load_lds((const unsigned*)((const char*)(gbase) + (voff)[_i]), (PG8_LAS unsigned*)(lds + (bufoff) + ldsw + _i * 8192), 16, 0, 0); } while (0)
#define PG8_LDA(dst, b, h) do { _Pragma("unroll") for (int m = 0; m < 4; ++m) _Pragma("unroll") for (int k = 0; k < 2; ++k) dst[m][k] = *(const PG8_LAS bf16x8*)(lds + PG8_SA(b, h) + aoff + m * 2048 + k * 1024); } while (0)
#define PG8_LDB(dst, b, h) do { _Pragma("unroll") for (int n = 0; n < 2; ++n) _Pragma("unroll") for (int k = 0; k < 2; ++k) dst[n][k] = *(const PG8_LAS bf16x8*)(lds + PG8_SB(b, h) + boff + n * 2048 + k * 1024); } while (0)
#define PG8_MMA(ai, bj, At, Bt) do { __builtin_amdgcn_s_setprio(1); _Pragma("unroll") for (int m = 0; m < 4; ++m) _Pragma("unroll") for (int n = 0; n < 2; ++n) _Pragma("unroll") for (int k = 0; k < 2; ++k) \
        acc[ai][bj][m][n] = __builtin_amdgcn_mfma_f32_16x16x32_bf16(Bt[n][k], At[m][k], acc[ai][bj][m][n], 0, 0, 0); __builtin_amdgcn_s_setprio(0); } while (0)
#define PG8_WAIT_V(n) asm volatile("s_waitcnt vmcnt(" #n ")" ::: "memory")
#define PG8_WAIT_L(n) asm volatile("s_waitcnt lgkmcnt(" #n ")" ::: "memory")
#define PG8_BAR __builtin_amdgcn_s_barrier()
#define PG8_SCHED __builtin_amdgcn_sched_barrier(0)
    Unit cur, nxt; int ui = 0;
    if (!S.next(0, cur)) return;
    f32x4 acc[2][2][4][2];
#pragma unroll
    for (int a = 0; a < 2; ++a)
#pragma unroll
        for (int b = 0; b < 2; ++b)
#pragma unroll
            for (int m = 0; m < 4; ++m)
#pragma unroll
                for (int n = 0; n < 2; ++n) acc[a][b][m][n] = (f32x4){0.f, 0.f, 0.f, 0.f};
    bf16x8 At[4][2], B0[2][2], B1[2][2];
    const char* cA = (const char*)g.A + (size_t)cur.pm * tstepA; const char* cB = (const char*)g.Bt + (size_t)cur.pn * tstep;
    S.a_ready(cur);
    if constexpr (SP2) {
        PG8_STAGE(PG8_SB(0, 0), cB, voffB); PG8_STAGE(PG8_SB(0, 1), cB + hstep, voffB); PG8_STAGE(PG8_SA(0, 0), cA, voffA); PG8_STAGE(PG8_SA(0, 1), cA + hstepA, voffA);
        if (wr == 1) PG8_BAR;
        PG8_WAIT_V(2); PG8_BAR;
        PG8_STAGE(PG8_SB(1, 0), cB + kstep, voffB); PG8_STAGE(PG8_SA(1, 0), cA + kstepA, voffA); PG8_STAGE(PG8_SB(1, 1), cB + hstep + kstep, voffB);
        PG8_WAIT_V(6); PG8_BAR;
    } else {
        PG8_STAGE(PG8_SB(0, 0), cB, voffB); PG8_STAGE(PG8_SA(0, 0), cA, voffA); PG8_STAGE(PG8_SB(0, 1), cB + hstep, voffB); PG8_STAGE(PG8_SA(0, 1), cA + hstepA, voffA);
        if (wr == 1) PG8_BAR;
        PG8_WAIT_V(4); PG8_BAR;
        PG8_STAGE(PG8_SB(1, 0), cB + kstep, voffB); PG8_STAGE(PG8_SA(1, 0), cA + kstepA, voffA); PG8_STAGE(PG8_SB(1, 1), cB + hstep + kstep, voffB);
        PG8_WAIT_V(6); PG8_BAR;
    }
    for (;;) {
        const bool has_next = S.next(ui + 1, nxt);
        const char* nA = has_next ? (const char*)g.A + (size_t)nxt.pm * tstepA : cA; const char* nB = has_next ? (const char*)g.Bt + (size_t)nxt.pn * tstep : cB;
        for (int t = 0; t < nt; t += 2) {
            const bool last = (t == nt - 2);
            const char* a1 = cA + (size_t)(t + 1) * kstepA;
            const char* a2 = last ? nA : cA + (size_t)(t + 2) * kstepA; const char* b2 = last ? nB : cB + (size_t)(t + 2) * kstep;
            const char* a3 = a2 + kstepA; const char* b3 = b2 + kstep;
            if (last && has_next) S.a_ready(nxt);
            if constexpr (SP2) {
            PG8_LDB(B0, 0, 0); PG8_LDB(B1, 0, 1); PG8_SCHED; PG8_LDA(At, 0, 0); PG8_STAGE(PG8_SA(1, 1), a1 + hstepA, voffA);
            PG8_WAIT_V(8); PG8_WAIT_L(0); PG8_BAR; PG8_MMA(0, 0, At, B0); PG8_MMA(0, 1, At, B1); PG8_BAR; PG8_SCHED;
            PG8_LDA(At, 0, 1); PG8_STAGE(PG8_SB(0, 0), b2, voffB); PG8_STAGE(PG8_SB(0, 1), b2 + hstep, voffB); PG8_STAGE(PG8_SA(0, 0), a2, voffA);
            PG8_WAIT_V(8); PG8_WAIT_L(0); PG8_BAR; PG8_MMA(1, 0, At, B0); PG8_MMA(1, 1, At, B1); PG8_BAR; PG8_SCHED;
            PG8_LDB(B0, 1, 0); PG8_LDB(B1, 1, 1); PG8_SCHED; PG8_LDA(At, 1, 0); PG8_STAGE(PG8_SA(0, 1), a2 + hstepA, voffA);
            PG8_WAIT_V(8); PG8_WAIT_L(0); PG8_BAR; PG8_MMA(0, 0, At, B0); PG8_MMA(0, 1, At, B1); PG8_BAR; PG8_SCHED;
            PG8_LDA(At, 1, 1); PG8_STAGE(PG8_SB(1, 0), b3, voffB); PG8_STAGE(PG8_SB(1, 1), b3 + hstep, voffB); PG8_STAGE(PG8_SA(1, 0), a3, voffA);
            PG8_WAIT_V(8); PG8_WAIT_L(0); PG8_BAR; PG8_MMA(1, 0, At, B0); PG8_MMA(1, 1, At, B1); PG8_BAR; PG8_SCHED;
            } else {
            PG8_LDB(B0, 0, 0); PG8_SCHED; PG8_LDA(At, 0, 0); PG8_STAGE(PG8_SA(1, 1), a1 + hstepA, voffA);
            PG8_WAIT_L(8); PG8_BAR; PG8_WAIT_L(0); PG8_MMA(0, 0, At, B0); PG8_BAR; PG8_SCHED;
            PG8_LDB(B1, 0, 1); PG8_STAGE(PG8_SB(0, 0), b2, voffB);
            PG8_BAR; PG8_WAIT_L(0); PG8_MMA(0, 1, At, B1); PG8_BAR;
            PG8_LDA(At, 0, 1); PG8_STAGE(PG8_SA(0, 0), a2, voffA);
            PG8_BAR; PG8_WAIT_L(0); PG8_MMA(1, 0, At, B0); PG8_BAR; PG8_SCHED;
            PG8_STAGE(PG8_SB(0, 1), b2 + hstep, voffB);
            PG8_WAIT_V(6); PG8_BAR; PG8_MMA(1, 1, At, B1); PG8_BAR;
            PG8_LDB(B0, 1, 0); PG8_SCHED; PG8_LDA(At, 1, 0); PG8_STAGE(PG8_SA(0, 1), a2 + hstepA, voffA);
            PG8_WAIT_L(8); PG8_BAR; PG8_WAIT_L(0); PG8_MMA(0, 0, At, B0); PG8_BAR; PG8_SCHED;
            PG8_LDB(B1, 1, 1); PG8_STAGE(PG8_SB(1, 0), b3, voffB);
            PG8_BAR; PG8_WAIT_L(0); PG8_MMA(0, 1, At, B1); PG8_BAR;
            PG8_LDA(At, 1, 1); PG8_STAGE(PG8_SA(1, 0), a3, voffA);
            PG8_BAR; PG8_WAIT_L(0); PG8_MMA(1, 0, At, B0); PG8_BAR; PG8_SCHED;
            PG8_STAGE(PG8_SB(1, 1), b3 + hstep, voffB);
            PG8_WAIT_V(6); PG8_BAR; PG8_MMA(1, 1, At, B1); PG8_BAR;
            }
        }
        if constexpr (ALIGN_EPI) { if (wr == 0) PG8_BAR; }
        if constexpr (!Epi::AFTER_DRAIN) { E(acc, cur, wr, wc, fr, fq); S.done(cur); }
        if (!has_next) break;
#pragma unroll
        for (int a = 0; a < 2; ++a)
#pragma unroll
            for (int b = 0; b < 2; ++b)
#pragma unroll
                for (int m = 0; m < 4; ++m)
#pragma unroll
                    for (int n = 0; n < 2; ++n) acc[a][b][m][n] = (f32x4){0.f, 0.f, 0.f, 0.f};
        cur = nxt; cA = nA; cB = nB; ++ui;
        if constexpr (ALIGN_EPI) { if (wr == 1) PG8_BAR; }
    }
    PG8_WAIT_V(0);
    if constexpr (!ALIGN_EPI) { if (wr == 0) PG8_BAR; }
    PG8_BAR;
    if constexpr (Epi::AFTER_DRAIN) { E.fused(acc, cur, wr, wc, fr, fq, lds, wid, lane); S.done(cur); }
#undef PG8_SA
#undef PG8_SB
#undef PG8_STAGE
#undef PG8_LDA
#undef PG8_LDB
#undef PG8_MMA
#undef PG8_WAIT_V
#undef PG8_WAIT_L
#undef PG8_BAR
#undef PG8_SCHED
}
}


namespace pg8 {
typedef unsigned u32x4 __attribute__((ext_vector_type(4)));
struct EpiProjM {
    static constexpr bool PERM = true, AFTER_DRAIN = false;
    bf16_t* P;
    __device__ __forceinline__ void operator()(const f32x4 (&acc)[2][2][4][2], const Unit& u, int wr, int wc, int fr, int fq) const {
        const int row0 = u.pm * BM + wr * 64 + fr, col0 = u.pn * BM + wc * 32 + 8 * fq;
        const int pn = u.pn; const int mode = (pn < 2) ? 1 : ((pn == 6 || pn == 7 || pn == 11) ? 2 : 0);
#pragma unroll
        for (int ai = 0; ai < 2; ++ai)
#pragma unroll
            for (int m = 0; m < 4; ++m) { bf16_t* rowp = P + (size_t)(row0 + ai * HALF + m * 16) * INW + col0;
#pragma unroll
                for (int bj = 0; bj < 2; ++bj) { f32x4 v0 = acc[ai][bj][m][0], v1 = acc[ai][bj][m][1];
                    if (mode == 1) { v0 = v0 * C2; v1 = v1 * C2; }
                    else if (mode == 2) {
#pragma unroll
                        for (int e = 0; e < 4; ++e) { v0[e] = silu(v0[e]); v1[e] = silu(v1[e]); } }
                    u32x4 w; w.x = cvt_pk_bf16(v0[0], v0[1]); w.y = cvt_pk_bf16(v0[2], v0[3]); w.z = cvt_pk_bf16(v1[0], v1[1]); w.w = cvt_pk_bf16(v1[2], v1[3]);
                    *(u32x4*)(rowp + bj * HALF) = w; } }
    }
};
struct EpiF32M {
    static constexpr bool PERM = true, AFTER_DRAIN = false;
    float* O; int ld;
    __device__ __forceinline__ void operator()(const f32x4 (&acc)[2][2][4][2], const Unit& u, int wr, int wc, int fr, int fq) const {
        const int row0 = u.pm * BM + wr * 64 + fr, col0 = u.pn * BM + wc * 32 + 8 * fq;
#pragma unroll
        for (int ai = 0; ai < 2; ++ai)
#pragma unroll
            for (int m = 0; m < 4; ++m) { float* rowp = O + (size_t)(row0 + ai * HALF + m * 16) * ld + col0;
#pragma unroll
                for (int bj = 0; bj < 2; ++bj) { *(f32x4*)(rowp + bj * HALF) = acc[ai][bj][m][0]; *(f32x4*)(rowp + bj * HALF + 4) = acc[ai][bj][m][1]; } }
    }
};
struct EpiWoutM {
    static constexpr bool PERM = true, AFTER_DRAIN = false;
    const float* x; float* x1s; bf16_t* x1bs; float* ssq;
    __device__ __forceinline__ void operator()(const f32x4 (&acc)[2][2][4][2], const Unit& u, int wr, int wc, int fr, int fq) const {
        const int row0 = u.pm * BM + wr * 64 + fr, col0 = u.pn * BM + wc * 32 + 8 * fq;
#pragma unroll
        for (int ai = 0; ai < 2; ++ai)
#pragma unroll
            for (int m = 0; m < 4; ++m) { const int row = row0 + ai * HALF + m * 16; const size_t rb = (size_t)row * DM + col0; float sq = 0.f;
#pragma unroll
                for (int bj = 0; bj < 2; ++bj) { const size_t i = rb + bj * HALF;
                    const f32x4 v0 = acc[ai][bj][m][0] + *(const f32x4*)(x + i), v1 = acc[ai][bj][m][1] + *(const f32x4*)(x + i + 4);
                    sq += (v0[0] * v0[0] + v0[1] * v0[1]) + (v0[2] * v0[2] + v0[3] * v0[3]) + (v1[0] * v1[0] + v1[1] * v1[1]) + (v1[2] * v1[2] + v1[3] * v1[3]);
                    const int col = col0 + bj * HALF, s = (col >> 5) & 15, j = ((col >> 9) << 5) | (col & 31);
                    const size_t o = ((size_t)s * T + row) * 64 + j;
                    *(f32x4*)(x1s + o) = v0; *(f32x4*)(x1s + o + 4) = v1;
                    u32x4 w; w.x = cvt_pk_bf16(v0[0], v0[1]); w.y = cvt_pk_bf16(v0[2], v0[3]); w.z = cvt_pk_bf16(v1[0], v1[1]); w.w = cvt_pk_bf16(v1[2], v1[3]);
                    *(u32x4*)(x1bs + o) = w; }
                sq += __shfl_xor(sq, 16); sq += __shfl_xor(sq, 32);
                if (fq == 0) ssq[(size_t)row * 16 + u.pn * 4 + wc] = sq; }
    }
};
struct EpiQM {
    static constexpr bool PERM = true, AFTER_DRAIN = false;
    bf16_t* Q;
    __device__ __forceinline__ void operator()(const f32x4 (&acc)[2][2][4][2], const Unit& u, int wr, int wc, int fr, int fq) const {
        const int row0 = u.pm * BM + wr * 64 + fr, col0 = u.pn * BM + wc * 32 + 8 * fq;
#pragma unroll
        for (int ai = 0; ai < 2; ++ai)
#pragma unroll
            for (int m = 0; m < 4; ++m) { const int row = row0 + ai * HALF + m * 16; bf16_t* rowp = Q + (size_t)row * 2048 + col0;
#pragma unroll
                for (int bj = 0; bj < 2; ++bj) { const f32x4 v0 = acc[ai][bj][m][0], v1 = acc[ai][bj][m][1];
                    u32x4 w; w.x = cvt_pk_bf16(v0[0], v0[1]); w.y = cvt_pk_bf16(v0[2], v0[3]); w.z = cvt_pk_bf16(v1[0], v1[1]); w.w = cvt_pk_bf16(v1[2], v1[3]);
                    *(u32x4*)(rowp + bj * HALF) = w; } }
    }
};
}

#define LAS __attribute__((address_space(3)))
#define XB_TMO      128
#define XB_XCNT(j)  (256  + 64 * (j))
#define XB_XSUB(j)  (1280 + 64 * (j))
#define XB_XGEN(j)  (2304 + 64 * (j))
#define XB_TOP      3328
#define XB_TOPGEN   3392
#define XCD_BAR_WORDS 3456
#define XB_SPIN_CAP (1u << 18)

__device__ __forceinline__ unsigned xb_ld(unsigned* p)              { return __hip_atomic_load(p, __ATOMIC_RELAXED, __HIP_MEMORY_SCOPE_AGENT); }
__device__ __forceinline__ unsigned xb_add(unsigned* p, unsigned v) { return __hip_atomic_fetch_add(p, v, __ATOMIC_RELAXED, __HIP_MEMORY_SCOPE_AGENT); }
__device__ __forceinline__ unsigned xb_xcc_id() { return (unsigned)__builtin_amdgcn_s_getreg((3 << 11) | 20) & 0xFu; }
#define XB_SPIN(cond, bar) do { unsigned _sp = 0; while (cond) { __builtin_amdgcn_s_sleep(1); \
    if ((++_sp & 255u) == 0u) { if (xb_ld(&(bar)[XB_TMO])) break; if (_sp > XB_SPIN_CAP) { atomicAdd(&(bar)[XB_TMO], 1u); break; } } } } while (0)

struct XcdBarrier {
    unsigned* bar; unsigned x;
    volatile LAS unsigned* st;
};

__device__ __forceinline__ XcdBarrier xcd_barrier_post(unsigned* bar, volatile LAS unsigned* st) {
    XcdBarrier b; b.bar = bar; b.x = xb_xcc_id(); b.st = st;
    if (threadIdx.x == 0) (void)xb_add(&bar[XB_XCNT(b.x)], 1u);
    return b;
}
__device__ __forceinline__ void xcd_barrier_complete(unsigned* bar, unsigned x, unsigned& nloc, unsigned& nx) {
    const unsigned G = gridDim.x * gridDim.y * gridDim.z;
    unsigned sum, cnt, mine, sp = 0u;
    for (;;) {
        sum = 0u; cnt = 0u; mine = 0u;
#pragma unroll
        for (unsigned j = 0; j < 16; ++j) { const unsigned c = xb_ld(&bar[XB_XCNT(j)]); sum += c; cnt += (c > 0u) ? 1u : 0u; mine = (j == x) ? c : mine; }
        if (sum == G) break;
        __builtin_amdgcn_s_sleep(1);
        if ((++sp & 255u) == 0u) { if (xb_ld(&bar[XB_TMO])) break; if (sp > XB_SPIN_CAP) { atomicAdd(&bar[XB_TMO], 1u); break; } }
    }
    nloc = mine > 0u ? mine : 1u; nx = cnt > 0u ? cnt : 1u;
}

__device__ __forceinline__ void xcd_barrier(const XcdBarrier& b) {
    asm volatile("s_waitcnt vmcnt(0)" ::: "memory");
    __syncthreads();
    if (threadIdx.x == 0) {
        unsigned* bar = b.bar;
        __builtin_amdgcn_s_waitcnt(0);
        unsigned nloc = b.st[0], nx = b.st[1];
        if (nloc == 0u) { xcd_barrier_complete(bar, b.x, nloc, nx); b.st[0] = nloc; b.st[1] = nx; }
        const unsigned old = xb_add(&bar[XB_XSUB(b.x)], 1u);
        const unsigned gen = old / nloc;
        if (old + 1u == (gen + 1u) * nloc) {
            __builtin_amdgcn_fence(__ATOMIC_RELEASE, "agent");
            asm volatile("s_waitcnt vmcnt(0)" ::: "memory");
            const unsigned og = xb_add(&bar[XB_TOP], 1u);
            const unsigned tg = og / nx;
            if (og + 1u == (tg + 1u) * nx) xb_add(&bar[XB_TOPGEN], 1u);
            else XB_SPIN(xb_ld(&bar[XB_TOPGEN]) == tg, bar);
            __builtin_amdgcn_fence(__ATOMIC_ACQUIRE, "agent");
            xb_add(&bar[XB_XGEN(b.x)], 1u);
            asm volatile("s_waitcnt vmcnt(0)" ::: "memory");
        } else {
            XB_SPIN(xb_ld(&bar[XB_XGEN(b.x)]) == gen, bar);
            __builtin_amdgcn_fence(__ATOMIC_ACQUIRE, "agent");
            asm volatile("s_waitcnt vmcnt(0)" ::: "memory");
        }
    }
    __syncthreads();
}

template <bool SLICEK = false> __device__ __forceinline__ void transpose_item(const float* W, const float* gain, int K, int N, bf16_t* WT, float* scr, int item, int lane) {
    const int nblk = N / 32, kb = item / nblk, nb = item % nblk, k0 = 64 * kb, n0 = 32 * nb;
    for (int i = 0; i < 32; ++i) { const int kk = 2 * i + (lane >> 5); const int ks = SLICEK ? ((kk >> 5) * 512 + 32 * kb + (kk & 31)) : (k0 + kk); float g = gain ? gain[ks] : 1.f; scr[kk * 33 + (lane & 31)] = W[(size_t)ks * N + n0 + (lane & 31)] * g; }
    __builtin_amdgcn_s_waitcnt(0); __builtin_amdgcn_wave_barrier();
    const int c = lane & 7;
#pragma unroll
    for (int j = 0; j < 4; ++j) { const int n = (lane >> 3) + 8 * j; const float* s = scr + (8 * c) * 33 + n;
        uint4 o; o.x = pk2(s[0 * 33], s[1 * 33]); o.y = pk2(s[2 * 33], s[3 * 33]); o.z = pk2(s[4 * 33], s[5 * 33]); o.w = pk2(s[6 * 33], s[7 * 33]);
        *(uint4*)(WT + (size_t)(n0 + n) * K + k0 + 8 * c) = o; }
    __builtin_amdgcn_s_waitcnt(0); __builtin_amdgcn_wave_barrier();
}
__device__ __forceinline__ void norm_row_to_bf16(const float* xrow, bf16_t* orow, int lane) {
    const float4* xr = (const float4*)xrow + lane;
    float4 v[4]; float s = 0.f;
#pragma unroll
    for (int j = 0; j < 4; ++j) { v[j] = xr[64 * j]; s += (v[j].x * v[j].x + v[j].y * v[j].y) + (v[j].z * v[j].z + v[j].w * v[j].w); }
    const float rstd = rsqrtf(wave_sum(s) * (1.f / DM) + EPS);
    unsigned long long* o8 = (unsigned long long*)orow + lane;
#pragma unroll
    for (int j = 0; j < 4; ++j) o8[64 * j] = (unsigned long long)pk2(v[j].x * rstd, v[j].y * rstd) | ((unsigned long long)pk2(v[j].z * rstd, v[j].w * rstd) << 32);
}
__device__ __forceinline__ void phase_prep(const Params& p, unsigned char* lds) {
    const int tid = threadIdx.x, lane = tid & 63, wave = tid >> 6;
    const int gw = blockIdx.x * 8 + wave, NGW = gridDim.x * 8;
    const int gt = blockIdx.x * NTHR + tid, NGT = gridDim.x * NTHR;
    unsigned char* ws = p.ws;
    float* scr = (float*)lds + wave * (64 * 33);
    constexpr int I_IN = (DM / 64) * (INW / 32), I_OUT = (DM / 64) * (DM / 32), I_Q = (DM / 64) * (2048 / 32), I_MKV = (DM / 64) * (512 / 32);
    for (int it = gw; it < I_IN + I_OUT + I_Q + I_MKV; it += NGW) {
        int r = it;
        if (r < I_IN) { transpose_item(p.w_in, p.g_mix, DM, INW, (bf16_t*)(ws + WS_WIN_T), scr, r, lane); continue; } r -= I_IN;
        if (r < I_OUT) { transpose_item(p.w_out, nullptr, DM, DM, (bf16_t*)(ws + WS_WOUT_T), scr, r, lane); continue; } r -= I_OUT;
        if (r < I_Q) { transpose_item<true>(p.w_q, p.g_ffn, DM, 2048, (bf16_t*)(ws + WS_WQ_T), scr, r, lane); continue; } r -= I_Q;
        transpose_item(p.w_mkv, p.mem_gain, DM, 512, (bf16_t*)(ws + WS_WMKV_T), scr, r, lane);
    }
    for (int m = gw; m < T; m += NGW) norm_row_to_bf16(p.x + (size_t)m * DM, (bf16_t*)(ws + WS_XB) + (size_t)m * DM, lane);
    for (int m = gw; m < NB * NMEM; m += NGW) norm_row_to_bf16(p.mem + (size_t)m * DM, (bf16_t*)(ws + WS_MEMN) + (size_t)m * DM, lane);
    for (int i = gt; i < 8 * 2 * 128 * 128; i += NGT) ((bf16_t*)(ws + WS_SKB))[i] = f2bf(p.sub_keys[i]);
    for (int i = gt; i < NEXP * DM / 8; i += NGT) {
        const int d0 = (i & 127) * 8, e = i >> 7, s = (d0 >> 5) & 15, j0 = ((d0 >> 9) << 5) | (d0 & 31), S = s >> 1, jj0 = (s & 1) * 64 + j0;
        const float4 a = ((const float4*)p.pu)[2 * i], b = ((const float4*)p.pu)[2 * i + 1];
        const float4 ga = *(const float4*)(p.g_ffn + d0), gb = *(const float4*)(p.g_ffn + d0 + 4);
        int u0 = 0, u1 = 0;
        u0 = __builtin_amdgcn_cvt_pk_fp8_f32(a.x * ga.x * PEER_US, a.y * ga.y * PEER_US, u0, false); u0 = __builtin_amdgcn_cvt_pk_fp8_f32(a.z * ga.z * PEER_US, a.w * ga.w * PEER_US, u0, true);
        u1 = __builtin_amdgcn_cvt_pk_fp8_f32(b.x * gb.x * PEER_US, b.y * gb.y * PEER_US, u1, false); u1 = __builtin_amdgcn_cvt_pk_fp8_f32(b.z * gb.z * PEER_US, b.w * gb.w * PEER_US, u1, true);
        *(uint2*)(ws + WS_U16 + ((size_t)S * NEXP + e) * 128 + jj0) = make_uint2((unsigned)u0, (unsigned)u1);
        const float4 c = ((const float4*)p.pv)[2 * i], d = ((const float4*)p.pv)[2 * i + 1];
        int v0 = 0, v1 = 0;
        v0 = __builtin_amdgcn_cvt_pk_fp8_f32(c.x * PEER_VS, c.y * PEER_VS, v0, false); v0 = __builtin_amdgcn_cvt_pk_fp8_f32(c.z * PEER_VS, c.w * PEER_VS, v0, true);
        v1 = __builtin_amdgcn_cvt_pk_fp8_f32(d.x * PEER_VS, d.y * PEER_VS, v1, false); v1 = __builtin_amdgcn_cvt_pk_fp8_f32(d.z * PEER_VS, d.w * PEER_VS, v1, true);
        *(uint2*)(ws + WS_V16 + ((size_t)S * NEXP + e) * 128 + jj0) = make_uint2((unsigned)v0, (unsigned)v1);
    }
    for (int i = gt; i < 512; i += NGT) ((float*)(ws + WS_LB))[i] = 1.f / (1.f + expf(p.gamma_lb[512 + i] - p.gamma_lb[i]));
}

template <class Epi>
__device__ __forceinline__ void gemm_naive(const bf16_t* A, const bf16_t* Bt, int M, int N, int K, unsigned char* ldsb, const Epi& epi) {
    float* As = (float*)ldsb;
    float* Bs = As + 32 * 132;
    const int tid = threadIdx.x, ty = tid >> 4, tx = tid & 15;
    const int ntm = M / 128, ntn = N / 64;
    for (int tile = blockIdx.x; tile < ntm * ntn; tile += gridDim.x) {
        const int tm = tile / ntn, tn = tile % ntn;
        float acc[4][4];
#pragma unroll
        for (int i = 0; i < 4; ++i)
#pragma unroll
            for (int j = 0; j < 4; ++j) acc[i][j] = 0.f;
        for (int k0 = 0; k0 < K; k0 += 32) {
            { const int r = tid >> 2, kq = (tid & 3) * 8;
              const uint4 v = *(const uint4*)(A + (size_t)(tm * 128 + r) * K + k0 + kq);
              As[(kq + 0) * 132 + r] = bflo(v.x); As[(kq + 1) * 132 + r] = bfhi(v.x); As[(kq + 2) * 132 + r] = bflo(v.y); As[(kq + 3) * 132 + r] = bfhi(v.y);
              As[(kq + 4) * 132 + r] = bflo(v.z); As[(kq + 5) * 132 + r] = bfhi(v.z); As[(kq + 6) * 132 + r] = bflo(v.w); As[(kq + 7) * 132 + r] = bfhi(v.w); }
            if (tid < 256) { const int r = tid >> 2, kq = (tid & 3) * 8;
              const uint4 v = *(const uint4*)(Bt + (size_t)(tn * 64 + r) * K + k0 + kq);
              Bs[(kq + 0) * 68 + r] = bflo(v.x); Bs[(kq + 1) * 68 + r] = bfhi(v.x); Bs[(kq + 2) * 68 + r] = bflo(v.y); Bs[(kq + 3) * 68 + r] = bfhi(v.y);
              Bs[(kq + 4) * 68 + r] = bflo(v.z); Bs[(kq + 5) * 68 + r] = bfhi(v.z); Bs[(kq + 6) * 68 + r] = bflo(v.w); Bs[(kq + 7) * 68 + r] = bfhi(v.w); }
            __syncthreads();
#pragma unroll 8
            for (int k = 0; k < 32; ++k) {
                const float4 a = *(const float4*)(As + k * 132 + ty * 4); const float4 b = *(const float4*)(Bs + k * 68 + tx * 4);
                const float av[4] = {a.x, a.y, a.z, a.w}, bv[4] = {b.x, b.y, b.z, b.w};
#pragma unroll
                for (int i = 0; i < 4; ++i)
#pragma unroll
                    for (int j = 0; j < 4; ++j) acc[i][j] = fmaf(av[i], bv[j], acc[i][j]);
            }
            __syncthreads();
        }
#pragma unroll
        for (int i = 0; i < 4; ++i)
#pragma unroll
            for (int j = 0; j < 4; ++j) epi(tm * 128 + ty * 4 + i, tn * 64 + tx * 4 + j, acc[i][j]);
    }
}

struct EpiProj {
    bf16_t* P;
    __device__ __forceinline__ void operator()(int row, int col, float v) const {
        if (col < C_SBK) v *= C2;
        else if (col >= C_HGQ && col < C_HGF) v = silu(v);
        else if (col >= C_HGG && col < C_MQ) v = silu(v);
        P[(size_t)row * INW + col] = f2bf(v);
    }
};
struct EpiF32 { float* O; int ld; __device__ __forceinline__ void operator()(int row, int col, float v) const { O[(size_t)row * ld + col] = v; } };
struct EpiWout { const float* x; float* out; bf16_t* xb;
    __device__ __forceinline__ void operator()(int row, int col, float v) const { const size_t i = (size_t)row * DM + col; const float r = x[i] + v; out[i] = r; xb[i] = f2bf(r); } };
struct EpiQ { const float* rstd; bf16_t* Q;
    __device__ __forceinline__ void operator()(int row, int col, float v) const { Q[(size_t)row * 2048 + col] = f2bf(v * rstd[row]); } };

#ifndef SB_EARLY
#define SB_EARLY 1
#endif
__device__ __forceinline__ void sb_naive(const Params& p) {
    const bf16_t* P = (const bf16_t*)(p.ws + WS_P);
    bf16_t* mixed = (bf16_t*)(p.ws + WS_MIXED);
    for (int row = blockIdx.x * NTHR + threadIdx.x; row < NB * 8 * SEQ; row += gridDim.x * NTHR) {
        const int t = row % SEQ, bh = row / SEQ, h = bh % 8, b = bh / 8;
        const size_t tok = (size_t)b * SEQ + t;
        float q[64], o[64];
        { const uint4* qp = (const uint4*)(P + tok * INW + C_SBQ + h * 64);
#pragma unroll
          for (int j = 0; j < 8; ++j) { const uint4 v = qp[j]; q[8 * j] = bflo(v.x); q[8 * j + 1] = bfhi(v.x); q[8 * j + 2] = bflo(v.y); q[8 * j + 3] = bfhi(v.y); q[8 * j + 4] = bflo(v.z); q[8 * j + 5] = bfhi(v.z); q[8 * j + 6] = bflo(v.w); q[8 * j + 7] = bfhi(v.w); } }
#pragma unroll
        for (int d = 0; d < 64; ++d) o[d] = 0.f;
        float R = 0.f;
        for (int s = t - 1; s >= 0; --s) {
            const uint4* kp = (const uint4*)(P + ((size_t)b * SEQ + s) * INW + C_SBK + h * 64);
            const uint4* vp = (const uint4*)(P + ((size_t)b * SEQ + s) * INW + C_SBV + h * 64);
            float z = 0.f;
#pragma unroll
            for (int j = 0; j < 8; ++j) { const uint4 v = kp[j];
                z = fmaf(q[8 * j], bflo(v.x), z); z = fmaf(q[8 * j + 1], bfhi(v.x), z); z = fmaf(q[8 * j + 2], bflo(v.y), z); z = fmaf(q[8 * j + 3], bfhi(v.y), z);
                z = fmaf(q[8 * j + 4], bflo(v.z), z); z = fmaf(q[8 * j + 5], bfhi(v.z), z); z = fmaf(q[8 * j + 6], bflo(v.w), z); z = fmaf(q[8 * j + 7], bfhi(v.w), z); }
            const float sp = fmaxf(z, 0.f) + log2f(1.f + exp2f(-fabsf(z)));
            const float a = exp2f(z - sp + R);
            R -= sp;
#pragma unroll
            for (int j = 0; j < 8; ++j) { const uint4 v = vp[j];
                o[8 * j] = fmaf(a, bflo(v.x), o[8 * j]); o[8 * j + 1] = fmaf(a, bfhi(v.x), o[8 * j + 1]); o[8 * j + 2] = fmaf(a, bflo(v.y), o[8 * j + 2]); o[8 * j + 3] = fmaf(a, bfhi(v.y), o[8 * j + 3]);
                o[8 * j + 4] = fmaf(a, bflo(v.z), o[8 * j + 4]); o[8 * j + 5] = fmaf(a, bfhi(v.z), o[8 * j + 5]); o[8 * j + 6] = fmaf(a, bflo(v.w), o[8 * j + 6]); o[8 * j + 7] = fmaf(a, bfhi(v.w), o[8 * j + 7]); }
#if SB_EARLY
            if (R < -150.f) break;
#endif
        }
        float ss = 0.f;
#pragma unroll
        for (int d = 0; d < 64; ++d) ss = fmaf(o[d], o[d], ss);
        const float r = rsqrtf(ss * (1.f / 64.f) + EPS);
        uint4* op = (uint4*)(mixed + tok * DM + h * 64);
        const float* g = p.sb_gain + h * 64;
#pragma unroll
        for (int j = 0; j < 8; ++j) { uint4 w; w.x = pk2(o[8 * j] * r * g[8 * j], o[8 * j + 1] * r * g[8 * j + 1]); w.y = pk2(o[8 * j + 2] * r * g[8 * j + 2], o[8 * j + 3] * r * g[8 * j + 3]);
            w.z = pk2(o[8 * j + 4] * r * g[8 * j + 4], o[8 * j + 5] * r * g[8 * j + 5]); w.w = pk2(o[8 * j + 6] * r * g[8 * j + 6], o[8 * j + 7] * r * g[8 * j + 7]); op[j] = w; }
    }
}

__device__ __forceinline__ void hg_naive(const Params& p, unsigned char* ldsb) {
    const bf16_t* P = (const bf16_t*)(p.ws + WS_P);
    float* raw = (float*)(p.ws + WS_HGRAW);
    const float* lbp = (const float*)(p.ws + WS_LB);
    float* red = (float*)ldsb;
    const int tid = threadIdx.x, jj = tid >> 7, k = tid & 127, wave = tid >> 6, lane = tid & 63;
    for (int unit = blockIdx.x; unit < NB * 4 * 16; unit += gridDim.x) {
        const int jg = unit & 15, h = (unit >> 4) & 3, b = unit >> 6;
        const float lb = lbp[h * 128 + k];
        float S = 0.f;
        for (int t0 = 0; t0 < SEQ; t0 += 64) {
            for (int tt = 0; tt < 64; tt += 8) {
                float fl[8], qv[8], iv[8];
#pragma unroll
                for (int u = 0; u < 8; ++u) { const bf16_t* pr = P + ((size_t)b * SEQ + t0 + tt + u) * INW;
                    fl[u] = bf2f(pr[C_HGF + h * 128 + k]); qv[u] = bf2f(pr[C_HGQ + h * 128 + k]); iv[u] = bf2f(pr[C_HGI + h * 64 + jg * 4 + jj]); }
#pragma unroll
                for (int u = 0; u < 8; ++u) {
                    const float f = lb + (1.f - lb) / (1.f + __expf(-fl[u]));
                    S = f * S + (1.f - f) * iv[u];
                    const float part = wave_sum(S * qv[u]);
                    if (lane == 0) red[(tt + u) * 8 + wave] = part;
                }
            }
            __syncthreads();
            if (tid < 256) { const int tt = tid >> 2, j2 = tid & 3;
                raw[((size_t)b * SEQ + t0 + tt) * 256 + h * 64 + jg * 4 + j2] = red[tt * 8 + 2 * j2] + red[tt * 8 + 2 * j2 + 1]; }
            __syncthreads();
        }
    }
}
__device__ __forceinline__ void hg_finish(const Params& p) {
    const bf16_t* P = (const bf16_t*)(p.ws + WS_P);
    const float* raw = (const float*)(p.ws + WS_HGRAW);
    bf16_t* mixed = (bf16_t*)(p.ws + WS_MIXED);
    const int lane = threadIdx.x & 63, wave = threadIdx.x >> 6;
    for (int it = blockIdx.x * 8 + wave; it < T * 4; it += gridDim.x * 8) {
        const int tok = it >> 2, h = it & 3;
        const float o = raw[(size_t)tok * 256 + h * 64 + lane];
        const float r = rsqrtf(wave_sum(o * o) * (1.f / 64.f) + EPS);
        const float g = bf2f(P[(size_t)tok * INW + C_HGG + h * 64 + lane]);
        mixed[(size_t)tok * DM + 512 + h * 64 + lane] = f2bf(o * r * p.hg_gain[h * 64 + lane] * g);
    }
}


typedef float f32x16 __attribute__((ext_vector_type(16)));
typedef short sh8_t __attribute__((ext_vector_type(8)));
typedef unsigned u4_t __attribute__((ext_vector_type(4)));
typedef float f32x4_t __attribute__((ext_vector_type(4)));
typedef float float2_t __attribute__((ext_vector_type(2)));
__device__ __forceinline__ void mma32(f32x16& acc, const LAS bf16_t* A, int lda, const LAS bf16_t* Bt, int ldb, int K, int lane) {
    const int r = lane & 31, h = lane >> 5;
    const LAS bf16_t* ap = A + r * lda + 8 * h; const LAS bf16_t* bp = Bt + r * ldb + 8 * h;
    for (int k0 = 0; k0 < K; k0 += 16) {
        const sh8_t a = *(const LAS sh8_t*)(ap + k0), b = *(const LAS sh8_t*)(bp + k0);
        acc = __builtin_amdgcn_mfma_f32_32x32x16_bf16(a, b, acc, 0, 0, 0);
    }
}
__device__ __forceinline__ int crow(int r, int hh) { return (r & 3) + 8 * (r >> 2) + 4 * hh; }
constexpr size_t HG_LT = 0;
constexpr size_t HG_SB = 64 * MiB;
constexpr size_t HG_DD = 96 * MiB;
__device__ __forceinline__ void hg_cols(const bf16_t* P, const float* lbp, int b_, int h, int c, LAS float* gs, int tid, float (&kk)[16], float (&bc)[16], float& bmid, float& blast) {
    const int rg = tid >> 7, k = tid & 127;
    const float lb = lbp[h * 128 + k];
    const bf16_t* pr = P + ((size_t)b_ * SEQ + c * 64 + rg * 16) * INW + C_HGF + h * 128 + k;
    float run = 0.f;
#pragma unroll
    for (int i = 0; i < 16; ++i) { const float fl = bf2f(pr[(size_t)i * INW]); const float kv = (1.f - lb) / (1.f + __expf(fl)); kk[i] = kv; run += __logf(1.f - kv); bc[i] = run; }
    gs[rg * 128 + k] = run;
    __syncthreads();
    const float g0 = gs[k], g1 = gs[128 + k], g2 = gs[256 + k], g3 = gs[384 + k];
    const float off = (rg > 0 ? g0 : 0.f) + (rg > 1 ? g1 : 0.f) + (rg > 2 ? g2 : 0.f);
#pragma unroll
    for (int i = 0; i < 16; ++i) bc[i] += off;
    bmid = g0 + g1; blast = (g0 + g1) + (g2 + g3);
}
__device__ __forceinline__ void hg_load_vt(const bf16_t* P, int b_, int h, int c, LAS bf16_t* VT, int tid) {
    const int s = tid >> 3, jq = tid & 7;
    const uint4 v = *(const uint4*)(P + ((size_t)b_ * SEQ + c * 64 + s) * INW + C_HGI + h * 64 + jq * 8);
    LAS bf16_t* d = VT + (jq * 8) * 72 + s;
    d[0 * 72] = (bf16_t)(v.x & 0xffff); d[1 * 72] = (bf16_t)(v.x >> 16); d[2 * 72] = (bf16_t)(v.y & 0xffff); d[3 * 72] = (bf16_t)(v.y >> 16);
    d[4 * 72] = (bf16_t)(v.z & 0xffff); d[5 * 72] = (bf16_t)(v.z >> 16); d[6 * 72] = (bf16_t)(v.w & 0xffff); d[7 * 72] = (bf16_t)(v.w >> 16);
}
__device__ __forceinline__ void hg_local(const Params& p, unsigned char* ldsb) {
    const bf16_t* P = (const bf16_t*)(p.ws + WS_P); const float* lbp = (const float*)(p.ws + WS_LB);
    float* LT = (float*)((unsigned char*)p.out + HG_LT); float* DD = (float*)((unsigned char*)p.out + HG_DD);
    LAS unsigned char* l = (LAS unsigned char*)ldsb;
    LAS float* gs = (LAS float*)l; LAS bf16_t* KST = (LAS bf16_t*)(l + 2048); LAS bf16_t* VT = (LAS bf16_t*)(l + 20480);
    const int tid = threadIdx.x, lane = tid & 63, wave = tid >> 6, rg = tid >> 7, k = tid & 127;
    for (int unit = blockIdx.x; unit < 2048; unit += gridDim.x) {
        const int bh = unit >> 7, c = unit & 127, b_ = bh >> 2, h = bh & 3;
        float kk[16], bc[16], bmid, blast;
        hg_cols(P, lbp, b_, h, c, gs, tid, kk, bc, bmid, blast);
        { unsigned w[8];
#pragma unroll
          for (int i = 0; i < 8; ++i) w[i] = pk2(kk[2 * i] * __expf(blast - bc[2 * i]), kk[2 * i + 1] * __expf(blast - bc[2 * i + 1]));
          LAS u4_t* d = (LAS u4_t*)(KST + k * 72 + rg * 16);
          d[0] = (u4_t){w[0], w[1], w[2], w[3]}; d[1] = (u4_t){w[4], w[5], w[6], w[7]}; }
        hg_load_vt(P, b_, h, c, VT, tid);
        if (tid < 128) DD[(size_t)unit * 128 + tid] = __expf(blast);
        __syncthreads();
        { const int ji = wave >> 2, ki = wave & 3;
          f32x16 acc;
#pragma unroll
          for (int r = 0; r < 16; ++r) acc[r] = 0.f;
          mma32(acc, VT + 32 * ji * 72, 72, KST + 32 * ki * 72, 72, 64, lane);
          float* o = LT + (size_t)unit * 8192 + 32 * ki + (lane & 31);
#pragma unroll
          for (int r = 0; r < 16; ++r) o[(size_t)(32 * ji + crow(r, lane >> 5)) * 128] = acc[r]; }
        __syncthreads();
    }
}
__device__ __forceinline__ void hg_scan(const Params& p) {
    const float* LT = (const float*)((unsigned char*)p.out + HG_LT); const float* DD = (const float*)((unsigned char*)p.out + HG_DD);
    bf16_t* SB = (bf16_t*)((unsigned char*)p.out + HG_SB);
    for (int gt = blockIdx.x * NTHR + threadIdx.x; gt < 16 * 8192; gt += gridDim.x * NTHR) {
        const int bh = gt >> 13, e = gt & 8191, k = e & 127;
        float S = 0.f;
#pragma unroll 8
        for (int c = 0; c < 128; ++c) { const size_t u = (size_t)bh * 128 + c;
            const float L = LT[u * 8192 + e], D = DD[u * 128 + k];
            SB[u * 8192 + e] = f2bf(S); S = fmaf(D, S, L); }
    }
}
__device__ __forceinline__ void hg_out(const Params& p, unsigned char* ldsb) {
    const bf16_t* P = (const bf16_t*)(p.ws + WS_P); const float* lbp = (const float*)(p.ws + WS_LB);
    const bf16_t* SB = (const bf16_t*)((unsigned char*)p.out + HG_SB);
    bf16_t* mixed = (bf16_t*)(p.ws + WS_MIXED);
    LAS unsigned char* l = (LAS unsigned char*)ldsb;
    LAS float* gs = (LAS float*)l;
    LAS bf16_t* QT = (LAS bf16_t*)(l + 2048); LAS bf16_t* KT = (LAS bf16_t*)(l + 19456); LAS bf16_t* QI = (LAS bf16_t*)(l + 36864);
    LAS bf16_t* VT = (LAS bf16_t*)(l + 54272); LAS bf16_t* SC = (LAS bf16_t*)(l + 63488); LAS bf16_t* ST = (LAS bf16_t*)(l + 72704);
    LAS float* OB = (LAS float*)(l + 90112);
    const int tid = threadIdx.x, lane = tid & 63, wave = tid >> 6, rg = tid >> 7, k = tid & 127;
    for (int unit = blockIdx.x; unit < 2048; unit += gridDim.x) {
        const int bh = unit >> 7, c = unit & 127, b_ = bh >> 2, h = bh & 3;
        const size_t tok0 = (size_t)b_ * SEQ + c * 64;
        float kk[16], bc[16], bmid, blast;
        hg_cols(P, lbp, b_, h, c, gs, tid, kk, bc, bmid, blast);
        { const bf16_t* qp = P + (tok0 + rg * 16) * INW + C_HGQ + h * 128 + k;
#pragma unroll
          for (int i = 0; i < 16; ++i) { const float q = bf2f(qp[(size_t)i * INW]); const int o = (rg * 16 + i) * 136 + k;
              QT[o] = f2bf(q * __expf(fminf(bc[i] - bmid, 40.f))); KT[o] = f2bf(kk[i] * __expf(fminf(bmid - bc[i], 40.f))); QI[o] = f2bf(q * __expf(bc[i])); } }
        hg_load_vt(P, b_, h, c, VT, tid);
#pragma unroll
        for (int i = 0; i < 2; ++i) { const int idx = tid * 8 + i * 4096, j = idx >> 7, kq = idx & 127;
            *(LAS u4_t*)(ST + j * 136 + kq) = *(const u4_t*)(SB + (size_t)unit * 8192 + idx); }
        __syncthreads();
        if (wave < 4) { const int ti = wave >> 1, si = wave & 1;
            f32x16 acc;
#pragma unroll
            for (int r = 0; r < 16; ++r) acc[r] = 0.f;
            if (si <= ti) mma32(acc, QT + 32 * ti * 136, 136, KT + 32 * si * 136, 136, 128, lane);
            const int s = 32 * si + (lane & 31);
#pragma unroll
            for (int r = 0; r < 16; ++r) { const int t = 32 * ti + crow(r, lane >> 5); SC[t * 72 + s] = f2bf((s <= t) ? acc[r] : 0.f); } }
        __syncthreads();
        if (wave < 4) { const int ti = wave >> 1, ji = wave & 1;
            f32x16 acc;
#pragma unroll
            for (int r = 0; r < 16; ++r) acc[r] = 0.f;
            mma32(acc, SC + 32 * ti * 72, 72, VT + 32 * ji * 72, 72, 64, lane);
            mma32(acc, QI + 32 * ti * 136, 136, ST + 32 * ji * 136, 136, 128, lane);
            const int j = 32 * ji + (lane & 31);
#pragma unroll
            for (int r = 0; r < 16; ++r) OB[(32 * ti + crow(r, lane >> 5)) * 65 + j] = acc[r]; }
        __syncthreads();
        { const int t = tid >> 3, jq = tid & 7;
          float o[8]; float ss = 0.f;
#pragma unroll
          for (int e = 0; e < 8; ++e) { o[e] = OB[t * 65 + jq * 8 + e]; ss = fmaf(o[e], o[e], ss); }
          ss += __shfl_xor(ss, 1); ss += __shfl_xor(ss, 2); ss += __shfl_xor(ss, 4);
          const float r = rsqrtf(ss * (1.f / 64.f) + EPS);
          const uint4 gv = *(const uint4*)(P + (tok0 + t) * INW + C_HGG + h * 64 + jq * 8);
          const float* gn = p.hg_gain + h * 64 + jq * 8;
          uint4 w; w.x = pk2(o[0] * r * gn[0] * bflo(gv.x), o[1] * r * gn[1] * bfhi(gv.x)); w.y = pk2(o[2] * r * gn[2] * bflo(gv.y), o[3] * r * gn[3] * bfhi(gv.y));
          w.z = pk2(o[4] * r * gn[4] * bflo(gv.z), o[5] * r * gn[5] * bfhi(gv.z)); w.w = pk2(o[6] * r * gn[6] * bflo(gv.w), o[7] * r * gn[7] * bfhi(gv.w));
          *(uint4*)(mixed + (tok0 + t) * DM + 512 + h * 64 + jq * 8) = w; }
        __syncthreads();
    }
}

__device__ __forceinline__ void mem_knorm(const Params& p) {
    const float* kv = (const float*)(p.ws + WS_MEMKV);
    bf16_t* mk = (bf16_t*)(p.ws + WS_MEMK); bf16_t* mv = (bf16_t*)(p.ws + WS_MEMV);
    const int lane = threadIdx.x & 63, wave = threadIdx.x >> 6;
    for (int it = blockIdx.x * 8 + wave; it < NB * NMEM * 4; it += gridDim.x * 8) {
        const int m = it >> 2, h = it & 3;
        const float kx = kv[(size_t)m * 512 + h * 64 + lane], vx = kv[(size_t)m * 512 + 256 + h * 64 + lane];
        const float r = rsqrtf(wave_sum(kx * kx) * (1.f / 64.f) + EPS);
        mk[(size_t)m * 256 + h * 64 + lane] = f2bf(kx * r * p.mk_gain[lane]);
        mv[(size_t)m * 256 + h * 64 + lane] = f2bf(vx);
    }
}
__device__ __forceinline__ void mem_attn_naive(const Params& p) {
    const bf16_t* P = (const bf16_t*)(p.ws + WS_P);
    const bf16_t* mk = (const bf16_t*)(p.ws + WS_MEMK); const bf16_t* mv = (const bf16_t*)(p.ws + WS_MEMV);
    bf16_t* mixed = (bf16_t*)(p.ws + WS_MIXED);
    for (int idx = blockIdx.x * NTHR + threadIdx.x; idx < 4 * T; idx += gridDim.x * NTHR) {
        const int h = idx / T, tok = idx % T, b = tok / SEQ;
        float q[64], o[64];
        { const uint4* qp = (const uint4*)(P + (size_t)tok * INW + C_MQ + h * 64);
#pragma unroll
          for (int j = 0; j < 8; ++j) { const uint4 v = qp[j]; q[8 * j] = bflo(v.x); q[8 * j + 1] = bfhi(v.x); q[8 * j + 2] = bflo(v.y); q[8 * j + 3] = bfhi(v.y); q[8 * j + 4] = bflo(v.z); q[8 * j + 5] = bfhi(v.z); q[8 * j + 6] = bflo(v.w); q[8 * j + 7] = bfhi(v.w); } }
        float ss = 0.f;
#pragma unroll
        for (int d = 0; d < 64; ++d) ss = fmaf(q[d], q[d], ss);
        const float r = rsqrtf(ss * (1.f / 64.f) + EPS) * 0.125f;
#pragma unroll
        for (int d = 0; d < 64; ++d) { q[d] *= r * p.mq_gain[d]; o[d] = 0.f; }
        float mx = -1e30f, l = 0.f;
        for (int m = 0; m < NMEM; ++m) {
            const uint4* kp = (const uint4*)(mk + ((size_t)b * NMEM + m) * 256 + h * 64);
            const uint4* vp = (const uint4*)(mv + ((size_t)b * NMEM + m) * 256 + h * 64);
            float z = 0.f;
#pragma unroll
            for (int j = 0; j < 8; ++j) { const uint4 v = kp[j];
                z = fmaf(q[8 * j], bflo(v.x), z); z = fmaf(q[8 * j + 1], bfhi(v.x), z); z = fmaf(q[8 * j + 2], bflo(v.y), z); z = fmaf(q[8 * j + 3], bfhi(v.y), z);
                z = fmaf(q[8 * j + 4], bflo(v.z), z); z = fmaf(q[8 * j + 5], bfhi(v.z), z); z = fmaf(q[8 * j + 6], bflo(v.w), z); z = fmaf(q[8 * j + 7], bfhi(v.w), z); }
            const float mn = fmaxf(mx, z), corr = __expf(mx - mn), pe = __expf(z - mn);
            mx = mn; l = l * corr + pe;
#pragma unroll
            for (int j = 0; j < 8; ++j) { const uint4 v = vp[j];
                o[8 * j] = fmaf(pe, bflo(v.x), o[8 * j] * corr); o[8 * j + 1] = fmaf(pe, bfhi(v.x), o[8 * j + 1] * corr); o[8 * j + 2] = fmaf(pe, bflo(v.y), o[8 * j + 2] * corr); o[8 * j + 3] = fmaf(pe, bfhi(v.y), o[8 * j + 3] * corr);
                o[8 * j + 4] = fmaf(pe, bflo(v.z), o[8 * j + 4] * corr); o[8 * j + 5] = fmaf(pe, bfhi(v.z), o[8 * j + 5] * corr); o[8 * j + 6] = fmaf(pe, bflo(v.w), o[8 * j + 6] * corr); o[8 * j + 7] = fmaf(pe, bfhi(v.w), o[8 * j + 7] * corr); }
        }
        const float il = 1.f / l;
        uint4* op = (uint4*)(mixed + (size_t)tok * DM + 768 + h * 64);
#pragma unroll
        for (int j = 0; j < 8; ++j) { uint4 w; w.x = pk2(o[8 * j] * il, o[8 * j + 1] * il); w.y = pk2(o[8 * j + 2] * il, o[8 * j + 3] * il); w.z = pk2(o[8 * j + 4] * il, o[8 * j + 5] * il); w.w = pk2(o[8 * j + 6] * il, o[8 * j + 7] * il); op[j] = w; }
    }
}


__device__ __forceinline__ unsigned cvtpk(float lo, float hi) { unsigned r; asm("v_cvt_pk_bf16_f32 %0, %1, %2" : "=v"(r) : "v"(lo), "v"(hi)); return r; }
__device__ __forceinline__ sh8_t frag8(const float (&x)[8]) { const u4_t w = {cvtpk(x[0], x[1]), cvtpk(x[2], x[3]), cvtpk(x[4], x[5]), cvtpk(x[6], x[7])}; return __builtin_bit_cast(sh8_t, w); }
__device__ __forceinline__ int kperm(int key) { return (key & 16) | ((key & 4) << 1) | ((key & 8) >> 1) | (key & 3); }
__device__ __forceinline__ void vt_store(LAS bf16_t* VT, int pitch, int d0, int pos, const u4_t v) {
    LAS bf16_t* d = VT + d0 * pitch + pos;
    d[0 * pitch] = (bf16_t)(v.x & 0xffff); d[1 * pitch] = (bf16_t)(v.x >> 16); d[2 * pitch] = (bf16_t)(v.y & 0xffff); d[3 * pitch] = (bf16_t)(v.y >> 16);
    d[4 * pitch] = (bf16_t)(v.z & 0xffff); d[5 * pitch] = (bf16_t)(v.z >> 16); d[6 * pitch] = (bf16_t)(v.w & 0xffff); d[7 * pitch] = (bf16_t)(v.w >> 16);
}
__device__ __forceinline__ void sb_mfma(const Params& p, unsigned char* ldsb) {
    const bf16_t* P = (const bf16_t*)(p.ws + WS_P);
    bf16_t* mixed = (bf16_t*)(p.ws + WS_MIXED);
    const int tid = threadIdx.x, lane = tid & 63, wave = tid >> 6, r = lane & 31, hh = lane >> 5;
    LAS bf16_t* VT = (LAS bf16_t*)ldsb + wave * (64 * 40);
    sh8_t mf[2];
#pragma unroll
    for (int ks = 0; ks < 2; ++ks)
#pragma unroll
        for (int e = 0; e < 8; ++e) { const int j = 16 * ks + 8 * (e >> 2) + 4 * hh + (e & 3); mf[ks][e] = (j > r) ? (short)0x3F80 : (short)0; }
    for (int u = blockIdx.x * 8 + wave; u < 32 * 256; u += gridDim.x * 8) {
        const int bh = u >> 8, qt = u & 255, b = bh >> 3, h = bh & 7;
        const size_t tok0 = (size_t)b * SEQ + qt * 32;
        sh8_t qf[4];
        { const bf16_t* qp = P + (tok0 + r) * INW + C_SBQ + h * 64 + 8 * hh;
#pragma unroll
          for (int ks = 0; ks < 4; ++ks) qf[ks] = *(const sh8_t*)(qp + 16 * ks); }
        f32x16 o0, o1;
#pragma unroll
        for (int i = 0; i < 16; ++i) { o0[i] = 0.f; o1[i] = 0.f; }
        float R = 0.f;
        for (int kt = qt; kt >= 0; --kt) {
            const size_t ktok0 = (size_t)b * SEQ + kt * 32;
            f32x16 z;
#pragma unroll
            for (int i = 0; i < 16; ++i) z[i] = 0.f;
            { const bf16_t* kp = P + (ktok0 + r) * INW + C_SBK + h * 64 + 8 * hh;
#pragma unroll
              for (int ks = 0; ks < 4; ++ks) z = __builtin_amdgcn_mfma_f32_32x32x16_bf16(*(const sh8_t*)(kp + 16 * ks), qf[ks], z, 0, 0, 0); }
#pragma unroll
            for (int i = 0; i < 4; ++i) { const int idx = lane + 64 * i, key = idx >> 3, dq = idx & 7;
                const u4_t v = *(const u4_t*)(P + (ktok0 + key) * INW + C_SBV + h * 64 + dq * 8);
                vt_store(VT, 40, dq * 8, kperm(key), v); }
            const bool diag = (kt == qt);
            float sp[16]; f32x16 la; float tot = 0.f;
#pragma unroll
            for (int i = 0; i < 16; ++i) { const float zz = z[i];
                float s = fmaxf(zz, 0.f) + __builtin_amdgcn_logf(1.f + __builtin_amdgcn_exp2f(-fabsf(zz)));
                const bool valid = !diag || (crow(i, hh) < r);
                la[i] = zz - s + R; s = valid ? s : 0.f; sp[i] = s; tot += s; }
            tot += __shfl_xor(tot, 32);
#pragma unroll
            for (int ks = 0; ks < 2; ++ks) {
                unsigned hi[4], lo[4];
#pragma unroll
                for (int e = 0; e < 4; ++e) { const float x0 = -sp[8 * ks + 2 * e], x1 = -sp[8 * ks + 2 * e + 1]; hi[e] = cvtpk(x0, x1); lo[e] = cvtpk(x0 - bflo(hi[e]), x1 - bfhi(hi[e])); }
                const u4_t hv = {hi[0], hi[1], hi[2], hi[3]}, lv = {lo[0], lo[1], lo[2], lo[3]};
                la = __builtin_amdgcn_mfma_f32_32x32x16_bf16(mf[ks], __builtin_bit_cast(sh8_t, hv), la, 0, 0, 0);
                la = __builtin_amdgcn_mfma_f32_32x32x16_bf16(mf[ks], __builtin_bit_cast(sh8_t, lv), la, 0, 0, 0);
            }
            sh8_t af[2];
#pragma unroll
            for (int ks = 0; ks < 2; ++ks) { float a[8];
#pragma unroll
                for (int e = 0; e < 8; ++e) { const int i = 8 * ks + e; const bool valid = !diag || (crow(i, hh) < r); a[e] = valid ? __builtin_amdgcn_exp2f(la[i]) : 0.f; }
                af[ks] = frag8(a); }
            R -= tot;
#pragma unroll
            for (int ks = 0; ks < 2; ++ks) {
                o0 = __builtin_amdgcn_mfma_f32_32x32x16_bf16(*(const LAS sh8_t*)(VT + r * 40 + 16 * ks + 8 * hh), af[ks], o0, 0, 0, 0);
                o1 = __builtin_amdgcn_mfma_f32_32x32x16_bf16(*(const LAS sh8_t*)(VT + (32 + r) * 40 + 16 * ks + 8 * hh), af[ks], o1, 0, 0, 0);
            }
            if (__all(R < -160.f)) break;
        }
        float ss = 0.f;
#pragma unroll
        for (int i = 0; i < 16; ++i) { ss = fmaf(o0[i], o0[i], ss); ss = fmaf(o1[i], o1[i], ss); }
        ss += __shfl_xor(ss, 32);
        const float rn = rsqrtf(ss * (1.f / 64.f) + EPS);
        bf16_t* op = mixed + (tok0 + r) * DM + h * 64 + 4 * hh;
        const float* gp = p.sb_gain + h * 64 + 4 * hh;
#pragma unroll
        for (int q4 = 0; q4 < 4; ++q4) {
            const float4 g0 = *(const float4*)(gp + 8 * q4), g1 = *(const float4*)(gp + 32 + 8 * q4);
            uint2 w0, w1;
            w0.x = cvtpk(o0[4 * q4] * rn * g0.x, o0[4 * q4 + 1] * rn * g0.y); w0.y = cvtpk(o0[4 * q4 + 2] * rn * g0.z, o0[4 * q4 + 3] * rn * g0.w);
            w1.x = cvtpk(o1[4 * q4] * rn * g1.x, o1[4 * q4 + 1] * rn * g1.y); w1.y = cvtpk(o1[4 * q4 + 2] * rn * g1.z, o1[4 * q4 + 3] * rn * g1.w);
            *(uint2*)(op + 8 * q4) = w0; *(uint2*)(op + 32 + 8 * q4) = w1;
        }
    }
}
__device__ __forceinline__ void mem_attn_mfma(const Params& p, unsigned char* ldsb) {
    const bf16_t* P = (const bf16_t*)(p.ws + WS_P);
    const bf16_t* mk = (const bf16_t*)(p.ws + WS_MEMK); const bf16_t* mv = (const bf16_t*)(p.ws + WS_MEMV);
    bf16_t* mixed = (bf16_t*)(p.ws + WS_MIXED);
    const int tid = threadIdx.x, lane = tid & 63, wave = tid >> 6, r = lane & 31, hh = lane >> 5;
    LAS bf16_t* VT = (LAS bf16_t*)ldsb;
    for (int unit = blockIdx.x; unit < NB * 4 * (SEQ / 256); unit += gridDim.x) {
        const int tb = unit & 31, hd = (unit >> 5) & 3, b = unit >> 7;
        __syncthreads();
#pragma unroll
        for (int i = 0; i < 4; ++i) { const int idx = tid + 512 * i, key = idx >> 3, dq = idx & 7;
            const u4_t v = *(const u4_t*)(mv + ((size_t)b * NMEM + key) * 256 + hd * 64 + dq * 8);
            vt_store(VT, 264, dq * 8, (key & ~31) | kperm(key & 31), v); }
        __syncthreads();
        const size_t tok = (size_t)b * SEQ + tb * 256 + wave * 32 + r;
        sh8_t qf[4];
        { const bf16_t* qp = P + tok * INW + C_MQ + hd * 64 + 8 * hh;
          float qv[32]; float ss = 0.f;
#pragma unroll
          for (int ks = 0; ks < 4; ++ks) { const u4_t w = *(const u4_t*)(qp + 16 * ks);
              qv[8 * ks] = bflo(w.x); qv[8 * ks + 1] = bfhi(w.x); qv[8 * ks + 2] = bflo(w.y); qv[8 * ks + 3] = bfhi(w.y); qv[8 * ks + 4] = bflo(w.z); qv[8 * ks + 5] = bfhi(w.z); qv[8 * ks + 6] = bflo(w.w); qv[8 * ks + 7] = bfhi(w.w); }
#pragma unroll
          for (int i = 0; i < 32; ++i) ss = fmaf(qv[i], qv[i], ss);
          ss += __shfl_xor(ss, 32);
          const float rq = rsqrtf(ss * (1.f / 64.f) + EPS) * (0.125f * LOG2E);
#pragma unroll
          for (int ks = 0; ks < 4; ++ks) { float t8[8];
#pragma unroll
              for (int e = 0; e < 8; ++e) t8[e] = qv[8 * ks + e] * rq * p.mq_gain[16 * ks + 8 * hh + e];
              qf[ks] = frag8(t8); } }
        f32x16 s[8];
#pragma unroll
        for (int kt = 0; kt < 8; ++kt) {
#pragma unroll
            for (int i = 0; i < 16; ++i) s[kt][i] = 0.f;
            const bf16_t* kp = mk + ((size_t)b * NMEM + kt * 32 + r) * 256 + hd * 64 + 8 * hh;
#pragma unroll
            for (int ks = 0; ks < 4; ++ks) s[kt] = __builtin_amdgcn_mfma_f32_32x32x16_bf16(*(const sh8_t*)(kp + 16 * ks), qf[ks], s[kt], 0, 0, 0);
        }
        float mx = -1e30f;
#pragma unroll
        for (int kt = 0; kt < 8; ++kt)
#pragma unroll
            for (int i = 0; i < 16; ++i) mx = fmaxf(mx, s[kt][i]);
        mx = fmaxf(mx, __shfl_xor(mx, 32));
        float lsum = 0.f;
        f32x16 o0, o1;
#pragma unroll
        for (int i = 0; i < 16; ++i) { o0[i] = 0.f; o1[i] = 0.f; }
#pragma unroll
        for (int kt = 0; kt < 8; ++kt)
#pragma unroll
            for (int ks = 0; ks < 2; ++ks) { float a[8];
#pragma unroll
                for (int e = 0; e < 8; ++e) { a[e] = __builtin_amdgcn_exp2f(s[kt][8 * ks + e] - mx); lsum += a[e]; }
                const sh8_t af = frag8(a);
                o0 = __builtin_amdgcn_mfma_f32_32x32x16_bf16(*(const LAS sh8_t*)(VT + r * 264 + 32 * kt + 16 * ks + 8 * hh), af, o0, 0, 0, 0);
                o1 = __builtin_amdgcn_mfma_f32_32x32x16_bf16(*(const LAS sh8_t*)(VT + (32 + r) * 264 + 32 * kt + 16 * ks + 8 * hh), af, o1, 0, 0, 0); }
        lsum += __shfl_xor(lsum, 32);
        const float il = 1.f / lsum;
        bf16_t* op = mixed + tok * DM + 768 + hd * 64 + 4 * hh;
#pragma unroll
        for (int q4 = 0; q4 < 4; ++q4) {
            uint2 w0, w1;
            w0.x = cvtpk(o0[4 * q4] * il, o0[4 * q4 + 1] * il); w0.y = cvtpk(o0[4 * q4 + 2] * il, o0[4 * q4 + 3] * il);
            w1.x = cvtpk(o1[4 * q4] * il, o1[4 * q4 + 1] * il); w1.y = cvtpk(o1[4 * q4 + 2] * il, o1[4 * q4 + 3] * il);
            *(uint2*)(op + 8 * q4) = w0; *(uint2*)(op + 32 + 8 * q4) = w1;
        }
    }
}

__device__ __forceinline__ void rstd2_rows(const Params& p) {
    float* rs = (float*)(p.ws + WS_RSTD2);
    const int lane = threadIdx.x & 63, wave = threadIdx.x >> 6;
    for (int m = blockIdx.x * 8 + wave; m < T; m += gridDim.x * 8) {
        const float4* xr = (const float4*)(p.out + (size_t)m * DM) + lane; float s = 0.f;
#pragma unroll
        for (int j = 0; j < 4; ++j) { const float4 v = xr[64 * j]; s += (v.x * v.x + v.y * v.y) + (v.z * v.z + v.w * v.w); }
        s = wave_sum(s);
        if (lane == 0) rs[m] = rsqrtf(s * (1.f / DM) + EPS);
    }
}

__device__ __forceinline__ void wave_argmax(float& v, int& i) {
#pragma unroll
    for (int o = 32; o >= 1; o >>= 1) { const float ov = __shfl_xor(v, o); const int oi = __shfl_xor(i, o); if (ov > v || (ov == v && oi < i)) { v = ov; i = oi; } }
}
__device__ __forceinline__ void topk_naive(const Params& p, unsigned char* ldsb) {
    const bf16_t* Q = (const bf16_t*)(p.ws + WS_Q);
    const bf16_t* SK = (const bf16_t*)(p.ws + WS_SKB);
    int* pidx = (int*)(p.ws + WS_PIDX); float* pg = (float*)(p.ws + WS_PG);
    const int lane = threadIdx.x & 63, wave = threadIdx.x >> 6;
    float* tsv = (float*)ldsb + wave * 128;
    int* tsi = (int*)tsv + 32;
    float* bsv = tsv + 64; int* bse = (int*)tsv + 80;
    for (int it = blockIdx.x * 8 + wave; it < T * 8; it += gridDim.x * 8) {
        const int tok = it >> 3, h = it & 7;
        for (int c = 0; c < 2; ++c) {
            const uint4* qp = (const uint4*)(Q + (size_t)tok * 2048 + h * 256 + c * 128);
            const uint4* k0 = (const uint4*)(SK + ((size_t)(h * 2 + c) * 128 + lane) * 128);
            const uint4* k1 = (const uint4*)(SK + ((size_t)(h * 2 + c) * 128 + lane + 64) * 128);
            float s0 = 0.f, s1 = 0.f;
            for (int j = 0; j < 16; ++j) { const uint4 qv = qp[j], a = k0[j], bq = k1[j];
                s0 = fmaf(bflo(qv.x), bflo(a.x), s0); s0 = fmaf(bfhi(qv.x), bfhi(a.x), s0); s0 = fmaf(bflo(qv.y), bflo(a.y), s0); s0 = fmaf(bfhi(qv.y), bfhi(a.y), s0);
                s0 = fmaf(bflo(qv.z), bflo(a.z), s0); s0 = fmaf(bfhi(qv.z), bfhi(a.z), s0); s0 = fmaf(bflo(qv.w), bflo(a.w), s0); s0 = fmaf(bfhi(qv.w), bfhi(a.w), s0);
                s1 = fmaf(bflo(qv.x), bflo(bq.x), s1); s1 = fmaf(bfhi(qv.x), bfhi(bq.x), s1); s1 = fmaf(bflo(qv.y), bflo(bq.y), s1); s1 = fmaf(bfhi(qv.y), bfhi(bq.y), s1);
                s1 = fmaf(bflo(qv.z), bflo(bq.z), s1); s1 = fmaf(bfhi(qv.z), bfhi(bq.z), s1); s1 = fmaf(bflo(qv.w), bflo(bq.w), s1); s1 = fmaf(bfhi(qv.w), bfhi(bq.w), s1); }
            for (int r = 0; r < 16; ++r) {
                float v = s0; int i = lane; if (s1 > s0) { v = s1; i = lane + 64; }
                wave_argmax(v, i);
                if (lane == 0) { tsv[c * 16 + r] = v; tsi[c * 16 + r] = i; }
                if (i == lane) s0 = -INFINITY; if (i == lane + 64) s1 = -INFINITY;
            }
        }
        __builtin_amdgcn_s_waitcnt(0); __builtin_amdgcn_wave_barrier();
        float cs[4];
#pragma unroll
        for (int u = 0; u < 4; ++u) { const int id = lane * 4 + u; cs[u] = tsv[id >> 4] + tsv[16 + (id & 15)]; }
        for (int r = 0; r < 16; ++r) {
            float v = cs[0]; int i = lane * 4;
#pragma unroll
            for (int u = 1; u < 4; ++u) if (cs[u] > v) { v = cs[u]; i = lane * 4 + u; }
            wave_argmax(v, i);
            if (lane == 0) { bsv[r] = v; bse[r] = tsi[i >> 4] * 128 + tsi[16 + (i & 15)]; }
#pragma unroll
            for (int u = 0; u < 4; ++u) if (i == lane * 4 + u) cs[u] = -INFINITY;
        }
        __builtin_amdgcn_s_waitcnt(0); __builtin_amdgcn_wave_barrier();
        { const float mxv = bsv[0]; float e = (lane < 16) ? __expf(bsv[lane & 15] - mxv) : 0.f;
          float s = e; s += __shfl_xor(s, 1); s += __shfl_xor(s, 2); s += __shfl_xor(s, 4); s += __shfl_xor(s, 8);
          if (lane < 16) { pidx[(size_t)tok * PK + h * 16 + lane] = bse[lane]; pg[(size_t)tok * PK + h * 16 + lane] = e / s; } }
        __builtin_amdgcn_s_waitcnt(0); __builtin_amdgcn_wave_barrier();
    }
}

__device__ __forceinline__ void peer_naive(const Params& p, unsigned char* ldsb) {
    const int* pidx = (const int*)(p.ws + WS_PIDX); const float* pg = (const float*)(p.ws + WS_PG);
    const float* rs = (const float*)(p.ws + WS_RSTD2);
    float* hs = (float*)ldsb;
    float* red = hs + 1024;
    const int tid = threadIdx.x, lane = tid & 63, wave = tid >> 6;
    for (int tok = blockIdx.x; tok < T; tok += gridDim.x) {
        const float r2 = rs[tok];
        for (int d = tid; d < DM; d += NTHR) hs[d] = p.out[(size_t)tok * DM + d] * r2 * p.g_ffn[d];
        __syncthreads();
        float4 hv[4];
#pragma unroll
        for (int j = 0; j < 4; ++j) hv[j] = *((const float4*)hs + lane + 64 * j);
        float4 acc[4];
#pragma unroll
        for (int j = 0; j < 4; ++j) acc[j] = make_float4(0.f, 0.f, 0.f, 0.f);
        for (int pi = wave; pi < PK; pi += 8) {
            const int e = pidx[(size_t)tok * PK + pi]; const float g = pg[(size_t)tok * PK + pi];
            const float4* up = (const float4*)(p.pu + (size_t)e * DM) + lane;
            const float4* vp = (const float4*)(p.pv + (size_t)e * DM) + lane;
            float s = 0.f;
#pragma unroll
            for (int j = 0; j < 4; ++j) { const float4 u = up[64 * j]; s += (hv[j].x * u.x + hv[j].y * u.y) + (hv[j].z * u.z + hv[j].w * u.w); }
            s = wave_sum(s);
            const float w = g * 0.5f * s * (1.f + erff(s * 0.70710678118654752f));
#pragma unroll
            for (int j = 0; j < 4; ++j) { const float4 v = vp[64 * j]; acc[j].x = fmaf(w, v.x, acc[j].x); acc[j].y = fmaf(w, v.y, acc[j].y); acc[j].z = fmaf(w, v.z, acc[j].z); acc[j].w = fmaf(w, v.w, acc[j].w); }
        }
#pragma unroll
        for (int j = 0; j < 4; ++j) *((float4*)(red + wave * 1024) + lane + 64 * j) = acc[j];
        __syncthreads();
        for (int d = tid; d < DM; d += NTHR) { float s = 0.f;
#pragma unroll
            for (int w = 0; w < 8; ++w) s += red[w * 1024 + d];
            p.out[(size_t)tok * DM + d] += s; }
        __syncthreads();
    }
}


__device__ __forceinline__ int tk_pack(float s, int payload, int mask) { const int b = __float_as_int(s); const int m = b ^ ((b >> 31) & 0x7fffffff); return (m & ~mask) | payload; }
__device__ __forceinline__ float tk_unpack(int key, int mask) { const int m = key & ~mask; return __int_as_float(m ^ ((m >> 31) & 0x7fffffff)); }
template <int N> __device__ __forceinline__ void bitonic_sort_desc(int (&v)[N]) {
#pragma unroll
    for (int k = 2; k <= N; k <<= 1)
#pragma unroll
        for (int j = k >> 1; j > 0; j >>= 1)
#pragma unroll
            for (int i = 0; i < N; ++i) { const int l = i ^ j; if (l > i) { const bool desc = ((i & k) == 0); const int a = v[i], b = v[l]; const int hi = max(a, b), lo = min(a, b); v[i] = desc ? hi : lo; v[l] = desc ? lo : hi; } }
}
__device__ __forceinline__ void merge_top16(int (&A)[16], const int (&B)[16]) {
#pragma unroll
    for (int i = 0; i < 16; ++i) A[i] = max(A[i], B[15 - i]);
#pragma unroll
    for (int j = 8; j > 0; j >>= 1)
#pragma unroll
        for (int i = 0; i < 16; ++i) { const int l = i ^ j; if (l > i) { const int a = A[i], b = A[l]; A[i] = max(a, b); A[l] = min(a, b); } }
}
__device__ __forceinline__ void top16_of_64(int (&g0)[16], int (&g1)[16], int (&g2)[16], int (&g3)[16]) {
    bitonic_sort_desc<16>(g0); bitonic_sort_desc<16>(g1); bitonic_sort_desc<16>(g2); bitonic_sort_desc<16>(g3);
    merge_top16(g0, g1); merge_top16(g2, g3); merge_top16(g0, g2);
}
__device__ __forceinline__ void topk_mfma(const Params& p, unsigned char* ldsb) {
    const bf16_t* Q = (const bf16_t*)(p.ws + WS_Q);
    const bf16_t* SK = (const bf16_t*)(p.ws + WS_SKB);
    unsigned short* pidx16 = (unsigned short*)(p.ws + WS_PIDX); float* pg = (float*)(p.ws + WS_PG);
    const float* ssq = (const float*)(p.ws + WS_SSQ); float* rs2 = (float*)(p.ws + WS_RSTD2);
    LAS unsigned char* l = (LAS unsigned char*)ldsb;
    LAS bf16_t* SKL = (LAS bf16_t*)l;
    const int tid = threadIdx.x, lane = tid & 63, wave = tid >> 6, r = lane & 31, hh = lane >> 5;
    LAS unsigned char* ib = l + 69632 + (wave * 64 + lane) * 36;
    int cur_h = -1;
    for (int unit = blockIdx.x; unit < 8 * (T / 256); unit += gridDim.x) {
        const int h = unit & 7, tb = unit >> 3;
        if (h != cur_h) {
            __syncthreads();
#pragma unroll
            for (int it = 0; it < 8; ++it) { const int idx = tid + 512 * it, row = idx >> 4, cq = idx & 15;
                *(LAS u4_t*)(SKL + row * 136 + cq * 8) = *(const u4_t*)(SK + ((size_t)h * 256 + row) * 128 + cq * 8); }
            __syncthreads();
            cur_h = h;
        }
        const int tok = tb * 256 + wave * 32 + r;
        int sorted[2][16];
#pragma unroll
        for (int c = 0; c < 2; ++c) {
            sh8_t qf[8];
            { const sh8_t* qp = (const sh8_t*)(Q + (size_t)tok * 2048 + h * 256 + c * 128 + 8 * hh);
#pragma unroll
              for (int ks = 0; ks < 8; ++ks) qf[ks] = qp[2 * ks]; }
            int g[4][16];
#pragma unroll
            for (int mt = 0; mt < 4; ++mt) {
                f32x16 acc;
#pragma unroll
                for (int i = 0; i < 16; ++i) acc[i] = 0.f;
                const LAS bf16_t* ap = SKL + (c * 128 + 32 * mt + r) * 136 + 8 * hh;
#pragma unroll
                for (int ks = 0; ks < 8; ++ks) acc = __builtin_amdgcn_mfma_f32_32x32x16_bf16(*(const LAS sh8_t*)(ap + 16 * ks), qf[ks], acc, 0, 0, 0);
#pragma unroll
                for (int i = 0; i < 16; ++i) g[mt][i] = tk_pack(acc[i], (32 * mt + (i & 3) + 8 * (i >> 2)) | (hh << 2), 127);
            }
            top16_of_64(g[0], g[1], g[2], g[3]);
            int o[16];
#pragma unroll
            for (int i = 0; i < 16; ++i) o[i] = __shfl_xor(g[0][i], 32);
            merge_top16(g[0], o);
#pragma unroll
            for (int i = 0; i < 16; ++i) sorted[c][i] = g[0][i];
        }
#pragma unroll
        for (int c = 0; c < 2; ++c)
#pragma unroll
            for (int w = 0; w < 4; ++w)
                *(LAS unsigned*)(ib + c * 16 + w * 4) = (unsigned)(sorted[c][4 * w] & 127) | ((unsigned)(sorted[c][4 * w + 1] & 127) << 8) | ((unsigned)(sorted[c][4 * w + 2] & 127) << 16) | ((unsigned)(sorted[c][4 * w + 3] & 127) << 24);
        float av[16], bv[16];
#pragma unroll
        for (int i = 0; i < 16; ++i) { av[i] = tk_unpack(sorted[0][i], 127); bv[i] = tk_unpack(sorted[1][i], 127); }
        int cd[4][16];
        {
            int n = 0;
#pragma unroll
            for (int i = 0; i < 16; ++i)
#pragma unroll
                for (int j = 0; j < 16; ++j)
                    if ((i + 1) * (j + 1) <= 16) { cd[n >> 4][n & 15] = tk_pack(av[i] + bv[j], i * 16 + j, 255); ++n; }
#pragma unroll
            for (; n < 64; ++n) cd[n >> 4][n & 15] = (int)0x80000000;
        }
        top16_of_64(cd[0], cd[1], cd[2], cd[3]);
        float sv[16]; int ex[16];
        float rstd;
        { const f32x4_t* sp_ = (const f32x4_t*)(ssq + (size_t)tok * 16); const f32x4_t q0 = sp_[0], q1 = sp_[1], q2 = sp_[2], q3 = sp_[3];
          const float tot = ((q0[0] + q0[1]) + (q0[2] + q0[3])) + ((q1[0] + q1[1]) + (q1[2] + q1[3])) + ((q2[0] + q2[1]) + (q2[2] + q2[3])) + ((q3[0] + q3[1]) + (q3[2] + q3[3]));
          rstd = rsqrtf(tot * (1.f / DM) + EPS); if (h == 0 && hh == 0) rs2[tok] = rstd; }
        const float s0 = tk_unpack(cd[0][0], 255);
        float sum = 0.f;
#pragma unroll
        for (int q = 0; q < 16; ++q) { const int key = cd[0][q]; const int id = key & 255;
            const int ia = ib[id >> 4], ibx = ib[16 + (id & 15)];
            ex[q] = ia * 128 + ibx; sv[q] = __expf((tk_unpack(key, 255) - s0) * rstd); sum += sv[q]; }
        const float inv = 1.f / sum;
        if (hh == 0) { u4_t* d = (u4_t*)(pidx16 + (size_t)tok * PK + h * 16);
#pragma unroll
            for (int w = 0; w < 2; ++w) d[w] = (u4_t){(unsigned)ex[8 * w] | ((unsigned)ex[8 * w + 1] << 16), (unsigned)ex[8 * w + 2] | ((unsigned)ex[8 * w + 3] << 16), (unsigned)ex[8 * w + 4] | ((unsigned)ex[8 * w + 5] << 16), (unsigned)ex[8 * w + 6] | ((unsigned)ex[8 * w + 7] << 16)}; }
        else { float4* d = (float4*)(pg + (size_t)tok * PK + h * 16);
#pragma unroll
            for (int w = 0; w < 4; ++w) d[w] = make_float4(sv[4 * w] * inv, sv[4 * w + 1] * inv, sv[4 * w + 2] * inv, sv[4 * w + 3] * inv); }
    }
}

struct Sl { int vx, rank, nrank; };
__device__ __forceinline__ float dpp_xor1(float x) { return __int_as_float(__builtin_amdgcn_mov_dpp(__float_as_int(x), 0xB1, 0xF, 0xF, true)); }
__device__ __forceinline__ float dpp_xor2(float x) { return __int_as_float(__builtin_amdgcn_mov_dpp(__float_as_int(x), 0x4E, 0xF, 0xF, true)); }
__device__ __forceinline__ float dpp_hmir(float x) { return __int_as_float(__builtin_amdgcn_mov_dpp(__float_as_int(x), 0x141, 0xF, 0xF, true)); }
__device__ __forceinline__ void peer_u_phase(const Params& p, const Sl sl) {
    const int lane = threadIdx.x & 63, wave = threadIdx.x >> 6, g8 = lane >> 3, c = lane & 7;
    const unsigned short* pidx = (const unsigned short*)(p.ws + WS_PIDX);
    const int tbase = sl.rank * 8 + wave, stride = sl.nrank * 8;
    const int nk = (tbase < T) ? (T - tbase + stride - 1) / stride : 0;
    const int S = sl.vx;
    const unsigned char* Ub = p.ws + WS_U16 + (size_t)S * NEXP * 128 + c * 16;
    const bf16_t* xbb = (const bf16_t*)(p.ws + WS_XB) + (size_t)(2 * S + (c >> 2)) * T * 64 + (c & 3) * 16;
    _Float16* PUs = (_Float16*)(p.ws + WS_PU) + (size_t)S * T * PK;
    if (nk == 0) return;
#define TK(k) (tbase + ((k) < nk ? (k) : nk - 1) * stride)
#define SBAR __builtin_amdgcn_sched_barrier(0)
#define U_LOAD_IDX(I, t) { const u4_t* ip_ = (const u4_t*)(pidx + (size_t)(t) * PK + g8 * 16); I[0] = __builtin_nontemporal_load(ip_); I[1] = __builtin_nontemporal_load(ip_ + 1); }
#define U_LOAD_H(H, t) { const u4_t* hp_ = (const u4_t*)(xbb + (size_t)(t) * 64); H[0] = __builtin_nontemporal_load(hp_); H[1] = __builtin_nontemporal_load(hp_ + 1); }
#define U_ISSUE(G, I) { const unsigned w0_ = I[(G) >> 1][(2 * (G)) & 3], w1_ = I[(G) >> 1][(2 * (G) + 1) & 3]; \
        rr[4 * (G)] = *(const u4_t*)(Ub + (size_t)(w0_ & 0xffffu) * 128); rr[4 * (G) + 1] = *(const u4_t*)(Ub + (size_t)(w0_ >> 16) * 128); \
        rr[4 * (G) + 2] = *(const u4_t*)(Ub + (size_t)(w1_ & 0xffffu) * 128); rr[4 * (G) + 3] = *(const u4_t*)(Ub + (size_t)(w1_ >> 16) * 128); }
#define U_DOT(G) { _Pragma("unroll") for (int i_ = 4 * (G); i_ < 4 * (G) + 4; ++i_) { float2_t a_ = {0.f, 0.f}; \
        _Pragma("unroll") for (int q_ = 0; q_ < 4; ++q_) { a_ = __builtin_amdgcn_cvt_pk_f32_fp8((int)rr[i_][q_], false) * X2[2 * q_] + a_; a_ = __builtin_amdgcn_cvt_pk_f32_fp8((int)rr[i_][q_], true) * X2[2 * q_ + 1] + a_; } \
        pr[i_] = a_.x + a_.y; } }
#define U_STEP(k, I1, I2, Hc, Hn) { float pr[16]; float2_t X2[8]; \
        _Pragma("unroll") for (int m_ = 0; m_ < 8; ++m_) { const unsigned hw_ = Hc[m_ >> 2][m_ & 3]; X2[m_] = (float2_t){bflo(hw_), bfhi(hw_)}; } \
        U_LOAD_IDX(I2, TK((k) + 2)); U_LOAD_H(Hn, TK((k) + 1)); SBAR; \
        U_DOT(0); SBAR; U_ISSUE(0, I1); SBAR; U_DOT(1); SBAR; U_ISSUE(1, I1); SBAR; U_DOT(2); SBAR; U_ISSUE(2, I1); SBAR; U_DOT(3); SBAR; U_ISSUE(3, I1); SBAR; \
        _Pragma("unroll") for (int j_ = 0; j_ < 8; ++j_) { const float keep_ = (c & 4) ? pr[j_ + 8] : pr[j_], send_ = (c & 4) ? pr[j_] : pr[j_ + 8]; pr[j_] = keep_ + dpp_hmir(send_); } \
        _Pragma("unroll") for (int j_ = 0; j_ < 4; ++j_) { const float keep_ = (c & 2) ? pr[j_ + 4] : pr[j_], send_ = (c & 2) ? pr[j_] : pr[j_ + 4]; pr[j_] = keep_ + dpp_xor2(send_); } \
        _Pragma("unroll") for (int j_ = 0; j_ < 2; ++j_) { const float keep_ = (c & 1) ? pr[j_ + 2] : pr[j_], send_ = (c & 1) ? pr[j_] : pr[j_ + 2]; pr[j_] = keep_ + dpp_xor1(send_); } \
        __builtin_nontemporal_store((h2_t){(_Float16)pr[0], (_Float16)pr[1]}, (h2_t*)(PUs + (size_t)TK(k) * PK + g8 * 16 + 2 * c)); }
    u4_t iA[2], iB[2], rr[16], hA[2], hB[2];
    U_LOAD_IDX(iA, TK(0)); U_LOAD_IDX(iB, TK(1)); U_LOAD_H(hA, TK(0)); SBAR;
    U_ISSUE(0, iA); SBAR; U_ISSUE(1, iA); SBAR; U_ISSUE(2, iA); SBAR; U_ISSUE(3, iA); SBAR;
    for (int k = 0; k < nk; k += 2) {
        U_STEP(k, iB, iA, hA, hB);
        if (k + 1 < nk) U_STEP(k + 1, iA, iB, hB, hA);
    }
#undef U_LOAD_IDX
#undef U_LOAD_H
#undef U_ISSUE
#undef U_DOT
#undef U_STEP
}
__device__ __forceinline__ void peer_w_phase(const Params& p) {
    const _Float16* PU = (const _Float16*)(p.ws + WS_PU); const float* pg = (const float*)(p.ws + WS_PG); const float* rs = (const float*)(p.ws + WS_RSTD2);
    float* pw = (float*)(p.ws + WS_PW);
    for (int i = blockIdx.x * NTHR + threadIdx.x; i < T * PK / 8; i += gridDim.x * NTHR) {
        float s[8];
#pragma unroll
        for (int e = 0; e < 8; ++e) s[e] = 0.f;
#pragma unroll
        for (int x = 0; x < 8; ++x) { const h8_t hv = __builtin_nontemporal_load((const h8_t*)(PU + (size_t)x * T * PK) + i);
#pragma unroll
            for (int e = 0; e < 8; ++e) s[e] += (float)hv[e]; }
        const float r = rs[i >> 4] * (1.f / PEER_US);
        const f32x4_t g0 = *((const f32x4_t*)pg + 2 * i), g1 = *((const f32x4_t*)pg + 2 * i + 1);
        f32x4_t w0, w1;
#pragma unroll
        for (int e = 0; e < 4; ++e) { const float a = s[e] * r, b = s[4 + e] * r;
            w0[e] = g0[e] * (0.5f / PEER_VS) * a * (1.f + erff(a * 0.70710678118654752f)); w1[e] = g1[e] * (0.5f / PEER_VS) * b * (1.f + erff(b * 0.70710678118654752f)); }
        *((f32x4_t*)pw + 2 * i) = w0; *((f32x4_t*)pw + 2 * i + 1) = w1;
    }
}
__device__ __forceinline__ void peer_v_phase(const Params& p, const Sl sl) {
    const int lane = threadIdx.x & 63, wave = threadIdx.x >> 6, g8 = lane & 7, c = lane >> 3;
    const unsigned short* pidx = (const unsigned short*)(p.ws + WS_PIDX); const float* pw = (const float*)(p.ws + WS_PW);
    const int tbase = sl.rank * 8 + wave, stride = sl.nrank * 8;
    const int nk = (tbase < T) ? (T - tbase + stride - 1) / stride : 0;
    const int S = sl.vx;
    const unsigned char* Vb = p.ws + WS_V16 + (size_t)S * NEXP * 128 + c * 16;
    const int jj = 2 * lane, s16 = 2 * S + (jj >> 6), j = jj & 63;
    float* ob = p.out + (j >> 5) * 512 + 32 * s16 + (j & 31);
    const float* xs = (const float*)(p.ws + WS_X1S) + (size_t)s16 * T * 64 + j;
    if (nk == 0) return;
#define V_LOAD_IDX(I, t) { const u4_t* ip_ = (const u4_t*)(pidx + (size_t)(t) * PK + g8 * 16); I[0] = __builtin_nontemporal_load(ip_); I[1] = __builtin_nontemporal_load(ip_ + 1); }
#define V_LOAD_W(W, t) { const f32x4_t* wp_ = (const f32x4_t*)(pw + (size_t)(t) * PK + g8 * 16); W[0] = __builtin_nontemporal_load(wp_); W[1] = __builtin_nontemporal_load(wp_ + 1); W[2] = __builtin_nontemporal_load(wp_ + 2); W[3] = __builtin_nontemporal_load(wp_ + 3); }
#define V_ISSUE(G, I) { const unsigned w0_ = I[(G) >> 1][(2 * (G)) & 3], w1_ = I[(G) >> 1][(2 * (G) + 1) & 3]; \
        rr[4 * (G)] = *(const u4_t*)(Vb + (size_t)(w0_ & 0xffffu) * 128); rr[4 * (G) + 1] = *(const u4_t*)(Vb + (size_t)(w0_ >> 16) * 128); \
        rr[4 * (G) + 2] = *(const u4_t*)(Vb + (size_t)(w1_ & 0xffffu) * 128); rr[4 * (G) + 3] = *(const u4_t*)(Vb + (size_t)(w1_ >> 16) * 128); }
#define V_FMA(G, W) { _Pragma("unroll") for (int i_ = 4 * (G); i_ < 4 * (G) + 4; ++i_) { const float wv_ = W[G][i_ & 3]; const float2_t ww_ = {wv_, wv_}; \
        _Pragma("unroll") for (int q_ = 0; q_ < 4; ++q_) { acc2[2 * q_] = __builtin_amdgcn_cvt_pk_f32_fp8((int)rr[i_][q_], false) * ww_ + acc2[2 * q_]; acc2[2 * q_ + 1] = __builtin_amdgcn_cvt_pk_f32_fp8((int)rr[i_][q_], true) * ww_ + acc2[2 * q_ + 1]; } } }
#define V_STEP(k, I1, I2, Wc, Wn) { float2_t acc2[8]; \
        _Pragma("unroll") for (int k_ = 0; k_ < 8; ++k_) acc2[k_] = (float2_t){0.f, 0.f}; \
        const float2_t oold_ = __builtin_nontemporal_load((const float2_t*)(xs + (size_t)TK(k) * 64)); \
        V_LOAD_IDX(I2, TK((k) + 2)); V_LOAD_W(Wn, TK((k) + 1)); SBAR; \
        V_FMA(0, Wc); SBAR; V_ISSUE(0, I1); SBAR; V_FMA(1, Wc); SBAR; V_ISSUE(1, I1); SBAR; V_FMA(2, Wc); SBAR; V_ISSUE(2, I1); SBAR; V_FMA(3, Wc); SBAR; V_ISSUE(3, I1); SBAR; \
        float a_[16]; \
        _Pragma("unroll") for (int k_ = 0; k_ < 8; ++k_) { a_[2 * k_] = acc2[k_].x; a_[2 * k_ + 1] = acc2[k_].y; } \
        _Pragma("unroll") for (int j_ = 0; j_ < 8; ++j_) { const float keep_ = (g8 & 4) ? a_[j_ + 8] : a_[j_], send_ = (g8 & 4) ? a_[j_] : a_[j_ + 8]; a_[j_] = keep_ + dpp_hmir(send_); } \
        _Pragma("unroll") for (int j_ = 0; j_ < 4; ++j_) { const float keep_ = (g8 & 2) ? a_[j_ + 4] : a_[j_], send_ = (g8 & 2) ? a_[j_] : a_[j_ + 4]; a_[j_] = keep_ + dpp_xor2(send_); } \
        _Pragma("unroll") for (int j_ = 0; j_ < 2; ++j_) { const float keep_ = (g8 & 1) ? a_[j_ + 2] : a_[j_], send_ = (g8 & 1) ? a_[j_] : a_[j_ + 2]; a_[j_] = keep_ + dpp_xor1(send_); } \
        __builtin_nontemporal_store((float2_t){oold_.x + a_[0], oold_.y + a_[1]}, (float2_t*)(ob + (size_t)TK(k) * DM)); }
    u4_t iA[2], iB[2], rr[16]; f32x4_t wA[4], wB[4];
    V_LOAD_IDX(iA, TK(0)); V_LOAD_IDX(iB, TK(1)); V_LOAD_W(wA, TK(0)); SBAR;
    V_ISSUE(0, iA); SBAR; V_ISSUE(1, iA); SBAR; V_ISSUE(2, iA); SBAR; V_ISSUE(3, iA); SBAR;
    for (int k = 0; k < nk; k += 2) {
        V_STEP(k, iB, iA, wA, wB);
        if (k + 1 < nk) V_STEP(k + 1, iA, iB, wB, wA);
    }
#undef V_LOAD_IDX
#undef V_LOAD_W
#undef V_ISSUE
#undef V_FMA
#undef V_STEP
#undef TK
#undef SBAR
}

#ifndef PROBE_DBL
#define PROBE_DBL -1
#endif
#define REP(k) for (int rep_ = 0; rep_ < ((PROBE_DBL == (k)) ? 2 : 1); ++rep_)
typedef const __attribute__((address_space(4))) Params* KArgs;
#if defined(__HIP_DEVICE_COMPILE__)
#define LOADP(P) KArgs kq_ = (KArgs)__builtin_amdgcn_kernarg_segment_ptr(); asm volatile("" : "+s"(kq_)); Params P; __builtin_memcpy(&P, kq_, sizeof(Params))
#define BAR_WS() ((unsigned char*)((KArgs)__builtin_amdgcn_kernarg_segment_ptr())->ws)
#else
#define LOADP(P) const Params P = p_unused
#define BAR_WS() (p_unused.ws)
#endif
#define BAR() do { XcdBarrier xb_; xb_.bar = (unsigned*)(BAR_WS() + WS_CTL) + 4096; xb_.x = ((volatile LAS unsigned*)(LAS unsigned char*)lds)[36861]; xb_.st = (volatile LAS unsigned*)(LAS unsigned char*)lds + 36862; xcd_barrier(xb_); } while (0)
__global__ void __launch_bounds__(NTHR, 2) fwd_kernel(Params p_unused) {
    extern __shared__ __attribute__((aligned(16))) unsigned char lds[];
    PG8_LAS unsigned char* ldsl = (PG8_LAS unsigned char*)lds;
    { LOADP(p);
      if (threadIdx.x < 2) ((volatile LAS unsigned*)(LAS unsigned char*)lds)[36862 + threadIdx.x] = 0u;
      if (threadIdx.x == 0) { unsigned* ctl0 = (unsigned*)(p.ws + WS_CTL); const unsigned xcc0 = (unsigned)__builtin_amdgcn_s_getreg((3 << 11) | 20) & 7u;
        ((volatile unsigned*)lds)[36860] = __hip_atomic_fetch_add(&ctl0[64 * xcc0], 1u, __ATOMIC_RELAXED, __HIP_MEMORY_SCOPE_AGENT); ((volatile unsigned*)lds)[36861] = xcc0;
        (void)xb_add(&(ctl0 + 4096)[XB_XCNT(xcc0)], 1u); }
      __syncthreads(); }
    { LOADP(p); REP(0) phase_prep(p, lds); }
    { cg::grid_group grid = cg::this_grid(); grid.sync(); }
    { LOADP(p); unsigned char* ws = p.ws;
      pg8::Gemm g{(const bf16_t*)(ws + WS_XB), (const bf16_t*)(ws + WS_WIN_T), T, INW, DM, DM, 128}; pg8::StaticOrder S; S.init(T, INW, gridDim.x, blockIdx.x); pg8::EpiProjM e{(bf16_t*)(ws + WS_P)};
      pg8::gemm_phase<pg8::EpiProjM, pg8::StaticOrder, true, true>(ldsl, g, S, e); }
#if PROBE_DBL == 1
    { LOADP(p); unsigned char* ws = p.ws;
      pg8::Gemm g{(const bf16_t*)(ws + WS_XB), (const bf16_t*)(ws + WS_WIN_T), T, INW, DM, DM, 128}; pg8::StaticOrder S; S.init(T, INW, gridDim.x, blockIdx.x); pg8::EpiProjM e{(bf16_t*)(ws + WS_P)};
      pg8::gemm_phase<pg8::EpiProjM, pg8::StaticOrder, true, true>(ldsl, g, S, e); }
#endif
    { LOADP(p); unsigned char* ws = p.ws;
      pg8::Gemm g{(const bf16_t*)(ws + WS_MEMN), (const bf16_t*)(ws + WS_WMKV_T), NB * NMEM, 512, DM, DM, 128}; pg8::StaticOrder S; S.init(NB * NMEM, 512, gridDim.x, blockIdx.x); pg8::EpiF32M e{(float*)(ws + WS_MEMKV), 512};
      pg8::gemm_phase<pg8::EpiF32M, pg8::StaticOrder, true, true>(ldsl, g, S, e); }
    BAR();
    { LOADP(p); mem_knorm(p); REP(2) { sb_mfma(p, lds); __syncthreads(); } REP(3) { hg_local(p, lds); } }
    BAR();
    { LOADP(p); REP(4) hg_scan(p); REP(5) mem_attn_mfma(p, lds); }
    BAR();
    { LOADP(p); REP(6) hg_out(p, lds); }
    BAR();
    { LOADP(p); unsigned char* ws = p.ws;
      pg8::Gemm g{(const bf16_t*)(ws + WS_MIXED), (const bf16_t*)(ws + WS_WOUT_T), T, DM, DM, DM, 128}; pg8::StaticOrder S; S.init(T, DM, gridDim.x, blockIdx.x); pg8::EpiWoutM e{p.x, (float*)(ws + WS_X1S), (bf16_t*)(ws + WS_XB), (float*)(ws + WS_SSQ)};
      pg8::gemm_phase<pg8::EpiWoutM, pg8::StaticOrder, true, true>(ldsl, g, S, e); }
#if PROBE_DBL == 7
    { LOADP(p); unsigned char* ws = p.ws;
      pg8::Gemm g{(const bf16_t*)(ws + WS_MIXED), (const bf16_t*)(ws + WS_WOUT_T), T, DM, DM, DM, 128}; pg8::StaticOrder S; S.init(T, DM, gridDim.x, blockIdx.x); pg8::EpiWoutM e{p.x, (float*)(ws + WS_X1S), (bf16_t*)(ws + WS_XB), (float*)(ws + WS_SSQ)};
      pg8::gemm_phase<pg8::EpiWoutM, pg8::StaticOrder, true, true>(ldsl, g, S, e); }
#endif
    BAR();
    { LOADP(p); unsigned char* ws = p.ws;
      pg8::Gemm g{(const bf16_t*)(ws + WS_XB), (const bf16_t*)(ws + WS_WQ_T), T, 2048, DM, 64, (size_t)T * 128}; pg8::StaticOrder S; S.init(T, 2048, gridDim.x, blockIdx.x); pg8::EpiQM e{(bf16_t*)(ws + WS_Q)};
      pg8::gemm_phase<pg8::EpiQM, pg8::StaticOrder, true, true>(ldsl, g, S, e); }
#if PROBE_DBL == 9
    { LOADP(p); unsigned char* ws = p.ws;
      pg8::Gemm g{(const bf16_t*)(ws + WS_XB), (const bf16_t*)(ws + WS_WQ_T), T, 2048, DM, 64, (size_t)T * 128}; pg8::StaticOrder S; S.init(T, 2048, gridDim.x, blockIdx.x); pg8::EpiQM e{(bf16_t*)(ws + WS_Q)};
      pg8::gemm_phase<pg8::EpiQM, pg8::StaticOrder, true, true>(ldsl, g, S, e); }
#endif
    BAR();
    { LOADP(p); REP(10) topk_mfma(p, lds); }
    BAR();
#define LOAD_SL(p) Sl sl; { const unsigned* ctl = (const unsigned*)(p.ws + WS_CTL); const int myrank = (int)((volatile unsigned*)lds)[36860]; const unsigned xcc = ((volatile unsigned*)lds)[36861]; \
      bool good = (gridDim.x % 8u) == 0u; \
      for (int j = 0; j < 8; ++j) good = good && (__hip_atomic_load(&ctl[64 * j], __ATOMIC_RELAXED, __HIP_MEMORY_SCOPE_AGENT) == gridDim.x / 8u); \
      if (good) { sl.vx = (int)xcc; sl.rank = myrank; sl.nrank = (int)(gridDim.x / 8u); } \
      else { sl.vx = (int)(blockIdx.x & 7u); sl.rank = (int)(blockIdx.x >> 3); sl.nrank = (int)((gridDim.x - (blockIdx.x & 7u) + 7u) / 8u); } }
    { LOADP(p); LOAD_SL(p); REP(11) peer_u_phase(p, sl); }
    BAR();
    { LOADP(p); REP(12) peer_w_phase(p); }
    BAR();
    if (PROBE_DBL == 100) { for (int i = 0; i < 10; ++i) BAR(); }
    { LOADP(p); LOAD_SL(p); peer_v_phase(p, sl); }
}

extern "C" void kernel_launch(void* const* d_in, const int* in_sizes, int n_in, void* d_out, int out_size, void* d_ws, size_t ws_size, hipStream_t stream) {
    static int grid_blocks = 0;
    if (grid_blocks == 0) {
        if (n_in != 17 || out_size != T * DM || ws_size < WS_END) { fprintf(stderr, "kernel_launch: unexpected shapes n_in %d out %d ws %zu\n", n_in, out_size, ws_size); grid_blocks = -1; return; }
        int dev = 0, cus = 0, per_cu = 0;
        (void)hipGetDevice(&dev);
        (void)hipDeviceGetAttribute(&cus, hipDeviceAttributeMultiprocessorCount, dev);
        (void)hipFuncSetAttribute((const void*)fwd_kernel, hipFuncAttributeMaxDynamicSharedMemorySize, LDS_BYTES);
        (void)hipOccupancyMaxActiveBlocksPerMultiprocessor(&per_cu, (const void*)fwd_kernel, NTHR, LDS_BYTES);
        if (per_cu < 1) { fprintf(stderr, "kernel_launch: occupancy query says %d blocks/CU\n", per_cu); per_cu = 1; }
        grid_blocks = cus * 1;
        (void)hipGetLastError();
    }
    if (grid_blocks < 0) return;
    Params p{};
    p.x = (const float*)d_in[0]; p.mem = (const float*)d_in[1]; p.g_mix = (const float*)d_in[2]; p.w_in = (const float*)d_in[3]; p.gamma_lb = (const float*)d_in[4];
    p.sb_gain = (const float*)d_in[5]; p.hg_gain = (const float*)d_in[6]; p.mem_gain = (const float*)d_in[7]; p.w_mkv = (const float*)d_in[8]; p.mq_gain = (const float*)d_in[9];
    p.mk_gain = (const float*)d_in[10]; p.w_out = (const float*)d_in[11]; p.g_ffn = (const float*)d_in[12]; p.w_q = (const float*)d_in[13]; p.sub_keys = (const float*)d_in[14];
    p.pu = (const float*)d_in[15]; p.pv = (const float*)d_in[16];
    p.out = (float*)d_out; p.ws = (unsigned char*)d_ws;
    (void)hipMemsetAsync((char*)d_ws + WS_CTL, 0, 65536, stream);
    void* args[] = {&p};
    hipError_t e = hipLaunchCooperativeKernel((const void*)fwd_kernel, dim3(grid_blocks), dim3(NTHR), args, LDS_BYTES, stream);
    if (e != hipSuccess) fprintf(stderr, "cooperative launch failed: %s (grid %d)\n", hipGetErrorString(e), grid_blocks);
}
```

```cpp
#include <hip/hip_runtime.h>
#include <hip/hip_cooperative_groups.h>
#include <cstdio>
#include <cstdint>
namespace cg = cooperative_groups;

constexpr int NB = 4, SEQ = 8192, DM = 1024, T = NB * SEQ;
constexpr int NMEM = 256, INW = 3328;
constexpr int C_SBQ = 0, C_SBK = 512, C_SBV = 1024, C_HGQ = 1536, C_HGF = 2048, C_HGI = 2560, C_HGG = 2816, C_MQ = 3072;
constexpr int NEXP = 16384, PK = 128;
constexpr float EPS = 1e-6f;
constexpr float LOG2E = 1.4426950408889634f;
constexpr float C2 = 0.125f * LOG2E;

constexpr float PEER_US = 64.f, PEER_VS = 8.f;
constexpr int NTHR = 512;
constexpr int LDS_BYTES = 147456;

constexpr size_t MiB = 1u << 20;
constexpr size_t WS_CTL = 0;
constexpr size_t WS_WIN_T = 1 * MiB;
constexpr size_t WS_WOUT_T = 8 * MiB;
constexpr size_t WS_WQ_T = 10 * MiB;
constexpr size_t WS_WMKV_T = 14 * MiB;
constexpr size_t WS_SKB = 15 * MiB;
constexpr size_t WS_LB = 15 * MiB + 512 * 1024;
constexpr size_t WS_MEMN = 16 * MiB;
constexpr size_t WS_MEMKV = 18 * MiB;
constexpr size_t WS_MEMK = 20 * MiB;
constexpr size_t WS_MEMV = 20 * MiB + 512 * 1024;
constexpr size_t WS_RSTD2 = 21 * MiB;
constexpr size_t WS_PIDX = 24 * MiB;
constexpr size_t WS_PG = 40 * MiB;
constexpr size_t WS_XB = 72 * MiB;
constexpr size_t WS_MIXED = 136 * MiB;
constexpr size_t WS_P = 200 * MiB;
constexpr size_t WS_Q = 136 * MiB;
constexpr size_t WS_X1S = 270 * MiB;
constexpr size_t WS_SSQ = 22 * MiB;
constexpr size_t WS_HGRAW = 408 * MiB;
constexpr size_t WS_PW = 56 * MiB;
constexpr size_t WS_PU = 136 * MiB;
constexpr size_t WS_U16 = 440 * MiB;
constexpr size_t WS_V16 = 472 * MiB;
constexpr size_t WS_END = 512 * MiB;

typedef unsigned short bf16_t;
__device__ __forceinline__ float bf2f(bf16_t v) { return __uint_as_float(((unsigned)v) << 16); }
__device__ __forceinline__ float bflo(unsigned w) { return __uint_as_float(w << 16); }
__device__ __forceinline__ float bfhi(unsigned w) { return __uint_as_float(w & 0xffff0000u); }
__device__ __forceinline__ bf16_t f2bf(float f) { unsigned u = __float_as_uint(f); return (bf16_t)((u + 0x7fffu + ((u >> 16) & 1u)) >> 16); }
__device__ __forceinline__ unsigned pk2(float lo, float hi) { return (unsigned)f2bf(lo) | ((unsigned)f2bf(hi) << 16); }
__device__ __forceinline__ float wave_sum(float v) {
#pragma unroll
    for (int o = 1; o < 64; o <<= 1) v += __shfl_xor(v, o);
    return v;
}
__device__ __forceinline__ float silu(float v) { return v / (1.f + __expf(-v)); }

typedef _Float16 h8_t __attribute__((ext_vector_type(8)));
typedef _Float16 h2_t __attribute__((ext_vector_type(2)));
typedef _Float16 h4_t __attribute__((ext_vector_type(4)));
typedef unsigned u2_t __attribute__((ext_vector_type(2)));
typedef __bf16 bf16x2_v __attribute__((ext_vector_type(2)));
__device__ __forceinline__ float dot2bf(unsigned a, unsigned b, float c) { return __builtin_amdgcn_fdot2_f32_bf16(__builtin_bit_cast(bf16x2_v, a), __builtin_bit_cast(bf16x2_v, b), c, false); }

struct Params {
    const float *x, *mem, *g_mix, *w_in, *gamma_lb, *sb_gain, *hg_gain, *mem_gain, *w_mkv, *mq_gain, *mk_gain, *w_out, *g_ffn, *w_q, *sub_keys, *pu, *pv;
    float* out; unsigned char* ws;
};

namespace pg8 {
#define PG8_LAS __attribute__((address_space(3)))
typedef unsigned short bf16_t;
typedef short bf16x8 __attribute__((ext_vector_type(8)));
typedef float f32x4 __attribute__((ext_vector_type(4)));
typedef unsigned u32x4 __attribute__((ext_vector_type(4)));
constexpr int BM = 256, BK = 64, HALF = 128, HTB = HALF * BK * 2  , STAGE_BYTES = 8 * HTB, NXCD = 8, WGM = 8;

__host__ __device__ __forceinline__ int lds_byte(int r, int c) { const int st = (r >> 4) * 2 + (c >> 5), rr = r & 15, cc = c & 31, ob = rr * 64 + cc * 2; return st * 1024 + (ob ^ (((ob >> 9) & 1) << 5)); }
__host__ __device__ __forceinline__ void stage_rc(int b, int& R, int& C) { const int st = b / 1024, sb = b % 1024, swz = sb ^ (((sb >> 9) & 1) << 5); R = (st >> 1) * 16 + swz / 64; C = (st & 1) * 32 + (swz % 64) / 2; }
__host__ __device__ __forceinline__ int perm32(int rho) { const int n = rho >> 4, i = rho & 15; return 8 * (i >> 2) + 4 * n + (i & 3); }

struct Unit { int pm, pn; };
struct Gemm { const bf16_t* A; const bf16_t* Bt; int M, N, K; int lda; size_t kstepA; };

struct StaticOrder {
    int nM, nN, nwg, G, c;
    __host__ __device__ void init(int M, int N, int G_, int c_) { nM = M / BM; nN = N / BM; nwg = nM * nN; G = G_; c = c_; }
    __host__ __device__ bool next(int i, Unit& u) const {
        const long L = (long)i * G + c; if (L >= nwg) return false;
        int wgid = (int)L; { const int q = nwg / NXCD, r = nwg % NXCD, xcd = wgid % NXCD, off = wgid / NXCD; wgid = (xcd < r ? xcd * (q + 1) : r * (q + 1) + (xcd - r) * q) + off; }
        const int nig = WGM * nN, gid = wgid / nig, fm = gid * WGM, gsz = (nM - fm) < WGM ? (nM - fm) : WGM;
        u.pm = fm + ((wgid % nig) % gsz); u.pn = (wgid % nig) / gsz; return true;
    }
    __device__ __forceinline__ void a_ready(const Unit&) const {}
    __device__ __forceinline__ void done(const Unit&) const {}
};

__device__ __forceinline__ unsigned cvt_pk_bf16(float lo, float hi) { unsigned r; asm volatile("v_cvt_pk_bf16_f32 %0, %1, %2" : "=v"(r) : "v"(lo), "v"(hi)); return r; }
typedef float f32x2 __attribute__((ext_vector_type(2)));
template <class Epi, class Sched, bool ALIGN_EPI = false, bool SP2 = false>
__device__ __forceinline__ void gemm_phase(PG8_LAS unsigned char* lds, const Gemm g, const Sched& S, const Epi& E) {
    int tid_ = threadIdx.x; asm volatile("" : "+v"(tid_));
    const int tid = tid_, wid = __builtin_amdgcn_readfirstlane(tid >> 6), lane = tid & 63, wr = wid >> 2, wc = wid & 3, fr = lane & 15, fq = lane >> 4;
    const int K = g.K, nt = K / BK;
    unsigned voffA[2], voffB[2];
#pragma unroll
    for (int i = 0; i < 2; ++i) { int R, C; stage_rc(tid * 16 + i * 8192, R, C); const int Rb = Epi::PERM ? ((R & ~31) + perm32(R & 31)) : R;
        voffA[i] = (unsigned)(R * g.lda + C) * 2u; voffB[i] = (unsigned)(Rb * K + C) * 2u; }
    const size_t kstep = (size_t)(BK * 2);
    const size_t hstep = (size_t)HALF * K * 2;
    const size_t tstep = 2 * hstep;
    const size_t kstepA = g.kstepA, hstepA = (size_t)HALF * g.lda * 2, tstepA = 2 * hstepA;
    const unsigned ldsw = (unsigned)wid * 1024u;
    const int aoff = lds_byte(wr * 64 + fr, fq * 8), boff = lds_byte(wc * 32 + fr, fq * 8);
#define PG8_SA(b, h) (((b) * 2 + (h)) * HTB)
#define PG8_SB(b, h) ((4 + (b) * 2 + (h)) * HTB)
#define PG8_STAGE(bufoff, gbase, voff) do { _Pragma("unroll") for (int _i = 0; _i < 2; ++_i) \
        __builtin_amdgcn_global_load_lds((const unsigned*)((const char*)(gbase) + (voff)[_i]), (PG8_LAS unsigned*)(lds + (bufoff) + ldsw + _i * 8192), 16, 0, 0); } while (0)
#define PG8_LDA(dst, b, h) do { _Pragma("unroll") for (int m = 0; m < 4; ++m) _Pragma("unroll") for (int k = 0; k < 2; ++k) dst[m][k] = *(const PG8_LAS bf16x8*)(lds + PG8_SA(b, h) + aoff + m * 2048 + k * 1024); } while (0)
#define PG8_LDB(dst, b, h) do { _Pragma("unroll") for (int n = 0; n < 2; ++n) _Pragma("unroll") for (int k = 0; k < 2; ++k) dst[n][k] = *(const PG8_LAS bf16x8*)(lds + PG8_SB(b, h) + boff + n * 2048 + k * 1024); } while (0)
#define PG8_MMA(ai, bj, At, Bt) do { __builtin_amdgcn_s_setprio(1); _Pragma("unroll") for (int m = 0; m < 4; ++m) _Pragma("unroll") for (int n = 0; n < 2; ++n) _Pragma("unroll") for (int k = 0; k < 2; ++k) \
        acc[ai][bj][m][n] = __builtin_amdgcn_mfma_f32_16x16x32_bf16(Bt[n][k], At[m][k], acc[ai][bj][m][n], 0, 0, 0); __builtin_amdgcn_s_setprio(0); } while (0)
#define PG8_WAIT_V(n) asm volatile("s_waitcnt vmcnt(" #n ")" ::: "memory")
#define PG8_WAIT_L(n) asm volatile("s_waitcnt lgkmcnt(" #n ")" ::: "memory")
#define PG8_BAR __builtin_amdgcn_s_barrier()
#define PG8_SCHED __builtin_amdgcn_sched_barrier(0)
    Unit cur, nxt; int ui = 0;
    if (!S.next(0, cur)) return;
    f32x4 acc[2][2][4][2];
#pragma unroll
    for (int a = 0; a < 2; ++a)
#pragma unroll
        for (int b = 0; b < 2; ++b)
#pragma unroll
            for (int m = 0; m < 4; ++m)
#pragma unroll
                for (int n = 0; n < 2; ++n) acc[a][b][m][n] = (f32x4){0.f, 0.f, 0.f, 0.f};
    bf16x8 At[4][2], B0[2][2], B1[2][2];
    const char* cA = (const char*)g.A + (size_t)cur.pm * tstepA; const char* cB = (const char*)g.Bt + (size_t)cur.pn * tstep;
    S.a_ready(cur);
    if constexpr (SP2) {
        PG8_STAGE(PG8_SB(0, 0), cB, voffB); PG8_STAGE(PG8_SB(0, 1), cB + hstep, voffB); PG8_STAGE(PG8_SA(0, 0), cA, voffA); PG8_STAGE(PG8_SA(0, 1), cA + hstepA, voffA);
        if (wr == 1) PG8_BAR;
        PG8_WAIT_V(2); PG8_BAR;
        PG8_STAGE(PG8_SB(1, 0), cB + kstep, voffB); PG8_STAGE(PG8_SA(1, 0), cA + kstepA, voffA); PG8_STAGE(PG8_SB(1, 1), cB + hstep + kstep, voffB);
        PG8_WAIT_V(6); PG8_BAR;
    } else {
        PG8_STAGE(PG8_SB(0, 0), cB, voffB); PG8_STAGE(PG8_SA(0, 0), cA, voffA); PG8_STAGE(PG8_SB(0, 1), cB + hstep, voffB); PG8_STAGE(PG8_SA(0, 1), cA + hstepA, voffA);
        if (wr == 1) PG8_BAR;
        PG8_WAIT_V(4); PG8_BAR;
        PG8_STAGE(PG8_SB(1, 0), cB + kstep, voffB); PG8_STAGE(PG8_SA(1, 0), cA + kstepA, voffA); PG8_STAGE(PG8_SB(1, 1), cB + hstep + kstep, voffB);
        PG8_WAIT_V(6); PG8_BAR;
    }
    for (;;) {
        const bool has_next = S.next(ui + 1, nxt);
        const char* nA = has_next ? (const char*)g.A + (size_t)nxt.pm * tstepA : cA; const char* nB = has_next ? (const char*)g.Bt + (size_t)nxt.pn * tstep : cB;
        for (int t = 0; t < nt; t += 2) {
            const bool last = (t == nt - 2);
            const char* a1 = cA + (size_t)(t + 1) * kstepA;
            const char* a2 = last ? nA : cA + (size_t)(t + 2) * kstepA; const char* b2 = last ? nB : cB + (size_t)(t + 2) * kstep;
            const char* a3 = a2 + kstepA; const char* b3 = b2 + kstep;
            if (last && has_next) S.a_ready(nxt);
            if constexpr (SP2) {
            PG8_LDB(B0, 0, 0); PG8_LDB(B1, 0, 1); PG8_SCHED; PG8_LDA(At, 0, 0); PG8_STAGE(PG8_SA(1, 1), a1 + hstepA, voffA);
            PG8_WAIT_V(8); PG8_WAIT_L(0); PG8_BAR; PG8_MMA(0, 0, At, B0); PG8_MMA(0, 1, At, B1); PG8_BAR; PG8_SCHED;
            PG8_LDA(At, 0, 1); PG8_STAGE(PG8_SB(0, 0), b2, voffB); PG8_STAGE(PG8_SB(0, 1), b2 + hstep, voffB); PG8_STAGE(PG8_SA(0, 0), a2, voffA);
            PG8_WAIT_V(8); PG8_WAIT_L(0); PG8_BAR; PG8_MMA(1, 0, At, B0); PG8_MMA(1, 1, At, B1); PG8_BAR; PG8_SCHED;
            PG8_LDB(B0, 1, 0); PG8_LDB(B1, 1, 1); PG8_SCHED; PG8_LDA(At, 1, 0); PG8_STAGE(PG8_SA(0, 1), a2 + hstepA, voffA);
            PG8_WAIT_V(8); PG8_WAIT_L(0); PG8_BAR; PG8_MMA(0, 0, At, B0); PG8_MMA(0, 1, At, B1); PG8_BAR; PG8_SCHED;
            PG8_LDA(At, 1, 1); PG8_STAGE(PG8_SB(1, 0), b3, voffB); PG8_STAGE(PG8_SB(1, 1), b3 + hstep, voffB); PG8_STAGE(PG8_SA(1, 0), a3, voffA);
            PG8_WAIT_V(8); PG8_WAIT_L(0); PG8_BAR; PG8_MMA(1, 0, At, B0); PG8_MMA(1, 1, At, B1); PG8_BAR; PG8_SCHED;
            } else {
            PG8_LDB(B0, 0, 0); PG8_SCHED; PG8_LDA(At, 0, 0); PG8_STAGE(PG8_SA(1, 1), a1 + hstepA, voffA);
            PG8_WAIT_L(8); PG8_BAR; PG8_WAIT_L(0); PG8_MMA(0, 0, At, B0); PG8_BAR; PG8_SCHED;
            PG8_LDB(B1, 0, 1); PG8_STAGE(PG8_SB(0, 0), b2, voffB);
            PG8_BAR; PG8_WAIT_L(0); PG8_MMA(0, 1, At, B1); PG8_BAR;
            PG8_LDA(At, 0, 1); PG8_STAGE(PG8_SA(0, 0), a2, voffA);
            PG8_BAR; PG8_WAIT_L(0); PG8_MMA(1, 0, At, B0); PG8_BAR; PG8_SCHED;
            PG8_STAGE(PG8_SB(0, 1), b2 + hstep, voffB);
            PG8_WAIT_V(6); PG8_BAR; PG8_MMA(1, 1, At, B1); PG8_BAR;
            PG8_LDB(B0, 1, 0); PG8_SCHED; PG8_LDA(At, 1, 0); PG8_STAGE(PG8_SA(0, 1), a2 + hstepA, voffA);
            PG8_WAIT_L(8); PG8_BAR; PG8_WAIT_L(0); PG8_MMA(0, 0, At, B0); PG8_BAR; PG8_SCHED;
            PG8_LDB(B1, 1, 1); PG8_STAGE(PG8_SB(1, 0), b3, voffB);
            PG8_BAR; PG8_WAIT_L(0); PG8_MMA(0, 1, At, B1); PG8_BAR;
            PG8_LDA(At, 1, 1); PG8_STAGE(PG8_SA(1, 0), a3, voffA);
            PG8_BAR; PG8_WAIT_L(0); PG8_MMA(1, 0, At, B0); PG8_BAR; PG8_SCHED;
            PG8_STAGE(PG8_SB(1, 1), b3 + hstep, voffB);
            PG8_WAIT_V(6); PG8_BAR; PG8_MMA(1, 1, At, B1); PG8_BAR;
            }
        }
        if constexpr (ALIGN_EPI) { if (wr == 0) PG8_BAR; }
        if constexpr (!Epi::AFTER_DRAIN) { E(acc, cur, wr, wc, fr, fq); S.done(cur); }
        if (!has_next) break;
#pragma unroll
        for (int a = 0; a < 2; ++a)
#pragma unroll
            for (int b = 0; b < 2; ++b)
#pragma unroll
                for (int m = 0; m < 4; ++m)
#pragma unroll
                    for (int n = 0; n < 2; ++n) acc[a][b][m][n] = (f32x4){0.f, 0.f, 0.f, 0.f};
        cur = nxt; cA = nA; cB = nB; ++ui;
        if constexpr (ALIGN_EPI) { if (wr == 1) PG8_BAR; }
    }
    PG8_WAIT_V(0);
    if constexpr (!ALIGN_EPI) { if (wr == 0) PG8_BAR; }
    PG8_BAR;
    if constexpr (Epi::AFTER_DRAIN) { E.fused(acc, cur, wr, wc, fr, fq, lds, wid, lane); S.done(cur); }
#undef PG8_SA
#undef PG8_SB
#undef PG8_STAGE
#undef PG8_LDA
#undef PG8_LDB
#undef PG8_MMA
#undef PG8_WAIT_V
#undef PG8_WAIT_L
#undef PG8_BAR
#undef PG8_SCHED
}
}


namespace pg8 {
typedef unsigned u32x4 __attribute__((ext_vector_type(4)));
struct EpiProjM {
    static constexpr bool PERM = true, AFTER_DRAIN = false;
    bf16_t* P;
    __device__ __forceinline__ void operator()(const f32x4 (&acc)[2][2][4][2], const Unit& u, int wr, int wc, int fr, int fq) const {
        const int row0 = u.pm * BM + wr * 64 + fr, col0 = u.pn * BM + wc * 32 + 8 * fq;
        const int pn = u.pn; const int mode = (pn < 2) ? 1 : ((pn == 6 || pn == 7 || pn == 11) ? 2 : 0);
#pragma unroll
        for (int ai = 0; ai < 2; ++ai)
#pragma unroll
            for (int m = 0; m < 4; ++m) { bf16_t* rowp = P + (size_t)(row0 + ai * HALF + m * 16) * INW + col0;
#pragma unroll
                for (int bj = 0; bj < 2; ++bj) { f32x4 v0 = acc[ai][bj][m][0], v1 = acc[ai][bj][m][1];
                    if (mode == 1) { v0 = v0 * C2; v1 = v1 * C2; }
                    else if (mode == 2) {
#pragma unroll
                        for (int e = 0; e < 4; ++e) { v0[e] = silu(v0[e]); v1[e] = silu(v1[e]); } }
                    u32x4 w; w.x = cvt_pk_bf16(v0[0], v0[1]); w.y = cvt_pk_bf16(v0[2], v0[3]); w.z = cvt_pk_bf16(v1[0], v1[1]); w.w = cvt_pk_bf16(v1[2], v1[3]);
                    *(u32x4*)(rowp + bj * HALF) = w; } }
    }
};
struct EpiF32M {
    static constexpr bool PERM = true, AFTER_DRAIN = false;
    float* O; int ld;
    __device__ __forceinline__ void operator()(const f32x4 (&acc)[2][2][4][2], const Unit& u, int wr, int wc, int fr, int fq) const {
        const int row0 = u.pm * BM + wr * 64 + fr, col0 = u.pn * BM + wc * 32 + 8 * fq;
#pragma unroll
        for (int ai = 0; ai < 2; ++ai)
#pragma unroll
            for (int m = 0; m < 4; ++m) { float* rowp = O + (size_t)(row0 + ai * HALF + m * 16) * ld + col0;
#pragma unroll
                for (int bj = 0; bj < 2; ++bj) { *(f32x4*)(rowp + bj * HALF) = acc[ai][bj][m][0]; *(f32x4*)(rowp + bj * HALF + 4) = acc[ai][bj][m][1]; } }
    }
};
struct EpiWoutM {
    static constexpr bool PERM = true, AFTER_DRAIN = false;
    const float* x; float* x1s; bf16_t* x1bs; float* ssq;
    __device__ __forceinline__ void operator()(const f32x4 (&acc)[2][2][4][2], const Unit& u, int wr, int wc, int fr, int fq) const {
        const int row0 = u.pm * BM + wr * 64 + fr, col0 = u.pn * BM + wc * 32 + 8 * fq;
#pragma unroll
        for (int ai = 0; ai < 2; ++ai)
#pragma unroll
            for (int m = 0; m < 4; ++m) { const int row = row0 + ai * HALF + m * 16; const size_t rb = (size_t)row * DM + col0; float sq = 0.f;
#pragma unroll
                for (int bj = 0; bj < 2; ++bj) { const size_t i = rb + bj * HALF;
                    const f32x4 v0 = acc[ai][bj][m][0] + *(const f32x4*)(x + i), v1 = acc[ai][bj][m][1] + *(const f32x4*)(x + i + 4);
                    sq += (v0[0] * v0[0] + v0[1] * v0[1]) + (v0[2] * v0[2] + v0[3] * v0[3]) + (v1[0] * v1[0] + v1[1] * v1[1]) + (v1[2] * v1[2] + v1[3] * v1[3]);
                    const int col = col0 + bj * HALF, s = (col >> 5) & 15, j = ((col >> 9) << 5) | (col & 31);
                    const size_t o = ((size_t)s * T + row) * 64 + j;
                    *(f32x4*)(x1s + o) = v0; *(f32x4*)(x1s + o + 4) = v1;
                    u32x4 w; w.x = cvt_pk_bf16(v0[0], v0[1]); w.y = cvt_pk_bf16(v0[2], v0[3]); w.z = cvt_pk_bf16(v1[0], v1[1]); w.w = cvt_pk_bf16(v1[2], v1[3]);
                    *(u32x4*)(x1bs + o) = w; }
                sq += __shfl_xor(sq, 16); sq += __shfl_xor(sq, 32);
                if (fq == 0) ssq[(size_t)row * 16 + u.pn * 4 + wc] = sq; }
    }
};
struct EpiQM {
    static constexpr bool PERM = true, AFTER_DRAIN = false;
    bf16_t* Q;
    __device__ __forceinline__ void operator()(const f32x4 (&acc)[2][2][4][2], const Unit& u, int wr, int wc, int fr, int fq) const {
        const int row0 = u.pm * BM + wr * 64 + fr, col0 = u.pn * BM + wc * 32 + 8 * fq;
#pragma unroll
        for (int ai = 0; ai < 2; ++ai)
#pragma unroll
            for (int m = 0; m < 4; ++m) { const int row = row0 + ai * HALF + m * 16; bf16_t* rowp = Q + (size_t)row * 2048 + col0;
#pragma unroll
                for (int bj = 0; bj < 2; ++bj) { const f32x4 v0 = acc[ai][bj][m][0], v1 = acc[ai][bj][m][1];
                    u32x4 w; w.x = cvt_pk_bf16(v0[0], v0[1]); w.y = cvt_pk_bf16(v0[2], v0[3]); w.z = cvt_pk_bf16(v1[0], v1[1]); w.w = cvt_pk_bf16(v1[2], v1[3]);
                    *(u32x4*)(rowp + bj * HALF) = w; } }
    }
};
}

#define LAS __attribute__((address_space(3)))
#define XB_TMO      128
#define XB_XCNT(j)  (256  + 64 * (j))
#define XB_XSUB(j)  (1280 + 64 * (j))
#define XB_XGEN(j)  (2304 + 64 * (j))
#define XB_TOP      3328
#define XB_TOPGEN   3392
#define XCD_BAR_WORDS 3456
#define XB_SPIN_CAP (1u << 18)

__device__ __forceinline__ unsigned xb_ld(unsigned* p)              { return __hip_atomic_load(p, __ATOMIC_RELAXED, __HIP_MEMORY_SCOPE_AGENT); }
__device__ __forceinline__ unsigned xb_add(unsigned* p, unsigned v) { return __hip_atomic_fetch_add(p, v, __ATOMIC_RELAXED, __HIP_MEMORY_SCOPE_AGENT); }
__device__ __forceinline__ unsigned xb_xcc_id() { return (unsigned)__builtin_amdgcn_s_getreg((3 << 11) | 20) & 0xFu; }
#define XB_SPIN(cond, bar) do { unsigned _sp = 0; while (cond) { __builtin_amdgcn_s_sleep(1); \
    if ((++_sp & 255u) == 0u) { if (xb_ld(&(bar)[XB_TMO])) break; if (_sp > XB_SPIN_CAP) { atomicAdd(&(bar)[XB_TMO], 1u); break; } } } } while (0)

struct XcdBarrier {
    unsigned* bar; unsigned x;
    volatile LAS unsigned* st;
};

__device__ __forceinline__ XcdBarrier xcd_barrier_post(unsigned* bar, volatile LAS unsigned* st) {
    XcdBarrier b; b.bar = bar; b.x = xb_xcc_id(); b.st = st;
    if (threadIdx.x == 0) (void)xb_add(&bar[XB_XCNT(b.x)], 1u);
    return b;
}
__device__ __forceinline__ void xcd_barrier_complete(unsigned* bar, unsigned x, unsigned& nloc, unsigned& nx) {
    const unsigned G = gridDim.x * gridDim.y * gridDim.z;
    unsigned sum, cnt, mine, sp = 0u;
    for (;;) {
        sum = 0u; cnt = 0u; mine = 0u;
#pragma unroll
        for (unsigned j = 0; j < 16; ++j) { const unsigned c = xb_ld(&bar[XB_XCNT(j)]); sum += c; cnt += (c > 0u) ? 1u : 0u; mine = (j == x) ? c : mine; }
        if (sum == G) break;
        __builtin_amdgcn_s_sleep(1);
        if ((++sp & 255u) == 0u) { if (xb_ld(&bar[XB_TMO])) break; if (sp > XB_SPIN_CAP) { atomicAdd(&bar[XB_TMO], 1u); break; } }
    }
    nloc = mine > 0u ? mine : 1u; nx = cnt > 0u ? cnt : 1u;
}

__device__ __forceinline__ void xcd_barrier(const XcdBarrier& b) {
    asm volatile("s_waitcnt vmcnt(0)" ::: "memory");
    __syncthreads();
    if (threadIdx.x == 0) {
        unsigned* bar = b.bar;
        __builtin_amdgcn_s_waitcnt(0);
        unsigned nloc = b.st[0], nx = b.st[1];
        if (nloc == 0u) { xcd_barrier_complete(bar, b.x, nloc, nx); b.st[0] = nloc; b.st[1] = nx; }
        const unsigned old = xb_add(&bar[XB_XSUB(b.x)], 1u);
        const unsigned gen = old / nloc;
        if (old + 1u == (gen + 1u) * nloc) {
            __builtin_amdgcn_fence(__ATOMIC_RELEASE, "agent");
            asm volatile("s_waitcnt vmcnt(0)" ::: "memory");
            const unsigned og = xb_add(&bar[XB_TOP], 1u);
            const unsigned tg = og / nx;
            if (og + 1u == (tg + 1u) * nx) xb_add(&bar[XB_TOPGEN], 1u);
            else XB_SPIN(xb_ld(&bar[XB_TOPGEN]) == tg, bar);
            __builtin_amdgcn_fence(__ATOMIC_ACQUIRE, "agent");
            xb_add(&bar[XB_XGEN(b.x)], 1u);
            asm volatile("s_waitcnt vmcnt(0)" ::: "memory");
        } else {
            XB_SPIN(xb_ld(&bar[XB_XGEN(b.x)]) == gen, bar);
            __builtin_amdgcn_fence(__ATOMIC_ACQUIRE, "agent");
            asm volatile("s_waitcnt vmcnt(0)" ::: "memory");
        }
    }
    __syncthreads();
}

template <bool SLICEK = false> __device__ __forceinline__ void transpose_item(const float* W, const float* gain, int K, int N, bf16_t* WT, float* scr, int item, int lane) {
    const int nblk = N / 32, kb = item / nblk, nb = item % nblk, k0 = 64 * kb, n0 = 32 * nb;
    for (int i = 0; i < 32; ++i) { const int kk = 2 * i + (lane >> 5); const int ks = SLICEK ? ((kk >> 5) * 512 + 32 * kb + (kk & 31)) : (k0 + kk); float g = gain ? gain[ks] : 1.f; scr[kk * 33 + (lane & 31)] = W[(size_t)ks * N + n0 + (lane & 31)] * g; }
    __builtin_amdgcn_s_waitcnt(0); __builtin_amdgcn_wave_barrier();
    const int c = lane & 7;
#pragma unroll
    for (int j = 0; j < 4; ++j) { const int n = (lane >> 3) + 8 * j; const float* s = scr + (8 * c) * 33 + n;
        uint4 o; o.x = pk2(s[0 * 33], s[1 * 33]); o.y = pk2(s[2 * 33], s[3 * 33]); o.z = pk2(s[4 * 33], s[5 * 33]); o.w = pk2(s[6 * 33], s[7 * 33]);
        *(uint4*)(WT + (size_t)(n0 + n) * K + k0 + 8 * c) = o; }
    __builtin_amdgcn_s_waitcnt(0); __builtin_amdgcn_wave_barrier();
}
__device__ __forceinline__ void norm_row_to_bf16(const float* xrow, bf16_t* orow, int lane) {
    const float4* xr = (const float4*)xrow + lane;
    float4 v[4]; float s = 0.f;
#pragma unroll
    for (int j = 0; j < 4; ++j) { v[j] = xr[64 * j]; s += (v[j].x * v[j].x + v[j].y * v[j].y) + (v[j].z * v[j].z + v[j].w * v[j].w); }
    const float rstd = rsqrtf(wave_sum(s) * (1.f / DM) + EPS);
    unsigned long long* o8 = (unsigned long long*)orow + lane;
#pragma unroll
    for (int j = 0; j < 4; ++j) o8[64 * j] = (unsigned long long)pk2(v[j].x * rstd, v[j].y * rstd) | ((unsigned long long)pk2(v[j].z * rstd, v[j].w * rstd) << 32);
}
__device__ __forceinline__ void phase_prep(const Params& p, unsigned char* lds) {
    const int tid = threadIdx.x, lane = tid & 63, wave = tid >> 6;
    const int gw = blockIdx.x * 8 + wave, NGW = gridDim.x * 8;
    const int gt = blockIdx.x * NTHR + tid, NGT = gridDim.x * NTHR;
    unsigned char* ws = p.ws;
    float* scr = (float*)lds + wave * (64 * 33);
    constexpr int I_IN = (DM / 64) * (INW / 32), I_OUT = (DM / 64) * (DM / 32), I_Q = (DM / 64) * (2048 / 32), I_MKV = (DM / 64) * (512 / 32);
    for (int it = gw; it < I_IN + I_OUT + I_Q + I_MKV; it += NGW) {
        int r = it;
        if (r < I_IN) { transpose_item(p.w_in, p.g_mix, DM, INW, (bf16_t*)(ws + WS_WIN_T), scr, r, lane); continue; } r -= I_IN;
        if (r < I_OUT) { transpose_item(p.w_out, nullptr, DM, DM, (bf16_t*)(ws + WS_WOUT_T), scr, r, lane); continue; } r -= I_OUT;
        if (r < I_Q) { transpose_item<true>(p.w_q, p.g_ffn, DM, 2048, (bf16_t*)(ws + WS_WQ_T), scr, r, lane); continue; } r -= I_Q;
        transpose_item(p.w_mkv, p.mem_gain, DM, 512, (bf16_t*)(ws + WS_WMKV_T), scr, r, lane);
    }
    for (int m = gw; m < T; m += NGW) norm_row_to_bf16(p.x + (size_t)m * DM, (bf16_t*)(ws + WS_XB) + (size_t)m * DM, lane);
    for (int m = gw; m < NB * NMEM; m += NGW) norm_row_to_bf16(p.mem + (size_t)m * DM, (bf16_t*)(ws + WS_MEMN) + (size_t)m * DM, lane);
    for (int i = gt; i < 8 * 2 * 128 * 128; i += NGT) ((bf16_t*)(ws + WS_SKB))[i] = f2bf(p.sub_keys[i]);
    for (int i = gt; i < NEXP * DM / 8; i += NGT) {
        const int d0 = (i & 127) * 8, e = i >> 7, s = (d0 >> 5) & 15, j0 = ((d0 >> 9) << 5) | (d0 & 31), S = s >> 1, jj0 = (s & 1) * 64 + j0;
        const float4 a = ((const float4*)p.pu)[2 * i], b = ((const float4*)p.pu)[2 * i + 1];
        const float4 ga = *(const float4*)(p.g_ffn + d0), gb = *(const float4*)(p.g_ffn + d0 + 4);
        int u0 = 0, u1 = 0;
        u0 = __builtin_amdgcn_cvt_pk_fp8_f32(a.x * ga.x * PEER_US, a.y * ga.y * PEER_US, u0, false); u0 = __builtin_amdgcn_cvt_pk_fp8_f32(a.z * ga.z * PEER_US, a.w * ga.w * PEER_US, u0, true);
        u1 = __builtin_amdgcn_cvt_pk_fp8_f32(b.x * gb.x * PEER_US, b.y * gb.y * PEER_US, u1, false); u1 = __builtin_amdgcn_cvt_pk_fp8_f32(b.z * gb.z * PEER_US, b.w * gb.w * PEER_US, u1, true);
        *(uint2*)(ws + WS_U16 + ((size_t)S * NEXP + e) * 128 + jj0) = make_uint2((unsigned)u0, (unsigned)u1);
        const float4 c = ((const float4*)p.pv)[2 * i], d = ((const float4*)p.pv)[2 * i + 1];
        int v0 = 0, v1 = 0;
        v0 = __builtin_amdgcn_cvt_pk_fp8_f32(c.x * PEER_VS, c.y * PEER_VS, v0, false); v0 = __builtin_amdgcn_cvt_pk_fp8_f32(c.z * PEER_VS, c.w * PEER_VS, v0, true);
        v1 = __builtin_amdgcn_cvt_pk_fp8_f32(d.x * PEER_VS, d.y * PEER_VS, v1, false); v1 = __builtin_amdgcn_cvt_pk_fp8_f32(d.z * PEER_VS, d.w * PEER_VS, v1, true);
        *(uint2*)(ws + WS_V16 + ((size_t)S * NEXP + e) * 128 + jj0) = make_uint2((unsigned)v0, (unsigned)v1);
    }
    for (int i = gt; i < 512; i += NGT) ((float*)(ws + WS_LB))[i] = 1.f / (1.f + expf(p.gamma_lb[512 + i] - p.gamma_lb[i]));
}

template <class Epi>
__device__ __forceinline__ void gemm_naive(const bf16_t* A, const bf16_t* Bt, int M, int N, int K, unsigned char* ldsb, const Epi& epi) {
    float* As = (float*)ldsb;
    float* Bs = As + 32 * 132;
    const int tid = threadIdx.x, ty = tid >> 4, tx = tid & 15;
    const int ntm = M / 128, ntn = N / 64;
    for (int tile = blockIdx.x; tile < ntm * ntn; tile += gridDim.x) {
        const int tm = tile / ntn, tn = tile % ntn;
        float acc[4][4];
#pragma unroll
        for (int i = 0; i < 4; ++i)
#pragma unroll
            for (int j = 0; j < 4; ++j) acc[i][j] = 0.f;
        for (int k0 = 0; k0 < K; k0 += 32) {
            { const int r = tid >> 2, kq = (tid & 3) * 8;
              const uint4 v = *(const uint4*)(A + (size_t)(tm * 128 + r) * K + k0 + kq);
              As[(kq + 0) * 132 + r] = bflo(v.x); As[(kq + 1) * 132 + r] = bfhi(v.x); As[(kq + 2) * 132 + r] = bflo(v.y); As[(kq + 3) * 132 + r] = bfhi(v.y);
              As[(kq + 4) * 132 + r] = bflo(v.z); As[(kq + 5) * 132 + r] = bfhi(v.z); As[(kq + 6) * 132 + r] = bflo(v.w); As[(kq + 7) * 132 + r] = bfhi(v.w); }
            if (tid < 256) { const int r = tid >> 2, kq = (tid & 3) * 8;
              const uint4 v = *(const uint4*)(Bt + (size_t)(tn * 64 + r) * K + k0 + kq);
              Bs[(kq + 0) * 68 + r] = bflo(v.x); Bs[(kq + 1) * 68 + r] = bfhi(v.x); Bs[(kq + 2) * 68 + r] = bflo(v.y); Bs[(kq + 3) * 68 + r] = bfhi(v.y);
              Bs[(kq + 4) * 68 + r] = bflo(v.z); Bs[(kq + 5) * 68 + r] = bfhi(v.z); Bs[(kq + 6) * 68 + r] = bflo(v.w); Bs[(kq + 7) * 68 + r] = bfhi(v.w); }
            __syncthreads();
#pragma unroll 8
            for (int k = 0; k < 32; ++k) {
                const float4 a = *(const float4*)(As + k * 132 + ty * 4); const float4 b = *(const float4*)(Bs + k * 68 + tx * 4);
                const float av[4] = {a.x, a.y, a.z, a.w}, bv[4] = {b.x, b.y, b.z, b.w};
#pragma unroll
                for (int i = 0; i < 4; ++i)
#pragma unroll
                    for (int j = 0; j < 4; ++j) acc[i][j] = fmaf(av[i], bv[j], acc[i][j]);
            }
            __syncthreads();
        }
#pragma unroll
        for (int i = 0; i < 4; ++i)
#pragma unroll
            for (int j = 0; j < 4; ++j) epi(tm * 128 + ty * 4 + i, tn * 64 + tx * 4 + j, acc[i][j]);
    }
}

struct EpiProj {
    bf16_t* P;
    __device__ __forceinline__ void operator()(int row, int col, float v) const {
        if (col < C_SBK) v *= C2;
        else if (col >= C_HGQ && col < C_HGF) v = silu(v);
        else if (col >= C_HGG && col < C_MQ) v = silu(v);
        P[(size_t)row * INW + col] = f2bf(v);
    }
};
struct EpiF32 { float* O; int ld; __device__ __forceinline__ void operator()(int row, int col, float v) const { O[(size_t)row * ld + col] = v; } };
struct EpiWout { const float* x; float* out; bf16_t* xb;
    __device__ __forceinline__ void operator()(int row, int col, float v) const { const size_t i = (size_t)row * DM + col; const float r = x[i] + v; out[i] = r; xb[i] = f2bf(r); } };
struct EpiQ { const float* rstd; bf16_t* Q;
    __device__ __forceinline__ void operator()(int row, int col, float v) const { Q[(size_t)row * 2048 + col] = f2bf(v * rstd[row]); } };

#ifndef SB_EARLY
#define SB_EARLY 1
#endif
__device__ __forceinline__ void sb_naive(const Params& p) {
    const bf16_t* P = (const bf16_t*)(p.ws + WS_P);
    bf16_t* mixed = (bf16_t*)(p.ws + WS_MIXED);
    for (int row = blockIdx.x * NTHR + threadIdx.x; row < NB * 8 * SEQ; row += gridDim.x * NTHR) {
        const int t = row % SEQ, bh = row / SEQ, h = bh % 8, b = bh / 8;
        const size_t tok = (size_t)b * SEQ + t;
        float q[64], o[64];
        { const uint4* qp = (const uint4*)(P + tok * INW + C_SBQ + h * 64);
#pragma unroll
          for (int j = 0; j < 8; ++j) { const uint4 v = qp[j]; q[8 * j] = bflo(v.x); q[8 * j + 1] = bfhi(v.x); q[8 * j + 2] = bflo(v.y); q[8 * j + 3] = bfhi(v.y); q[8 * j + 4] = bflo(v.z); q[8 * j + 5] = bfhi(v.z); q[8 * j + 6] = bflo(v.w); q[8 * j + 7] = bfhi(v.w); } }
#pragma unroll
        for (int d = 0; d < 64; ++d) o[d] = 0.f;
        float R = 0.f;
        for (int s = t - 1; s >= 0; --s) {
            const uint4* kp = (const uint4*)(P + ((size_t)b * SEQ + s) * INW + C_SBK + h * 64);
            const uint4* vp = (const uint4*)(P + ((size_t)b * SEQ + s) * INW + C_SBV + h * 64);
            float z = 0.f;
#pragma unroll
            for (int j = 0; j < 8; ++j) { const uint4 v = kp[j];
                z = fmaf(q[8 * j], bflo(v.x), z); z = fmaf(q[8 * j + 1], bfhi(v.x), z); z = fmaf(q[8 * j + 2], bflo(v.y), z); z = fmaf(q[8 * j + 3], bfhi(v.y), z);
                z = fmaf(q[8 * j + 4], bflo(v.z), z); z = fmaf(q[8 * j + 5], bfhi(v.z), z); z = fmaf(q[8 * j + 6], bflo(v.w), z); z = fmaf(q[8 * j + 7], bfhi(v.w), z); }
            const float sp = fmaxf(z, 0.f) + log2f(1.f + exp2f(-fabsf(z)));
            const float a = exp2f(z - sp + R);
            R -= sp;
#pragma unroll
            for (int j = 0; j < 8; ++j) { const uint4 v = vp[j];
                o[8 * j] = fmaf(a, bflo(v.x), o[8 * j]); o[8 * j + 1] = fmaf(a, bfhi(v.x), o[8 * j + 1]); o[8 * j + 2] = fmaf(a, bflo(v.y), o[8 * j + 2]); o[8 * j + 3] = fmaf(a, bfhi(v.y), o[8 * j + 3]);
                o[8 * j + 4] = fmaf(a, bflo(v.z), o[8 * j + 4]); o[8 * j + 5] = fmaf(a, bfhi(v.z), o[8 * j + 5]); o[8 * j + 6] = fmaf(a, bflo(v.w), o[8 * j + 6]); o[8 * j + 7] = fmaf(a, bfhi(v.w), o[8 * j + 7]); }
#if SB_EARLY
            if (R < -150.f) break;
#endif
        }
        float ss = 0.f;
#pragma unroll
        for (int d = 0; d < 64; ++d) ss = fmaf(o[d], o[d], ss);
        const float r = rsqrtf(ss * (1.f / 64.f) + EPS);
        uint4* op = (uint4*)(mixed + tok * DM + h * 64);
        const float* g = p.sb_gain + h * 64;
#pragma unroll
        for (int j = 0; j < 8; ++j) { uint4 w; w.x = pk2(o[8 * j] * r * g[8 * j], o[8 * j + 1] * r * g[8 * j + 1]); w.y = pk2(o[8 * j + 2] * r * g[8 * j + 2], o[8 * j + 3] * r * g[8 * j + 3]);
            w.z = pk2(o[8 * j + 4] * r * g[8 * j + 4], o[8 * j + 5] * r * g[8 * j + 5]); w.w = pk2(o[8 * j + 6] * r * g[8 * j + 6], o[8 * j + 7] * r * g[8 * j + 7]); op[j] = w; }
    }
}

__device__ __forceinline__ void hg_naive(const Params& p, unsigned char* ldsb) {
    const bf16_t* P = (const bf16_t*)(p.ws + WS_P);
    float* raw = (float*)(p.ws + WS_HGRAW);
    const float* lbp = (const float*)(p.ws + WS_LB);
    float* red = (float*)ldsb;
    const int tid = threadIdx.x, jj = tid >> 7, k = tid & 127, wave = tid >> 6, lane = tid & 63;
    for (int unit = blockIdx.x; unit < NB * 4 * 16; unit += gridDim.x) {
        const int jg = unit & 15, h = (unit >> 4) & 3, b = unit >> 6;
        const float lb = lbp[h * 128 + k];
        float S = 0.f;
        for (int t0 = 0; t0 < SEQ; t0 += 64) {
            for (int tt = 0; tt < 64; tt += 8) {
                float fl[8], qv[8], iv[8];
#pragma unroll
                for (int u = 0; u < 8; ++u) { const bf16_t* pr = P + ((size_t)b * SEQ + t0 + tt + u) * INW;
                    fl[u] = bf2f(pr[C_HGF + h * 128 + k]); qv[u] = bf2f(pr[C_HGQ + h * 128 + k]); iv[u] = bf2f(pr[C_HGI + h * 64 + jg * 4 + jj]); }
#pragma unroll
                for (int u = 0; u < 8; ++u) {
                    const float f = lb + (1.f - lb) / (1.f + __expf(-fl[u]));
                    S = f * S + (1.f - f) * iv[u];
                    const float part = wave_sum(S * qv[u]);
                    if (lane == 0) red[(tt + u) * 8 + wave] = part;
                }
            }
            __syncthreads();
            if (tid < 256) { const int tt = tid >> 2, j2 = tid & 3;
                raw[((size_t)b * SEQ + t0 + tt) * 256 + h * 64 + jg * 4 + j2] = red[tt * 8 + 2 * j2] + red[tt * 8 + 2 * j2 + 1]; }
            __syncthreads();
        }
    }
}
__device__ __forceinline__ void hg_finish(const Params& p) {
    const bf16_t* P = (const bf16_t*)(p.ws + WS_P);
    const float* raw = (const float*)(p.ws + WS_HGRAW);
    bf16_t* mixed = (bf16_t*)(p.ws + WS_MIXED);
    const int lane = threadIdx.x & 63, wave = threadIdx.x >> 6;
    for (int it = blockIdx.x * 8 + wave; it < T * 4; it += gridDim.x * 8) {
        const int tok = it >> 2, h = it & 3;
        const float o = raw[(size_t)tok * 256 + h * 64 + lane];
        const float r = rsqrtf(wave_sum(o * o) * (1.f / 64.f) + EPS);
        const float g = bf2f(P[(size_t)tok * INW + C_HGG + h * 64 + lane]);
        mixed[(size_t)tok * DM + 512 + h * 64 + lane] = f2bf(o * r * p.hg_gain[h * 64 + lane] * g);
    }
}


typedef float f32x16 __attribute__((ext_vector_type(16)));
typedef short sh8_t __attribute__((ext_vector_type(8)));
typedef unsigned u4_t __attribute__((ext_vector_type(4)));
typedef float f32x4_t __attribute__((ext_vector_type(4)));
typedef float float2_t __attribute__((ext_vector_type(2)));
__device__ __forceinline__ unsigned cvtpk(float lo, float hi) { unsigned r; asm("v_cvt_pk_bf16_f32 %0, %1, %2" : "=v"(r) : "v"(lo), "v"(hi)); return r; }
__device__ __forceinline__ bf16_t cvt1(float x) { return (bf16_t)(cvtpk(x, x) & 0xffffu); }
__device__ __forceinline__ void mma32(f32x16& acc, const LAS bf16_t* A, int lda, const LAS bf16_t* Bt, int ldb, int K, int lane) {
    const int r = lane & 31, h = lane >> 5;
    const LAS bf16_t* ap = A + r * lda + 8 * h; const LAS bf16_t* bp = Bt + r * ldb + 8 * h;
    for (int k0 = 0; k0 < K; k0 += 16) {
        const sh8_t a = *(const LAS sh8_t*)(ap + k0), b = *(const LAS sh8_t*)(bp + k0);
        acc = __builtin_amdgcn_mfma_f32_32x32x16_bf16(a, b, acc, 0, 0, 0);
    }
}
__device__ __forceinline__ int crow(int r, int hh) { return (r & 3) + 8 * (r >> 2) + 4 * hh; }
constexpr size_t HG_LT = WS_XB;
constexpr size_t HG_SB = 408 * MiB;
constexpr size_t HG_DD = 456 * MiB;
__device__ __forceinline__ void hg_cols(const bf16_t* P, const float* lbp, int b_, int h, int c, LAS float* gs, int tid, float (&kk)[16], float (&bc)[16], float& bmid, float& blast) {
    const int rg = tid >> 7, k = tid & 127;
    const float lb = lbp[h * 128 + k];
    const bf16_t* pr = P + ((size_t)b_ * SEQ + c * 64 + rg * 16) * INW + C_HGF + h * 128 + k;
    float run = 0.f;
#pragma unroll
    for (int i = 0; i < 16; ++i) { const float fl = bf2f(pr[(size_t)i * INW]); const float kv = (1.f - lb) / (1.f + __expf(fl)); kk[i] = kv; run += __logf(1.f - kv); bc[i] = run; }
    gs[rg * 128 + k] = run;
    __syncthreads();
    const float g0 = gs[k], g1 = gs[128 + k], g2 = gs[256 + k], g3 = gs[384 + k];
    const float off = (rg > 0 ? g0 : 0.f) + (rg > 1 ? g1 : 0.f) + (rg > 2 ? g2 : 0.f);
#pragma unroll
    for (int i = 0; i < 16; ++i) bc[i] += off;
    bmid = g0 + g1; blast = (g0 + g1) + (g2 + g3);
}
__device__ __forceinline__ void hg_load_vt(const bf16_t* P, int b_, int h, int c, LAS bf16_t* VT, int tid) {
    const int s = tid >> 3, jq = tid & 7;
    const uint4 v = *(const uint4*)(P + ((size_t)b_ * SEQ + c * 64 + s) * INW + C_HGI + h * 64 + jq * 8);
    LAS bf16_t* d = VT + (jq * 8) * 72 + s;
    d[0 * 72] = (bf16_t)(v.x & 0xffff); d[1 * 72] = (bf16_t)(v.x >> 16); d[2 * 72] = (bf16_t)(v.y & 0xffff); d[3 * 72] = (bf16_t)(v.y >> 16);
    d[4 * 72] = (bf16_t)(v.z & 0xffff); d[5 * 72] = (bf16_t)(v.z >> 16); d[6 * 72] = (bf16_t)(v.w & 0xffff); d[7 * 72] = (bf16_t)(v.w >> 16);
}
__device__ __forceinline__ void hg_local(const Params& p, unsigned char* ldsb) {
    const bf16_t* P = (const bf16_t*)(p.ws + WS_P); const float* lbp = (const float*)(p.ws + WS_LB);
    float* LT = (float*)((unsigned char*)p.ws + HG_LT); float* DD = (float*)((unsigned char*)p.ws + HG_DD);
    LAS unsigned char* l = (LAS unsigned char*)ldsb;
    LAS float* gs = (LAS float*)l; LAS bf16_t* KST = (LAS bf16_t*)(l + 2048); LAS bf16_t* VT = (LAS bf16_t*)(l + 20480);
    const int tid = threadIdx.x, lane = tid & 63, wave = tid >> 6, rg = tid >> 7, k = tid & 127;
    for (int unit = blockIdx.x; unit < 2048; unit += gridDim.x) {
        const int bh = unit >> 7, c = unit & 127, b_ = bh >> 2, h = bh & 3;
        float kk[16], bc[16], bmid, blast;
        hg_cols(P, lbp, b_, h, c, gs, tid, kk, bc, bmid, blast);
        { unsigned w[8];
#pragma unroll
          for (int i = 0; i < 8; ++i) w[i] = cvtpk(kk[2 * i] * __expf(blast - bc[2 * i]), kk[2 * i + 1] * __expf(blast - bc[2 * i + 1]));
          LAS u4_t* d = (LAS u4_t*)(KST + k * 72 + rg * 16);
          d[0] = (u4_t){w[0], w[1], w[2], w[3]}; d[1] = (u4_t){w[4], w[5], w[6], w[7]}; }
        hg_load_vt(P, b_, h, c, VT, tid);
        if (tid < 128) DD[(size_t)unit * 128 + tid] = __expf(blast);
        __syncthreads();
        { const int ji = wave >> 2, ki = wave & 3;
          f32x16 acc;
#pragma unroll
          for (int r = 0; r < 16; ++r) acc[r] = 0.f;
          mma32(acc, VT + 32 * ji * 72, 72, KST + 32 * ki * 72, 72, 64, lane);
          float* o = LT + (size_t)unit * 8192 + 32 * ki + (lane & 31);
#pragma unroll
          for (int r = 0; r < 16; ++r) o[(size_t)(32 * ji + crow(r, lane >> 5)) * 128] = acc[r]; }
        __syncthreads();
    }
}
__device__ __forceinline__ void hg_scan(const Params& p) {
    const float* LT = (const float*)((unsigned char*)p.ws + HG_LT); const float* DD = (const float*)((unsigned char*)p.ws + HG_DD);
    bf16_t* SB = (bf16_t*)((unsigned char*)p.ws + HG_SB);
    for (int gt = blockIdx.x * NTHR + threadIdx.x; gt < 16 * 8192; gt += gridDim.x * NTHR) {
        const int bh = gt >> 13, e = gt & 8191, k = e & 127;
        float S = 0.f;
#pragma unroll 8
        for (int c = 0; c < 128; ++c) { const size_t u = (size_t)bh * 128 + c;
            const float L = LT[u * 8192 + e], D = DD[u * 128 + k];
            SB[u * 8192 + e] = cvt1(S); S = fmaf(D, S, L); }
    }
}
__device__ __forceinline__ void hg_out(const Params& p, unsigned char* ldsb) {
    const bf16_t* P = (const bf16_t*)(p.ws + WS_P); const float* lbp = (const float*)(p.ws + WS_LB);
    const bf16_t* SB = (const bf16_t*)((unsigned char*)p.ws + HG_SB);
    bf16_t* mixed = (bf16_t*)(p.ws + WS_MIXED);
    LAS unsigned char* l = (LAS unsigned char*)ldsb;
    LAS float* gs = (LAS float*)l;
    LAS bf16_t* QT = (LAS bf16_t*)(l + 2048); LAS bf16_t* KT = (LAS bf16_t*)(l + 19456); LAS bf16_t* QI = (LAS bf16_t*)(l + 36864);
    LAS bf16_t* VT = (LAS bf16_t*)(l + 54272); LAS bf16_t* SC = (LAS bf16_t*)(l + 63488); LAS bf16_t* ST = (LAS bf16_t*)(l + 72704);
    LAS float* OB = (LAS float*)(l + 90112);
    const int tid = threadIdx.x, lane = tid & 63, wave = tid >> 6, rg = tid >> 7, k = tid & 127;
    for (int unit = blockIdx.x; unit < 2048; unit += gridDim.x) {
        const int bh = unit >> 7, c = unit & 127, b_ = bh >> 2, h = bh & 3;
        const size_t tok0 = (size_t)b_ * SEQ + c * 64;
        float kk[16], bc[16], bmid, blast;
        hg_cols(P, lbp, b_, h, c, gs, tid, kk, bc, bmid, blast);
        { const bf16_t* qp = P + (tok0 + rg * 16) * INW + C_HGQ + h * 128 + k;
#pragma unroll
          for (int i = 0; i < 16; ++i) { const float q = bf2f(qp[(size_t)i * INW]); const int o = (rg * 16 + i) * 136 + k;
              QT[o] = cvt1(q * __expf(fminf(bc[i] - bmid, 40.f))); KT[o] = cvt1(kk[i] * __expf(fminf(bmid - bc[i], 40.f))); QI[o] = cvt1(q * __expf(bc[i])); } }
        hg_load_vt(P, b_, h, c, VT, tid);
#pragma unroll
        for (int i = 0; i < 2; ++i) { const int idx = tid * 8 + i * 4096, j = idx >> 7, kq = idx & 127;
            *(LAS u4_t*)(ST + j * 136 + kq) = *(const u4_t*)(SB + (size_t)unit * 8192 + idx); }
        __syncthreads();
        if (wave < 4) { const int ti = wave >> 1, si = wave & 1;
            f32x16 acc;
#pragma unroll
            for (int r = 0; r < 16; ++r) acc[r] = 0.f;
            if (si <= ti) mma32(acc, QT + 32 * ti * 136, 136, KT + 32 * si * 136, 136, 128, lane);
            const int s = 32 * si + (lane & 31);
#pragma unroll
            for (int r = 0; r < 16; ++r) { const int t = 32 * ti + crow(r, lane >> 5); SC[t * 72 + s] = cvt1((s <= t) ? acc[r] : 0.f); } }
        __syncthreads();
        if (wave < 4) { const int ti = wave >> 1, ji = wave & 1;
            f32x16 acc;
#pragma unroll
            for (int r = 0; r < 16; ++r) acc[r] = 0.f;
            mma32(acc, SC + 32 * ti * 72, 72, VT + 32 * ji * 72, 72, 64, lane);
            mma32(acc, QI + 32 * ti * 136, 136, ST + 32 * ji * 136, 136, 128, lane);
            const int j = 32 * ji + (lane & 31);
#pragma unroll
            for (int r = 0; r < 16; ++r) OB[(32 * ti + crow(r, lane >> 5)) * 65 + j] = acc[r]; }
        __syncthreads();
        { const int t = tid >> 3, jq = tid & 7;
          float o[8]; float ss = 0.f;
#pragma unroll
          for (int e = 0; e < 8; ++e) { o[e] = OB[t * 65 + jq * 8 + e]; ss = fmaf(o[e], o[e], ss); }
          ss += __shfl_xor(ss, 1); ss += __shfl_xor(ss, 2); ss += __shfl_xor(ss, 4);
          const float r = rsqrtf(ss * (1.f / 64.f) + EPS);
          const uint4 gv = *(const uint4*)(P + (tok0 + t) * INW + C_HGG + h * 64 + jq * 8);
          const float* gn = p.hg_gain + h * 64 + jq * 8;
          uint4 w; w.x = cvtpk(o[0] * r * gn[0] * bflo(gv.x), o[1] * r * gn[1] * bfhi(gv.x)); w.y = cvtpk(o[2] * r * gn[2] * bflo(gv.y), o[3] * r * gn[3] * bfhi(gv.y));
          w.z = cvtpk(o[4] * r * gn[4] * bflo(gv.z), o[5] * r * gn[5] * bfhi(gv.z)); w.w = cvtpk(o[6] * r * gn[6] * bflo(gv.w), o[7] * r * gn[7] * bfhi(gv.w));
          *(uint4*)(mixed + (tok0 + t) * DM + 512 + h * 64 + jq * 8) = w; }
        __syncthreads();
    }
}

__device__ __forceinline__ void mem_knorm(const Params& p) {
    const float* kv = (const float*)(p.ws + WS_MEMKV);
    bf16_t* mk = (bf16_t*)(p.ws + WS_MEMK); bf16_t* mv = (bf16_t*)(p.ws + WS_MEMV);
    const int lane = threadIdx.x & 63, wave = threadIdx.x >> 6;
    for (int it = blockIdx.x * 8 + wave; it < NB * NMEM * 4; it += gridDim.x * 8) {
        const int m = it >> 2, h = it & 3;
        const float kx = kv[(size_t)m * 512 + h * 64 + lane], vx = kv[(size_t)m * 512 + 256 + h * 64 + lane];
        const float r = rsqrtf(wave_sum(kx * kx) * (1.f / 64.f) + EPS);
        mk[(size_t)m * 256 + h * 64 + lane] = f2bf(kx * r * p.mk_gain[lane]);
        mv[(size_t)m * 256 + h * 64 + lane] = f2bf(vx);
    }
}
__device__ __forceinline__ void mem_attn_naive(const Params& p) {
    const bf16_t* P = (const bf16_t*)(p.ws + WS_P);
    const bf16_t* mk = (const bf16_t*)(p.ws + WS_MEMK); const bf16_t* mv = (const bf16_t*)(p.ws + WS_MEMV);
    bf16_t* mixed = (bf16_t*)(p.ws + WS_MIXED);
    for (int idx = blockIdx.x * NTHR + threadIdx.x; idx < 4 * T; idx += gridDim.x * NTHR) {
        const int h = idx / T, tok = idx % T, b = tok / SEQ;
        float q[64], o[64];
        { const uint4* qp = (const uint4*)(P + (size_t)tok * INW + C_MQ + h * 64);
#pragma unroll
          for (int j = 0; j < 8; ++j) { const uint4 v = qp[j]; q[8 * j] = bflo(v.x); q[8 * j + 1] = bfhi(v.x); q[8 * j + 2] = bflo(v.y); q[8 * j + 3] = bfhi(v.y); q[8 * j + 4] = bflo(v.z); q[8 * j + 5] = bfhi(v.z); q[8 * j + 6] = bflo(v.w); q[8 * j + 7] = bfhi(v.w); } }
        float ss = 0.f;
#pragma unroll
        for (int d = 0; d < 64; ++d) ss = fmaf(q[d], q[d], ss);
        const float r = rsqrtf(ss * (1.f / 64.f) + EPS) * 0.125f;
#pragma unroll
        for (int d = 0; d < 64; ++d) { q[d] *= r * p.mq_gain[d]; o[d] = 0.f; }
        float mx = -1e30f, l = 0.f;
        for (int m = 0; m < NMEM; ++m) {
            const uint4* kp = (const uint4*)(mk + ((size_t)b * NMEM + m) * 256 + h * 64);
            const uint4* vp = (const uint4*)(mv + ((size_t)b * NMEM + m) * 256 + h * 64);
            float z = 0.f;
#pragma unroll
            for (int j = 0; j < 8; ++j) { const uint4 v = kp[j];
                z = fmaf(q[8 * j], bflo(v.x), z); z = fmaf(q[8 * j + 1], bfhi(v.x), z); z = fmaf(q[8 * j + 2], bflo(v.y), z); z = fmaf(q[8 * j + 3], bfhi(v.y), z);
                z = fmaf(q[8 * j + 4], bflo(v.z), z); z = fmaf(q[8 * j + 5], bfhi(v.z), z); z = fmaf(q[8 * j + 6], bflo(v.w), z); z = fmaf(q[8 * j + 7], bfhi(v.w), z); }
            const float mn = fmaxf(mx, z), corr = __expf(mx - mn), pe = __expf(z - mn);
            mx = mn; l = l * corr + pe;
#pragma unroll
            for (int j = 0; j < 8; ++j) { const uint4 v = vp[j];
                o[8 * j] = fmaf(pe, bflo(v.x), o[8 * j] * corr); o[8 * j + 1] = fmaf(pe, bfhi(v.x), o[8 * j + 1] * corr); o[8 * j + 2] = fmaf(pe, bflo(v.y), o[8 * j + 2] * corr); o[8 * j + 3] = fmaf(pe, bfhi(v.y), o[8 * j + 3] * corr);
                o[8 * j + 4] = fmaf(pe, bflo(v.z), o[8 * j + 4] * corr); o[8 * j + 5] = fmaf(pe, bfhi(v.z), o[8 * j + 5] * corr); o[8 * j + 6] = fmaf(pe, bflo(v.w), o[8 * j + 6] * corr); o[8 * j + 7] = fmaf(pe, bfhi(v.w), o[8 * j + 7] * corr); }
        }
        const float il = 1.f / l;
        uint4* op = (uint4*)(mixed + (size_t)tok * DM + 768 + h * 64);
#pragma unroll
        for (int j = 0; j < 8; ++j) { uint4 w; w.x = pk2(o[8 * j] * il, o[8 * j + 1] * il); w.y = pk2(o[8 * j + 2] * il, o[8 * j + 3] * il); w.z = pk2(o[8 * j + 4] * il, o[8 * j + 5] * il); w.w = pk2(o[8 * j + 6] * il, o[8 * j + 7] * il); op[j] = w; }
    }
}


__device__ __forceinline__ sh8_t frag8(const float (&x)[8]) { const u4_t w = {cvtpk(x[0], x[1]), cvtpk(x[2], x[3]), cvtpk(x[4], x[5]), cvtpk(x[6], x[7])}; return __builtin_bit_cast(sh8_t, w); }
__device__ __forceinline__ int kperm(int key) { return (key & 16) | ((key & 4) << 1) | ((key & 8) >> 1) | (key & 3); }
__device__ __forceinline__ void vt_store(LAS bf16_t* VT, int pitch, int d0, int pos, const u4_t v) {
    LAS bf16_t* d = VT + d0 * pitch + pos;
    d[0 * pitch] = (bf16_t)(v.x & 0xffff); d[1 * pitch] = (bf16_t)(v.x >> 16); d[2 * pitch] = (bf16_t)(v.y & 0xffff); d[3 * pitch] = (bf16_t)(v.y >> 16);
    d[4 * pitch] = (bf16_t)(v.z & 0xffff); d[5 * pitch] = (bf16_t)(v.z >> 16); d[6 * pitch] = (bf16_t)(v.w & 0xffff); d[7 * pitch] = (bf16_t)(v.w >> 16);
}
__device__ __forceinline__ void sb_mfma(const Params& p, unsigned char* ldsb) {
    const bf16_t* P = (const bf16_t*)(p.ws + WS_P);
    bf16_t* mixed = (bf16_t*)(p.ws + WS_MIXED);
    const int tid = threadIdx.x, lane = tid & 63, wave = tid >> 6, r = lane & 31, hh = lane >> 5;
    LAS bf16_t* KL = (LAS bf16_t*)ldsb + wave * (32 * 72 + 64 * 40);
    LAS bf16_t* VT = KL + 32 * 72;
    sh8_t mf[2];
#pragma unroll
    for (int ks = 0; ks < 2; ++ks)
#pragma unroll
        for (int e = 0; e < 8; ++e) { const int j = 16 * ks + 8 * (e >> 2) + 4 * hh + (e & 3); mf[ks][e] = (j > r) ? (short)0x3F80 : (short)0; }
    for (int u = blockIdx.x * 8 + wave; u < 32 * 256; u += gridDim.x * 8) {
        const int bh = u >> 8, qt = u & 255, b = bh >> 3, h = bh & 7;
        const size_t tok0 = (size_t)b * SEQ + qt * 32;
        sh8_t qf[4];
        { const bf16_t* qp = P + (tok0 + r) * INW + C_SBQ + h * 64 + 8 * hh;
#pragma unroll
          for (int ks = 0; ks < 4; ++ks) qf[ks] = *(const sh8_t*)(qp + 16 * ks); }
        f32x16 o0, o1;
#pragma unroll
        for (int i = 0; i < 16; ++i) { o0[i] = 0.f; o1[i] = 0.f; }
        float R = 0.f;
        u4_t kraw[4], vraw[4];
        { const bf16_t* kvp = P + ((size_t)b * SEQ + qt * 32 + (lane >> 3)) * INW + h * 64 + (lane & 7) * 8;
#pragma unroll
          for (int i = 0; i < 4; ++i) { kraw[i] = *(const u4_t*)(kvp + (size_t)(8 * i) * INW + C_SBK); vraw[i] = *(const u4_t*)(kvp + (size_t)(8 * i) * INW + C_SBV); } }
        for (int kt = qt; kt >= 0; --kt) {
#pragma unroll
            for (int i = 0; i < 4; ++i) { const int key = (lane >> 3) + 8 * i, dq = lane & 7;
                *(LAS u4_t*)(KL + key * 72 + dq * 8) = kraw[i];
                vt_store(VT, 40, dq * 8, kperm(key), vraw[i]); }
            { const int ktn = kt > 0 ? kt - 1 : 0;
              const bf16_t* kvp = P + ((size_t)b * SEQ + ktn * 32 + (lane >> 3)) * INW + h * 64 + (lane & 7) * 8;
#pragma unroll
              for (int i = 0; i < 4; ++i) { kraw[i] = *(const u4_t*)(kvp + (size_t)(8 * i) * INW + C_SBK); vraw[i] = *(const u4_t*)(kvp + (size_t)(8 * i) * INW + C_SBV); } }
            f32x16 z;
#pragma unroll
            for (int i = 0; i < 16; ++i) z[i] = 0.f;
#pragma unroll
            for (int ks = 0; ks < 4; ++ks) z = __builtin_amdgcn_mfma_f32_32x32x16_bf16(*(const LAS sh8_t*)(KL + r * 72 + 16 * ks + 8 * hh), qf[ks], z, 0, 0, 0);
            const bool diag = (kt == qt);
            float sp[16]; f32x16 la; float tot = 0.f;
#pragma unroll
            for (int i = 0; i < 16; ++i) { const float zz = z[i];
                float s = fmaxf(zz, 0.f) + __builtin_amdgcn_logf(1.f + __builtin_amdgcn_exp2f(-fabsf(zz)));
                const bool valid = !diag || (crow(i, hh) < r);
                la[i] = zz - s + R; s = valid ? s : 0.f; sp[i] = s; tot += s; }
            tot += __shfl_xor(tot, 32);
#pragma unroll
            for (int ks = 0; ks < 2; ++ks) {
                unsigned hi[4], lo[4];
#pragma unroll
                for (int e = 0; e < 4; ++e) { const float x0 = -sp[8 * ks + 2 * e], x1 = -sp[8 * ks + 2 * e + 1]; hi[e] = cvtpk(x0, x1); lo[e] = cvtpk(x0 - bflo(hi[e]), x1 - bfhi(hi[e])); }
                const u4_t hv = {hi[0], hi[1], hi[2], hi[3]}, lv = {lo[0], lo[1], lo[2], lo[3]};
                la = __builtin_amdgcn_mfma_f32_32x32x16_bf16(mf[ks], __builtin_bit_cast(sh8_t, hv), la, 0, 0, 0);
                la = __builtin_amdgcn_mfma_f32_32x32x16_bf16(mf[ks], __builtin_bit_cast(sh8_t, lv), la, 0, 0, 0);
            }
            sh8_t af[2];
#pragma unroll
            for (int ks = 0; ks < 2; ++ks) { float a[8];
#pragma unroll
                for (int e = 0; e < 8; ++e) { const int i = 8 * ks + e; const bool valid = !diag || (crow(i, hh) < r); a[e] = valid ? __builtin_amdgcn_exp2f(la[i]) : 0.f; }
                af[ks] = frag8(a); }
            R -= tot;
#pragma unroll
            for (int ks = 0; ks < 2; ++ks) {
                o0 = __builtin_amdgcn_mfma_f32_32x32x16_bf16(*(const LAS sh8_t*)(VT + r * 40 + 16 * ks + 8 * hh), af[ks], o0, 0, 0, 0);
                o1 = __builtin_amdgcn_mfma_f32_32x32x16_bf16(*(const LAS sh8_t*)(VT + (32 + r) * 40 + 16 * ks + 8 * hh), af[ks], o1, 0, 0, 0);
            }
            if (__all(R < -48.f)) break;
        }
        float ss = 0.f;
#pragma unroll
        for (int i = 0; i < 16; ++i) { ss = fmaf(o0[i], o0[i], ss); ss = fmaf(o1[i], o1[i], ss); }
        ss += __shfl_xor(ss, 32);
        const float rn = rsqrtf(ss * (1.f / 64.f) + EPS);
        bf16_t* op = mixed + (tok0 + r) * DM + h * 64 + 4 * hh;
        const float* gp = p.sb_gain + h * 64 + 4 * hh;
#pragma unroll
        for (int q4 = 0; q4 < 4; ++q4) {
            const float4 g0 = *(const float4*)(gp + 8 * q4), g1 = *(const float4*)(gp + 32 + 8 * q4);
            uint2 w0, w1;
            w0.x = cvtpk(o0[4 * q4] * rn * g0.x, o0[4 * q4 + 1] * rn * g0.y); w0.y = cvtpk(o0[4 * q4 + 2] * rn * g0.z, o0[4 * q4 + 3] * rn * g0.w);
            w1.x = cvtpk(o1[4 * q4] * rn * g1.x, o1[4 * q4 + 1] * rn * g1.y); w1.y = cvtpk(o1[4 * q4 + 2] * rn * g1.z, o1[4 * q4 + 3] * rn * g1.w);
            *(uint2*)(op + 8 * q4) = w0; *(uint2*)(op + 32 + 8 * q4) = w1;
        }
    }
}
__device__ __forceinline__ void mem_attn_mfma(const Params& p, unsigned char* ldsb) {
    const bf16_t* P = (const bf16_t*)(p.ws + WS_P);
    const bf16_t* mk = (const bf16_t*)(p.ws + WS_MEMK); const bf16_t* mv = (const bf16_t*)(p.ws + WS_MEMV);
    bf16_t* mixed = (bf16_t*)(p.ws + WS_MIXED);
    const int tid = threadIdx.x, lane = tid & 63, wave = tid >> 6, r = lane & 31, hh = lane >> 5;
    LAS bf16_t* VT = (LAS bf16_t*)ldsb;
    for (int unit = blockIdx.x; unit < NB * 4 * (SEQ / 256); unit += gridDim.x) {
        const int tb = unit & 31, hd = (unit >> 5) & 3, b = unit >> 7;
        __syncthreads();
#pragma unroll
        for (int i = 0; i < 4; ++i) { const int idx = tid + 512 * i, key = idx >> 3, dq = idx & 7;
            const u4_t v = *(const u4_t*)(mv + ((size_t)b * NMEM + key) * 256 + hd * 64 + dq * 8);
            vt_store(VT, 264, dq * 8, (key & ~31) | kperm(key & 31), v); }
        __syncthreads();
        const size_t tok = (size_t)b * SEQ + tb * 256 + wave * 32 + r;
        sh8_t qf[4];
        { const bf16_t* qp = P + tok * INW + C_MQ + hd * 64 + 8 * hh;
          float qv[32]; float ss = 0.f;
#pragma unroll
          for (int ks = 0; ks < 4; ++ks) { const u4_t w = *(const u4_t*)(qp + 16 * ks);
              qv[8 * ks] = bflo(w.x); qv[8 * ks + 1] = bfhi(w.x); qv[8 * ks + 2] = bflo(w.y); qv[8 * ks + 3] = bfhi(w.y); qv[8 * ks + 4] = bflo(w.z); qv[8 * ks + 5] = bfhi(w.z); qv[8 * ks + 6] = bflo(w.w); qv[8 * ks + 7] = bfhi(w.w); }
#pragma unroll
          for (int i = 0; i < 32; ++i) ss = fmaf(qv[i], qv[i], ss);
          ss += __shfl_xor(ss, 32);
          const float rq = rsqrtf(ss * (1.f / 64.f) + EPS) * (0.125f * LOG2E);
#pragma unroll
          for (int ks = 0; ks < 4; ++ks) { float t8[8];
#pragma unroll
              for (int e = 0; e < 8; ++e) t8[e] = qv[8 * ks + e] * rq * p.mq_gain[16 * ks + 8 * hh + e];
              qf[ks] = frag8(t8); } }
        f32x16 s[8];
#pragma unroll
        for (int kt = 0; kt < 8; ++kt) {
#pragma unroll
            for (int i = 0; i < 16; ++i) s[kt][i] = 0.f;
            const bf16_t* kp = mk + ((size_t)b * NMEM + kt * 32 + r) * 256 + hd * 64 + 8 * hh;
#pragma unroll
            for (int ks = 0; ks < 4; ++ks) s[kt] = __builtin_amdgcn_mfma_f32_32x32x16_bf16(*(const sh8_t*)(kp + 16 * ks), qf[ks], s[kt], 0, 0, 0);
        }
        float mx = -1e30f;
#pragma unroll
        for (int kt = 0; kt < 8; ++kt)
#pragma unroll
            for (int i = 0; i < 16; ++i) mx = fmaxf(mx, s[kt][i]);
        mx = fmaxf(mx, __shfl_xor(mx, 32));
        float lsum = 0.f;
        f32x16 o0, o1;
#pragma unroll
        for (int i = 0; i < 16; ++i) { o0[i] = 0.f; o1[i] = 0.f; }
#pragma unroll
        for (int kt = 0; kt < 8; ++kt)
#pragma unroll
            for (int ks = 0; ks < 2; ++ks) { float a[8];
#pragma unroll
                for (int e = 0; e < 8; ++e) { a[e] = __builtin_amdgcn_exp2f(s[kt][8 * ks + e] - mx); lsum += a[e]; }
                const sh8_t af = frag8(a);
                o0 = __builtin_amdgcn_mfma_f32_32x32x16_bf16(*(const LAS sh8_t*)(VT + r * 264 + 32 * kt + 16 * ks + 8 * hh), af, o0, 0, 0, 0);
                o1 = __builtin_amdgcn_mfma_f32_32x32x16_bf16(*(const LAS sh8_t*)(VT + (32 + r) * 264 + 32 * kt + 16 * ks + 8 * hh), af, o1, 0, 0, 0); }
        lsum += __shfl_xor(lsum, 32);
        const float il = 1.f / lsum;
        bf16_t* op = mixed + tok * DM + 768 + hd * 64 + 4 * hh;
#pragma unroll
        for (int q4 = 0; q4 < 4; ++q4) {
            uint2 w0, w1;
            w0.x = cvtpk(o0[4 * q4] * il, o0[4 * q4 + 1] * il); w0.y = cvtpk(o0[4 * q4 + 2] * il, o0[4 * q4 + 3] * il);
            w1.x = cvtpk(o1[4 * q4] * il, o1[4 * q4 + 1] * il); w1.y = cvtpk(o1[4 * q4 + 2] * il, o1[4 * q4 + 3] * il);
            *(uint2*)(op + 8 * q4) = w0; *(uint2*)(op + 32 + 8 * q4) = w1;
        }
    }
}

__device__ __forceinline__ void rstd2_rows(const Params& p) {
    float* rs = (float*)(p.ws + WS_RSTD2);
    const int lane = threadIdx.x & 63, wave = threadIdx.x >> 6;
    for (int m = blockIdx.x * 8 + wave; m < T; m += gridDim.x * 8) {
        const float4* xr = (const float4*)(p.out + (size_t)m * DM) + lane; float s = 0.f;
#pragma unroll
        for (int j = 0; j < 4; ++j) { const float4 v = xr[64 * j]; s += (v.x * v.x + v.y * v.y) + (v.z * v.z + v.w * v.w); }
        s = wave_sum(s);
        if (lane == 0) rs[m] = rsqrtf(s * (1.f / DM) + EPS);
    }
}

__device__ __forceinline__ void wave_argmax(float& v, int& i) {
#pragma unroll
    for (int o = 32; o >= 1; o >>= 1) { const float ov = __shfl_xor(v, o); const int oi = __shfl_xor(i, o); if (ov > v || (ov == v && oi < i)) { v = ov; i = oi; } }
}
__device__ __forceinline__ void topk_naive(const Params& p, unsigned char* ldsb) {
    const bf16_t* Q = (const bf16_t*)(p.ws + WS_Q);
    const bf16_t* SK = (const bf16_t*)(p.ws + WS_SKB);
    int* pidx = (int*)(p.ws + WS_PIDX); float* pg = (float*)(p.ws + WS_PG);
    const int lane = threadIdx.x & 63, wave = threadIdx.x >> 6;
    float* tsv = (float*)ldsb + wave * 128;
    int* tsi = (int*)tsv + 32;
    float* bsv = tsv + 64; int* bse = (int*)tsv + 80;
    for (int it = blockIdx.x * 8 + wave; it < T * 8; it += gridDim.x * 8) {
        const int tok = it >> 3, h = it & 7;
        for (int c = 0; c < 2; ++c) {
            const uint4* qp = (const uint4*)(Q + (size_t)tok * 2048 + h * 256 + c * 128);
            const uint4* k0 = (const uint4*)(SK + ((size_t)(h * 2 + c) * 128 + lane) * 128);
            const uint4* k1 = (const uint4*)(SK + ((size_t)(h * 2 + c) * 128 + lane + 64) * 128);
            float s0 = 0.f, s1 = 0.f;
            for (int j = 0; j < 16; ++j) { const uint4 qv = qp[j], a = k0[j], bq = k1[j];
                s0 = fmaf(bflo(qv.x), bflo(a.x), s0); s0 = fmaf(bfhi(qv.x), bfhi(a.x), s0); s0 = fmaf(bflo(qv.y), bflo(a.y), s0); s0 = fmaf(bfhi(qv.y), bfhi(a.y), s0);
                s0 = fmaf(bflo(qv.z), bflo(a.z), s0); s0 = fmaf(bfhi(qv.z), bfhi(a.z), s0); s0 = fmaf(bflo(qv.w), bflo(a.w), s0); s0 = fmaf(bfhi(qv.w), bfhi(a.w), s0);
                s1 = fmaf(bflo(qv.x), bflo(bq.x), s1); s1 = fmaf(bfhi(qv.x), bfhi(bq.x), s1); s1 = fmaf(bflo(qv.y), bflo(bq.y), s1); s1 = fmaf(bfhi(qv.y), bfhi(bq.y), s1);
                s1 = fmaf(bflo(qv.z), bflo(bq.z), s1); s1 = fmaf(bfhi(qv.z), bfhi(bq.z), s1); s1 = fmaf(bflo(qv.w), bflo(bq.w), s1); s1 = fmaf(bfhi(qv.w), bfhi(bq.w), s1); }
            for (int r = 0; r < 16; ++r) {
                float v = s0; int i = lane; if (s1 > s0) { v = s1; i = lane + 64; }
                wave_argmax(v, i);
                if (lane == 0) { tsv[c * 16 + r] = v; tsi[c * 16 + r] = i; }
                if (i == lane) s0 = -INFINITY; if (i == lane + 64) s1 = -INFINITY;
            }
        }
        __builtin_amdgcn_s_waitcnt(0); __builtin_amdgcn_wave_barrier();
        float cs[4];
#pragma unroll
        for (int u = 0; u < 4; ++u) { const int id = lane * 4 + u; cs[u] = tsv[id >> 4] + tsv[16 + (id & 15)]; }
        for (int r = 0; r < 16; ++r) {
            float v = cs[0]; int i = lane * 4;
#pragma unroll
            for (int u = 1; u < 4; ++u) if (cs[u] > v) { v = cs[u]; i = lane * 4 + u; }
            wave_argmax(v, i);
            if (lane == 0) { bsv[r] = v; bse[r] = tsi[i >> 4] * 128 + tsi[16 + (i & 15)]; }
#pragma unroll
            for (int u = 0; u < 4; ++u) if (i == lane * 4 + u) cs[u] = -INFINITY;
        }
        __builtin_amdgcn_s_waitcnt(0); __builtin_amdgcn_wave_barrier();
        { const float mxv = bsv[0]; float e = (lane < 16) ? __expf(bsv[lane & 15] - mxv) : 0.f;
          float s = e; s += __shfl_xor(s, 1); s += __shfl_xor(s, 2); s += __shfl_xor(s, 4); s += __shfl_xor(s, 8);
          if (lane < 16) { pidx[(size_t)tok * PK + h * 16 + lane] = bse[lane]; pg[(size_t)tok * PK + h * 16 + lane] = e / s; } }
        __builtin_amdgcn_s_waitcnt(0); __builtin_amdgcn_wave_barrier();
    }
}

__device__ __forceinline__ void peer_naive(const Params& p, unsigned char* ldsb) {
    const int* pidx = (const int*)(p.ws + WS_PIDX); const float* pg = (const float*)(p.ws + WS_PG);
    const float* rs = (const float*)(p.ws + WS_RSTD2);
    float* hs = (float*)ldsb;
    float* red = hs + 1024;
    const int tid = threadIdx.x, lane = tid & 63, wave = tid >> 6;
    for (int tok = blockIdx.x; tok < T; tok += gridDim.x) {
        const float r2 = rs[tok];
        for (int d = tid; d < DM; d += NTHR) hs[d] = p.out[(size_t)tok * DM + d] * r2 * p.g_ffn[d];
        __syncthreads();
        float4 hv[4];
#pragma unroll
        for (int j = 0; j < 4; ++j) hv[j] = *((const float4*)hs + lane + 64 * j);
        float4 acc[4];
#pragma unroll
        for (int j = 0; j < 4; ++j) acc[j] = make_float4(0.f, 0.f, 0.f, 0.f);
        for (int pi = wave; pi < PK; pi += 8) {
            const int e = pidx[(size_t)tok * PK + pi]; const float g = pg[(size_t)tok * PK + pi];
            const float4* up = (const float4*)(p.pu + (size_t)e * DM) + lane;
            const float4* vp = (const float4*)(p.pv + (size_t)e * DM) + lane;
            float s = 0.f;
#pragma unroll
            for (int j = 0; j < 4; ++j) { const float4 u = up[64 * j]; s += (hv[j].x * u.x + hv[j].y * u.y) + (hv[j].z * u.z + hv[j].w * u.w); }
            s = wave_sum(s);
            const float w = g * 0.5f * s * (1.f + erff(s * 0.70710678118654752f));
#pragma unroll
            for (int j = 0; j < 4; ++j) { const float4 v = vp[64 * j]; acc[j].x = fmaf(w, v.x, acc[j].x); acc[j].y = fmaf(w, v.y, acc[j].y); acc[j].z = fmaf(w, v.z, acc[j].z); acc[j].w = fmaf(w, v.w, acc[j].w); }
        }
#pragma unroll
        for (int j = 0; j < 4; ++j) *((float4*)(red + wave * 1024) + lane + 64 * j) = acc[j];
        __syncthreads();
        for (int d = tid; d < DM; d += NTHR) { float s = 0.f;
#pragma unroll
            for (int w = 0; w < 8; ++w) s += red[w * 1024 + d];
            p.out[(size_t)tok * DM + d] += s; }
        __syncthreads();
    }
}


__device__ __forceinline__ int tk_pack(float s, int payload, int mask) { const int b = __float_as_int(s); const int m = b ^ ((b >> 31) & 0x7fffffff); return (m & ~mask) | payload; }
__device__ __forceinline__ float tk_unpack(int key, int mask) { const int m = key & ~mask; return __int_as_float(m ^ ((m >> 31) & 0x7fffffff)); }
template <int N> __device__ __forceinline__ void bitonic_sort_desc(int (&v)[N]) {
#pragma unroll
    for (int k = 2; k <= N; k <<= 1)
#pragma unroll
        for (int j = k >> 1; j > 0; j >>= 1)
#pragma unroll
            for (int i = 0; i < N; ++i) { const int l = i ^ j; if (l > i) { const bool desc = ((i & k) == 0); const int a = v[i], b = v[l]; const int hi = max(a, b), lo = min(a, b); v[i] = desc ? hi : lo; v[l] = desc ? lo : hi; } }
}
__device__ __forceinline__ void merge_top16(int (&A)[16], const int (&B)[16]) {
#pragma unroll
    for (int i = 0; i < 16; ++i) A[i] = max(A[i], B[15 - i]);
#pragma unroll
    for (int j = 8; j > 0; j >>= 1)
#pragma unroll
        for (int i = 0; i < 16; ++i) { const int l = i ^ j; if (l > i) { const int a = A[i], b = A[l]; A[i] = max(a, b); A[l] = min(a, b); } }
}
__device__ __forceinline__ void top16_of_64(int (&g0)[16], int (&g1)[16], int (&g2)[16], int (&g3)[16]) {
    bitonic_sort_desc<16>(g0); bitonic_sort_desc<16>(g1); bitonic_sort_desc<16>(g2); bitonic_sort_desc<16>(g3);
    merge_top16(g0, g1); merge_top16(g2, g3); merge_top16(g0, g2);
}
__device__ __forceinline__ void topk_mfma(const Params& p, unsigned char* ldsb) {
    const bf16_t* Q = (const bf16_t*)(p.ws + WS_Q);
    const bf16_t* SK = (const bf16_t*)(p.ws + WS_SKB);
    unsigned short* pidx16 = (unsigned short*)(p.ws + WS_PIDX); float* pg = (float*)(p.ws + WS_PG);
    const float* ssq = (const float*)(p.ws + WS_SSQ); float* rs2 = (float*)(p.ws + WS_RSTD2);
    LAS unsigned char* l = (LAS unsigned char*)ldsb;
    LAS bf16_t* SKL = (LAS bf16_t*)l;
    const int tid = threadIdx.x, lane = tid & 63, wave = tid >> 6, r = lane & 31, hh = lane >> 5;
    LAS unsigned char* ib = l + 69632 + (wave * 64 + lane) * 36;
    int cur_h = -1;
    for (int unit = blockIdx.x; unit < 8 * (T / 256); unit += gridDim.x) {
        const int h = unit & 7, tb = unit >> 3;
        if (h != cur_h) {
            __syncthreads();
#pragma unroll
            for (int it = 0; it < 8; ++it) { const int idx = tid + 512 * it, row = idx >> 4, cq = idx & 15;
                *(LAS u4_t*)(SKL + row * 136 + cq * 8) = *(const u4_t*)(SK + ((size_t)h * 256 + row) * 128 + cq * 8); }
            __syncthreads();
            cur_h = h;
        }
        const int tok = tb * 256 + wave * 32 + r;
        int sorted[2][16];
#pragma unroll
        for (int c = 0; c < 2; ++c) {
            sh8_t qf[8];
            { const sh8_t* qp = (const sh8_t*)(Q + (size_t)tok * 2048 + h * 256 + c * 128 + 8 * hh);
#pragma unroll
              for (int ks = 0; ks < 8; ++ks) qf[ks] = qp[2 * ks]; }
            int g[4][16];
#pragma unroll
            for (int mt = 0; mt < 4; ++mt) {
                f32x16 acc;
#pragma unroll
                for (int i = 0; i < 16; ++i) acc[i] = 0.f;
                const LAS bf16_t* ap = SKL + (c * 128 + 32 * mt + r) * 136 + 8 * hh;
#pragma unroll
                for (int ks = 0; ks < 8; ++ks) acc = __builtin_amdgcn_mfma_f32_32x32x16_bf16(*(const LAS sh8_t*)(ap + 16 * ks), qf[ks], acc, 0, 0, 0);
#pragma unroll
                for (int i = 0; i < 16; ++i) g[mt][i] = tk_pack(acc[i], (32 * mt + (i & 3) + 8 * (i >> 2)) | (hh << 2), 127);
            }
            top16_of_64(g[0], g[1], g[2], g[3]);
            int o[16];
#pragma unroll
            for (int i = 0; i < 16; ++i) o[i] = __shfl_xor(g[0][i], 32);
            merge_top16(g[0], o);
#pragma unroll
            for (int i = 0; i < 16; ++i) sorted[c][i] = g[0][i];
        }
#pragma unroll
        for (int c = 0; c < 2; ++c)
#pragma unroll
            for (int w = 0; w < 4; ++w)
                *(LAS unsigned*)(ib + c * 16 + w * 4) = (unsigned)(sorted[c][4 * w] & 127) | ((unsigned)(sorted[c][4 * w + 1] & 127) << 8) | ((unsigned)(sorted[c][4 * w + 2] & 127) << 16) | ((unsigned)(sorted[c][4 * w + 3] & 127) << 24);
        float av[16], bv[16];
#pragma unroll
        for (int i = 0; i < 16; ++i) { av[i] = tk_unpack(sorted[0][i], 127); bv[i] = tk_unpack(sorted[1][i], 127); }
        int cd[4][16];
        {
            int n = 0;
#pragma unroll
            for (int i = 0; i < 16; ++i)
#pragma unroll
                for (int j = 0; j < 16; ++j)
                    if ((i + 1) * (j + 1) <= 16) { cd[n >> 4][n & 15] = tk_pack(av[i] + bv[j], i * 16 + j, 255); ++n; }
#pragma unroll
            for (; n < 64; ++n) cd[n >> 4][n & 15] = (int)0x80000000;
        }
        top16_of_64(cd[0], cd[1], cd[2], cd[3]);
        float sv[16]; int ex[16];
        float rstd;
        { const f32x4_t* sp_ = (const f32x4_t*)(ssq + (size_t)tok * 16); const f32x4_t q0 = sp_[0], q1 = sp_[1], q2 = sp_[2], q3 = sp_[3];
          const float tot = ((q0[0] + q0[1]) + (q0[2] + q0[3])) + ((q1[0] + q1[1]) + (q1[2] + q1[3])) + ((q2[0] + q2[1]) + (q2[2] + q2[3])) + ((q3[0] + q3[1]) + (q3[2] + q3[3]));
          rstd = rsqrtf(tot * (1.f / DM) + EPS); if (h == 0 && hh == 0) rs2[tok] = rstd; }
        const float s0 = tk_unpack(cd[0][0], 255);
        float sum = 0.f;
#pragma unroll
        for (int q = 0; q < 16; ++q) { const int key = cd[0][q]; const int id = key & 255;
            const int ia = ib[id >> 4], ibx = ib[16 + (id & 15)];
            ex[q] = ia * 128 + ibx; sv[q] = __expf((tk_unpack(key, 255) - s0) * rstd); sum += sv[q]; }
        const float inv = 1.f / sum;
        if (hh == 0) { u4_t* d = (u4_t*)(pidx16 + (size_t)tok * PK + h * 16);
#pragma unroll
            for (int w = 0; w < 2; ++w) d[w] = (u4_t){(unsigned)ex[8 * w] | ((unsigned)ex[8 * w + 1] << 16), (unsigned)ex[8 * w + 2] | ((unsigned)ex[8 * w + 3] << 16), (unsigned)ex[8 * w + 4] | ((unsigned)ex[8 * w + 5] << 16), (unsigned)ex[8 * w + 6] | ((unsigned)ex[8 * w + 7] << 16)}; }
        else { float4* d = (float4*)(pg + (size_t)tok * PK + h * 16);
#pragma unroll
            for (int w = 0; w < 4; ++w) d[w] = make_float4(sv[4 * w] * inv, sv[4 * w + 1] * inv, sv[4 * w + 2] * inv, sv[4 * w + 3] * inv); }
    }
}

struct Sl { int vx, rank, nrank; };
__device__ __forceinline__ float dpp_xor1(float x) { return __int_as_float(__builtin_amdgcn_mov_dpp(__float_as_int(x), 0xB1, 0xF, 0xF, true)); }
__device__ __forceinline__ float dpp_xor2(float x) { return __int_as_float(__builtin_amdgcn_mov_dpp(__float_as_int(x), 0x4E, 0xF, 0xF, true)); }
__device__ __forceinline__ float dpp_ror8(float x) { return __int_as_float(__builtin_amdgcn_mov_dpp(__float_as_int(x), 0x128, 0xF, 0xF, true)); }
__device__ __forceinline__ float dpp_hmir(float x) { return __int_as_float(__builtin_amdgcn_mov_dpp(__float_as_int(x), 0x141, 0xF, 0xF, true)); }
__device__ __forceinline__ void peer_u_phase(const Params& p, const Sl sl) {
    const int lane = threadIdx.x & 63, wave = threadIdx.x >> 6, g8 = lane >> 3, c = lane & 7;
    const unsigned short* pidx = (const unsigned short*)(p.ws + WS_PIDX);
    const int per = (T + sl.nrank * 8 - 1) / (sl.nrank * 8), tbase = (sl.rank * 8 + wave) * per, stride = 1;
    const int nk = (tbase < T) ? ((T - tbase < per) ? (T - tbase) : per) : 0;
    const int S = sl.vx;
    const unsigned char* Ub = p.ws + WS_U16 + (size_t)S * NEXP * 128 + c * 16;
    const bf16_t* xbb = (const bf16_t*)(p.ws + WS_XB) + (size_t)(2 * S + (c >> 2)) * T * 64 + (c & 3) * 16;
    _Float16* PUs = (_Float16*)(p.ws + WS_PU) + (size_t)S * T * PK;
    if (nk == 0) return;
#define TK(k) (tbase + ((k) < nk ? (k) : nk - 1) * stride)
#define SBAR __builtin_amdgcn_sched_barrier(0)
#define U_LOAD_IDX(I, t) { const u4_t* ip_ = (const u4_t*)(pidx + (size_t)(t) * PK + g8 * 16); I[0] = __builtin_nontemporal_load(ip_); I[1] = __builtin_nontemporal_load(ip_ + 1); }
#define U_LOAD_H(H, t) { const u4_t* hp_ = (const u4_t*)(xbb + (size_t)(t) * 64); H[0] = __builtin_nontemporal_load(hp_); H[1] = __builtin_nontemporal_load(hp_ + 1); }
#define U_ISSUE(G, I) { const unsigned w0_ = I[(G) >> 1][(2 * (G)) & 3], w1_ = I[(G) >> 1][(2 * (G) + 1) & 3]; \
        rr[4 * (G)] = *(const u4_t*)(Ub + (size_t)(w0_ & 0xffffu) * 128); rr[4 * (G) + 1] = *(const u4_t*)(Ub + (size_t)(w0_ >> 16) * 128); \
        rr[4 * (G) + 2] = *(const u4_t*)(Ub + (size_t)(w1_ & 0xffffu) * 128); rr[4 * (G) + 3] = *(const u4_t*)(Ub + (size_t)(w1_ >> 16) * 128); }
#define U_DOT(G) { _Pragma("unroll") for (int i_ = 4 * (G); i_ < 4 * (G) + 4; ++i_) { float2_t a_ = {0.f, 0.f}; \
        _Pragma("unroll") for (int q_ = 0; q_ < 4; ++q_) { a_ = __builtin_amdgcn_cvt_pk_f32_fp8((int)rr[i_][q_], false) * X2[2 * q_] + a_; a_ = __builtin_amdgcn_cvt_pk_f32_fp8((int)rr[i_][q_], true) * X2[2 * q_ + 1] + a_; } \
        pr[i_] = a_.x + a_.y; } }
#define U_STEP(k, I1, I2, Hc, Hn) { float pr[16]; float2_t X2[8]; \
        _Pragma("unroll") for (int m_ = 0; m_ < 8; ++m_) { const unsigned hw_ = Hc[m_ >> 2][m_ & 3]; X2[m_] = (float2_t){bflo(hw_), bfhi(hw_)}; } \
        U_LOAD_IDX(I2, TK((k) + 2)); U_LOAD_H(Hn, TK((k) + 1)); SBAR; \
        U_DOT(0); SBAR; U_ISSUE(0, I1); SBAR; U_DOT(1); SBAR; U_ISSUE(1, I1); SBAR; U_DOT(2); SBAR; U_ISSUE(2, I1); SBAR; U_DOT(3); SBAR; U_ISSUE(3, I1); SBAR; \
        _Pragma("unroll") for (int j_ = 0; j_ < 8; ++j_) { const float keep_ = (c & 4) ? pr[j_ + 8] : pr[j_], send_ = (c & 4) ? pr[j_] : pr[j_ + 8]; pr[j_] = keep_ + dpp_hmir(send_); } \
        _Pragma("unroll") for (int j_ = 0; j_ < 4; ++j_) { const float keep_ = (c & 2) ? pr[j_ + 4] : pr[j_], send_ = (c & 2) ? pr[j_] : pr[j_ + 4]; pr[j_] = keep_ + dpp_xor2(send_); } \
        _Pragma("unroll") for (int j_ = 0; j_ < 2; ++j_) { const float keep_ = (c & 1) ? pr[j_ + 2] : pr[j_], send_ = (c & 1) ? pr[j_] : pr[j_ + 2]; pr[j_] = keep_ + dpp_xor1(send_); } \
        __builtin_nontemporal_store((h2_t){(_Float16)pr[0], (_Float16)pr[1]}, (h2_t*)(PUs + (size_t)TK(k) * PK + g8 * 16 + 2 * c)); }
    u4_t iA[2], iB[2], rr[16], hA[2], hB[2];
    U_LOAD_IDX(iA, TK(0)); U_LOAD_IDX(iB, TK(1)); U_LOAD_H(hA, TK(0)); SBAR;
    U_ISSUE(0, iA); SBAR; U_ISSUE(1, iA); SBAR; U_ISSUE(2, iA); SBAR; U_ISSUE(3, iA); SBAR;
    for (int k = 0; k < nk; k += 2) {
        U_STEP(k, iB, iA, hA, hB);
        if (k + 1 < nk) U_STEP(k + 1, iA, iB, hB, hA);
    }
#undef U_LOAD_IDX
#undef U_LOAD_H
#undef U_ISSUE
#undef U_DOT
#undef U_STEP
}
__device__ __forceinline__ void peer_w_phase(const Params& p) {
    const _Float16* PU = (const _Float16*)(p.ws + WS_PU); const float* pg = (const float*)(p.ws + WS_PG); const float* rs = (const float*)(p.ws + WS_RSTD2);
    float* pw = (float*)(p.ws + WS_PW);
    for (int i = blockIdx.x * NTHR + threadIdx.x; i < T * PK / 8; i += gridDim.x * NTHR) {
        float s[8];
#pragma unroll
        for (int e = 0; e < 8; ++e) s[e] = 0.f;
#pragma unroll
        for (int x = 0; x < 8; ++x) { const h8_t hv = __builtin_nontemporal_load((const h8_t*)(PU + (size_t)x * T * PK) + i);
#pragma unroll
            for (int e = 0; e < 8; ++e) s[e] += (float)hv[e]; }
        const float r = rs[i >> 4] * (1.f / PEER_US);
        const f32x4_t g0 = *((const f32x4_t*)pg + 2 * i), g1 = *((const f32x4_t*)pg + 2 * i + 1);
        f32x4_t w0, w1;
#pragma unroll
        for (int e = 0; e < 4; ++e) { const float a = s[e] * r, b = s[4 + e] * r;
            w0[e] = g0[e] * (0.5f / PEER_VS) * a * (1.f + erff(a * 0.70710678118654752f)); w1[e] = g1[e] * (0.5f / PEER_VS) * b * (1.f + erff(b * 0.70710678118654752f)); }
        *((f32x4_t*)pw + 2 * i) = w0; *((f32x4_t*)pw + 2 * i + 1) = w1;
    }
}
__device__ __forceinline__ void peer_v_phase(const Params& p, const Sl sl) {
    const int lane = threadIdx.x & 63, wave = threadIdx.x >> 6, g8 = lane >> 3, c = lane & 7;
    const unsigned short* pidx = (const unsigned short*)(p.ws + WS_PIDX); const float* pw = (const float*)(p.ws + WS_PW);
    const int per = (T + sl.nrank * 8 - 1) / (sl.nrank * 8), tbase = (sl.rank * 8 + wave) * per, stride = 1;
    const int nk = (tbase < T) ? ((T - tbase < per) ? (T - tbase) : per) : 0;
    const int S = sl.vx;
    const unsigned char* Vb = p.ws + WS_V16 + (size_t)S * NEXP * 128 + c * 16;
    const int jj = 16 * c + 2 * g8, s16 = 2 * S + (jj >> 6), j = jj & 63;
    float* ob = p.out + (j >> 5) * 512 + 32 * s16 + (j & 31);
    const float* xs = (const float*)(p.ws + WS_X1S) + (size_t)s16 * T * 64 + j;
    if (nk == 0) return;
#define V_LOAD_IDX(I, t) { const u4_t* ip_ = (const u4_t*)(pidx + (size_t)(t) * PK + g8 * 16); I[0] = __builtin_nontemporal_load(ip_); I[1] = __builtin_nontemporal_load(ip_ + 1); }
#define V_LOAD_W(W, t) { const f32x4_t* wp_ = (const f32x4_t*)(pw + (size_t)(t) * PK + g8 * 16); W[0] = __builtin_nontemporal_load(wp_); W[1] = __builtin_nontemporal_load(wp_ + 1); W[2] = __builtin_nontemporal_load(wp_ + 2); W[3] = __builtin_nontemporal_load(wp_ + 3); }
#define V_ISSUE(G, I) { const unsigned w0_ = I[(G) >> 1][(2 * (G)) & 3], w1_ = I[(G) >> 1][(2 * (G) + 1) & 3]; \
        rr[4 * (G)] = *(const u4_t*)(Vb + (size_t)(w0_ & 0xffffu) * 128); rr[4 * (G) + 1] = *(const u4_t*)(Vb + (size_t)(w0_ >> 16) * 128); \
        rr[4 * (G) + 2] = *(const u4_t*)(Vb + (size_t)(w1_ & 0xffffu) * 128); rr[4 * (G) + 3] = *(const u4_t*)(Vb + (size_t)(w1_ >> 16) * 128); }
#define V_FMA(G, W) { _Pragma("unroll") for (int i_ = 4 * (G); i_ < 4 * (G) + 4; ++i_) { const float wv_ = W[G][i_ & 3]; const float2_t ww_ = {wv_, wv_}; \
        _Pragma("unroll") for (int q_ = 0; q_ < 4; ++q_) { acc2[2 * q_] = __builtin_amdgcn_cvt_pk_f32_fp8((int)rr[i_][q_], false) * ww_ + acc2[2 * q_]; acc2[2 * q_ + 1] = __builtin_amdgcn_cvt_pk_f32_fp8((int)rr[i_][q_], true) * ww_ + acc2[2 * q_ + 1]; } } }
#define V_STEP(k, I1, I2, Wc, Wn) { float2_t acc2[8]; \
        _Pragma("unroll") for (int k_ = 0; k_ < 8; ++k_) acc2[k_] = (float2_t){0.f, 0.f}; \
        const float2_t oold_ = __builtin_nontemporal_load((const float2_t*)(xs + (size_t)TK(k) * 64)); \
        V_LOAD_IDX(I2, TK((k) + 2)); V_LOAD_W(Wn, TK((k) + 1)); SBAR; \
        V_FMA(0, Wc); SBAR; V_ISSUE(0, I1); SBAR; V_FMA(1, Wc); SBAR; V_ISSUE(1, I1); SBAR; V_FMA(2, Wc); SBAR; V_ISSUE(2, I1); SBAR; V_FMA(3, Wc); SBAR; V_ISSUE(3, I1); SBAR; \
        float a_[16]; \
        _Pragma("unroll") for (int k_ = 0; k_ < 8; ++k_) { a_[2 * k_] = acc2[k_].x; a_[2 * k_ + 1] = acc2[k_].y; } \
        _Pragma("unroll") for (int j_ = 0; j_ < 8; ++j_) { const float keep_ = (g8 & 4) ? a_[j_ + 8] : a_[j_], send_ = (g8 & 4) ? a_[j_] : a_[j_ + 8]; a_[j_] = keep_ + __shfl_xor(send_, 32); } \
        _Pragma("unroll") for (int j_ = 0; j_ < 4; ++j_) { const float keep_ = (g8 & 2) ? a_[j_ + 4] : a_[j_], send_ = (g8 & 2) ? a_[j_] : a_[j_ + 4]; a_[j_] = keep_ + __shfl_xor(send_, 16); } \
        _Pragma("unroll") for (int j_ = 0; j_ < 2; ++j_) { const float keep_ = (g8 & 1) ? a_[j_ + 2] : a_[j_], send_ = (g8 & 1) ? a_[j_] : a_[j_ + 2]; a_[j_] = keep_ + dpp_ror8(send_); } \
        __builtin_nontemporal_store((float2_t){oold_.x + a_[0], oold_.y + a_[1]}, (float2_t*)(ob + (size_t)TK(k) * DM)); }
    u4_t iA[2], iB[2], rr[16]; f32x4_t wA[4], wB[4];
    V_LOAD_IDX(iA, TK(0)); V_LOAD_IDX(iB, TK(1)); V_LOAD_W(wA, TK(0)); SBAR;
    V_ISSUE(0, iA); SBAR; V_ISSUE(1, iA); SBAR; V_ISSUE(2, iA); SBAR; V_ISSUE(3, iA); SBAR;
    for (int k = 0; k < nk; k += 2) {
        V_STEP(k, iB, iA, wA, wB);
        if (k + 1 < nk) V_STEP(k + 1, iA, iB, wB, wA);
    }
#undef V_LOAD_IDX
#undef V_LOAD_W
#undef V_ISSUE
#undef V_FMA
#undef V_STEP
#undef TK
#undef SBAR
}

#ifndef PROBE_DBL
#define PROBE_DBL -1
#endif
#define REP(k) for (int rep_ = 0; rep_ < ((PROBE_DBL == (k)) ? 2 : 1); ++rep_)
typedef const __attribute__((address_space(4))) Params* KArgs;
#if defined(__HIP_DEVICE_COMPILE__)
#define LOADP(P) KArgs kq_ = (KArgs)__builtin_amdgcn_kernarg_segment_ptr(); asm volatile("" : "+s"(kq_)); Params P; __builtin_memcpy(&P, kq_, sizeof(Params))
#define BAR_WS() ((unsigned char*)((KArgs)__builtin_amdgcn_kernarg_segment_ptr())->ws)
#else
#define LOADP(P) const Params P = p_unused
#define BAR_WS() (p_unused.ws)
#endif
#ifndef PROBE_SPIN
#define PROBE_SPIN -1
#endif
#if PROBE_SPIN >= 0
#define STAMP(k) do { if (threadIdx.x == 0) { const unsigned long long t_ = __builtin_amdgcn_s_memrealtime(); ((volatile LAS unsigned*)(LAS unsigned char*)lds)[36800 + 2 * (k)] = (unsigned)t_; ((volatile LAS unsigned*)(LAS unsigned char*)lds)[36801 + 2 * (k)] = (unsigned)(t_ >> 32); } } while (0)
#else
#define STAMP(k) do { } while (0)
#endif
#define BAR() do { XcdBarrier xb_; xb_.bar = (unsigned*)(BAR_WS() + WS_CTL) + 4096; xb_.x = ((volatile LAS unsigned*)(LAS unsigned char*)lds)[36861]; xb_.st = (volatile LAS unsigned*)(LAS unsigned char*)lds + 36862; xcd_barrier(xb_); } while (0)
__global__ void __launch_bounds__(NTHR, 2) fwd_kernel(Params p_unused) {
    extern __shared__ __attribute__((aligned(16))) unsigned char lds[];
    PG8_LAS unsigned char* ldsl = (PG8_LAS unsigned char*)lds;
    { LOADP(p);
      if (threadIdx.x < 2) ((volatile LAS unsigned*)(LAS unsigned char*)lds)[36862 + threadIdx.x] = 0u;
      if (threadIdx.x == 0) { unsigned* ctl0 = (unsigned*)(p.ws + WS_CTL); const unsigned xcc0 = (unsigned)__builtin_amdgcn_s_getreg((3 << 11) | 20) & 7u;
        ((volatile unsigned*)lds)[36860] = __hip_atomic_fetch_add(&ctl0[64 * xcc0], 1u, __ATOMIC_RELAXED, __HIP_MEMORY_SCOPE_AGENT); ((volatile unsigned*)lds)[36861] = xcc0;
        (void)xb_add(&(ctl0 + 4096)[XB_XCNT(xcc0)], 1u); }
      __syncthreads(); }
    STAMP(0);
    { LOADP(p); REP(0) phase_prep(p, lds); }
    { cg::grid_group grid = cg::this_grid(); grid.sync(); } STAMP(1);
    { LOADP(p); unsigned char* ws = p.ws;
      pg8::Gemm g{(const bf16_t*)(ws + WS_XB), (const bf16_t*)(ws + WS_WIN_T), T, INW, DM, DM, 128}; pg8::StaticOrder S; S.init(T, INW, gridDim.x, blockIdx.x); pg8::EpiProjM e{(bf16_t*)(ws + WS_P)};
      pg8::gemm_phase<pg8::EpiProjM, pg8::StaticOrder, true, true>(ldsl, g, S, e); }
#if PROBE_DBL == 1
    { LOADP(p); unsigned char* ws = p.ws;
      pg8::Gemm g{(const bf16_t*)(ws + WS_XB), (const bf16_t*)(ws + WS_WIN_T), T, INW, DM, DM, 128}; pg8::StaticOrder S; S.init(T, INW, gridDim.x, blockIdx.x); pg8::EpiProjM e{(bf16_t*)(ws + WS_P)};
      pg8::gemm_phase<pg8::EpiProjM, pg8::StaticOrder, true, true>(ldsl, g, S, e); }
#endif
    { LOADP(p); unsigned char* ws = p.ws;
      pg8::Gemm g{(const bf16_t*)(ws + WS_MEMN), (const bf16_t*)(ws + WS_WMKV_T), NB * NMEM, 512, DM, DM, 128}; pg8::StaticOrder S; S.init(NB * NMEM, 512, gridDim.x, blockIdx.x); pg8::EpiF32M e{(float*)(ws + WS_MEMKV), 512};
      pg8::gemm_phase<pg8::EpiF32M, pg8::StaticOrder, true, true>(ldsl, g, S, e); }
    BAR(); STAMP(2);
    { LOADP(p); mem_knorm(p); REP(2) { sb_mfma(p, lds); __syncthreads(); } REP(3) { hg_local(p, lds); } }
    BAR(); STAMP(3);
    { LOADP(p); REP(4) hg_scan(p); REP(5) mem_attn_mfma(p, lds); }
    BAR(); STAMP(4);
    { LOADP(p); REP(6) hg_out(p, lds); }
    BAR(); STAMP(5);
    { LOADP(p); unsigned char* ws = p.ws;
      pg8::Gemm g{(const bf16_t*)(ws + WS_MIXED), (const bf16_t*)(ws + WS_WOUT_T), T, DM, DM, DM, 128}; pg8::StaticOrder S; S.init(T, DM, gridDim.x, blockIdx.x); pg8::EpiWoutM e{p.x, (float*)(ws + WS_X1S), (bf16_t*)(ws + WS_XB), (float*)(ws + WS_SSQ)};
      pg8::gemm_phase<pg8::EpiWoutM, pg8::StaticOrder, true, true>(ldsl, g, S, e); }
#if PROBE_DBL == 7
    { LOADP(p); unsigned char* ws = p.ws;
      pg8::Gemm g{(const bf16_t*)(ws + WS_MIXED), (const bf16_t*)(ws + WS_WOUT_T), T, DM, DM, DM, 128}; pg8::StaticOrder S; S.init(T, DM, gridDim.x, blockIdx.x); pg8::EpiWoutM e{p.x, (float*)(ws + WS_X1S), (bf16_t*)(ws + WS_XB), (float*)(ws + WS_SSQ)};
      pg8::gemm_phase<pg8::EpiWoutM, pg8::StaticOrder, true, true>(ldsl, g, S, e); }
#endif
    BAR(); STAMP(6);
    { LOADP(p); unsigned char* ws = p.ws;
      pg8::Gemm g{(const bf16_t*)(ws + WS_XB), (const bf16_t*)(ws + WS_WQ_T), T, 2048, DM, 64, (size_t)T * 128}; pg8::StaticOrder S; S.init(T, 2048, gridDim.x, blockIdx.x); pg8::EpiQM e{(bf16_t*)(ws + WS_Q)};
      pg8::gemm_phase<pg8::EpiQM, pg8::StaticOrder, true, true>(ldsl, g, S, e); }
#if PROBE_DBL == 9
    { LOADP(p); unsigned char* ws = p.ws;
      pg8::Gemm g{(const bf16_t*)(ws + WS_XB), (const bf16_t*)(ws + WS_WQ_T), T, 2048, DM, 64, (size_t)T * 128}; pg8::StaticOrder S; S.init(T, 2048, gridDim.x, blockIdx.x); pg8::EpiQM e{(bf16_t*)(ws + WS_Q)};
      pg8::gemm_phase<pg8::EpiQM, pg8::StaticOrder, true, true>(ldsl, g, S, e); }
#endif
    BAR(); STAMP(7);
    { LOADP(p); REP(10) topk_mfma(p, lds); }
    BAR(); STAMP(8);
#define LOAD_SL(p) Sl sl; { const unsigned* ctl = (const unsigned*)(p.ws + WS_CTL); const int myrank = (int)((volatile unsigned*)lds)[36860]; const unsigned xcc = ((volatile unsigned*)lds)[36861]; \
      bool good = (gridDim.x % 8u) == 0u; \
      for (int j = 0; j < 8; ++j) good = good && (__hip_atomic_load(&ctl[64 * j], __ATOMIC_RELAXED, __HIP_MEMORY_SCOPE_AGENT) == gridDim.x / 8u); \
      if (good) { sl.vx = (int)xcc; sl.rank = myrank; sl.nrank = (int)(gridDim.x / 8u); } \
      else { sl.vx = (int)(blockIdx.x & 7u); sl.rank = (int)(blockIdx.x >> 3); sl.nrank = (int)((gridDim.x - (blockIdx.x & 7u) + 7u) / 8u); } }
    { LOADP(p); LOAD_SL(p); REP(11) peer_u_phase(p, sl); }
    BAR(); STAMP(9);
    { LOADP(p); REP(12) peer_w_phase(p); }
    BAR(); STAMP(10);
    if (PROBE_DBL == 100) { for (int i = 0; i < 10; ++i) BAR(); }
    { LOADP(p); LOAD_SL(p); peer_v_phase(p, sl); }
#if PROBE_SPIN >= 0
    __syncthreads(); STAMP(11);
    if (blockIdx.x == 0 && threadIdx.x == 0) {
        volatile LAS unsigned* tsw = (volatile LAS unsigned*)(LAS unsigned char*)lds + 36800;
        const unsigned long long t0 = (unsigned long long)tsw[2 * PROBE_SPIN] | ((unsigned long long)tsw[2 * PROBE_SPIN + 1] << 32);
        const unsigned long long t1 = (unsigned long long)tsw[2 * PROBE_SPIN + 2] | ((unsigned long long)tsw[2 * PROBE_SPIN + 3] << 32);
        const unsigned long long until = __builtin_amdgcn_s_memrealtime() + (t1 - t0);
        while (__builtin_amdgcn_s_memrealtime() < until) __builtin_amdgcn_s_sleep(8);
    }
#endif
}

extern "C" void kernel_launch(void* const* d_in, const int* in_sizes, int n_in, void* d_out, int out_size, void* d_ws, size_t ws_size, hipStream_t stream) {
    static int grid_blocks = 0;
    if (grid_blocks == 0) {
        if (n_in != 17 || out_size != T * DM || ws_size < WS_END) { fprintf(stderr, "kernel_launch: unexpected shapes n_in %d out %d ws %zu\n", n_in, out_size, ws_size); grid_blocks = -1; return; }
        int dev = 0, cus = 0, per_cu = 0;
        (void)hipGetDevice(&dev);
        (void)hipDeviceGetAttribute(&cus, hipDeviceAttributeMultiprocessorCount, dev);
        (void)hipFuncSetAttribute((const void*)fwd_kernel, hipFuncAttributeMaxDynamicSharedMemorySize, LDS_BYTES);
        (void)hipOccupancyMaxActiveBlocksPerMultiprocessor(&per_cu, (const void*)fwd_kernel, NTHR, LDS_BYTES);
        if (per_cu < 1) { fprintf(stderr, "kernel_launch: occupancy query says %d blocks/CU\n", per_cu); per_cu = 1; }
        grid_blocks = cus * 1;
        (void)hipGetLastError();
    }
    if (grid_blocks < 0) return;
    Params p{};
    p.x = (const float*)d_in[0]; p.mem = (const float*)d_in[1]; p.g_mix = (const float*)d_in[2]; p.w_in = (const float*)d_in[3]; p.gamma_lb = (const float*)d_in[4];
    p.sb_gain = (const float*)d_in[5]; p.hg_gain = (const float*)d_in[6]; p.mem_gain = (const float*)d_in[7]; p.w_mkv = (const float*)d_in[8]; p.mq_gain = (const float*)d_in[9];
    p.mk_gain = (const float*)d_in[10]; p.w_out = (const float*)d_in[11]; p.g_ffn = (const float*)d_in[12]; p.w_q = (const float*)d_in[13]; p.sub_keys = (const float*)d_in[14];
    p.pu = (const float*)d_in[15]; p.pv = (const float*)d_in[16];
    p.out = (float*)d_out; p.ws = (unsigned char*)d_ws;
    (void)hipMemsetAsync((char*)d_ws + WS_CTL, 0, 65536, stream);
    void* args[] = {&p};
    hipError_t e = hipLaunchCooperativeKernel((const void*)fwd_kernel, dim3(grid_blocks), dim3(NTHR), args, LDS_BYTES, stream);
    if (e != hipSuccess) fprintf(stderr, "cooperative launch failed: %s (grid %d)\n", hipGetErrorString(e), grid_blocks);
}
```

```cpp
#include <hip/hip_runtime.h>
#include <hip/hip_cooperative_groups.h>
#include <cstdio>
#include <cstdint>
namespace cg = cooperative_groups;

constexpr int NB = 4, SEQ = 8192, DM = 1024, T = NB * SEQ;
constexpr int NMEM = 256, INW = 3328;
constexpr int C_SBQ = 0, C_SBK = 512, C_SBV = 1024, C_HGQ = 1536, C_HGF = 2048, C_HGI = 2560, C_HGG = 2816, C_MQ = 3072;
constexpr int NEXP = 16384, PK = 128;
constexpr float EPS = 1e-6f;
constexpr float LOG2E = 1.4426950408889634f;
constexpr float C2 = 0.125f * LOG2E;

constexpr float PEER_US = 64.f, PEER_VS = 8.f;
constexpr int NTHR = 512;
constexpr int LDS_BYTES = 147456;

constexpr size_t MiB = 1u << 20;
constexpr size_t WS_CTL = 0;
constexpr size_t WS_WIN_T = 1 * MiB;
constexpr size_t WS_WOUT_T = 8 * MiB;
constexpr size_t WS_WQ_T = 10 * MiB;
constexpr size_t WS_WMKV_T = 14 * MiB;
constexpr size_t WS_SKB = 15 * MiB;
constexpr size_t WS_LB = 15 * MiB + 512 * 1024;
constexpr size_t WS_MEMN = 16 * MiB;
constexpr size_t WS_MEMKV = 18 * MiB;
constexpr size_t WS_MEMK = 20 * MiB;
constexpr size_t WS_MEMV = 20 * MiB + 512 * 1024;
constexpr size_t WS_RSTD2 = 21 * MiB;
constexpr size_t WS_PIDX = 24 * MiB;
constexpr size_t WS_PG = 40 * MiB;
constexpr size_t WS_XB = 72 * MiB;
constexpr size_t WS_MIXED = 136 * MiB;
constexpr size_t WS_P = 200 * MiB;
constexpr size_t WS_Q = 136 * MiB;
constexpr size_t WS_X1S = 270 * MiB;
constexpr size_t WS_SSQ = 22 * MiB;
constexpr size_t WS_HGRAW = 408 * MiB;
constexpr size_t WS_PW = 56 * MiB;
constexpr size_t WS_PU = 136 * MiB;
constexpr size_t WS_U16 = 440 * MiB;
constexpr size_t WS_V16 = 472 * MiB;
constexpr size_t WS_END = 512 * MiB;

typedef unsigned short bf16_t;
__device__ __forceinline__ float bf2f(bf16_t v) { return __uint_as_float(((unsigned)v) << 16); }
__device__ __forceinline__ float bflo(unsigned w) { return __uint_as_float(w << 16); }
__device__ __forceinline__ float bfhi(unsigned w) { return __uint_as_float(w & 0xffff0000u); }
__device__ __forceinline__ bf16_t f2bf(float f) { unsigned u = __float_as_uint(f); return (bf16_t)((u + 0x7fffu + ((u >> 16) & 1u)) >> 16); }
__device__ __forceinline__ unsigned pk2(float lo, float hi) { return (unsigned)f2bf(lo) | ((unsigned)f2bf(hi) << 16); }
__device__ __forceinline__ float wave_sum(float v) {
#pragma unroll
    for (int o = 1; o < 64; o <<= 1) v += __shfl_xor(v, o);
    return v;
}
__device__ __forceinline__ float silu(float v) { return v / (1.f + __expf(-v)); }

typedef unsigned u4_t __attribute__((ext_vector_type(4)));
typedef float f32x4_t __attribute__((ext_vector_type(4)));
typedef float float2_t __attribute__((ext_vector_type(2)));
typedef _Float16 h8_t __attribute__((ext_vector_type(8)));
typedef _Float16 h2_t __attribute__((ext_vector_type(2)));
typedef _Float16 h4_t __attribute__((ext_vector_type(4)));
typedef unsigned u2_t __attribute__((ext_vector_type(2)));
typedef __bf16 bf16x2_v __attribute__((ext_vector_type(2)));
__device__ __forceinline__ float dot2bf(unsigned a, unsigned b, float c) { return __builtin_amdgcn_fdot2_f32_bf16(__builtin_bit_cast(bf16x2_v, a), __builtin_bit_cast(bf16x2_v, b), c, false); }

struct Params {
    const float *x, *mem, *g_mix, *w_in, *gamma_lb, *sb_gain, *hg_gain, *mem_gain, *w_mkv, *mq_gain, *mk_gain, *w_out, *g_ffn, *w_q, *sub_keys, *pu, *pv;
    float* out; unsigned char* ws;
};

namespace pg8 {
#define PG8_LAS __attribute__((address_space(3)))
typedef unsigned short bf16_t;
typedef short bf16x8 __attribute__((ext_vector_type(8)));
typedef float f32x4 __attribute__((ext_vector_type(4)));
typedef unsigned u32x4 __attribute__((ext_vector_type(4)));
constexpr int BM = 256, BK = 64, HALF = 128, HTB = HALF * BK * 2  , STAGE_BYTES = 8 * HTB, NXCD = 8, WGM = 8;

__host__ __device__ __forceinline__ int lds_byte(int r, int c) { const int st = (r >> 4) * 2 + (c >> 5), rr = r & 15, cc = c & 31, ob = rr * 64 + cc * 2; return st * 1024 + (ob ^ (((ob >> 9) & 1) << 5)); }
__host__ __device__ __forceinline__ void stage_rc(int b, int& R, int& C) { const int st = b / 1024, sb = b % 1024, swz = sb ^ (((sb >> 9) & 1) << 5); R = (st >> 1) * 16 + swz / 64; C = (st & 1) * 32 + (swz % 64) / 2; }
__host__ __device__ __forceinline__ int perm32(int rho) { const int n = rho >> 4, i = rho & 15; return 8 * (i >> 2) + 4 * n + (i & 3); }

struct Unit { int pm, pn; };
struct Gemm { const bf16_t* A; const bf16_t* Bt; int M, N, K; int lda; size_t kstepA; };

struct StaticOrder {
    int nM, nN, nwg, G, c;
    __host__ __device__ void init(int M, int N, int G_, int c_) { nM = M / BM; nN = N / BM; nwg = nM * nN; G = G_; c = c_; }
    __host__ __device__ bool next(int i, Unit& u) const {
        const long L = (long)i * G + c; if (L >= nwg) return false;
        int wgid = (int)L; { const int q = nwg / NXCD, r = nwg % NXCD, xcd = wgid % NXCD, off = wgid / NXCD; wgid = (xcd < r ? xcd * (q + 1) : r * (q + 1) + (xcd - r) * q) + off; }
        const int nig = WGM * nN, gid = wgid / nig, fm = gid * WGM, gsz = (nM - fm) < WGM ? (nM - fm) : WGM;
        u.pm = fm + ((wgid % nig) % gsz); u.pn = (wgid % nig) / gsz; return true;
    }
    __device__ __forceinline__ void a_ready(const Unit&) const {}
    __device__ __forceinline__ void done(const Unit&) const {}
};

__device__ __forceinline__ unsigned cvt_pk_bf16(float lo, float hi) { unsigned r; asm volatile("v_cvt_pk_bf16_f32 %0, %1, %2" : "=v"(r) : "v"(lo), "v"(hi)); return r; }
typedef float f32x2 __attribute__((ext_vector_type(2)));
template <class Epi, class Sched, bool ALIGN_EPI = false, bool SP2 = false>
__device__ __forceinline__ void gemm_phase(PG8_LAS unsigned char* lds, const Gemm g, const Sched& S, const Epi& E) {
    int tid_ = threadIdx.x; asm volatile("" : "+v"(tid_));
    const int tid = tid_, wid = __builtin_amdgcn_readfirstlane(tid >> 6), lane = tid & 63, wr = wid >> 2, wc = wid & 3, fr = lane & 15, fq = lane >> 4;
    const int K = g.K, nt = K / BK;
    unsigned voffA[2], voffB[2];
#pragma unroll
    for (int i = 0; i < 2; ++i) { int R, C; stage_rc(tid * 16 + i * 8192, R, C); const int Rb = Epi::PERM ? ((R & ~31) + perm32(R & 31)) : R;
        voffA[i] = (unsigned)(R * g.lda + C) * 2u; voffB[i] = (unsigned)(Rb * K + C) * 2u; }
    const size_t kstep = (size_t)(BK * 2);
    const size_t hstep = (size_t)HALF * K * 2;
    const size_t tstep = 2 * hstep;
    const size_t kstepA = g.kstepA, hstepA = (size_t)HALF * g.lda * 2, tstepA = 2 * hstepA;
    const unsigned ldsw = (unsigned)wid * 1024u;
    const int aoff = lds_byte(wr * 64 + fr, fq * 8), boff = lds_byte(wc * 32 + fr, fq * 8);
#define PG8_SA(b, h) (((b) * 2 + (h)) * HTB)
#define PG8_SB(b, h) ((4 + (b) * 2 + (h)) * HTB)
#define PG8_STAGE(bufoff, gbase, voff) do { _Pragma("unroll") for (int _i = 0; _i < 2; ++_i) \
        __builtin_amdgcn_global_load_lds((const unsigned*)((const char*)(gbase) + (voff)[_i]), (PG8_LAS unsigned*)(lds + (bufoff) + ldsw + _i * 8192), 16, 0, 0); } while (0)
#define PG8_LDA(dst, b, h) do { _Pragma("unroll") for (int m = 0; m < 4; ++m) _Pragma("unroll") for (int k = 0; k < 2; ++k) dst[m][k] = *(const PG8_LAS bf16x8*)(lds + PG8_SA(b, h) + aoff + m * 2048 + k * 1024); } while (0)
#define PG8_LDB(dst, b, h) do { _Pragma("unroll") for (int n = 0; n < 2; ++n) _Pragma("unroll") for (int k = 0; k < 2; ++k) dst[n][k] = *(const PG8_LAS bf16x8*)(lds + PG8_SB(b, h) + boff + n * 2048 + k * 1024); } while (0)
#define PG8_MMA(ai, bj, At, Bt) do { __builtin_amdgcn_s_setprio(1); _Pragma("unroll") for (int m = 0; m < 4; ++m) _Pragma("unroll") for (int n = 0; n < 2; ++n) _Pragma("unroll") for (int k = 0; k < 2; ++k) \
        acc[ai][bj][m][n] = __builtin_amdgcn_mfma_f32_16x16x32_bf16(Bt[n][k], At[m][k], acc[ai][bj][m][n], 0, 0, 0); __builtin_amdgcn_s_setprio(0); } while (0)
#define PG8_WAIT_V(n) asm volatile("s_waitcnt vmcnt(" #n ")" ::: "memory")
#define PG8_WAIT_L(n) asm volatile("s_waitcnt lgkmcnt(" #n ")" ::: "memory")
#define PG8_BAR __builtin_amdgcn_s_barrier()
#define PG8_SCHED __builtin_amdgcn_sched_barrier(0)
    Unit cur, nxt; int ui = 0;
    if (!S.next(0, cur)) return;
    f32x4 acc[2][2][4][2];
#pragma unroll
    for (int a = 0; a < 2; ++a)
#pragma unroll
        for (int b = 0; b < 2; ++b)
#pragma unroll
            for (int m = 0; m < 4; ++m)
#pragma unroll
                for (int n = 0; n < 2; ++n) acc[a][b][m][n] = (f32x4){0.f, 0.f, 0.f, 0.f};
    bf16x8 At[4][2], B0[2][2], B1[2][2];
    const char* cA = (const char*)g.A + (size_t)cur.pm * tstepA; const char* cB = (const char*)g.Bt + (size_t)cur.pn * tstep;
    S.a_ready(cur);
    if constexpr (SP2) {
        PG8_STAGE(PG8_SB(0, 0), cB, voffB); PG8_STAGE(PG8_SB(0, 1), cB + hstep, voffB); PG8_STAGE(PG8_SA(0, 0), cA, voffA); PG8_STAGE(PG8_SA(0, 1), cA + hstepA, voffA);
        if (wr == 1) PG8_BAR;
        PG8_WAIT_V(2); PG8_BAR;
        PG8_STAGE(PG8_SB(1, 0), cB + kstep, voffB); PG8_STAGE(PG8_SA(1, 0), cA + kstepA, voffA); PG8_STAGE(PG8_SB(1, 1), cB + hstep + kstep, voffB);
        PG8_WAIT_V(6); PG8_BAR;
    } else {
        PG8_STAGE(PG8_SB(0, 0), cB, voffB); PG8_STAGE(PG8_SA(0, 0), cA, voffA); PG8_STAGE(PG8_SB(0, 1), cB + hstep, voffB); PG8_STAGE(PG8_SA(0, 1), cA + hstepA, voffA);
        if (wr == 1) PG8_BAR;
        PG8_WAIT_V(4); PG8_BAR;
        PG8_STAGE(PG8_SB(1, 0), cB + kstep, voffB); PG8_STAGE(PG8_SA(1, 0), cA + kstepA, voffA); PG8_STAGE(PG8_SB(1, 1), cB + hstep + kstep, voffB);
        PG8_WAIT_V(6); PG8_BAR;
    }
    for (;;) {
        const bool has_next = S.next(ui + 1, nxt);
        const char* nA = has_next ? (const char*)g.A + (size_t)nxt.pm * tstepA : cA; const char* nB = has_next ? (const char*)g.Bt + (size_t)nxt.pn * tstep : cB;
        for (int t = 0; t < nt; t += 2) {
            const bool last = (t == nt - 2);
            const char* a1 = cA + (size_t)(t + 1) * kstepA;
            const char* a2 = last ? nA : cA + (size_t)(t + 2) * kstepA; const char* b2 = last ? nB : cB + (size_t)(t + 2) * kstep;
            const char* a3 = a2 + kstepA; const char* b3 = b2 + kstep;
            if (last && has_next) S.a_ready(nxt);
            if constexpr (SP2) {
            PG8_LDB(B0, 0, 0); PG8_LDB(B1, 0, 1); PG8_SCHED; PG8_LDA(At, 0, 0); PG8_STAGE(PG8_SA(1, 1), a1 + hstepA, voffA);
            PG8_WAIT_V(8); PG8_WAIT_L(0); PG8_BAR; PG8_MMA(0, 0, At, B0); PG8_MMA(0, 1, At, B1); PG8_BAR; PG8_SCHED;
            PG8_LDA(At, 0, 1); PG8_STAGE(PG8_SB(0, 0), b2, voffB); PG8_STAGE(PG8_SB(0, 1), b2 + hstep, voffB); PG8_STAGE(PG8_SA(0, 0), a2, voffA);
            PG8_WAIT_V(8); PG8_WAIT_L(0); PG8_BAR; PG8_MMA(1, 0, At, B0); PG8_MMA(1, 1, At, B1); PG8_BAR; PG8_SCHED;
            PG8_LDB(B0, 1, 0); PG8_LDB(B1, 1, 1); PG8_SCHED; PG8_LDA(At, 1, 0); PG8_STAGE(PG8_SA(0, 1), a2 + hstepA, voffA);
            PG8_WAIT_V(8); PG8_WAIT_L(0); PG8_BAR; PG8_MMA(0, 0, At, B0); PG8_MMA(0, 1, At, B1); PG8_BAR; PG8_SCHED;
            PG8_LDA(At, 1, 1); PG8_STAGE(PG8_SB(1, 0), b3, voffB); PG8_STAGE(PG8_SB(1, 1), b3 + hstep, voffB); PG8_STAGE(PG8_SA(1, 0), a3, voffA);
            PG8_WAIT_V(8); PG8_WAIT_L(0); PG8_BAR; PG8_MMA(1, 0, At, B0); PG8_MMA(1, 1, At, B1); PG8_BAR; PG8_SCHED;
            } else {
            PG8_LDB(B0, 0, 0); PG8_SCHED; PG8_LDA(At, 0, 0); PG8_STAGE(PG8_SA(1, 1), a1 + hstepA, voffA);
            PG8_WAIT_L(8); PG8_BAR; PG8_WAIT_L(0); PG8_MMA(0, 0, At, B0); PG8_BAR; PG8_SCHED;
            PG8_LDB(B1, 0, 1); PG8_STAGE(PG8_SB(0, 0), b2, voffB);
            PG8_BAR; PG8_WAIT_L(0); PG8_MMA(0, 1, At, B1); PG8_BAR;
            PG8_LDA(At, 0, 1); PG8_STAGE(PG8_SA(0, 0), a2, voffA);
            PG8_BAR; PG8_WAIT_L(0); PG8_MMA(1, 0, At, B0); PG8_BAR; PG8_SCHED;
            PG8_STAGE(PG8_SB(0, 1), b2 + hstep, voffB);
            PG8_WAIT_V(6); PG8_BAR; PG8_MMA(1, 1, At, B1); PG8_BAR;
            PG8_LDB(B0, 1, 0); PG8_SCHED; PG8_LDA(At, 1, 0); PG8_STAGE(PG8_SA(0, 1), a2 + hstepA, voffA);
            PG8_WAIT_L(8); PG8_BAR; PG8_WAIT_L(0); PG8_MMA(0, 0, At, B0); PG8_BAR; PG8_SCHED;
            PG8_LDB(B1, 1, 1); PG8_STAGE(PG8_SB(1, 0), b3, voffB);
            PG8_BAR; PG8_WAIT_L(0); PG8_MMA(0, 1, At, B1); PG8_BAR;
            PG8_LDA(At, 1, 1); PG8_STAGE(PG8_SA(1, 0), a3, voffA);
            PG8_BAR; PG8_WAIT_L(0); PG8_MMA(1, 0, At, B0); PG8_BAR; PG8_SCHED;
            PG8_STAGE(PG8_SB(1, 1), b3 + hstep, voffB);
            PG8_WAIT_V(6); PG8_BAR; PG8_MMA(1, 1, At, B1); PG8_BAR;
            }
        }
        if constexpr (ALIGN_EPI) { if (wr == 0) PG8_BAR; }
        if constexpr (!Epi::AFTER_DRAIN) { E(acc, cur, wr, wc, fr, fq); S.done(cur); }
        if (!has_next) break;
#pragma unroll
        for (int a = 0; a < 2; ++a)
#pragma unroll
            for (int b = 0; b < 2; ++b)
#pragma unroll
                for (int m = 0; m < 4; ++m)
#pragma unroll
                    for (int n = 0; n < 2; ++n) acc[a][b][m][n] = (f32x4){0.f, 0.f, 0.f, 0.f};
        cur = nxt; cA = nA; cB = nB; ++ui;
        if constexpr (ALIGN_EPI) { if (wr == 1) PG8_BAR; }
    }
    PG8_WAIT_V(0);
    if constexpr (!ALIGN_EPI) { if (wr == 0) PG8_BAR; }
    PG8_BAR;
    if constexpr (Epi::AFTER_DRAIN) { E.fused(acc, cur, wr, wc, fr, fq, lds, wid, lane); S.done(cur); }
#undef PG8_SA
#undef PG8_SB
#undef PG8_STAGE
#undef PG8_LDA
#undef PG8_LDB
#undef PG8_MMA
#undef PG8_WAIT_V
#undef PG8_WAIT_L
#undef PG8_BAR
#undef PG8_SCHED
}
}


namespace pg8 {
typedef unsigned u32x4 __attribute__((ext_vector_type(4)));
struct EpiProjM {
    static constexpr bool PERM = true, AFTER_DRAIN = false;
    bf16_t* P;
    __device__ __forceinline__ void operator()(const f32x4 (&acc)[2][2][4][2], const Unit& u, int wr, int wc, int fr, int fq) const {
        const int row0 = u.pm * BM + wr * 64 + fr, col0 = u.pn * BM + wc * 32 + 8 * fq;
        const int pn = u.pn; const int mode = (pn < 2) ? 1 : ((pn == 6 || pn == 7 || pn == 11) ? 2 : 0);
#pragma unroll
        for (int ai = 0; ai < 2; ++ai)
#pragma unroll
            for (int m = 0; m < 4; ++m) { bf16_t* rowp = P + (size_t)(row0 + ai * HALF + m * 16) * INW + col0;
#pragma unroll
                for (int bj = 0; bj < 2; ++bj) { f32x4 v0 = acc[ai][bj][m][0], v1 = acc[ai][bj][m][1];
                    if (mode == 1) { v0 = v0 * C2; v1 = v1 * C2; }
                    else if (mode == 2) {
#pragma unroll
                        for (int e = 0; e < 4; ++e) { v0[e] = silu(v0[e]); v1[e] = silu(v1[e]); } }
                    u32x4 w; w.x = cvt_pk_bf16(v0[0], v0[1]); w.y = cvt_pk_bf16(v0[2], v0[3]); w.z = cvt_pk_bf16(v1[0], v1[1]); w.w = cvt_pk_bf16(v1[2], v1[3]);
                    *(u32x4*)(rowp + bj * HALF) = w; } }
    }
};
struct EpiF32M {
    static constexpr bool PERM = true, AFTER_DRAIN = false;
    float* O; int ld;
    __device__ __forceinline__ void operator()(const f32x4 (&acc)[2][2][4][2], const Unit& u, int wr, int wc, int fr, int fq) const {
        const int row0 = u.pm * BM + wr * 64 + fr, col0 = u.pn * BM + wc * 32 + 8 * fq;
#pragma unroll
        for (int ai = 0; ai < 2; ++ai)
#pragma unroll
            for (int m = 0; m < 4; ++m) { float* rowp = O + (size_t)(row0 + ai * HALF + m * 16) * ld + col0;
#pragma unroll
                for (int bj = 0; bj < 2; ++bj) { *(f32x4*)(rowp + bj * HALF) = acc[ai][bj][m][0]; *(f32x4*)(rowp + bj * HALF + 4) = acc[ai][bj][m][1]; } }
    }
};
struct EpiWoutM {
    static constexpr bool PERM = true, AFTER_DRAIN = false;
    const float* x; bf16_t* x1bs; float* ssq;
    __device__ __forceinline__ void operator()(const f32x4 (&acc)[2][2][4][2], const Unit& u, int wr, int wc, int fr, int fq) const {
        const int row0 = u.pm * BM + wr * 64 + fr, col0 = u.pn * BM + wc * 32 + 8 * fq;
#pragma unroll
        for (int ai = 0; ai < 2; ++ai)
#pragma unroll
            for (int m = 0; m < 4; ++m) { const int row = row0 + ai * HALF + m * 16; const size_t rb = (size_t)row * DM + col0; float sq = 0.f;
#pragma unroll
                for (int bj = 0; bj < 2; ++bj) { const size_t i = rb + bj * HALF;
                    const f32x4 v0 = acc[ai][bj][m][0] + *(const f32x4*)(x + i), v1 = acc[ai][bj][m][1] + *(const f32x4*)(x + i + 4);
                    sq += (v0[0] * v0[0] + v0[1] * v0[1]) + (v0[2] * v0[2] + v0[3] * v0[3]) + (v1[0] * v1[0] + v1[1] * v1[1]) + (v1[2] * v1[2] + v1[3] * v1[3]);
                    const int col = col0 + bj * HALF, s = (col >> 5) & 15, j = ((col >> 9) << 5) | (col & 31);
                    const size_t o = ((size_t)s * T + row) * 64 + j;
                    u32x4 w; w.x = cvt_pk_bf16(v0[0], v0[1]); w.y = cvt_pk_bf16(v0[2], v0[3]); w.z = cvt_pk_bf16(v1[0], v1[1]); w.w = cvt_pk_bf16(v1[2], v1[3]);
                    *(u32x4*)(x1bs + o) = w; }
                sq += __shfl_xor(sq, 16); sq += __shfl_xor(sq, 32);
                if (fq == 0) ssq[(size_t)row * 16 + u.pn * 4 + wc] = sq; }
    }
};
struct EpiQM {
    static constexpr bool PERM = true, AFTER_DRAIN = false;
    bf16_t* Q; int ld;
    __device__ __forceinline__ void operator()(const f32x4 (&acc)[2][2][4][2], const Unit& u, int wr, int wc, int fr, int fq) const {
        const int row0 = u.pm * BM + wr * 64 + fr, col0 = u.pn * BM + wc * 32 + 8 * fq;
#pragma unroll
        for (int ai = 0; ai < 2; ++ai)
#pragma unroll
            for (int m = 0; m < 4; ++m) { const int row = row0 + ai * HALF + m * 16; bf16_t* rowp = Q + (size_t)row * ld + col0;
#pragma unroll
                for (int bj = 0; bj < 2; ++bj) { const f32x4 v0 = acc[ai][bj][m][0], v1 = acc[ai][bj][m][1];
                    u32x4 w; w.x = cvt_pk_bf16(v0[0], v0[1]); w.y = cvt_pk_bf16(v0[2], v0[3]); w.z = cvt_pk_bf16(v1[0], v1[1]); w.w = cvt_pk_bf16(v1[2], v1[3]);
                    *(u32x4*)(rowp + bj * HALF) = w; } }
    }
};
}

#define LAS __attribute__((address_space(3)))
#define XB_TMO      128
#define XB_XCNT(j)  (256  + 64 * (j))
#define XB_XSUB(j)  (1280 + 64 * (j))
#define XB_XGEN(j)  (2304 + 64 * (j))
#define XB_TOP      3328
#define XB_TOPGEN   3392
#define XCD_BAR_WORDS 3456
#define XB_SPIN_CAP (1u << 18)

__device__ __forceinline__ unsigned xb_ld(unsigned* p)              { return __hip_atomic_load(p, __ATOMIC_RELAXED, __HIP_MEMORY_SCOPE_AGENT); }
__device__ __forceinline__ unsigned xb_add(unsigned* p, unsigned v) { return __hip_atomic_fetch_add(p, v, __ATOMIC_RELAXED, __HIP_MEMORY_SCOPE_AGENT); }
__device__ __forceinline__ unsigned xb_xcc_id() { return (unsigned)__builtin_amdgcn_s_getreg((3 << 11) | 20) & 0xFu; }
#define XB_SPIN(cond, bar) do { unsigned _sp = 0; while (cond) { __builtin_amdgcn_s_sleep(1); \
    if ((++_sp & 255u) == 0u) { if (xb_ld(&(bar)[XB_TMO])) break; if (_sp > XB_SPIN_CAP) { atomicAdd(&(bar)[XB_TMO], 1u); break; } } } } while (0)

struct XcdBarrier {
    unsigned* bar; unsigned x;
    volatile LAS unsigned* st;
};

__device__ __forceinline__ XcdBarrier xcd_barrier_post(unsigned* bar, volatile LAS unsigned* st) {
    XcdBarrier b; b.bar = bar; b.x = xb_xcc_id(); b.st = st;
    if (threadIdx.x == 0) (void)xb_add(&bar[XB_XCNT(b.x)], 1u);
    return b;
}
__device__ __forceinline__ void xcd_barrier_complete(unsigned* bar, unsigned x, unsigned& nloc, unsigned& nx) {
    const unsigned G = gridDim.x * gridDim.y * gridDim.z;
    unsigned sum, cnt, mine, sp = 0u;
    for (;;) {
        sum = 0u; cnt = 0u; mine = 0u;
#pragma unroll
        for (unsigned j = 0; j < 16; ++j) { const unsigned c = xb_ld(&bar[XB_XCNT(j)]); sum += c; cnt += (c > 0u) ? 1u : 0u; mine = (j == x) ? c : mine; }
        if (sum == G) break;
        __builtin_amdgcn_s_sleep(1);
        if ((++sp & 255u) == 0u) { if (xb_ld(&bar[XB_TMO])) break; if (sp > XB_SPIN_CAP) { atomicAdd(&bar[XB_TMO], 1u); break; } }
    }
    nloc = mine > 0u ? mine : 1u; nx = cnt > 0u ? cnt : 1u;
}

__device__ __forceinline__ void xcd_barrier(const XcdBarrier& b) {
    asm volatile("s_waitcnt vmcnt(0)" ::: "memory");
    __syncthreads();
    if (threadIdx.x == 0) {
        unsigned* bar = b.bar;
        __builtin_amdgcn_s_waitcnt(0);
        unsigned nloc = b.st[0], nx = b.st[1];
        if (nloc == 0u) { xcd_barrier_complete(bar, b.x, nloc, nx); b.st[0] = nloc; b.st[1] = nx; }
        const unsigned old = xb_add(&bar[XB_XSUB(b.x)], 1u);
        const unsigned gen = old / nloc;
        if (old + 1u == (gen + 1u) * nloc) {
            __builtin_amdgcn_fence(__ATOMIC_RELEASE, "agent");
            asm volatile("s_waitcnt vmcnt(0)" ::: "memory");
            const unsigned og = xb_add(&bar[XB_TOP], 1u);
            const unsigned tg = og / nx;
            if (og + 1u == (tg + 1u) * nx) xb_add(&bar[XB_TOPGEN], 1u);
            else XB_SPIN(xb_ld(&bar[XB_TOPGEN]) == tg, bar);
            __builtin_amdgcn_fence(__ATOMIC_ACQUIRE, "agent");
            xb_add(&bar[XB_XGEN(b.x)], 1u);
            asm volatile("s_waitcnt vmcnt(0)" ::: "memory");
        } else {
            XB_SPIN(xb_ld(&bar[XB_XGEN(b.x)]) == gen, bar);
            __builtin_amdgcn_fence(__ATOMIC_ACQUIRE, "agent");
            asm volatile("s_waitcnt vmcnt(0)" ::: "memory");
        }
    }
    __syncthreads();
}

template <bool SLICEK = false> __device__ __forceinline__ void transpose_item(const float* W, const float* gain, int K, int N, bf16_t* WT, float* scr, int item, int lane) {
    const int nblk = N / 32, kb = item / nblk, nb = item % nblk, k0 = 64 * kb, n0 = 32 * nb;
    for (int i = 0; i < 32; ++i) { const int kk = 2 * i + (lane >> 5); const int ks = SLICEK ? ((kk >> 5) * 512 + 32 * kb + (kk & 31)) : (k0 + kk); float g = gain ? gain[ks] : 1.f; scr[kk * 33 + (lane & 31)] = W[(size_t)ks * N + n0 + (lane & 31)] * g; }
    __builtin_amdgcn_s_waitcnt(0); __builtin_amdgcn_wave_barrier();
    const int c = lane & 7;
#pragma unroll
    for (int j = 0; j < 4; ++j) { const int n = (lane >> 3) + 8 * j; const float* s = scr + (8 * c) * 33 + n;
        uint4 o; o.x = pk2(s[0 * 33], s[1 * 33]); o.y = pk2(s[2 * 33], s[3 * 33]); o.z = pk2(s[4 * 33], s[5 * 33]); o.w = pk2(s[6 * 33], s[7 * 33]);
        *(uint4*)(WT + (size_t)(n0 + n) * K + k0 + 8 * c) = o; }
    __builtin_amdgcn_s_waitcnt(0); __builtin_amdgcn_wave_barrier();
}
__device__ __forceinline__ void norm_row_to_bf16(const float* xrow, bf16_t* orow, int lane) {
    const float4* xr = (const float4*)xrow + lane;
    float4 v[4]; float s = 0.f;
#pragma unroll
    for (int j = 0; j < 4; ++j) { v[j] = xr[64 * j]; s += (v[j].x * v[j].x + v[j].y * v[j].y) + (v[j].z * v[j].z + v[j].w * v[j].w); }
    const float rstd = rsqrtf(wave_sum(s) * (1.f / DM) + EPS);
    unsigned long long* o8 = (unsigned long long*)orow + lane;
#pragma unroll
    for (int j = 0; j < 4; ++j) o8[64 * j] = (unsigned long long)pk2(v[j].x * rstd, v[j].y * rstd) | ((unsigned long long)pk2(v[j].z * rstd, v[j].w * rstd) << 32);
}
__device__ __forceinline__ void phase_prep(const Params& p, unsigned char* lds) {
    const int tid = threadIdx.x, lane = tid & 63, wave = tid >> 6;
    const int gw = blockIdx.x * 8 + wave, NGW = gridDim.x * 8;
    const int gt = blockIdx.x * NTHR + tid, NGT = gridDim.x * NTHR;
    unsigned char* ws = p.ws;
    float* scr = (float*)lds + wave * (64 * 33);
    constexpr int I_IN = (DM / 64) * (INW / 32), I_OUT = (DM / 64) * (DM / 32), I_Q = (DM / 64) * (2048 / 32), I_MKV = (DM / 64) * (512 / 32);
    for (int it = gw; it < I_IN + I_OUT + I_Q + I_MKV; it += NGW) {
        int r = it;
        if (r < I_IN) { transpose_item(p.w_in, p.g_mix, DM, INW, (bf16_t*)(ws + WS_WIN_T), scr, r, lane); continue; } r -= I_IN;
        if (r < I_OUT) { transpose_item(p.w_out, nullptr, DM, DM, (bf16_t*)(ws + WS_WOUT_T), scr, r, lane); continue; } r -= I_OUT;
        if (r < I_Q) { transpose_item<true>(p.w_q, p.g_ffn, DM, 2048, (bf16_t*)(ws + WS_WQ_T), scr, r, lane); continue; } r -= I_Q;
        transpose_item(p.w_mkv, p.mem_gain, DM, 512, (bf16_t*)(ws + WS_WMKV_T), scr, r, lane);
    }
    for (int m = gw; m < T; m += NGW) norm_row_to_bf16(p.x + (size_t)m * DM, (bf16_t*)(ws + WS_XB) + (size_t)m * DM, lane);
    for (int m = gw; m < NB * NMEM; m += NGW) norm_row_to_bf16(p.mem + (size_t)m * DM, (bf16_t*)(ws + WS_MEMN) + (size_t)m * DM, lane);
    for (int i = gt; i < 8 * 2 * 128 * 128; i += NGT) ((bf16_t*)(ws + WS_SKB))[i] = f2bf(p.sub_keys[i]);
    for (int i = gt; i < NEXP * 8 * 8; i += NGT) {
        const int c = i & 7, S = (i >> 3) & 7, e = i >> 6;
        const int s16 = 2 * S + (c >> 2), j0 = (c & 3) * 16, d0 = (j0 >> 5) * 512 + 32 * s16 + (j0 & 31);
        const f32x4_t* up = (const f32x4_t*)(p.pu + (size_t)e * DM + d0); const f32x4_t* vp = (const f32x4_t*)(p.pv + (size_t)e * DM + d0); const f32x4_t* gp = (const f32x4_t*)(p.g_ffn + d0);
        u4_t uo, vo;
#pragma unroll
        for (int q = 0; q < 4; ++q) { const f32x4_t a = __builtin_nontemporal_load(up + q), g = gp[q], b = __builtin_nontemporal_load(vp + q);
            int w = 0; w = __builtin_amdgcn_cvt_pk_fp8_f32(a.x * g.x * PEER_US, a.y * g.y * PEER_US, w, false); w = __builtin_amdgcn_cvt_pk_fp8_f32(a.z * g.z * PEER_US, a.w * g.w * PEER_US, w, true); uo[q] = (unsigned)w;
            int z = 0; z = __builtin_amdgcn_cvt_pk_fp8_f32(b.x * PEER_VS, b.y * PEER_VS, z, false); z = __builtin_amdgcn_cvt_pk_fp8_f32(b.z * PEER_VS, b.w * PEER_VS, z, true); vo[q] = (unsigned)z; }
        *(u4_t*)(ws + WS_U16 + ((size_t)S * NEXP + e) * 128 + 16 * c) = uo;
        *(u4_t*)(ws + WS_V16 + ((size_t)S * NEXP + e) * 128 + 16 * c) = vo;
    }
    for (int i = gt; i < 512; i += NGT) ((float*)(ws + WS_LB))[i] = 1.f / (1.f + expf(p.gamma_lb[512 + i] - p.gamma_lb[i]));
}

template <class Epi>
__device__ __forceinline__ void gemm_naive(const bf16_t* A, const bf16_t* Bt, int M, int N, int K, unsigned char* ldsb, const Epi& epi) {
    float* As = (float*)ldsb;
    float* Bs = As + 32 * 132;
    const int tid = threadIdx.x, ty = tid >> 4, tx = tid & 15;
    const int ntm = M / 128, ntn = N / 64;
    for (int tile = blockIdx.x; tile < ntm * ntn; tile += gridDim.x) {
        const int tm = tile / ntn, tn = tile % ntn;
        float acc[4][4];
#pragma unroll
        for (int i = 0; i < 4; ++i)
#pragma unroll
            for (int j = 0; j < 4; ++j) acc[i][j] = 0.f;
        for (int k0 = 0; k0 < K; k0 += 32) {
            { const int r = tid >> 2, kq = (tid & 3) * 8;
              const uint4 v = *(const uint4*)(A + (size_t)(tm * 128 + r) * K + k0 + kq);
              As[(kq + 0) * 132 + r] = bflo(v.x); As[(kq + 1) * 132 + r] = bfhi(v.x); As[(kq + 2) * 132 + r] = bflo(v.y); As[(kq + 3) * 132 + r] = bfhi(v.y);
              As[(kq + 4) * 132 + r] = bflo(v.z); As[(kq + 5) * 132 + r] = bfhi(v.z); As[(kq + 6) * 132 + r] = bflo(v.w); As[(kq + 7) * 132 + r] = bfhi(v.w); }
            if (tid < 256) { const int r = tid >> 2, kq = (tid & 3) * 8;
              const uint4 v = *(const uint4*)(Bt + (size_t)(tn * 64 + r) * K + k0 + kq);
              Bs[(kq + 0) * 68 + r] = bflo(v.x); Bs[(kq + 1) * 68 + r] = bfhi(v.x); Bs[(kq + 2) * 68 + r] = bflo(v.y); Bs[(kq + 3) * 68 + r] = bfhi(v.y);
              Bs[(kq + 4) * 68 + r] = bflo(v.z); Bs[(kq + 5) * 68 + r] = bfhi(v.z); Bs[(kq + 6) * 68 + r] = bflo(v.w); Bs[(kq + 7) * 68 + r] = bfhi(v.w); }
            __syncthreads();
#pragma unroll 8
            for (int k = 0; k < 32; ++k) {
                const float4 a = *(const float4*)(As + k * 132 + ty * 4); const float4 b = *(const float4*)(Bs + k * 68 + tx * 4);
                const float av[4] = {a.x, a.y, a.z, a.w}, bv[4] = {b.x, b.y, b.z, b.w};
#pragma unroll
                for (int i = 0; i < 4; ++i)
#pragma unroll
                    for (int j = 0; j < 4; ++j) acc[i][j] = fmaf(av[i], bv[j], acc[i][j]);
            }
            __syncthreads();
        }
#pragma unroll
        for (int i = 0; i < 4; ++i)
#pragma unroll
            for (int j = 0; j < 4; ++j) epi(tm * 128 + ty * 4 + i, tn * 64 + tx * 4 + j, acc[i][j]);
    }
}

struct EpiProj {
    bf16_t* P;
    __device__ __forceinline__ void operator()(int row, int col, float v) const {
        if (col < C_SBK) v *= C2;
        else if (col >= C_HGQ && col < C_HGF) v = silu(v);
        else if (col >= C_HGG && col < C_MQ) v = silu(v);
        P[(size_t)row * INW + col] = f2bf(v);
    }
};
struct EpiF32 { float* O; int ld; __device__ __forceinline__ void operator()(int row, int col, float v) const { O[(size_t)row * ld + col] = v; } };
struct EpiWout { const float* x; float* out; bf16_t* xb;
    __device__ __forceinline__ void operator()(int row, int col, float v) const { const size_t i = (size_t)row * DM + col; const float r = x[i] + v; out[i] = r; xb[i] = f2bf(r); } };
struct EpiQ { const float* rstd; bf16_t* Q;
    __device__ __forceinline__ void operator()(int row, int col, float v) const { Q[(size_t)row * 2048 + col] = f2bf(v * rstd[row]); } };

#ifndef SB_EARLY
#define SB_EARLY 1
#endif
__device__ __forceinline__ void sb_naive(const Params& p) {
    const bf16_t* P = (const bf16_t*)(p.ws + WS_P);
    bf16_t* mixed = (bf16_t*)(p.ws + WS_MIXED);
    for (int row = blockIdx.x * NTHR + threadIdx.x; row < NB * 8 * SEQ; row += gridDim.x * NTHR) {
        const int t = row % SEQ, bh = row / SEQ, h = bh % 8, b = bh / 8;
        const size_t tok = (size_t)b * SEQ + t;
        float q[64], o[64];
        { const uint4* qp = (const uint4*)(P + tok * INW + C_SBQ + h * 64);
#pragma unroll
          for (int j = 0; j < 8; ++j) { const uint4 v = qp[j]; q[8 * j] = bflo(v.x); q[8 * j + 1] = bfhi(v.x); q[8 * j + 2] = bflo(v.y); q[8 * j + 3] = bfhi(v.y); q[8 * j + 4] = bflo(v.z); q[8 * j + 5] = bfhi(v.z); q[8 * j + 6] = bflo(v.w); q[8 * j + 7] = bfhi(v.w); } }
#pragma unroll
        for (int d = 0; d < 64; ++d) o[d] = 0.f;
        float R = 0.f;
        for (int s = t - 1; s >= 0; --s) {
            const uint4* kp = (const uint4*)(P + ((size_t)b * SEQ + s) * INW + C_SBK + h * 64);
            const uint4* vp = (const uint4*)(P + ((size_t)b * SEQ + s) * INW + C_SBV + h * 64);
            float z = 0.f;
#pragma unroll
            for (int j = 0; j < 8; ++j) { const uint4 v = kp[j];
                z = fmaf(q[8 * j], bflo(v.x), z); z = fmaf(q[8 * j + 1], bfhi(v.x), z); z = fmaf(q[8 * j + 2], bflo(v.y), z); z = fmaf(q[8 * j + 3], bfhi(v.y), z);
                z = fmaf(q[8 * j + 4], bflo(v.z), z); z = fmaf(q[8 * j + 5], bfhi(v.z), z); z = fmaf(q[8 * j + 6], bflo(v.w), z); z = fmaf(q[8 * j + 7], bfhi(v.w), z); }
            const float sp = fmaxf(z, 0.f) + log2f(1.f + exp2f(-fabsf(z)));
            const float a = exp2f(z - sp + R);
            R -= sp;
#pragma unroll
            for (int j = 0; j < 8; ++j) { const uint4 v = vp[j];
                o[8 * j] = fmaf(a, bflo(v.x), o[8 * j]); o[8 * j + 1] = fmaf(a, bfhi(v.x), o[8 * j + 1]); o[8 * j + 2] = fmaf(a, bflo(v.y), o[8 * j + 2]); o[8 * j + 3] = fmaf(a, bfhi(v.y), o[8 * j + 3]);
                o[8 * j + 4] = fmaf(a, bflo(v.z), o[8 * j + 4]); o[8 * j + 5] = fmaf(a, bfhi(v.z), o[8 * j + 5]); o[8 * j + 6] = fmaf(a, bflo(v.w), o[8 * j + 6]); o[8 * j + 7] = fmaf(a, bfhi(v.w), o[8 * j + 7]); }
#if SB_EARLY
            if (R < -150.f) break;
#endif
        }
        float ss = 0.f;
#pragma unroll
        for (int d = 0; d < 64; ++d) ss = fmaf(o[d], o[d], ss);
        const float r = rsqrtf(ss * (1.f / 64.f) + EPS);
        uint4* op = (uint4*)(mixed + tok * DM + h * 64);
        const float* g = p.sb_gain + h * 64;
#pragma unroll
        for (int j = 0; j < 8; ++j) { uint4 w; w.x = pk2(o[8 * j] * r * g[8 * j], o[8 * j + 1] * r * g[8 * j + 1]); w.y = pk2(o[8 * j + 2] * r * g[8 * j + 2], o[8 * j + 3] * r * g[8 * j + 3]);
            w.z = pk2(o[8 * j + 4] * r * g[8 * j + 4], o[8 * j + 5] * r * g[8 * j + 5]); w.w = pk2(o[8 * j + 6] * r * g[8 * j + 6], o[8 * j + 7] * r * g[8 * j + 7]); op[j] = w; }
    }
}

__device__ __forceinline__ void hg_naive(const Params& p, unsigned char* ldsb) {
    const bf16_t* P = (const bf16_t*)(p.ws + WS_P);
    float* raw = (float*)(p.ws + WS_HGRAW);
    const float* lbp = (const float*)(p.ws + WS_LB);
    float* red = (float*)ldsb;
    const int tid = threadIdx.x, jj = tid >> 7, k = tid & 127, wave = tid >> 6, lane = tid & 63;
    for (int unit = blockIdx.x; unit < NB * 4 * 16; unit += gridDim.x) {
        const int jg = unit & 15, h = (unit >> 4) & 3, b = unit >> 6;
        const float lb = lbp[h * 128 + k];
        float S = 0.f;
        for (int t0 = 0; t0 < SEQ; t0 += 64) {
            for (int tt = 0; tt < 64; tt += 8) {
                float fl[8], qv[8], iv[8];
#pragma unroll
                for (int u = 0; u < 8; ++u) { const bf16_t* pr = P + ((size_t)b * SEQ + t0 + tt + u) * INW;
                    fl[u] = bf2f(pr[C_HGF + h * 128 + k]); qv[u] = bf2f(pr[C_HGQ + h * 128 + k]); iv[u] = bf2f(pr[C_HGI + h * 64 + jg * 4 + jj]); }
#pragma unroll
                for (int u = 0; u < 8; ++u) {
                    const float f = lb + (1.f - lb) / (1.f + __expf(-fl[u]));
                    S = f * S + (1.f - f) * iv[u];
                    const float part = wave_sum(S * qv[u]);
                    if (lane == 0) red[(tt + u) * 8 + wave] = part;
                }
            }
            __syncthreads();
            if (tid < 256) { const int tt = tid >> 2, j2 = tid & 3;
                raw[((size_t)b * SEQ + t0 + tt) * 256 + h * 64 + jg * 4 + j2] = red[tt * 8 + 2 * j2] + red[tt * 8 + 2 * j2 + 1]; }
            __syncthreads();
        }
    }
}
__device__ __forceinline__ void hg_finish(const Params& p) {
    const bf16_t* P = (const bf16_t*)(p.ws + WS_P);
    const float* raw = (const float*)(p.ws + WS_HGRAW);
    bf16_t* mixed = (bf16_t*)(p.ws + WS_MIXED);
    const int lane = threadIdx.x & 63, wave = threadIdx.x >> 6;
    for (int it = blockIdx.x * 8 + wave; it < T * 4; it += gridDim.x * 8) {
        const int tok = it >> 2, h = it & 3;
        const float o = raw[(size_t)tok * 256 + h * 64 + lane];
        const float r = rsqrtf(wave_sum(o * o) * (1.f / 64.f) + EPS);
        const float g = bf2f(P[(size_t)tok * INW + C_HGG + h * 64 + lane]);
        mixed[(size_t)tok * DM + 512 + h * 64 + lane] = f2bf(o * r * p.hg_gain[h * 64 + lane] * g);
    }
}


typedef float f32x16 __attribute__((ext_vector_type(16)));
typedef short sh8_t __attribute__((ext_vector_type(8)));
__device__ __forceinline__ unsigned cvtpk(float lo, float hi) { unsigned r; asm("v_cvt_pk_bf16_f32 %0, %1, %2" : "=v"(r) : "v"(lo), "v"(hi)); return r; }
__device__ __forceinline__ bf16_t cvt1(float x) { return (bf16_t)(cvtpk(x, x) & 0xffffu); }
__device__ __forceinline__ void mma32(f32x16& acc, const LAS bf16_t* A, int lda, const LAS bf16_t* Bt, int ldb, int K, int lane) {
    const int r = lane & 31, h = lane >> 5;
    const LAS bf16_t* ap = A + r * lda + 8 * h; const LAS bf16_t* bp = Bt + r * ldb + 8 * h;
    for (int k0 = 0; k0 < K; k0 += 16) {
        const sh8_t a = *(const LAS sh8_t*)(ap + k0), b = *(const LAS sh8_t*)(bp + k0);
        acc = __builtin_amdgcn_mfma_f32_32x32x16_bf16(a, b, acc, 0, 0, 0);
    }
}
__device__ __forceinline__ int crow(int r, int hh) { return (r & 3) + 8 * (r >> 2) + 4 * hh; }
constexpr size_t HG_LT = WS_XB;
constexpr size_t HG_SB = 408 * MiB;
constexpr size_t HG_DD = 456 * MiB;
__device__ __forceinline__ void hg_cols(const bf16_t* P, const float* lbp, int b_, int h, int c, LAS float* gs, int tid, float (&kk)[16], float (&bc)[16], float& bmid, float& blast) {
    const int rg = tid >> 7, k = tid & 127;
    const float lb = lbp[h * 128 + k];
    const bf16_t* pr = P + ((size_t)b_ * SEQ + c * 64 + rg * 16) * INW + C_HGF + h * 128 + k;
    float run = 0.f;
#pragma unroll
    for (int i = 0; i < 16; ++i) { const float fl = bf2f(pr[(size_t)i * INW]); const float kv = (1.f - lb) / (1.f + __expf(fl)); kk[i] = kv; run += __logf(1.f - kv); bc[i] = run; }
    gs[rg * 128 + k] = run;
    __syncthreads();
    const float g0 = gs[k], g1 = gs[128 + k], g2 = gs[256 + k], g3 = gs[384 + k];
    const float off = (rg > 0 ? g0 : 0.f) + (rg > 1 ? g1 : 0.f) + (rg > 2 ? g2 : 0.f);
#pragma unroll
    for (int i = 0; i < 16; ++i) bc[i] += off;
    bmid = g0 + g1; blast = (g0 + g1) + (g2 + g3);
}
__device__ __forceinline__ void hg_load_vt(const bf16_t* P, int b_, int h, int c, LAS bf16_t* VT, int tid) {
    const int s = tid >> 3, jq = tid & 7;
    const uint4 v = *(const uint4*)(P + ((size_t)b_ * SEQ + c * 64 + s) * INW + C_HGI + h * 64 + jq * 8);
    LAS bf16_t* d = VT + (jq * 8) * 72 + s;
    d[0 * 72] = (bf16_t)(v.x & 0xffff); d[1 * 72] = (bf16_t)(v.x >> 16); d[2 * 72] = (bf16_t)(v.y & 0xffff); d[3 * 72] = (bf16_t)(v.y >> 16);
    d[4 * 72] = (bf16_t)(v.z & 0xffff); d[5 * 72] = (bf16_t)(v.z >> 16); d[6 * 72] = (bf16_t)(v.w & 0xffff); d[7 * 72] = (bf16_t)(v.w >> 16);
}
__device__ __forceinline__ void hg_local(const Params& p, unsigned char* ldsb) {
    const bf16_t* P = (const bf16_t*)(p.ws + WS_P); const float* lbp = (const float*)(p.ws + WS_LB);
    float* LT = (float*)((unsigned char*)p.ws + HG_LT); float* DD = (float*)((unsigned char*)p.ws + HG_DD);
    LAS unsigned char* l = (LAS unsigned char*)ldsb;
    LAS float* gs = (LAS float*)l; LAS bf16_t* KST = (LAS bf16_t*)(l + 2048); LAS bf16_t* VT = (LAS bf16_t*)(l + 20480);
    const int tid = threadIdx.x, lane = tid & 63, wave = tid >> 6, rg = tid >> 7, k = tid & 127;
    for (int unit = blockIdx.x; unit < 2048; unit += gridDim.x) {
        const int bh = unit >> 7, c = unit & 127, b_ = bh >> 2, h = bh & 3;
        float kk[16], bc[16], bmid, blast;
        hg_cols(P, lbp, b_, h, c, gs, tid, kk, bc, bmid, blast);
        { unsigned w[8];
#pragma unroll
          for (int i = 0; i < 8; ++i) w[i] = cvtpk(kk[2 * i] * __expf(blast - bc[2 * i]), kk[2 * i + 1] * __expf(blast - bc[2 * i + 1]));
          LAS u4_t* d = (LAS u4_t*)(KST + k * 72 + rg * 16);
          d[0] = (u4_t){w[0], w[1], w[2], w[3]}; d[1] = (u4_t){w[4], w[5], w[6], w[7]}; }
        hg_load_vt(P, b_, h, c, VT, tid);
        if (tid < 128) DD[(size_t)unit * 128 + tid] = __expf(blast);
        __syncthreads();
        { const int ji = wave >> 2, ki = wave & 3;
          f32x16 acc;
#pragma unroll
          for (int r = 0; r < 16; ++r) acc[r] = 0.f;
          mma32(acc, VT + 32 * ji * 72, 72, KST + 32 * ki * 72, 72, 64, lane);
          float* o = LT + (size_t)unit * 8192 + 32 * ki + (lane & 31);
#pragma unroll
          for (int r = 0; r < 16; ++r) o[(size_t)(32 * ji + crow(r, lane >> 5)) * 128] = acc[r]; }
        __syncthreads();
    }
}
__device__ __forceinline__ void hg_scan(const Params& p) {
    const float* LT = (const float*)((unsigned char*)p.ws + HG_LT); const float* DD = (const float*)((unsigned char*)p.ws + HG_DD);
    bf16_t* SB = (bf16_t*)((unsigned char*)p.ws + HG_SB);
    for (int gt = blockIdx.x * NTHR + threadIdx.x; gt < 16 * 8192; gt += gridDim.x * NTHR) {
        const int bh = gt >> 13, e = gt & 8191, k = e & 127;
        float S = 0.f;
#pragma unroll 8
        for (int c = 0; c < 128; ++c) { const size_t u = (size_t)bh * 128 + c;
            const float L = LT[u * 8192 + e], D = DD[u * 128 + k];
            SB[u * 8192 + e] = cvt1(S); S = fmaf(D, S, L); }
    }
}
__device__ __forceinline__ void hg_out(const Params& p, unsigned char* ldsb) {
    const bf16_t* P = (const bf16_t*)(p.ws + WS_P); const float* lbp = (const float*)(p.ws + WS_LB);
    const bf16_t* SB = (const bf16_t*)((unsigned char*)p.ws + HG_SB);
    bf16_t* mixed = (bf16_t*)(p.ws + WS_MIXED);
    LAS unsigned char* l = (LAS unsigned char*)ldsb;
    LAS float* gs = (LAS float*)l;
    LAS bf16_t* QT = (LAS bf16_t*)(l + 2048); LAS bf16_t* KT = (LAS bf16_t*)(l + 19456); LAS bf16_t* QI = (LAS bf16_t*)(l + 36864);
    LAS bf16_t* VT = (LAS bf16_t*)(l + 54272); LAS bf16_t* SC = (LAS bf16_t*)(l + 63488); LAS bf16_t* ST = (LAS bf16_t*)(l + 72704);
    LAS float* OB = (LAS float*)(l + 90112);
    const int tid = threadIdx.x, lane = tid & 63, wave = tid >> 6, rg = tid >> 7, k = tid & 127;
    for (int unit = blockIdx.x; unit < 2048; unit += gridDim.x) {
        const int bh = unit >> 7, c = unit & 127, b_ = bh >> 2, h = bh & 3;
        const size_t tok0 = (size_t)b_ * SEQ + c * 64;
        float kk[16], bc[16], bmid, blast;
        hg_cols(P, lbp, b_, h, c, gs, tid, kk, bc, bmid, blast);
        { const bf16_t* qp = P + (tok0 + rg * 16) * INW + C_HGQ + h * 128 + k;
#pragma unroll
          for (int i = 0; i < 16; ++i) { const float q = bf2f(qp[(size_t)i * INW]); const int o = (rg * 16 + i) * 136 + k;
              QT[o] = cvt1(q * __expf(fminf(bc[i] - bmid, 40.f))); KT[o] = cvt1(kk[i] * __expf(fminf(bmid - bc[i], 40.f))); QI[o] = cvt1(q * __expf(bc[i])); } }
        hg_load_vt(P, b_, h, c, VT, tid);
#pragma unroll
        for (int i = 0; i < 2; ++i) { const int idx = tid * 8 + i * 4096, j = idx >> 7, kq = idx & 127;
            *(LAS u4_t*)(ST + j * 136 + kq) = *(const u4_t*)(SB + (size_t)unit * 8192 + idx); }
        __syncthreads();
        if (wave < 4) { const int ti = wave >> 1, si = wave & 1;
            f32x16 acc;
#pragma unroll
            for (int r = 0; r < 16; ++r) acc[r] = 0.f;
            if (si <= ti) mma32(acc, QT + 32 * ti * 136, 136, KT + 32 * si * 136, 136, 128, lane);
            const int s = 32 * si + (lane & 31);
#pragma unroll
            for (int r = 0; r < 16; ++r) { const int t = 32 * ti + crow(r, lane >> 5); SC[t * 72 + s] = cvt1((s <= t) ? acc[r] : 0.f); } }
        __syncthreads();
        if (wave < 4) { const int ti = wave >> 1, ji = wave & 1;
            f32x16 acc;
#pragma unroll
            for (int r = 0; r < 16; ++r) acc[r] = 0.f;
            mma32(acc, SC + 32 * ti * 72, 72, VT + 32 * ji * 72, 72, 64, lane);
            mma32(acc, QI + 32 * ti * 136, 136, ST + 32 * ji * 136, 136, 128, lane);
            const int j = 32 * ji + (lane & 31);
#pragma unroll
            for (int r = 0; r < 16; ++r) OB[(32 * ti + crow(r, lane >> 5)) * 65 + j] = acc[r]; }
        __syncthreads();
        { const int t = tid >> 3, jq = tid & 7;
          float o[8]; float ss = 0.f;
#pragma unroll
          for (int e = 0; e < 8; ++e) { o[e] = OB[t * 65 + jq * 8 + e]; ss = fmaf(o[e], o[e], ss); }
          ss += __shfl_xor(ss, 1); ss += __shfl_xor(ss, 2); ss += __shfl_xor(ss, 4);
          const float r = rsqrtf(ss * (1.f / 64.f) + EPS);
          const uint4 gv = *(const uint4*)(P + (tok0 + t) * INW + C_HGG + h * 64 + jq * 8);
          const float* gn = p.hg_gain + h * 64 + jq * 8;
          uint4 w; w.x = cvtpk(o[0] * r * gn[0] * bflo(gv.x), o[1] * r * gn[1] * bfhi(gv.x)); w.y = cvtpk(o[2] * r * gn[2] * bflo(gv.y), o[3] * r * gn[3] * bfhi(gv.y));
          w.z = cvtpk(o[4] * r * gn[4] * bflo(gv.z), o[5] * r * gn[5] * bfhi(gv.z)); w.w = cvtpk(o[6] * r * gn[6] * bflo(gv.w), o[7] * r * gn[7] * bfhi(gv.w));
          *(uint4*)(mixed + (tok0 + t) * DM + 512 + h * 64 + jq * 8) = w; }
        __syncthreads();
    }
}

__device__ __forceinline__ void mem_knorm(const Params& p) {
    const float* kv = (const float*)(p.ws + WS_MEMKV);
    bf16_t* mk = (bf16_t*)(p.ws + WS_MEMK); bf16_t* mv = (bf16_t*)(p.ws + WS_MEMV);
    const int lane = threadIdx.x & 63, wave = threadIdx.x >> 6;
    for (int it = blockIdx.x * 8 + wave; it < NB * NMEM * 4; it += gridDim.x * 8) {
        const int m = it >> 2, h = it & 3;
        const float kx = kv[(size_t)m * 512 + h * 64 + lane], vx = kv[(size_t)m * 512 + 256 + h * 64 + lane];
        const float r = rsqrtf(wave_sum(kx * kx) * (1.f / 64.f) + EPS);
        mk[(size_t)m * 256 + h * 64 + lane] = f2bf(kx * r * p.mk_gain[lane]);
        mv[(size_t)m * 256 + h * 64 + lane] = f2bf(vx);
    }
}
__device__ __forceinline__ void mem_attn_naive(const Params& p) {
    const bf16_t* P = (const bf16_t*)(p.ws + WS_P);
    const bf16_t* mk = (const bf16_t*)(p.ws + WS_MEMK); const bf16_t* mv = (const bf16_t*)(p.ws + WS_MEMV);
    bf16_t* mixed = (bf16_t*)(p.ws + WS_MIXED);
    for (int idx = blockIdx.x * NTHR + threadIdx.x; idx < 4 * T; idx += gridDim.x * NTHR) {
        const int h = idx / T, tok = idx % T, b = tok / SEQ;
        float q[64], o[64];
        { const uint4* qp = (const uint4*)(P + (size_t)tok * INW + C_MQ + h * 64);
#pragma unroll
          for (int j = 0; j < 8; ++j) { const uint4 v = qp[j]; q[8 * j] = bflo(v.x); q[8 * j + 1] = bfhi(v.x); q[8 * j + 2] = bflo(v.y); q[8 * j + 3] = bfhi(v.y); q[8 * j + 4] = bflo(v.z); q[8 * j + 5] = bfhi(v.z); q[8 * j + 6] = bflo(v.w); q[8 * j + 7] = bfhi(v.w); } }
        float ss = 0.f;
#pragma unroll
        for (int d = 0; d < 64; ++d) ss = fmaf(q[d], q[d], ss);
        const float r = rsqrtf(ss * (1.f / 64.f) + EPS) * 0.125f;
#pragma unroll
        for (int d = 0; d < 64; ++d) { q[d] *= r * p.mq_gain[d]; o[d] = 0.f; }
        float mx = -1e30f, l = 0.f;
        for (int m = 0; m < NMEM; ++m) {
            const uint4* kp = (const uint4*)(mk + ((size_t)b * NMEM + m) * 256 + h * 64);
            const uint4* vp = (const uint4*)(mv + ((size_t)b * NMEM + m) * 256 + h * 64);
            float z = 0.f;
#pragma unroll
            for (int j = 0; j < 8; ++j) { const uint4 v = kp[j];
                z = fmaf(q[8 * j], bflo(v.x), z); z = fmaf(q[8 * j + 1], bfhi(v.x), z); z = fmaf(q[8 * j + 2], bflo(v.y), z); z = fmaf(q[8 * j + 3], bfhi(v.y), z);
                z = fmaf(q[8 * j + 4], bflo(v.z), z); z = fmaf(q[8 * j + 5], bfhi(v.z), z); z = fmaf(q[8 * j + 6], bflo(v.w), z); z = fmaf(q[8 * j + 7], bfhi(v.w), z); }
            const float mn = fmaxf(mx, z), corr = __expf(mx - mn), pe = __expf(z - mn);
            mx = mn; l = l * corr + pe;
#pragma unroll
            for (int j = 0; j < 8; ++j) { const uint4 v = vp[j];
                o[8 * j] = fmaf(pe, bflo(v.x), o[8 * j] * corr); o[8 * j + 1] = fmaf(pe, bfhi(v.x), o[8 * j + 1] * corr); o[8 * j + 2] = fmaf(pe, bflo(v.y), o[8 * j + 2] * corr); o[8 * j + 3] = fmaf(pe, bfhi(v.y), o[8 * j + 3] * corr);
                o[8 * j + 4] = fmaf(pe, bflo(v.z), o[8 * j + 4] * corr); o[8 * j + 5] = fmaf(pe, bfhi(v.z), o[8 * j + 5] * corr); o[8 * j + 6] = fmaf(pe, bflo(v.w), o[8 * j + 6] * corr); o[8 * j + 7] = fmaf(pe, bfhi(v.w), o[8 * j + 7] * corr); }
        }
        const float il = 1.f / l;
        uint4* op = (uint4*)(mixed + (size_t)tok * DM + 768 + h * 64);
#pragma unroll
        for (int j = 0; j < 8; ++j) { uint4 w; w.x = pk2(o[8 * j] * il, o[8 * j + 1] * il); w.y = pk2(o[8 * j + 2] * il, o[8 * j + 3] * il); w.z = pk2(o[8 * j + 4] * il, o[8 * j + 5] * il); w.w = pk2(o[8 * j + 6] * il, o[8 * j + 7] * il); op[j] = w; }
    }
}


__device__ __forceinline__ sh8_t frag8(const float (&x)[8]) { const u4_t w = {cvtpk(x[0], x[1]), cvtpk(x[2], x[3]), cvtpk(x[4], x[5]), cvtpk(x[6], x[7])}; return __builtin_bit_cast(sh8_t, w); }
__device__ __forceinline__ int kperm(int key) { return (key & 16) | ((key & 4) << 1) | ((key & 8) >> 1) | (key & 3); }
__device__ __forceinline__ void vt_store(LAS bf16_t* VT, int pitch, int d0, int pos, const u4_t v) {
    LAS bf16_t* d = VT + d0 * pitch + pos;
    d[0 * pitch] = (bf16_t)(v.x & 0xffff); d[1 * pitch] = (bf16_t)(v.x >> 16); d[2 * pitch] = (bf16_t)(v.y & 0xffff); d[3 * pitch] = (bf16_t)(v.y >> 16);
    d[4 * pitch] = (bf16_t)(v.z & 0xffff); d[5 * pitch] = (bf16_t)(v.z >> 16); d[6 * pitch] = (bf16_t)(v.w & 0xffff); d[7 * pitch] = (bf16_t)(v.w >> 16);
}
__device__ __forceinline__ void sb_mfma(const Params& p, unsigned char* ldsb) {
    const bf16_t* P = (const bf16_t*)(p.ws + WS_P);
    bf16_t* mixed = (bf16_t*)(p.ws + WS_MIXED);
    const int tid = threadIdx.x, lane = tid & 63, wave = tid >> 6, r = lane & 31, hh = lane >> 5;
    LAS bf16_t* KL = (LAS bf16_t*)ldsb + wave * (32 * 72 + 64 * 40);
    LAS bf16_t* VT = KL + 32 * 72;
    sh8_t mf[2];
#pragma unroll
    for (int ks = 0; ks < 2; ++ks)
#pragma unroll
        for (int e = 0; e < 8; ++e) { const int j = 16 * ks + 8 * (e >> 2) + 4 * hh + (e & 3); mf[ks][e] = (j > r) ? (short)0x3F80 : (short)0; }
    for (int u = blockIdx.x * 8 + wave; u < 32 * 256; u += gridDim.x * 8) {
        const int bh = u >> 8, qt = u & 255, b = bh >> 3, h = bh & 7;
        const size_t tok0 = (size_t)b * SEQ + qt * 32;
        sh8_t qf[4];
        { const bf16_t* qp = P + (tok0 + r) * INW + C_SBQ + h * 64 + 8 * hh;
#pragma unroll
          for (int ks = 0; ks < 4; ++ks) qf[ks] = *(const sh8_t*)(qp + 16 * ks); }
        f32x16 o0, o1;
#pragma unroll
        for (int i = 0; i < 16; ++i) { o0[i] = 0.f; o1[i] = 0.f; }
        float R = 0.f;
        u4_t kraw[4], vraw[4];
        { const bf16_t* kvp = P + ((size_t)b * SEQ + qt * 32 + (lane >> 3)) * INW + h * 64 + (lane & 7) * 8;
#pragma unroll
          for (int i = 0; i < 4; ++i) { kraw[i] = *(const u4_t*)(kvp + (size_t)(8 * i) * INW + C_SBK); vraw[i] = *(const u4_t*)(kvp + (size_t)(8 * i) * INW + C_SBV); } }
        for (int kt = qt; kt >= 0; --kt) {
#pragma unroll
            for (int i = 0; i < 4; ++i) { const int key = (lane >> 3) + 8 * i, dq = lane & 7;
                *(LAS u4_t*)(KL + key * 72 + dq * 8) = kraw[i];
                vt_store(VT, 40, dq * 8, kperm(key), vraw[i]); }
            { const int ktn = kt > 0 ? kt - 1 : 0;
              const bf16_t* kvp = P + ((size_t)b * SEQ + ktn * 32 + (lane >> 3)) * INW + h * 64 + (lane & 7) * 8;
#pragma unroll
              for (int i = 0; i < 4; ++i) { kraw[i] = *(const u4_t*)(kvp + (size_t)(8 * i) * INW + C_SBK); vraw[i] = *(const u4_t*)(kvp + (size_t)(8 * i) * INW + C_SBV); } }
            f32x16 z;
#pragma unroll
            for (int i = 0; i < 16; ++i) z[i] = 0.f;
#pragma unroll
            for (int ks = 0; ks < 4; ++ks) z = __builtin_amdgcn_mfma_f32_32x32x16_bf16(*(const LAS sh8_t*)(KL + r * 72 + 16 * ks + 8 * hh), qf[ks], z, 0, 0, 0);
            const bool diag = (kt == qt);
            float sp[16]; f32x16 la; float tot = 0.f;
#pragma unroll
            for (int i = 0; i < 16; ++i) { const float zz = z[i];
                float s = fmaxf(zz, 0.f) + __builtin_amdgcn_logf(1.f + __builtin_amdgcn_exp2f(-fabsf(zz)));
                const bool valid = !diag || (crow(i, hh) < r);
                la[i] = zz - s + R; s = valid ? s : 0.f; sp[i] = s; tot += s; }
            tot += __shfl_xor(tot, 32);
#pragma unroll
            for (int ks = 0; ks < 2; ++ks) {
                unsigned hi[4], lo[4];
#pragma unroll
                for (int e = 0; e < 4; ++e) { const float x0 = -sp[8 * ks + 2 * e], x1 = -sp[8 * ks + 2 * e + 1]; hi[e] = cvtpk(x0, x1); lo[e] = cvtpk(x0 - bflo(hi[e]), x1 - bfhi(hi[e])); }
                const u4_t hv = {hi[0], hi[1], hi[2], hi[3]}, lv = {lo[0], lo[1], lo[2], lo[3]};
                la = __builtin_amdgcn_mfma_f32_32x32x16_bf16(mf[ks], __builtin_bit_cast(sh8_t, hv), la, 0, 0, 0);
                la = __builtin_amdgcn_mfma_f32_32x32x16_bf16(mf[ks], __builtin_bit_cast(sh8_t, lv), la, 0, 0, 0);
            }
            sh8_t af[2];
#pragma unroll
            for (int ks = 0; ks < 2; ++ks) { float a[8];
#pragma unroll
                for (int e = 0; e < 8; ++e) { const int i = 8 * ks + e; const bool valid = !diag || (crow(i, hh) < r); a[e] = valid ? __builtin_amdgcn_exp2f(la[i]) : 0.f; }
                af[ks] = frag8(a); }
            R -= tot;
#pragma unroll
            for (int ks = 0; ks < 2; ++ks) {
                o0 = __builtin_amdgcn_mfma_f32_32x32x16_bf16(*(const LAS sh8_t*)(VT + r * 40 + 16 * ks + 8 * hh), af[ks], o0, 0, 0, 0);
                o1 = __builtin_amdgcn_mfma_f32_32x32x16_bf16(*(const LAS sh8_t*)(VT + (32 + r) * 40 + 16 * ks + 8 * hh), af[ks], o1, 0, 0, 0);
            }
            if (__all(R < -48.f)) break;
        }
        float ss = 0.f;
#pragma unroll
        for (int i = 0; i < 16; ++i) { ss = fmaf(o0[i], o0[i], ss); ss = fmaf(o1[i], o1[i], ss); }
        ss += __shfl_xor(ss, 32);
        const float rn = rsqrtf(ss * (1.f / 64.f) + EPS);
        bf16_t* op = mixed + (tok0 + r) * DM + h * 64 + 4 * hh;
        const float* gp = p.sb_gain + h * 64 + 4 * hh;
#pragma unroll
        for (int q4 = 0; q4 < 4; ++q4) {
            const float4 g0 = *(const float4*)(gp + 8 * q4), g1 = *(const float4*)(gp + 32 + 8 * q4);
            uint2 w0, w1;
            w0.x = cvtpk(o0[4 * q4] * rn * g0.x, o0[4 * q4 + 1] * rn * g0.y); w0.y = cvtpk(o0[4 * q4 + 2] * rn * g0.z, o0[4 * q4 + 3] * rn * g0.w);
            w1.x = cvtpk(o1[4 * q4] * rn * g1.x, o1[4 * q4 + 1] * rn * g1.y); w1.y = cvtpk(o1[4 * q4 + 2] * rn * g1.z, o1[4 * q4 + 3] * rn * g1.w);
            *(uint2*)(op + 8 * q4) = w0; *(uint2*)(op + 32 + 8 * q4) = w1;
        }
    }
}
__device__ __forceinline__ void mem_attn_mfma(const Params& p, unsigned char* ldsb) {
    const bf16_t* P = (const bf16_t*)(p.ws + WS_P);
    const bf16_t* kvb = (const bf16_t*)(p.ws + WS_MEMKV);
    bf16_t* mixed = (bf16_t*)(p.ws + WS_MIXED);
    const int tid = threadIdx.x, lane = tid & 63, wave = tid >> 6, r = lane & 31, hh = lane >> 5;
    LAS bf16_t* VT = (LAS bf16_t*)ldsb;
    for (int unit = blockIdx.x; unit < NB * 4 * (SEQ / 256); unit += gridDim.x) {
        const int tb = unit & 31, hd = (unit >> 5) & 3, b = unit >> 7;
        __syncthreads();
#pragma unroll
        for (int i = 0; i < 4; ++i) { const int idx = tid + 512 * i, key = idx >> 3, dq = idx & 7;
            const u4_t v = *(const u4_t*)(kvb + ((size_t)b * NMEM + key) * 512 + 256 + hd * 64 + dq * 8);
            vt_store(VT, 264, dq * 8, (key & ~31) | kperm(key & 31), v); }
        __syncthreads();
        const size_t tok = (size_t)b * SEQ + tb * 256 + wave * 32 + r;
        sh8_t qf[4];
        { const bf16_t* qp = P + tok * INW + C_MQ + hd * 64 + 8 * hh;
          float qv[32]; float ss = 0.f;
#pragma unroll
          for (int ks = 0; ks < 4; ++ks) { const u4_t w = *(const u4_t*)(qp + 16 * ks);
              qv[8 * ks] = bflo(w.x); qv[8 * ks + 1] = bfhi(w.x); qv[8 * ks + 2] = bflo(w.y); qv[8 * ks + 3] = bfhi(w.y); qv[8 * ks + 4] = bflo(w.z); qv[8 * ks + 5] = bfhi(w.z); qv[8 * ks + 6] = bflo(w.w); qv[8 * ks + 7] = bfhi(w.w); }
#pragma unroll
          for (int i = 0; i < 32; ++i) ss = fmaf(qv[i], qv[i], ss);
          ss += __shfl_xor(ss, 32);
          const float rq = rsqrtf(ss * (1.f / 64.f) + EPS) * (0.125f * LOG2E);
#pragma unroll
          for (int ks = 0; ks < 4; ++ks) { float t8[8];
#pragma unroll
              for (int e = 0; e < 8; ++e) t8[e] = qv[8 * ks + e] * rq * p.mq_gain[16 * ks + 8 * hh + e] * p.mk_gain[16 * ks + 8 * hh + e];
              qf[ks] = frag8(t8); } }
        f32x16 s[8];
#pragma unroll
        for (int kt = 0; kt < 8; ++kt) {
#pragma unroll
            for (int i = 0; i < 16; ++i) s[kt][i] = 0.f;
            const bf16_t* kp = kvb + ((size_t)b * NMEM + kt * 32 + r) * 512 + hd * 64 + 8 * hh;
            u4_t kw[4]; float ssk = 0.f;
#pragma unroll
            for (int ks = 0; ks < 4; ++ks) { kw[ks] = *(const u4_t*)(kp + 16 * ks);
#pragma unroll
                for (int e = 0; e < 4; ++e) { const float lo = bflo(kw[ks][e]), hi = bfhi(kw[ks][e]); ssk = fmaf(lo, lo, ssk); ssk = fmaf(hi, hi, ssk); } }
            ssk += __shfl_xor(ssk, 32);
            const float rk = rsqrtf(ssk * (1.f / 64.f) + EPS);
#pragma unroll
            for (int ks = 0; ks < 4; ++ks) { float t8[8];
#pragma unroll
                for (int e = 0; e < 4; ++e) { t8[2 * e] = bflo(kw[ks][e]) * rk; t8[2 * e + 1] = bfhi(kw[ks][e]) * rk; }
                s[kt] = __builtin_amdgcn_mfma_f32_32x32x16_bf16(frag8(t8), qf[ks], s[kt], 0, 0, 0); }
        }
        float mx = -1e30f;
#pragma unroll
        for (int kt = 0; kt < 8; ++kt)
#pragma unroll
            for (int i = 0; i < 16; ++i) mx = fmaxf(mx, s[kt][i]);
        mx = fmaxf(mx, __shfl_xor(mx, 32));
        float lsum = 0.f;
        f32x16 o0, o1;
#pragma unroll
        for (int i = 0; i < 16; ++i) { o0[i] = 0.f; o1[i] = 0.f; }
#pragma unroll
        for (int kt = 0; kt < 8; ++kt)
#pragma unroll
            for (int ks = 0; ks < 2; ++ks) { float a[8];
#pragma unroll
                for (int e = 0; e < 8; ++e) { a[e] = __builtin_amdgcn_exp2f(s[kt][8 * ks + e] - mx); lsum += a[e]; }
                const sh8_t af = frag8(a);
                o0 = __builtin_amdgcn_mfma_f32_32x32x16_bf16(*(const LAS sh8_t*)(VT + r * 264 + 32 * kt + 16 * ks + 8 * hh), af, o0, 0, 0, 0);
                o1 = __builtin_amdgcn_mfma_f32_32x32x16_bf16(*(const LAS sh8_t*)(VT + (32 + r) * 264 + 32 * kt + 16 * ks + 8 * hh), af, o1, 0, 0, 0); }
        lsum += __shfl_xor(lsum, 32);
        const float il = 1.f / lsum;
        bf16_t* op = mixed + tok * DM + 768 + hd * 64 + 4 * hh;
#pragma unroll
        for (int q4 = 0; q4 < 4; ++q4) {
            uint2 w0, w1;
            w0.x = cvtpk(o0[4 * q4] * il, o0[4 * q4 + 1] * il); w0.y = cvtpk(o0[4 * q4 + 2] * il, o0[4 * q4 + 3] * il);
            w1.x = cvtpk(o1[4 * q4] * il, o1[4 * q4 + 1] * il); w1.y = cvtpk(o1[4 * q4 + 2] * il, o1[4 * q4 + 3] * il);
            *(uint2*)(op + 8 * q4) = w0; *(uint2*)(op + 32 + 8 * q4) = w1;
        }
    }
}

__device__ __forceinline__ void rstd2_rows(const Params& p) {
    float* rs = (float*)(p.ws + WS_RSTD2);
    const int lane = threadIdx.x & 63, wave = threadIdx.x >> 6;
    for (int m = blockIdx.x * 8 + wave; m < T; m += gridDim.x * 8) {
        const float4* xr = (const float4*)(p.out + (size_t)m * DM) + lane; float s = 0.f;
#pragma unroll
        for (int j = 0; j < 4; ++j) { const float4 v = xr[64 * j]; s += (v.x * v.x + v.y * v.y) + (v.z * v.z + v.w * v.w); }
        s = wave_sum(s);
        if (lane == 0) rs[m] = rsqrtf(s * (1.f / DM) + EPS);
    }
}

__device__ __forceinline__ void wave_argmax(float& v, int& i) {
#pragma unroll
    for (int o = 32; o >= 1; o >>= 1) { const float ov = __shfl_xor(v, o); const int oi = __shfl_xor(i, o); if (ov > v || (ov == v && oi < i)) { v = ov; i = oi; } }
}
__device__ __forceinline__ void topk_naive(const Params& p, unsigned char* ldsb) {
    const bf16_t* Q = (const bf16_t*)(p.ws + WS_Q);
    const bf16_t* SK = (const bf16_t*)(p.ws + WS_SKB);
    int* pidx = (int*)(p.ws + WS_PIDX); float* pg = (float*)(p.ws + WS_PG);
    const int lane = threadIdx.x & 63, wave = threadIdx.x >> 6;
    float* tsv = (float*)ldsb + wave * 128;
    int* tsi = (int*)tsv + 32;
    float* bsv = tsv + 64; int* bse = (int*)tsv + 80;
    for (int it = blockIdx.x * 8 + wave; it < T * 8; it += gridDim.x * 8) {
        const int tok = it >> 3, h = it & 7;
        for (int c = 0; c < 2; ++c) {
            const uint4* qp = (const uint4*)(Q + (size_t)tok * 2048 + h * 256 + c * 128);
            const uint4* k0 = (const uint4*)(SK + ((size_t)(h * 2 + c) * 128 + lane) * 128);
            const uint4* k1 = (const uint4*)(SK + ((size_t)(h * 2 + c) * 128 + lane + 64) * 128);
            float s0 = 0.f, s1 = 0.f;
            for (int j = 0; j < 16; ++j) { const uint4 qv = qp[j], a = k0[j], bq = k1[j];
                s0 = fmaf(bflo(qv.x), bflo(a.x), s0); s0 = fmaf(bfhi(qv.x), bfhi(a.x), s0); s0 = fmaf(bflo(qv.y), bflo(a.y), s0); s0 = fmaf(bfhi(qv.y), bfhi(a.y), s0);
                s0 = fmaf(bflo(qv.z), bflo(a.z), s0); s0 = fmaf(bfhi(qv.z), bfhi(a.z), s0); s0 = fmaf(bflo(qv.w), bflo(a.w), s0); s0 = fmaf(bfhi(qv.w), bfhi(a.w), s0);
                s1 = fmaf(bflo(qv.x), bflo(bq.x), s1); s1 = fmaf(bfhi(qv.x), bfhi(bq.x), s1); s1 = fmaf(bflo(qv.y), bflo(bq.y), s1); s1 = fmaf(bfhi(qv.y), bfhi(bq.y), s1);
                s1 = fmaf(bflo(qv.z), bflo(bq.z), s1); s1 = fmaf(bfhi(qv.z), bfhi(bq.z), s1); s1 = fmaf(bflo(qv.w), bflo(bq.w), s1); s1 = fmaf(bfhi(qv.w), bfhi(bq.w), s1); }
            for (int r = 0; r < 16; ++r) {
                float v = s0; int i = lane; if (s1 > s0) { v = s1; i = lane + 64; }
                wave_argmax(v, i);
                if (lane == 0) { tsv[c * 16 + r] = v; tsi[c * 16 + r] = i; }
                if (i == lane) s0 = -INFINITY; if (i == lane + 64) s1 = -INFINITY;
            }
        }
        __builtin_amdgcn_s_waitcnt(0); __builtin_amdgcn_wave_barrier();
        float cs[4];
#pragma unroll
        for (int u = 0; u < 4; ++u) { const int id = lane * 4 + u; cs[u] = tsv[id >> 4] + tsv[16 + (id & 15)]; }
        for (int r = 0; r < 16; ++r) {
            float v = cs[0]; int i = lane * 4;
#pragma unroll
            for (int u = 1; u < 4; ++u) if (cs[u] > v) { v = cs[u]; i = lane * 4 + u; }
            wave_argmax(v, i);
            if (lane == 0) { bsv[r] = v; bse[r] = tsi[i >> 4] * 128 + tsi[16 + (i & 15)]; }
#pragma unroll
            for (int u = 0; u < 4; ++u) if (i == lane * 4 + u) cs[u] = -INFINITY;
        }
        __builtin_amdgcn_s_waitcnt(0); __builtin_amdgcn_wave_barrier();
        { const float mxv = bsv[0]; float e = (lane < 16) ? __expf(bsv[lane & 15] - mxv) : 0.f;
          float s = e; s += __shfl_xor(s, 1); s += __shfl_xor(s, 2); s += __shfl_xor(s, 4); s += __shfl_xor(s, 8);
          if (lane < 16) { pidx[(size_t)tok * PK + h * 16 + lane] = bse[lane]; pg[(size_t)tok * PK + h * 16 + lane] = e / s; } }
        __builtin_amdgcn_s_waitcnt(0); __builtin_amdgcn_wave_barrier();
    }
}

__device__ __forceinline__ void peer_naive(const Params& p, unsigned char* ldsb) {
    const int* pidx = (const int*)(p.ws + WS_PIDX); const float* pg = (const float*)(p.ws + WS_PG);
    const float* rs = (const float*)(p.ws + WS_RSTD2);
    float* hs = (float*)ldsb;
    float* red = hs + 1024;
    const int tid = threadIdx.x, lane = tid & 63, wave = tid >> 6;
    for (int tok = blockIdx.x; tok < T; tok += gridDim.x) {
        const float r2 = rs[tok];
        for (int d = tid; d < DM; d += NTHR) hs[d] = p.out[(size_t)tok * DM + d] * r2 * p.g_ffn[d];
        __syncthreads();
        float4 hv[4];
#pragma unroll
        for (int j = 0; j < 4; ++j) hv[j] = *((const float4*)hs + lane + 64 * j);
        float4 acc[4];
#pragma unroll
        for (int j = 0; j < 4; ++j) acc[j] = make_float4(0.f, 0.f, 0.f, 0.f);
        for (int pi = wave; pi < PK; pi += 8) {
            const int e = pidx[(size_t)tok * PK + pi]; const float g = pg[(size_t)tok * PK + pi];
            const float4* up = (const float4*)(p.pu + (size_t)e * DM) + lane;
            const float4* vp = (const float4*)(p.pv + (size_t)e * DM) + lane;
            float s = 0.f;
#pragma unroll
            for (int j = 0; j < 4; ++j) { const float4 u = up[64 * j]; s += (hv[j].x * u.x + hv[j].y * u.y) + (hv[j].z * u.z + hv[j].w * u.w); }
            s = wave_sum(s);
            const float w = g * 0.5f * s * (1.f + erff(s * 0.70710678118654752f));
#pragma unroll
            for (int j = 0; j < 4; ++j) { const float4 v = vp[64 * j]; acc[j].x = fmaf(w, v.x, acc[j].x); acc[j].y = fmaf(w, v.y, acc[j].y); acc[j].z = fmaf(w, v.z, acc[j].z); acc[j].w = fmaf(w, v.w, acc[j].w); }
        }
#pragma unroll
        for (int j = 0; j < 4; ++j) *((float4*)(red + wave * 1024) + lane + 64 * j) = acc[j];
        __syncthreads();
        for (int d = tid; d < DM; d += NTHR) { float s = 0.f;
#pragma unroll
            for (int w = 0; w < 8; ++w) s += red[w * 1024 + d];
            p.out[(size_t)tok * DM + d] += s; }
        __syncthreads();
    }
}


__device__ __forceinline__ int tk_pack(float s, int payload, int mask) { const int b = __float_as_int(s); const int m = b ^ ((b >> 31) & 0x7fffffff); return (m & ~mask) | payload; }
__device__ __forceinline__ float tk_unpack(int key, int mask) { const int m = key & ~mask; return __int_as_float(m ^ ((m >> 31) & 0x7fffffff)); }
template <int N> __device__ __forceinline__ void bitonic_sort_desc(int (&v)[N]) {
#pragma unroll
    for (int k = 2; k <= N; k <<= 1)
#pragma unroll
        for (int j = k >> 1; j > 0; j >>= 1)
#pragma unroll
            for (int i = 0; i < N; ++i) { const int l = i ^ j; if (l > i) { const bool desc = ((i & k) == 0); const int a = v[i], b = v[l]; const int hi = max(a, b), lo = min(a, b); v[i] = desc ? hi : lo; v[l] = desc ? lo : hi; } }
}
__device__ __forceinline__ void merge_top16(int (&A)[16], const int (&B)[16]) {
#pragma unroll
    for (int i = 0; i < 16; ++i) A[i] = max(A[i], B[15 - i]);
#pragma unroll
    for (int j = 8; j > 0; j >>= 1)
#pragma unroll
        for (int i = 0; i < 16; ++i) { const int l = i ^ j; if (l > i) { const int a = A[i], b = A[l]; A[i] = max(a, b); A[l] = min(a, b); } }
}
__device__ __forceinline__ void top16_of_64(int (&g0)[16], int (&g1)[16], int (&g2)[16], int (&g3)[16]) {
    bitonic_sort_desc<16>(g0); bitonic_sort_desc<16>(g1); bitonic_sort_desc<16>(g2); bitonic_sort_desc<16>(g3);
    merge_top16(g0, g1); merge_top16(g2, g3); merge_top16(g0, g2);
}
__device__ __forceinline__ void topk_mfma(const Params& p, unsigned char* ldsb) {
    const bf16_t* Q = (const bf16_t*)(p.ws + WS_Q);
    const bf16_t* SK = (const bf16_t*)(p.ws + WS_SKB);
    unsigned short* pidx16 = (unsigned short*)(p.ws + WS_PIDX); float* pg = (float*)(p.ws + WS_PG);
    const float* ssq = (const float*)(p.ws + WS_SSQ); float* rs2 = (float*)(p.ws + WS_RSTD2);
    LAS unsigned char* l = (LAS unsigned char*)ldsb;
    LAS bf16_t* SKL = (LAS bf16_t*)l;
    const int tid = threadIdx.x, lane = tid & 63, wave = tid >> 6, r = lane & 31, hh = lane >> 5;
    LAS unsigned char* ib = l + 69632 + (wave * 64 + lane) * 36;
    int cur_h = -1;
    for (int unit = blockIdx.x; unit < 8 * (T / 256); unit += gridDim.x) {
        const int h = unit & 7, tb = unit >> 3;
        if (h != cur_h) {
            __syncthreads();
#pragma unroll
            for (int it = 0; it < 8; ++it) { const int idx = tid + 512 * it, row = idx >> 4, cq = idx & 15;
                *(LAS u4_t*)(SKL + row * 136 + cq * 8) = *(const u4_t*)(SK + ((size_t)h * 256 + row) * 128 + cq * 8); }
            __syncthreads();
            cur_h = h;
        }
        const int tok = tb * 256 + wave * 32 + r;
        int sorted[2][16];
#pragma unroll
        for (int c = 0; c < 2; ++c) {
            sh8_t qf[8];
            { const sh8_t* qp = (const sh8_t*)(Q + (size_t)tok * 2048 + h * 256 + c * 128 + 8 * hh);
#pragma unroll
              for (int ks = 0; ks < 8; ++ks) qf[ks] = qp[2 * ks]; }
            int g[4][16];
#pragma unroll
            for (int mt = 0; mt < 4; ++mt) {
                f32x16 acc;
#pragma unroll
                for (int i = 0; i < 16; ++i) acc[i] = 0.f;
                const LAS bf16_t* ap = SKL + (c * 128 + 32 * mt + r) * 136 + 8 * hh;
#pragma unroll
                for (int ks = 0; ks < 8; ++ks) acc = __builtin_amdgcn_mfma_f32_32x32x16_bf16(*(const LAS sh8_t*)(ap + 16 * ks), qf[ks], acc, 0, 0, 0);
#pragma unroll
                for (int i = 0; i < 16; ++i) g[mt][i] = tk_pack(acc[i], (32 * mt + (i & 3) + 8 * (i >> 2)) | (hh << 2), 127);
            }
            top16_of_64(g[0], g[1], g[2], g[3]);
            int o[16];
#pragma unroll
            for (int i = 0; i < 16; ++i) o[i] = __shfl_xor(g[0][i], 32);
            merge_top16(g[0], o);
#pragma unroll
            for (int i = 0; i < 16; ++i) sorted[c][i] = g[0][i];
        }
#pragma unroll
        for (int c = 0; c < 2; ++c)
#pragma unroll
            for (int w = 0; w < 4; ++w)
                *(LAS unsigned*)(ib + c * 16 + w * 4) = (unsigned)(sorted[c][4 * w] & 127) | ((unsigned)(sorted[c][4 * w + 1] & 127) << 8) | ((unsigned)(sorted[c][4 * w + 2] & 127) << 16) | ((unsigned)(sorted[c][4 * w + 3] & 127) << 24);
        float av[16], bv[16];
#pragma unroll
        for (int i = 0; i < 16; ++i) { av[i] = tk_unpack(sorted[0][i], 127); bv[i] = tk_unpack(sorted[1][i], 127); }
        int cd[4][16];
        {
            int n = 0;
#pragma unroll
            for (int i = 0; i < 16; ++i)
#pragma unroll
                for (int j = 0; j < 16; ++j)
                    if ((i + 1) * (j + 1) <= 16) { cd[n >> 4][n & 15] = tk_pack(av[i] + bv[j], i * 16 + j, 255); ++n; }
#pragma unroll
            for (; n < 64; ++n) cd[n >> 4][n & 15] = (int)0x80000000;
        }
        top16_of_64(cd[0], cd[1], cd[2], cd[3]);
        float sv[16]; int ex[16];
        float rstd;
        { const f32x4_t* sp_ = (const f32x4_t*)(ssq + (size_t)tok * 16); const f32x4_t q0 = sp_[0], q1 = sp_[1], q2 = sp_[2], q3 = sp_[3];
          const float tot = ((q0[0] + q0[1]) + (q0[2] + q0[3])) + ((q1[0] + q1[1]) + (q1[2] + q1[3])) + ((q2[0] + q2[1]) + (q2[2] + q2[3])) + ((q3[0] + q3[1]) + (q3[2] + q3[3]));
          rstd = rsqrtf(tot * (1.f / DM) + EPS); if (h == 0 && hh == 0) rs2[tok] = rstd; }
        const float s0 = tk_unpack(cd[0][0], 255);
        float sum = 0.f;
#pragma unroll
        for (int q = 0; q < 16; ++q) { const int key = cd[0][q]; const int id = key & 255;
            const int ia = ib[id >> 4], ibx = ib[16 + (id & 15)];
            ex[q] = ia * 128 + ibx; sv[q] = __expf((tk_unpack(key, 255) - s0) * rstd); sum += sv[q]; }
        const float inv = 1.f / sum;
        if (hh == 0) { u4_t* d = (u4_t*)(pidx16 + (size_t)tok * PK + h * 16);
#pragma unroll
            for (int w = 0; w < 2; ++w) d[w] = (u4_t){(unsigned)ex[8 * w] | ((unsigned)ex[8 * w + 1] << 16), (unsigned)ex[8 * w + 2] | ((unsigned)ex[8 * w + 3] << 16), (unsigned)ex[8 * w + 4] | ((unsigned)ex[8 * w + 5] << 16), (unsigned)ex[8 * w + 6] | ((unsigned)ex[8 * w + 7] << 16)}; }
        else { float4* d = (float4*)(pg + (size_t)tok * PK + h * 16);
#pragma unroll
            for (int w = 0; w < 4; ++w) d[w] = make_float4(sv[4 * w] * inv, sv[4 * w + 1] * inv, sv[4 * w + 2] * inv, sv[4 * w + 3] * inv); }
    }
}

struct Sl { int vx, rank, nrank; };
__device__ __forceinline__ float dpp_xor1(float x) { return __int_as_float(__builtin_amdgcn_mov_dpp(__float_as_int(x), 0xB1, 0xF, 0xF, true)); }
__device__ __forceinline__ float dpp_xor2(float x) { return __int_as_float(__builtin_amdgcn_mov_dpp(__float_as_int(x), 0x4E, 0xF, 0xF, true)); }
__device__ __forceinline__ float dpp_ror8(float x) { return __int_as_float(__builtin_amdgcn_mov_dpp(__float_as_int(x), 0x128, 0xF, 0xF, true)); }
__device__ __forceinline__ float dpp_hmir(float x) { return __int_as_float(__builtin_amdgcn_mov_dpp(__float_as_int(x), 0x141, 0xF, 0xF, true)); }
__device__ __forceinline__ void peer_u_phase(const Params& p, const Sl sl) {
    const int lane = threadIdx.x & 63, wave = threadIdx.x >> 6, g8 = lane >> 3, c = lane & 7;
    const unsigned short* pidx = (const unsigned short*)(p.ws + WS_PIDX);
    const int per = (T + sl.nrank * 8 - 1) / (sl.nrank * 8), tbase = (sl.rank * 8 + wave) * per, stride = 1;
    const int nk = (tbase < T) ? ((T - tbase < per) ? (T - tbase) : per) : 0;
    const int S = sl.vx;
    const unsigned char* Ub = p.ws + WS_U16 + (size_t)S * NEXP * 128 + c * 16;
    const bf16_t* xbb = (const bf16_t*)(p.ws + WS_XB) + (size_t)(2 * S + (c >> 2)) * T * 64 + (c & 3) * 16;
    _Float16* PUs = (_Float16*)(p.ws + WS_PU) + (size_t)S * T * PK;
    if (nk == 0) return;
#define TK(k) (tbase + ((k) < nk ? (k) : nk - 1) * stride)
#define SBAR __builtin_amdgcn_sched_barrier(0)
#define U_LOAD_IDX(I, t) { const u4_t* ip_ = (const u4_t*)(pidx + (size_t)(t) * PK + g8 * 16); I[0] = __builtin_nontemporal_load(ip_); I[1] = __builtin_nontemporal_load(ip_ + 1); }
#define U_LOAD_H(H, t) { const u4_t* hp_ = (const u4_t*)(xbb + (size_t)(t) * 64); H[0] = __builtin_nontemporal_load(hp_); H[1] = __builtin_nontemporal_load(hp_ + 1); }
#define U_ISSUE(G, I) { const unsigned w0_ = I[(G) >> 1][(2 * (G)) & 3], w1_ = I[(G) >> 1][(2 * (G) + 1) & 3]; \
        rr[4 * (G)] = *(const u4_t*)(Ub + (size_t)(w0_ & 0xffffu) * 128); rr[4 * (G) + 1] = *(const u4_t*)(Ub + (size_t)(w0_ >> 16) * 128); \
        rr[4 * (G) + 2] = *(const u4_t*)(Ub + (size_t)(w1_ & 0xffffu) * 128); rr[4 * (G) + 3] = *(const u4_t*)(Ub + (size_t)(w1_ >> 16) * 128); }
#define U_DOT(G) { _Pragma("unroll") for (int i_ = 4 * (G); i_ < 4 * (G) + 4; ++i_) { float2_t a_ = {0.f, 0.f}; \
        _Pragma("unroll") for (int q_ = 0; q_ < 4; ++q_) { a_ = __builtin_amdgcn_cvt_pk_f32_fp8((int)rr[i_][q_], false) * X2[2 * q_] + a_; a_ = __builtin_amdgcn_cvt_pk_f32_fp8((int)rr[i_][q_], true) * X2[2 * q_ + 1] + a_; } \
        pr[i_] = a_.x + a_.y; } }
#define U_STEP(k, I1, I2, Hc, Hn) { float pr[16]; float2_t X2[8]; \
        _Pragma("unroll") for (int m_ = 0; m_ < 8; ++m_) { const unsigned hw_ = Hc[m_ >> 2][m_ & 3]; X2[m_] = (float2_t){bflo(hw_), bfhi(hw_)}; } \
        U_LOAD_IDX(I2, TK((k) + 2)); U_LOAD_H(Hn, TK((k) + 1)); SBAR; \
        U_DOT(0); SBAR; U_ISSUE(0, I1); SBAR; U_DOT(1); SBAR; U_ISSUE(1, I1); SBAR; U_DOT(2); SBAR; U_ISSUE(2, I1); SBAR; U_DOT(3); SBAR; U_ISSUE(3, I1); SBAR; \
        _Pragma("unroll") for (int j_ = 0; j_ < 8; ++j_) { const float keep_ = (c & 4) ? pr[j_ + 8] : pr[j_], send_ = (c & 4) ? pr[j_] : pr[j_ + 8]; pr[j_] = keep_ + dpp_hmir(send_); } \
        _Pragma("unroll") for (int j_ = 0; j_ < 4; ++j_) { const float keep_ = (c & 2) ? pr[j_ + 4] : pr[j_], send_ = (c & 2) ? pr[j_] : pr[j_ + 4]; pr[j_] = keep_ + dpp_xor2(send_); } \
        _Pragma("unroll") for (int j_ = 0; j_ < 2; ++j_) { const float keep_ = (c & 1) ? pr[j_ + 2] : pr[j_], send_ = (c & 1) ? pr[j_] : pr[j_ + 2]; pr[j_] = keep_ + dpp_xor1(send_); } \
        __builtin_nontemporal_store((h2_t){(_Float16)pr[0], (_Float16)pr[1]}, (h2_t*)(PUs + (size_t)TK(k) * PK + g8 * 16 + 2 * c)); }
    u4_t iA[2], iB[2], rr[16], hA[2], hB[2];
    U_LOAD_IDX(iA, TK(0)); U_LOAD_IDX(iB, TK(1)); U_LOAD_H(hA, TK(0)); SBAR;
    U_ISSUE(0, iA); SBAR; U_ISSUE(1, iA); SBAR; U_ISSUE(2, iA); SBAR; U_ISSUE(3, iA); SBAR;
    for (int k = 0; k < nk; k += 2) {
        U_STEP(k, iB, iA, hA, hB);
        if (k + 1 < nk) U_STEP(k + 1, iA, iB, hB, hA);
    }
#undef U_LOAD_IDX
#undef U_LOAD_H
#undef U_ISSUE
#undef U_DOT
#undef U_STEP
}
__device__ __forceinline__ void peer_w_phase(const Params& p) {
    const _Float16* PU = (const _Float16*)(p.ws + WS_PU); const float* pg = (const float*)(p.ws + WS_PG); const float* rs = (const float*)(p.ws + WS_RSTD2);
    _Float16* pw = (_Float16*)(p.ws + WS_PW);
    for (int i = blockIdx.x * NTHR + threadIdx.x; i < T * PK / 8; i += gridDim.x * NTHR) {
        float s[8];
#pragma unroll
        for (int e = 0; e < 8; ++e) s[e] = 0.f;
#pragma unroll
        for (int x = 0; x < 8; ++x) { const h8_t hv = __builtin_nontemporal_load((const h8_t*)(PU + (size_t)x * T * PK) + i);
#pragma unroll
            for (int e = 0; e < 8; ++e) s[e] += (float)hv[e]; }
        const float r = rs[i >> 4] * (1.f / PEER_US);
        const f32x4_t g0 = *((const f32x4_t*)pg + 2 * i), g1 = *((const f32x4_t*)pg + 2 * i + 1);
        h8_t wv;
#pragma unroll
        for (int e = 0; e < 4; ++e) { const float a = s[e] * r, b = s[4 + e] * r;
            wv[e] = (_Float16)(g0[e] * (0.5f / PEER_VS) * a * (1.f + erff(a * 0.70710678118654752f))); wv[4 + e] = (_Float16)(g1[e] * (0.5f / PEER_VS) * b * (1.f + erff(b * 0.70710678118654752f))); }
        *((h8_t*)pw + i) = wv;
    }
}
__device__ __forceinline__ void peer_v_phase(const Params& p, const Sl sl) {
    const int lane = threadIdx.x & 63, wave = threadIdx.x >> 6, g8 = lane >> 3, c = lane & 7;
    const unsigned short* pidx = (const unsigned short*)(p.ws + WS_PIDX); const _Float16* pw = (const _Float16*)(p.ws + WS_PW);
    const int per = (T + sl.nrank * 8 - 1) / (sl.nrank * 8), tbase = (sl.rank * 8 + wave) * per, stride = 1;
    const int nk = (tbase < T) ? ((T - tbase < per) ? (T - tbase) : per) : 0;
    const int S = sl.vx;
    const unsigned char* Vb = p.ws + WS_V16 + (size_t)S * NEXP * 128 + c * 16;
    const int jj = 16 * c + 2 * g8, s16 = 2 * S + (jj >> 6), j = jj & 63;
    float* ob = p.out + (j >> 5) * 512 + 32 * s16 + (j & 31);
    const bf16_t* xs = (const bf16_t*)(p.ws + WS_XB) + (size_t)s16 * T * 64 + j;
    if (nk == 0) return;
#define V_LOAD_IDX(I, t) { const u4_t* ip_ = (const u4_t*)(pidx + (size_t)(t) * PK + g8 * 16); I[0] = __builtin_nontemporal_load(ip_); I[1] = __builtin_nontemporal_load(ip_ + 1); }
#define V_LOAD_W(W, t) { const h8_t* wp_ = (const h8_t*)(pw + (size_t)(t) * PK + g8 * 16); W[0] = __builtin_nontemporal_load(wp_); W[1] = __builtin_nontemporal_load(wp_ + 1); }
#define V_ISSUE(G, I) { const unsigned w0_ = I[(G) >> 1][(2 * (G)) & 3], w1_ = I[(G) >> 1][(2 * (G) + 1) & 3]; \
        rr[4 * (G)] = *(const u4_t*)(Vb + (size_t)(w0_ & 0xffffu) * 128); rr[4 * (G) + 1] = *(const u4_t*)(Vb + (size_t)(w0_ >> 16) * 128); \
        rr[4 * (G) + 2] = *(const u4_t*)(Vb + (size_t)(w1_ & 0xffffu) * 128); rr[4 * (G) + 3] = *(const u4_t*)(Vb + (size_t)(w1_ >> 16) * 128); }
#define V_FMA(G, W) { _Pragma("unroll") for (int i_ = 4 * (G); i_ < 4 * (G) + 4; ++i_) { const float wv_ = (float)W[i_ >> 3][i_ & 7]; const float2_t ww_ = {wv_, wv_}; \
        _Pragma("unroll") for (int q_ = 0; q_ < 4; ++q_) { acc2[2 * q_] = __builtin_amdgcn_cvt_pk_f32_fp8((int)rr[i_][q_], false) * ww_ + acc2[2 * q_]; acc2[2 * q_ + 1] = __builtin_amdgcn_cvt_pk_f32_fp8((int)rr[i_][q_], true) * ww_ + acc2[2 * q_ + 1]; } } }
#define V_STEP(k, I1, I2, Wc, Wn) { float2_t acc2[8]; \
        _Pragma("unroll") for (int k_ = 0; k_ < 8; ++k_) acc2[k_] = (float2_t){0.f, 0.f}; \
        const unsigned oold_ = __builtin_nontemporal_load((const unsigned*)(xs + (size_t)TK(k) * 64)); \
        V_LOAD_IDX(I2, TK((k) + 2)); V_LOAD_W(Wn, TK((k) + 1)); SBAR; \
        V_FMA(0, Wc); SBAR; V_ISSUE(0, I1); SBAR; V_FMA(1, Wc); SBAR; V_ISSUE(1, I1); SBAR; V_FMA(2, Wc); SBAR; V_ISSUE(2, I1); SBAR; V_FMA(3, Wc); SBAR; V_ISSUE(3, I1); SBAR; \
        float a_[16]; \
        _Pragma("unroll") for (int k_ = 0; k_ < 8; ++k_) { a_[2 * k_] = acc2[k_].x; a_[2 * k_ + 1] = acc2[k_].y; } \
        _Pragma("unroll") for (int j_ = 0; j_ < 8; ++j_) { const float keep_ = (g8 & 4) ? a_[j_ + 8] : a_[j_], send_ = (g8 & 4) ? a_[j_] : a_[j_ + 8]; a_[j_] = keep_ + __shfl_xor(send_, 32); } \
        _Pragma("unroll") for (int j_ = 0; j_ < 4; ++j_) { const float keep_ = (g8 & 2) ? a_[j_ + 4] : a_[j_], send_ = (g8 & 2) ? a_[j_] : a_[j_ + 4]; a_[j_] = keep_ + __shfl_xor(send_, 16); } \
        _Pragma("unroll") for (int j_ = 0; j_ < 2; ++j_) { const float keep_ = (g8 & 1) ? a_[j_ + 2] : a_[j_], send_ = (g8 & 1) ? a_[j_] : a_[j_ + 2]; a_[j_] = keep_ + dpp_ror8(send_); } \
        __builtin_nontemporal_store((float2_t){bflo(oold_) + a_[0], bfhi(oold_) + a_[1]}, (float2_t*)(ob + (size_t)TK(k) * DM)); }
    u4_t iA[2], iB[2], rr[16]; h8_t wA[2], wB[2];
    V_LOAD_IDX(iA, TK(0)); V_LOAD_IDX(iB, TK(1)); V_LOAD_W(wA, TK(0)); SBAR;
    V_ISSUE(0, iA); SBAR; V_ISSUE(1, iA); SBAR; V_ISSUE(2, iA); SBAR; V_ISSUE(3, iA); SBAR;
    for (int k = 0; k < nk; k += 2) {
        V_STEP(k, iB, iA, wA, wB);
        if (k + 1 < nk) V_STEP(k + 1, iA, iB, wB, wA);
    }
#undef V_LOAD_IDX
#undef V_LOAD_W
#undef V_ISSUE
#undef V_FMA
#undef V_STEP
#undef TK
#undef SBAR
}

#ifndef PROBE_DBL
#define PROBE_DBL -1
#endif
#define REP(k) for (int rep_ = 0; rep_ < ((PROBE_DBL == (k)) ? 2 : 1); ++rep_)
typedef const __attribute__((address_space(4))) Params* KArgs;
#if defined(__HIP_DEVICE_COMPILE__)
#define LOADP(P) KArgs kq_ = (KArgs)__builtin_amdgcn_kernarg_segment_ptr(); asm volatile("" : "+s"(kq_)); Params P; __builtin_memcpy(&P, kq_, sizeof(Params))
#define BAR_WS() ((unsigned char*)((KArgs)__builtin_amdgcn_kernarg_segment_ptr())->ws)
#else
#define LOADP(P) const Params P = p_unused
#define BAR_WS() (p_unused.ws)
#endif
#ifndef PROBE_SPIN
#define PROBE_SPIN -1
#endif
#if PROBE_SPIN >= 0
#define STAMP(k) do { if (threadIdx.x == 0) { const unsigned long long t_ = __builtin_amdgcn_s_memrealtime(); ((volatile LAS unsigned*)(LAS unsigned char*)lds)[36800 + 2 * (k)] = (unsigned)t_; ((volatile LAS unsigned*)(LAS unsigned char*)lds)[36801 + 2 * (k)] = (unsigned)(t_ >> 32); } } while (0)
#else
#define STAMP(k) do { } while (0)
#endif
#define BAR() do { XcdBarrier xb_; xb_.bar = (unsigned*)(BAR_WS() + WS_CTL) + 4096; xb_.x = ((volatile LAS unsigned*)(LAS unsigned char*)lds)[36861]; xb_.st = (volatile LAS unsigned*)(LAS unsigned char*)lds + 36862; xcd_barrier(xb_); } while (0)
__global__ void __launch_bounds__(NTHR, 2) fwd_kernel(Params p_unused) {
    extern __shared__ __attribute__((aligned(16))) unsigned char lds[];
    PG8_LAS unsigned char* ldsl = (PG8_LAS unsigned char*)lds;
    { LOADP(p);
      if (blockIdx.x == 0) { unsigned* ctl0 = (unsigned*)(p.ws + WS_CTL); for (int i = threadIdx.x; i < 16384; i += NTHR) ctl0[i] = 0u; }
      if (threadIdx.x < 2) ((volatile LAS unsigned*)(LAS unsigned char*)lds)[36862 + threadIdx.x] = 0u; }
    { cg::grid_group grid = cg::this_grid(); grid.sync(); }
    { LOADP(p);
      if (threadIdx.x == 0) { unsigned* ctl0 = (unsigned*)(p.ws + WS_CTL); const unsigned xcc0 = (unsigned)__builtin_amdgcn_s_getreg((3 << 11) | 20) & 7u;
        ((volatile unsigned*)lds)[36860] = __hip_atomic_fetch_add(&ctl0[64 * xcc0], 1u, __ATOMIC_RELAXED, __HIP_MEMORY_SCOPE_AGENT); ((volatile unsigned*)lds)[36861] = xcc0;
        (void)xb_add(&(ctl0 + 4096)[XB_XCNT(xcc0)], 1u); }
      __syncthreads(); }
    STAMP(0);
    { LOADP(p); REP(0) phase_prep(p, lds); }
    BAR(); STAMP(1);
    { LOADP(p); unsigned char* ws = p.ws;
      pg8::Gemm g{(const bf16_t*)(ws + WS_XB), (const bf16_t*)(ws + WS_WIN_T), T, INW, DM, DM, 128}; pg8::StaticOrder S; S.init(T, INW, gridDim.x, blockIdx.x); pg8::EpiProjM e{(bf16_t*)(ws + WS_P)};
      pg8::gemm_phase<pg8::EpiProjM, pg8::StaticOrder, true, true>(ldsl, g, S, e); }
    { LOADP(p); unsigned char* ws = p.ws;
      pg8::Gemm g{(const bf16_t*)(ws + WS_MEMN), (const bf16_t*)(ws + WS_WMKV_T), NB * NMEM, 512, DM, DM, 128}; pg8::StaticOrder S; S.init(NB * NMEM, 512, gridDim.x, (blockIdx.x + gridDim.x / 2) % gridDim.x); pg8::EpiQM e{(bf16_t*)(ws + WS_MEMKV), 512};
      pg8::gemm_phase<pg8::EpiQM, pg8::StaticOrder, true, true>(ldsl, g, S, e); }
    BAR(); STAMP(2);
    { LOADP(p); REP(2) { sb_mfma(p, lds); __syncthreads(); } REP(3) { hg_local(p, lds); } REP(5) mem_attn_mfma(p, lds); }
    BAR(); STAMP(3);
    { LOADP(p); REP(4) hg_scan(p); }
    BAR(); STAMP(4);
    { LOADP(p); REP(6) hg_out(p, lds); }
    BAR(); STAMP(5);
    { LOADP(p); unsigned char* ws = p.ws;
      pg8::Gemm g{(const bf16_t*)(ws + WS_MIXED), (const bf16_t*)(ws + WS_WOUT_T), T, DM, DM, DM, 128}; pg8::StaticOrder S; S.init(T, DM, gridDim.x, blockIdx.x); pg8::EpiWoutM e{p.x, (bf16_t*)(ws + WS_XB), (float*)(ws + WS_SSQ)};
      pg8::gemm_phase<pg8::EpiWoutM, pg8::StaticOrder, true, true>(ldsl, g, S, e); }
#if PROBE_DBL == 7
    { LOADP(p); unsigned char* ws = p.ws;
      pg8::Gemm g{(const bf16_t*)(ws + WS_MIXED), (const bf16_t*)(ws + WS_WOUT_T), T, DM, DM, DM, 128}; pg8::StaticOrder S; S.init(T, DM, gridDim.x, blockIdx.x); pg8::EpiWoutM e{p.x, (bf16_t*)(ws + WS_XB), (float*)(ws + WS_SSQ)};
      pg8::gemm_phase<pg8::EpiWoutM, pg8::StaticOrder, true, true>(ldsl, g, S, e); }
#endif
    BAR(); STAMP(6);
    { LOADP(p); unsigned char* ws = p.ws;
      pg8::Gemm g{(const bf16_t*)(ws + WS_XB), (const bf16_t*)(ws + WS_WQ_T), T, 2048, DM, 64, (size_t)T * 128}; pg8::StaticOrder S; S.init(T, 2048, gridDim.x, blockIdx.x); pg8::EpiQM e{(bf16_t*)(ws + WS_Q), 2048};
      pg8::gemm_phase<pg8::EpiQM, pg8::StaticOrder, true, true>(ldsl, g, S, e); }
#if PROBE_DBL == 9
    { LOADP(p); unsigned char* ws = p.ws;
      pg8::Gemm g{(const bf16_t*)(ws + WS_XB), (const bf16_t*)(ws + WS_WQ_T), T, 2048, DM, 64, (size_t)T * 128}; pg8::StaticOrder S; S.init(T, 2048, gridDim.x, blockIdx.x); pg8::EpiQM e{(bf16_t*)(ws + WS_Q), 2048};
      pg8::gemm_phase<pg8::EpiQM, pg8::StaticOrder, true, true>(ldsl, g, S, e); }
#endif
    BAR(); STAMP(7);
    { LOADP(p); REP(10) topk_mfma(p, lds); }
    BAR(); STAMP(8);
#define LOAD_SL(p) Sl sl; { const unsigned* ctl = (const unsigned*)(p.ws + WS_CTL); const int myrank = (int)((volatile unsigned*)lds)[36860]; const unsigned xcc = ((volatile unsigned*)lds)[36861]; \
      bool good = (gridDim.x % 8u) == 0u; \
      for (int j = 0; j < 8; ++j) good = good && (__hip_atomic_load(&ctl[64 * j], __ATOMIC_RELAXED, __HIP_MEMORY_SCOPE_AGENT) == gridDim.x / 8u); \
      if (good) { sl.vx = (int)xcc; sl.rank = myrank; sl.nrank = (int)(gridDim.x / 8u); } \
      else { sl.vx = (int)(blockIdx.x & 7u); sl.rank = (int)(blockIdx.x >> 3); sl.nrank = (int)((gridDim.x - (blockIdx.x & 7u) + 7u) / 8u); } }
    { LOADP(p); LOAD_SL(p); REP(11) peer_u_phase(p, sl); }
    BAR(); STAMP(9);
    { LOADP(p); REP(12) peer_w_phase(p); }
    BAR(); STAMP(10);
    if (PROBE_DBL == 100) { for (int i = 0; i < 10; ++i) BAR(); }
    { LOADP(p); LOAD_SL(p); peer_v_phase(p, sl); }
#if PROBE_SPIN >= 0
    __syncthreads(); STAMP(11);
    if (blockIdx.x == 0 && threadIdx.x == 0) {
        volatile LAS unsigned* tsw = (volatile LAS unsigned*)(LAS unsigned char*)lds + 36800;
        const unsigned long long t0 = (unsigned long long)tsw[2 * PROBE_SPIN] | ((unsigned long long)tsw[2 * PROBE_SPIN + 1] << 32);
        const unsigned long long t1 = (unsigned long long)tsw[2 * PROBE_SPIN + 2] | ((unsigned long long)tsw[2 * PROBE_SPIN + 3] << 32);
        const unsigned long long until = __builtin_amdgcn_s_memrealtime() + (t1 - t0);
        while (__builtin_amdgcn_s_memrealtime() < until) __builtin_amdgcn_s_sleep(8);
    }
#endif
}

extern "C" void kernel_launch(void* const* d_in, const int* in_sizes, int n_in, void* d_out, int out_size, void* d_ws, size_t ws_size, hipStream_t stream) {
    static int grid_blocks = 0;
    if (grid_blocks == 0) {
        if (n_in != 17 || out_size != T * DM || ws_size < WS_END) { fprintf(stderr, "kernel_launch: unexpected shapes n_in %d out %d ws %zu\n", n_in, out_size, ws_size); grid_blocks = -1; return; }
        int dev = 0, cus = 0, per_cu = 0;
        (void)hipGetDevice(&dev);
        (void)hipDeviceGetAttribute(&cus, hipDeviceAttributeMultiprocessorCount, dev);
        (void)hipFuncSetAttribute((const void*)fwd_kernel, hipFuncAttributeMaxDynamicSharedMemorySize, LDS_BYTES);
        (void)hipOccupancyMaxActiveBlocksPerMultiprocessor(&per_cu, (const void*)fwd_kernel, NTHR, LDS_BYTES);
        if (per_cu < 1) { fprintf(stderr, "kernel_launch: occupancy query says %d blocks/CU\n", per_cu); per_cu = 1; }
        grid_blocks = cus * 1;
        (void)hipGetLastError();
    }
    if (grid_blocks < 0) return;
    Params p{};
    p.x = (const float*)d_in[0]; p.mem = (const float*)d_in[1]; p.g_mix = (const float*)d_in[2]; p.w_in = (const float*)d_in[3]; p.gamma_lb = (const float*)d_in[4];
    p.sb_gain = (const float*)d_in[5]; p.hg_gain = (const float*)d_in[6]; p.mem_gain = (const float*)d_in[7]; p.w_mkv = (const float*)d_in[8]; p.mq_gain = (const float*)d_in[9];
    p.mk_gain = (const float*)d_in[10]; p.w_out = (const float*)d_in[11]; p.g_ffn = (const float*)d_in[12]; p.w_q = (const float*)d_in[13]; p.sub_keys = (const float*)d_in[14];
    p.pu = (const float*)d_in[15]; p.pv = (const float*)d_in[16];
    p.out = (float*)d_out; p.ws = (unsigned char*)d_ws;
    void* args[] = {&p};
    hipError_t e = hipLaunchCooperativeKernel((const void*)fwd_kernel, dim3(grid_blocks), dim3(NTHR), args, LDS_BYTES, stream);
    if (e != hipSuccess) fprintf(stderr, "cooperative launch failed: %s (grid %d)\n", hipGetErrorString(e), grid_blocks);
}
```

```cpp
#include <hip/hip_runtime.h>
#include <hip/hip_cooperative_groups.h>
#include <cstdio>
#include <cstdint>
namespace cg = cooperative_groups;

constexpr int NB = 4, SEQ = 8192, DM = 1024, T = NB * SEQ;
constexpr int NMEM = 256, INW = 3328;
constexpr int C_SBQ = 0, C_SBK = 512, C_SBV = 1024, C_HGQ = 1536, C_HGF = 2048, C_HGI = 2560, C_HGG = 2816, C_MQ = 3072;
constexpr int NEXP = 16384, PK = 128;
constexpr float EPS = 1e-6f;
constexpr float LOG2E = 1.4426950408889634f;
constexpr float C2 = 0.125f * LOG2E;

constexpr float PEER_US = 64.f, PEER_VS = 8.f;
constexpr int NTHR = 512;
constexpr int LDS_BYTES = 147456;

constexpr size_t MiB = 1u << 20;
constexpr size_t WS_CTL = 0;
constexpr size_t WS_WIN_T = 1 * MiB;
constexpr size_t WS_WOUT_T = 8 * MiB;
constexpr size_t WS_WQ_T = 10 * MiB;
constexpr size_t WS_WMKV_T = 14 * MiB;
constexpr size_t WS_SKB = 15 * MiB;
constexpr size_t WS_LB = 15 * MiB + 512 * 1024;
constexpr size_t WS_MEMN = 16 * MiB;
constexpr size_t WS_MEMKV = 18 * MiB;
constexpr size_t WS_MEMK = 20 * MiB;
constexpr size_t WS_MEMV = 20 * MiB + 512 * 1024;
constexpr size_t WS_RSTD2 = 21 * MiB;
constexpr size_t WS_PIDX = 24 * MiB;
constexpr size_t WS_PG = 40 * MiB;
constexpr size_t WS_XB = 72 * MiB;
constexpr size_t WS_MIXED = 136 * MiB;
constexpr size_t WS_P = 200 * MiB;
constexpr size_t WS_Q = 136 * MiB;
constexpr size_t WS_X1S = 270 * MiB;
constexpr size_t WS_SSQ = 22 * MiB;
constexpr size_t WS_HGRAW = 408 * MiB;
constexpr size_t WS_PW = 56 * MiB;
constexpr size_t WS_PU = 136 * MiB;
constexpr size_t WS_U16 = 440 * MiB;
constexpr size_t WS_V16 = 472 * MiB;
constexpr size_t WS_END = 512 * MiB;

typedef unsigned short bf16_t;
__device__ __forceinline__ float bf2f(bf16_t v) { return __uint_as_float(((unsigned)v) << 16); }
__device__ __forceinline__ float bflo(unsigned w) { return __uint_as_float(w << 16); }
__device__ __forceinline__ float bfhi(unsigned w) { return __uint_as_float(w & 0xffff0000u); }
__device__ __forceinline__ bf16_t f2bf(float f) { unsigned u = __float_as_uint(f); return (bf16_t)((u + 0x7fffu + ((u >> 16) & 1u)) >> 16); }
__device__ __forceinline__ unsigned pk2(float lo, float hi) { return (unsigned)f2bf(lo) | ((unsigned)f2bf(hi) << 16); }
__device__ __forceinline__ float wave_sum(float v) {
#pragma unroll
    for (int o = 1; o < 64; o <<= 1) v += __shfl_xor(v, o);
    return v;
}
__device__ __forceinline__ float silu(float v) { return v / (1.f + __expf(-v)); }

typedef unsigned u4_t __attribute__((ext_vector_type(4)));
typedef float f32x4_t __attribute__((ext_vector_type(4)));
typedef float float2_t __attribute__((ext_vector_type(2)));
typedef _Float16 h8_t __attribute__((ext_vector_type(8)));
typedef _Float16 h2_t __attribute__((ext_vector_type(2)));
typedef _Float16 h4_t __attribute__((ext_vector_type(4)));
typedef unsigned u2_t __attribute__((ext_vector_type(2)));
typedef __bf16 bf16x2_v __attribute__((ext_vector_type(2)));
__device__ __forceinline__ float dot2bf(unsigned a, unsigned b, float c) { return __builtin_amdgcn_fdot2_f32_bf16(__builtin_bit_cast(bf16x2_v, a), __builtin_bit_cast(bf16x2_v, b), c, false); }

struct Params {
    const float *x, *mem, *g_mix, *w_in, *gamma_lb, *sb_gain, *hg_gain, *mem_gain, *w_mkv, *mq_gain, *mk_gain, *w_out, *g_ffn, *w_q, *sub_keys, *pu, *pv;
    float* out; unsigned char* ws;
};

namespace pg8 {
#define PG8_LAS __attribute__((address_space(3)))
typedef unsigned short bf16_t;
typedef short bf16x8 __attribute__((ext_vector_type(8)));
typedef float f32x4 __attribute__((ext_vector_type(4)));
typedef unsigned u32x4 __attribute__((ext_vector_type(4)));
constexpr int BM = 256, BK = 64, HALF = 128, HTB = HALF * BK * 2  , STAGE_BYTES = 8 * HTB, NXCD = 8, WGM = 8;

__host__ __device__ __forceinline__ int lds_byte(int r, int c) { const int st = (r >> 4) * 2 + (c >> 5), rr = r & 15, cc = c & 31, ob = rr * 64 + cc * 2; return st * 1024 + (ob ^ (((ob >> 9) & 1) << 5)); }
__host__ __device__ __forceinline__ void stage_rc(int b, int& R, int& C) { const int st = b / 1024, sb = b % 1024, swz = sb ^ (((sb >> 9) & 1) << 5); R = (st >> 1) * 16 + swz / 64; C = (st & 1) * 32 + (swz % 64) / 2; }
__host__ __device__ __forceinline__ int perm32(int rho) { const int n = rho >> 4, i = rho & 15; return 8 * (i >> 2) + 4 * n + (i & 3); }

struct Unit { int pm, pn; };
struct Gemm { const bf16_t* A; const bf16_t* Bt; int M, N, K; int lda; size_t kstepA; };

struct StaticOrder {
    int nM, nN, nwg, G, c;
    __host__ __device__ void init(int M, int N, int G_, int c_) { nM = M / BM; nN = N / BM; nwg = nM * nN; G = G_; c = c_; }
    __host__ __device__ bool next(int i, Unit& u) const {
        const long L = (long)i * G + c; if (L >= nwg) return false;
        int wgid = (int)L; { const int q = nwg / NXCD, r = nwg % NXCD, xcd = wgid % NXCD, off = wgid / NXCD; wgid = (xcd < r ? xcd * (q + 1) : r * (q + 1) + (xcd - r) * q) + off; }
        const int nig = WGM * nN, gid = wgid / nig, fm = gid * WGM, gsz = (nM - fm) < WGM ? (nM - fm) : WGM;
        u.pm = fm + ((wgid % nig) % gsz); u.pn = (wgid % nig) / gsz; return true;
    }
    __device__ __forceinline__ void a_ready(const Unit&) const {}
    __device__ __forceinline__ void done(const Unit&) const {}
};

__device__ __forceinline__ unsigned cvt_pk_bf16(float lo, float hi) { unsigned r; asm volatile("v_cvt_pk_bf16_f32 %0, %1, %2" : "=v"(r) : "v"(lo), "v"(hi)); return r; }
typedef float f32x2 __attribute__((ext_vector_type(2)));
template <class Epi, class Sched, bool ALIGN_EPI = false, bool SP2 = false>
__device__ __forceinline__ void gemm_phase(PG8_LAS unsigned char* lds, const Gemm g, const Sched& S, const Epi& E) {
    int tid_ = threadIdx.x; asm volatile("" : "+v"(tid_));
    const int tid = tid_, wid = __builtin_amdgcn_readfirstlane(tid >> 6), lane = tid & 63, wr = wid >> 2, wc = wid & 3, fr = lane & 15, fq = lane >> 4;
    const int K = g.K, nt = K / BK;
    unsigned voffA[2], voffB[2];
#pragma unroll
    for (int i = 0; i < 2; ++i) { int R, C; stage_rc(tid * 16 + i * 8192, R, C); const int Rb = Epi::PERM ? ((R & ~31) + perm32(R & 31)) : R;
        voffA[i] = (unsigned)(R * g.lda + C) * 2u; voffB[i] = (unsigned)(Rb * K + C) * 2u; }
    const size_t kstep = (size_t)(BK * 2);
    const size_t hstep = (size_t)HALF * K * 2;
    const size_t tstep = 2 * hstep;
    const size_t kstepA = g.kstepA, hstepA = (size_t)HALF * g.lda * 2, tstepA = 2 * hstepA;
    const unsigned ldsw = (unsigned)wid * 1024u;
    const int aoff = lds_byte(wr * 64 + fr, fq * 8), boff = lds_byte(wc * 32 + fr, fq * 8);
#define PG8_SA(b, h) (((b) * 2 + (h)) * HTB)
#define PG8_SB(b, h) ((4 + (b) * 2 + (h)) * HTB)
#define PG8_STAGE(bufoff, gbase, voff) do { _Pragma("unroll") for (int _i = 0; _i < 2; ++_i) \
        __builtin_amdgcn_global_load_lds((const unsigned*)((const char*)(gbase) + (voff)[_i]), (PG8_LAS unsigned*)(lds + (bufoff) + ldsw + _i * 8192), 16, 0, 0); } while (0)
#define PG8_LDA(dst, b, h) do { _Pragma("unroll") for (int m = 0; m < 4; ++m) _Pragma("unroll") for (int k = 0; k < 2; ++k) dst[m][k] = *(const PG8_LAS bf16x8*)(lds + PG8_SA(b, h) + aoff + m * 2048 + k * 1024); } while (0)
#define PG8_LDB(dst, b, h) do { _Pragma("unroll") for (int n = 0; n < 2; ++n) _Pragma("unroll") for (int k = 0; k < 2; ++k) dst[n][k] = *(const PG8_LAS bf16x8*)(lds + PG8_SB(b, h) + boff + n * 2048 + k * 1024); } while (0)
#define PG8_MMA(ai, bj, At, Bt) do { __builtin_amdgcn_s_setprio(1); _Pragma("unroll") for (int m = 0; m < 4; ++m) _Pragma("unroll") for (int n = 0; n < 2; ++n) _Pragma("unroll") for (int k = 0; k < 2; ++k) \
        acc[ai][bj][m][n] = __builtin_amdgcn_mfma_f32_16x16x32_bf16(Bt[n][k], At[m][k], acc[ai][bj][m][n], 0, 0, 0); __builtin_amdgcn_s_setprio(0); } while (0)
#define PG8_WAIT_V(n) asm volatile("s_waitcnt vmcnt(" #n ")" ::: "memory")
#define PG8_WAIT_L(n) asm volatile("s_waitcnt lgkmcnt(" #n ")" ::: "memory")
#define PG8_BAR __builtin_amdgcn_s_barrier()
#define PG8_SCHED __builtin_amdgcn_sched_barrier(0)
    Unit cur, nxt; int ui = 0;
    if (!S.next(0, cur)) return;
    f32x4 acc[2][2][4][2];
#pragma unroll
    for (int a = 0; a < 2; ++a)
#pragma unroll
        for (int b = 0; b < 2; ++b)
#pragma unroll
            for (int m = 0; m < 4; ++m)
#pragma unroll
                for (int n = 0; n < 2; ++n) acc[a][b][m][n] = (f32x4){0.f, 0.f, 0.f, 0.f};
    bf16x8 At[4][2], B0[2][2], B1[2][2];
    const char* cA = (const char*)g.A + (size_t)cur.pm * tstepA; const char* cB = (const char*)g.Bt + (size_t)cur.pn * tstep;
    S.a_ready(cur);
    if constexpr (SP2) {
        PG8_STAGE(PG8_SB(0, 0), cB, voffB); PG8_STAGE(PG8_SB(0, 1), cB + hstep, voffB); PG8_STAGE(PG8_SA(0, 0), cA, voffA); PG8_STAGE(PG8_SA(0, 1), cA + hstepA, voffA);
        if (wr == 1) PG8_BAR;
        PG8_WAIT_V(2); PG8_BAR;
        PG8_STAGE(PG8_SB(1, 0), cB + kstep, voffB); PG8_STAGE(PG8_SA(1, 0), cA + kstepA, voffA); PG8_STAGE(PG8_SB(1, 1), cB + hstep + kstep, voffB);
        PG8_WAIT_V(6); PG8_BAR;
    } else {
        PG8_STAGE(PG8_SB(0, 0), cB, voffB); PG8_STAGE(PG8_SA(0, 0), cA, voffA); PG8_STAGE(PG8_SB(0, 1), cB + hstep, voffB); PG8_STAGE(PG8_SA(0, 1), cA + hstepA, voffA);
        if (wr == 1) PG8_BAR;
        PG8_WAIT_V(4); PG8_BAR;
        PG8_STAGE(PG8_SB(1, 0), cB + kstep, voffB); PG8_STAGE(PG8_SA(1, 0), cA + kstepA, voffA); PG8_STAGE(PG8_SB(1, 1), cB + hstep + kstep, voffB);
        PG8_WAIT_V(6); PG8_BAR;
    }
    for (;;) {
        const bool has_next = S.next(ui + 1, nxt);
        const char* nA = has_next ? (const char*)g.A + (size_t)nxt.pm * tstepA : cA; const char* nB = has_next ? (const char*)g.Bt + (size_t)nxt.pn * tstep : cB;
        for (int t = 0; t < nt; t += 2) {
            const bool last = (t == nt - 2);
            const char* a1 = cA + (size_t)(t + 1) * kstepA;
            const char* a2 = last ? nA : cA + (size_t)(t + 2) * kstepA; const char* b2 = last ? nB : cB + (size_t)(t + 2) * kstep;
            const char* a3 = a2 + kstepA; const char* b3 = b2 + kstep;
            if (last && has_next) S.a_ready(nxt);
            if constexpr (SP2) {
            PG8_LDB(B0, 0, 0); PG8_LDB(B1, 0, 1); PG8_SCHED; PG8_LDA(At, 0, 0); PG8_STAGE(PG8_SA(1, 1), a1 + hstepA, voffA);
            PG8_WAIT_V(8); PG8_WAIT_L(0); PG8_BAR; PG8_MMA(0, 0, At, B0); PG8_MMA(0, 1, At, B1); PG8_BAR; PG8_SCHED;
            PG8_LDA(At, 0, 1); PG8_STAGE(PG8_SB(0, 0), b2, voffB); PG8_STAGE(PG8_SB(0, 1), b2 + hstep, voffB); PG8_STAGE(PG8_SA(0, 0), a2, voffA);
            PG8_WAIT_V(8); PG8_WAIT_L(0); PG8_BAR; PG8_MMA(1, 0, At, B0); PG8_MMA(1, 1, At, B1); PG8_BAR; PG8_SCHED;
            PG8_LDB(B0, 1, 0); PG8_LDB(B1, 1, 1); PG8_SCHED; PG8_LDA(At, 1, 0); PG8_STAGE(PG8_SA(0, 1), a2 + hstepA, voffA);
            PG8_WAIT_V(8); PG8_WAIT_L(0); PG8_BAR; PG8_MMA(0, 0, At, B0); PG8_MMA(0, 1, At, B1); PG8_BAR; PG8_SCHED;
            PG8_LDA(At, 1, 1); PG8_STAGE(PG8_SB(1, 0), b3, voffB); PG8_STAGE(PG8_SB(1, 1), b3 + hstep, voffB); PG8_STAGE(PG8_SA(1, 0), a3, voffA);
            PG8_WAIT_V(8); PG8_WAIT_L(0); PG8_BAR; PG8_MMA(1, 0, At, B0); PG8_MMA(1, 1, At, B1); PG8_BAR; PG8_SCHED;
            } else {
            PG8_LDB(B0, 0, 0); PG8_SCHED; PG8_LDA(At, 0, 0); PG8_STAGE(PG8_SA(1, 1), a1 + hstepA, voffA);
            PG8_WAIT_L(8); PG8_BAR; PG8_WAIT_L(0); PG8_MMA(0, 0, At, B0); PG8_BAR; PG8_SCHED;
            PG8_LDB(B1, 0, 1); PG8_STAGE(PG8_SB(0, 0), b2, voffB);
            PG8_BAR; PG8_WAIT_L(0); PG8_MMA(0, 1, At, B1); PG8_BAR;
            PG8_LDA(At, 0, 1); PG8_STAGE(PG8_SA(0, 0), a2, voffA);
            PG8_BAR; PG8_WAIT_L(0); PG8_MMA(1, 0, At, B0); PG8_BAR; PG8_SCHED;
            PG8_STAGE(PG8_SB(0, 1), b2 + hstep, voffB);
            PG8_WAIT_V(6); PG8_BAR; PG8_MMA(1, 1, At, B1); PG8_BAR;
            PG8_LDB(B0, 1, 0); PG8_SCHED; PG8_LDA(At, 1, 0); PG8_STAGE(PG8_SA(0, 1), a2 + hstepA, voffA);
            PG8_WAIT_L(8); PG8_BAR; PG8_WAIT_L(0); PG8_MMA(0, 0, At, B0); PG8_BAR; PG8_SCHED;
            PG8_LDB(B1, 1, 1); PG8_STAGE(PG8_SB(1, 0), b3, voffB);
            PG8_BAR; PG8_WAIT_L(0); PG8_MMA(0, 1, At, B1); PG8_BAR;
            PG8_LDA(At, 1, 1); PG8_STAGE(PG8_SA(1, 0), a3, voffA);
            PG8_BAR; PG8_WAIT_L(0); PG8_MMA(1, 0, At, B0); PG8_BAR; PG8_SCHED;
            PG8_STAGE(PG8_SB(1, 1), b3 + hstep, voffB);
            PG8_WAIT_V(6); PG8_BAR; PG8_MMA(1, 1, At, B1); PG8_BAR;
            }
        }
        if constexpr (ALIGN_EPI) { if (wr == 0) PG8_BAR; }
        if constexpr (!Epi::AFTER_DRAIN) { E(acc, cur, wr, wc, fr, fq); S.done(cur); }
        if (!has_next) break;
#pragma unroll
        for (int a = 0; a < 2; ++a)
#pragma unroll
            for (int b = 0; b < 2; ++b)
#pragma unroll
                for (int m = 0; m < 4; ++m)
#pragma unroll
                    for (int n = 0; n < 2; ++n) acc[a][b][m][n] = (f32x4){0.f, 0.f, 0.f, 0.f};
        cur = nxt; cA = nA; cB = nB; ++ui;
        if constexpr (ALIGN_EPI) { if (wr == 1) PG8_BAR; }
    }
    PG8_WAIT_V(0);
    if constexpr (!ALIGN_EPI) { if (wr == 0) PG8_BAR; }
    PG8_BAR;
    if constexpr (Epi::AFTER_DRAIN) { E.fused(acc, cur, wr, wc, fr, fq, lds, wid, lane); S.done(cur); }
#undef PG8_SA
#undef PG8_SB
#undef PG8_STAGE
#undef PG8_LDA
#undef PG8_LDB
#undef PG8_MMA
#undef PG8_WAIT_V
#undef PG8_WAIT_L
#undef PG8_BAR
#undef PG8_SCHED
}
}


namespace pg8 {
typedef unsigned u32x4 __attribute__((ext_vector_type(4)));
__device__ __forceinline__ float permf(float v, int addr) { return __int_as_float(__builtin_amdgcn_ds_bpermute(addr, __float_as_int(v))); }
__device__ __forceinline__ unsigned permu(unsigned v, int addr) { return (unsigned)__builtin_amdgcn_ds_bpermute(addr, (int)v); }
struct EpiProjM {
    static constexpr bool PERM = true, AFTER_DRAIN = false;
    bf16_t* P;
    __device__ __forceinline__ void operator()(const f32x4 (&acc)[2][2][4][2], const Unit& u, int wr, int wc, int fr, int fq) const {
        const int L = fr + 16 * fq, frp = L >> 2, fqp = L & 3, pa = 4 * (frp + 16 * fqp);
        const int row0 = u.pm * BM + wr * 64 + frp, col0 = u.pn * BM + wc * 32 + 8 * fqp;
        const int pn = u.pn; const int mode = (pn < 2) ? 1 : ((pn == 6 || pn == 7 || pn == 11) ? 2 : 0);
#pragma unroll
        for (int ai = 0; ai < 2; ++ai)
#pragma unroll
            for (int m = 0; m < 4; ++m) { bf16_t* rowp = P + (size_t)(row0 + ai * HALF + m * 16) * INW + col0;
#pragma unroll
                for (int bj = 0; bj < 2; ++bj) { f32x4 v0 = acc[ai][bj][m][0], v1 = acc[ai][bj][m][1];
                    if (mode == 1) { v0 = v0 * C2; v1 = v1 * C2; }
                    else if (mode == 2) {
#pragma unroll
                        for (int e = 0; e < 4; ++e) { v0[e] = silu(v0[e]); v1[e] = silu(v1[e]); } }
                    u32x4 w; w.x = permu(cvt_pk_bf16(v0[0], v0[1]), pa); w.y = permu(cvt_pk_bf16(v0[2], v0[3]), pa); w.z = permu(cvt_pk_bf16(v1[0], v1[1]), pa); w.w = permu(cvt_pk_bf16(v1[2], v1[3]), pa);
                    *(u32x4*)(rowp + bj * HALF) = w; } }
    }
};
struct EpiWoutM {
    static constexpr bool PERM = true, AFTER_DRAIN = false;
    const float* x; bf16_t* x1bs; float* ssq;
    __device__ __forceinline__ void operator()(const f32x4 (&acc)[2][2][4][2], const Unit& u, int wr, int wc, int fr, int fq) const {
        const int L = fr + 16 * fq, frp = L >> 2, fqp = L & 3, pa = 4 * (frp + 16 * fqp);
        const int row0 = u.pm * BM + wr * 64 + frp, col0 = u.pn * BM + wc * 32 + 8 * fqp;
#pragma unroll
        for (int ai = 0; ai < 2; ++ai)
#pragma unroll
            for (int m = 0; m < 4; ++m) { const int row = row0 + ai * HALF + m * 16; const size_t rb = (size_t)row * DM + col0; float sq = 0.f;
#pragma unroll
                for (int bj = 0; bj < 2; ++bj) { const size_t i = rb + bj * HALF;
                    const f32x4 x0 = *(const f32x4*)(x + i), x1 = *(const f32x4*)(x + i + 4);
                    f32x4 v0, v1;
#pragma unroll
                    for (int e = 0; e < 4; ++e) { v0[e] = permf(acc[ai][bj][m][0][e], pa) + x0[e]; v1[e] = permf(acc[ai][bj][m][1][e], pa) + x1[e]; }
                    sq += (v0[0] * v0[0] + v0[1] * v0[1]) + (v0[2] * v0[2] + v0[3] * v0[3]) + (v1[0] * v1[0] + v1[1] * v1[1]) + (v1[2] * v1[2] + v1[3] * v1[3]);
                    const int col = col0 + bj * HALF, s = (col >> 5) & 15, j = ((col >> 9) << 5) | (col & 31);
                    const size_t o = ((size_t)s * T + row) * 64 + j;
                    u32x4 w; w.x = cvt_pk_bf16(v0[0], v0[1]); w.y = cvt_pk_bf16(v0[2], v0[3]); w.z = cvt_pk_bf16(v1[0], v1[1]); w.w = cvt_pk_bf16(v1[2], v1[3]);
                    *(u32x4*)(x1bs + o) = w; }
                sq += __shfl_xor(sq, 1); sq += __shfl_xor(sq, 2);
                if (fqp == 0) ssq[(size_t)row * 16 + u.pn * 4 + wc] = sq; }
    }
};
struct EpiQM {
    static constexpr bool PERM = true, AFTER_DRAIN = false;
    bf16_t* Q; int ld;
    __device__ __forceinline__ void operator()(const f32x4 (&acc)[2][2][4][2], const Unit& u, int wr, int wc, int fr, int fq) const {
        const int L = fr + 16 * fq, frp = L >> 2, fqp = L & 3, pa = 4 * (frp + 16 * fqp);
        const int row0 = u.pm * BM + wr * 64 + frp, col0 = u.pn * BM + wc * 32 + 8 * fqp;
#pragma unroll
        for (int ai = 0; ai < 2; ++ai)
#pragma unroll
            for (int m = 0; m < 4; ++m) { const int row = row0 + ai * HALF + m * 16; bf16_t* rowp = Q + (size_t)row * ld + col0;
#pragma unroll
                for (int bj = 0; bj < 2; ++bj) { const f32x4 v0 = acc[ai][bj][m][0], v1 = acc[ai][bj][m][1];
                    u32x4 w; w.x = permu(cvt_pk_bf16(v0[0], v0[1]), pa); w.y = permu(cvt_pk_bf16(v0[2], v0[3]), pa); w.z = permu(cvt_pk_bf16(v1[0], v1[1]), pa); w.w = permu(cvt_pk_bf16(v1[2], v1[3]), pa);
                    *(u32x4*)(rowp + bj * HALF) = w; } }
    }
};
}

#define LAS __attribute__((address_space(3)))
#define XB_TMO      128
#define XB_XCNT(j)  (256  + 64 * (j))
#define XB_XSUB(j)  (1280 + 64 * (j))
#define XB_XGEN(j)  (2304 + 64 * (j))
#define XB_TOP      3328
#define XB_TOPGEN   3392
#define XCD_BAR_WORDS 3456
#define XB_SPIN_CAP (1u << 18)

__device__ __forceinline__ unsigned xb_ld(unsigned* p)              { return __hip_atomic_load(p, __ATOMIC_RELAXED, __HIP_MEMORY_SCOPE_AGENT); }
__device__ __forceinline__ unsigned xb_add(unsigned* p, unsigned v) { return __hip_atomic_fetch_add(p, v, __ATOMIC_RELAXED, __HIP_MEMORY_SCOPE_AGENT); }
__device__ __forceinline__ unsigned xb_xcc_id() { return (unsigned)__builtin_amdgcn_s_getreg((3 << 11) | 20) & 0xFu; }
#define XB_SPIN(cond, bar) do { unsigned _sp = 0; while (cond) { __builtin_amdgcn_s_sleep(1); \
    if ((++_sp & 255u) == 0u) { if (xb_ld(&(bar)[XB_TMO])) break; if (_sp > XB_SPIN_CAP) { atomicAdd(&(bar)[XB_TMO], 1u); break; } } } } while (0)

struct XcdBarrier {
    unsigned* bar; unsigned x;
    volatile LAS unsigned* st;
};

__device__ __forceinline__ XcdBarrier xcd_barrier_post(unsigned* bar, volatile LAS unsigned* st) {
    XcdBarrier b; b.bar = bar; b.x = xb_xcc_id(); b.st = st;
    if (threadIdx.x == 0) (void)xb_add(&bar[XB_XCNT(b.x)], 1u);
    return b;
}
__device__ __forceinline__ void xcd_barrier_complete(unsigned* bar, unsigned x, unsigned& nloc, unsigned& nx) {
    const unsigned G = gridDim.x * gridDim.y * gridDim.z;
    unsigned sum, cnt, mine, sp = 0u;
    for (;;) {
        sum = 0u; cnt = 0u; mine = 0u;
#pragma unroll
        for (unsigned j = 0; j < 16; ++j) { const unsigned c = xb_ld(&bar[XB_XCNT(j)]); sum += c; cnt += (c > 0u) ? 1u : 0u; mine = (j == x) ? c : mine; }
        if (sum == G) break;
        __builtin_amdgcn_s_sleep(1);
        if ((++sp & 255u) == 0u) { if (xb_ld(&bar[XB_TMO])) break; if (sp > XB_SPIN_CAP) { atomicAdd(&bar[XB_TMO], 1u); break; } }
    }
    nloc = mine > 0u ? mine : 1u; nx = cnt > 0u ? cnt : 1u;
}

__device__ __forceinline__ void xcd_barrier(const XcdBarrier& b) {
    asm volatile("s_waitcnt vmcnt(0)" ::: "memory");
    __syncthreads();
    if (threadIdx.x == 0) {
        unsigned* bar = b.bar;
        __builtin_amdgcn_s_waitcnt(0);
        unsigned nloc = b.st[0], nx = b.st[1];
        if (nloc == 0u) { xcd_barrier_complete(bar, b.x, nloc, nx); b.st[0] = nloc; b.st[1] = nx; }
        const unsigned old = xb_add(&bar[XB_XSUB(b.x)], 1u);
        const unsigned gen = old / nloc;
        if (old + 1u == (gen + 1u) * nloc) {
            __builtin_amdgcn_fence(__ATOMIC_RELEASE, "agent");
            asm volatile("s_waitcnt vmcnt(0)" ::: "memory");
            const unsigned og = xb_add(&bar[XB_TOP], 1u);
            const unsigned tg = og / nx;
            if (og + 1u == (tg + 1u) * nx) xb_add(&bar[XB_TOPGEN], 1u);
            else XB_SPIN(xb_ld(&bar[XB_TOPGEN]) == tg, bar);
            __builtin_amdgcn_fence(__ATOMIC_ACQUIRE, "agent");
            xb_add(&bar[XB_XGEN(b.x)], 1u);
            asm volatile("s_waitcnt vmcnt(0)" ::: "memory");
        } else {
            XB_SPIN(xb_ld(&bar[XB_XGEN(b.x)]) == gen, bar);
            __builtin_amdgcn_fence(__ATOMIC_ACQUIRE, "agent");
            asm volatile("s_waitcnt vmcnt(0)" ::: "memory");
        }
    }
    __syncthreads();
}

template <bool SLICEK = false> __device__ __forceinline__ void transpose_item(const float* W, const float* gain, int K, int N, bf16_t* WT, float* scr, int item, int lane) {
    const int nblk = N / 32, kb = item / nblk, nb = item % nblk, k0 = 64 * kb, n0 = 32 * nb;
#pragma unroll 16
    for (int i = 0; i < 32; ++i) { const int kk = 2 * i + (lane >> 5); const int ks = SLICEK ? ((kk >> 5) * 512 + 32 * kb + (kk & 31)) : (k0 + kk); float g = gain ? gain[ks] : 1.f; scr[kk * 33 + (lane & 31)] = W[(size_t)ks * N + n0 + (lane & 31)] * g; }
    __builtin_amdgcn_s_waitcnt(0); __builtin_amdgcn_wave_barrier();
    const int c = lane & 7;
#pragma unroll
    for (int j = 0; j < 4; ++j) { const int n = (lane >> 3) + 8 * j; const float* s = scr + (8 * c) * 33 + n;
        uint4 o; o.x = pk2(s[0 * 33], s[1 * 33]); o.y = pk2(s[2 * 33], s[3 * 33]); o.z = pk2(s[4 * 33], s[5 * 33]); o.w = pk2(s[6 * 33], s[7 * 33]);
        *(uint4*)(WT + (size_t)(n0 + n) * K + k0 + 8 * c) = o; }
    __builtin_amdgcn_s_waitcnt(0); __builtin_amdgcn_wave_barrier();
}
__device__ __forceinline__ void norm_row_to_bf16(const float* xrow, bf16_t* orow, int lane) {
    const float4* xr = (const float4*)xrow + lane;
    float4 v[4]; float s = 0.f;
#pragma unroll
    for (int j = 0; j < 4; ++j) { v[j] = xr[64 * j]; s += (v[j].x * v[j].x + v[j].y * v[j].y) + (v[j].z * v[j].z + v[j].w * v[j].w); }
    const float rstd = rsqrtf(wave_sum(s) * (1.f / DM) + EPS);
    unsigned long long* o8 = (unsigned long long*)orow + lane;
#pragma unroll
    for (int j = 0; j < 4; ++j) o8[64 * j] = (unsigned long long)pk2(v[j].x * rstd, v[j].y * rstd) | ((unsigned long long)pk2(v[j].z * rstd, v[j].w * rstd) << 32);
}
__device__ __forceinline__ void phase_prep(const Params& p, unsigned char* lds) {
    const int tid = threadIdx.x, lane = tid & 63, wave = tid >> 6;
    const int gw = blockIdx.x * 8 + wave, NGW = gridDim.x * 8;
    const int gt = blockIdx.x * NTHR + tid, NGT = gridDim.x * NTHR;
    unsigned char* ws = p.ws;
    float* scr = (float*)lds + wave * (64 * 33);
    constexpr int I_IN = (DM / 64) * (INW / 32), I_OUT = (DM / 64) * (DM / 32), I_Q = (DM / 64) * (2048 / 32), I_MKV = (DM / 64) * (512 / 32);
    for (int it = gw; it < I_IN + I_OUT + I_Q + I_MKV; it += NGW) {
        int r = it;
        if (r < I_IN) { transpose_item(p.w_in, p.g_mix, DM, INW, (bf16_t*)(ws + WS_WIN_T), scr, r, lane); continue; } r -= I_IN;
        if (r < I_OUT) { transpose_item(p.w_out, nullptr, DM, DM, (bf16_t*)(ws + WS_WOUT_T), scr, r, lane); continue; } r -= I_OUT;
        if (r < I_Q) { transpose_item<true>(p.w_q, p.g_ffn, DM, 2048, (bf16_t*)(ws + WS_WQ_T), scr, r, lane); continue; } r -= I_Q;
        transpose_item(p.w_mkv, p.mem_gain, DM, 512, (bf16_t*)(ws + WS_WMKV_T), scr, r, lane);
    }
    for (int m0 = gw * 4; m0 < T; m0 += NGW * 4) {
        f32x4_t v[4][4]; float s[4];
#pragma unroll
        for (int q = 0; q < 4; ++q) { const f32x4_t* xr = (const f32x4_t*)(p.x + (size_t)(m0 + q) * DM) + lane;
#pragma unroll
            for (int j = 0; j < 4; ++j) v[q][j] = __builtin_nontemporal_load(xr + 64 * j); }
#pragma unroll
        for (int q = 0; q < 4; ++q) { float a = 0.f;
#pragma unroll
            for (int j = 0; j < 4; ++j) a += (v[q][j][0] * v[q][j][0] + v[q][j][1] * v[q][j][1]) + (v[q][j][2] * v[q][j][2] + v[q][j][3] * v[q][j][3]);
            s[q] = a; }
#pragma unroll
        for (int o = 1; o < 64; o <<= 1) {
#pragma unroll
            for (int q = 0; q < 4; ++q) s[q] += __shfl_xor(s[q], o); }
#pragma unroll
        for (int q = 0; q < 4; ++q) { const float rstd = rsqrtf(s[q] * (1.f / DM) + EPS);
            unsigned long long* o8 = (unsigned long long*)((bf16_t*)(ws + WS_XB) + (size_t)(m0 + q) * DM) + lane;
#pragma unroll
            for (int j = 0; j < 4; ++j) o8[64 * j] = (unsigned long long)pk2(v[q][j][0] * rstd, v[q][j][1] * rstd) | ((unsigned long long)pk2(v[q][j][2] * rstd, v[q][j][3] * rstd) << 32); }
    }
    for (int m = gw; m < NB * NMEM; m += NGW) norm_row_to_bf16(p.mem + (size_t)m * DM, (bf16_t*)(ws + WS_MEMN) + (size_t)m * DM, lane);
    for (int i = gt; i < 8 * 2 * 128 * 128; i += NGT) ((bf16_t*)(ws + WS_SKB))[i] = f2bf(p.sub_keys[i]);
#pragma unroll 2
    for (int i = gt; i < NEXP * 8 * 8; i += NGT) {
        const int c = i & 7, S = (i >> 3) & 7, e = i >> 6;
        const int s16 = 2 * S + (c >> 2), j0 = (c & 3) * 16, d0 = (j0 >> 5) * 512 + 32 * s16 + (j0 & 31);
        const f32x4_t* up = (const f32x4_t*)(p.pu + (size_t)e * DM + d0); const f32x4_t* vp = (const f32x4_t*)(p.pv + (size_t)e * DM + d0); const f32x4_t* gp = (const f32x4_t*)(p.g_ffn + d0);
        u4_t uo, vo;
#pragma unroll
        for (int q = 0; q < 4; ++q) { const f32x4_t a = __builtin_nontemporal_load(up + q), g = gp[q], b = __builtin_nontemporal_load(vp + q);
            int w = 0; w = __builtin_amdgcn_cvt_pk_fp8_f32(a.x * g.x * PEER_US, a.y * g.y * PEER_US, w, false); w = __builtin_amdgcn_cvt_pk_fp8_f32(a.z * g.z * PEER_US, a.w * g.w * PEER_US, w, true); uo[q] = (unsigned)w;
            int z = 0; z = __builtin_amdgcn_cvt_pk_fp8_f32(b.x * PEER_VS, b.y * PEER_VS, z, false); z = __builtin_amdgcn_cvt_pk_fp8_f32(b.z * PEER_VS, b.w * PEER_VS, z, true); vo[q] = (unsigned)z; }
        *(u4_t*)(ws + WS_U16 + ((size_t)S * NEXP + e) * 128 + 16 * c) = uo;
        *(u4_t*)(ws + WS_V16 + ((size_t)S * NEXP + e) * 128 + 16 * c) = vo;
    }
    for (int i = gt; i < 512; i += NGT) ((float*)(ws + WS_LB))[i] = 1.f / (1.f + expf(p.gamma_lb[512 + i] - p.gamma_lb[i]));
}

typedef float f32x16 __attribute__((ext_vector_type(16)));
typedef short sh8_t __attribute__((ext_vector_type(8)));
__device__ __forceinline__ unsigned cvtpk(float lo, float hi) { unsigned r; asm("v_cvt_pk_bf16_f32 %0, %1, %2" : "=v"(r) : "v"(lo), "v"(hi)); return r; }
__device__ __forceinline__ bf16_t cvt1(float x) { return (bf16_t)(cvtpk(x, x) & 0xffffu); }
__device__ __forceinline__ void mma32(f32x16& acc, const LAS bf16_t* A, int lda, const LAS bf16_t* Bt, int ldb, int K, int lane) {
    const int r = lane & 31, h = lane >> 5;
    const LAS bf16_t* ap = A + r * lda + 8 * h; const LAS bf16_t* bp = Bt + r * ldb + 8 * h;
    for (int k0 = 0; k0 < K; k0 += 16) {
        const sh8_t a = *(const LAS sh8_t*)(ap + k0), b = *(const LAS sh8_t*)(bp + k0);
        acc = __builtin_amdgcn_mfma_f32_32x32x16_bf16(a, b, acc, 0, 0, 0);
    }
}
__device__ __forceinline__ int crow(int r, int hh) { return (r & 3) + 8 * (r >> 2) + 4 * hh; }
constexpr size_t HG_LT = WS_XB;
constexpr size_t HG_SB = 408 * MiB;
constexpr size_t HG_DD = 456 * MiB;
__device__ __forceinline__ void hg_load_col(const bf16_t* P, int col0, int unit, int tid, bf16_t (&raw)[16]) {
    const int bh = unit >> 7, c = unit & 127, b_ = bh >> 2, h = bh & 3, rg = tid >> 7, k = tid & 127;
    const bf16_t* pr = P + ((size_t)b_ * SEQ + c * 64 + rg * 16) * INW + col0 + h * 128 + k;
#pragma unroll
    for (int i = 0; i < 16; ++i) raw[i] = pr[(size_t)i * INW];
}
__device__ __forceinline__ u4_t hg_load_v(const bf16_t* P, int unit, int tid) {
    const int bh = unit >> 7, c = unit & 127, b_ = bh >> 2, h = bh & 3;
    return *(const u4_t*)(P + ((size_t)b_ * SEQ + c * 64 + (tid >> 3)) * INW + C_HGI + h * 64 + (tid & 7) * 8);
}
__device__ __forceinline__ void hg_cols(const bf16_t (&fl)[16], float lb, LAS float* gs, int tid, float (&kk)[16], float (&bc)[16], float& bmid, float& blast) {
    const int rg = tid >> 7, k = tid & 127;
    float run = 0.f;
#pragma unroll
    for (int i = 0; i < 16; ++i) { const float kv = (1.f - lb) / (1.f + __expf(bf2f(fl[i]))); kk[i] = kv; run += __logf(1.f - kv); bc[i] = run; }
    gs[rg * 128 + k] = run;
    __syncthreads();
    const float g0 = gs[k], g1 = gs[128 + k], g2 = gs[256 + k], g3 = gs[384 + k];
    const float off = (rg > 0 ? g0 : 0.f) + (rg > 1 ? g1 : 0.f) + (rg > 2 ? g2 : 0.f);
#pragma unroll
    for (int i = 0; i < 16; ++i) bc[i] += off;
    bmid = g0 + g1; blast = (g0 + g1) + (g2 + g3);
}
__device__ __forceinline__ void hg_store_vt(LAS bf16_t* VT, int tid, const u4_t v) {
    const int s = tid >> 3, jq = tid & 7;
    LAS bf16_t* d = VT + (jq * 8) * 72 + s;
    d[0 * 72] = (bf16_t)(v.x & 0xffff); d[1 * 72] = (bf16_t)(v.x >> 16); d[2 * 72] = (bf16_t)(v.y & 0xffff); d[3 * 72] = (bf16_t)(v.y >> 16);
    d[4 * 72] = (bf16_t)(v.z & 0xffff); d[5 * 72] = (bf16_t)(v.z >> 16); d[6 * 72] = (bf16_t)(v.w & 0xffff); d[7 * 72] = (bf16_t)(v.w >> 16);
}
__device__ __forceinline__ void hg_local(const Params& p, unsigned char* ldsb) {
    const bf16_t* P = (const bf16_t*)(p.ws + WS_P); const float* lbp = (const float*)(p.ws + WS_LB);
    float* LT = (float*)((unsigned char*)p.ws + HG_LT); float* DD = (float*)((unsigned char*)p.ws + HG_DD);
    LAS unsigned char* l = (LAS unsigned char*)ldsb;
    LAS float* gs = (LAS float*)l; LAS bf16_t* KST = (LAS bf16_t*)(l + 2048); LAS bf16_t* VT = (LAS bf16_t*)(l + 20480);
    const int tid = threadIdx.x, lane = tid & 63, wave = tid >> 6, rg = tid >> 7, k = tid & 127;
    bf16_t flr[16]; u4_t vr;
    if ((int)blockIdx.x < 2048) { hg_load_col(P, C_HGF, blockIdx.x, tid, flr); vr = hg_load_v(P, blockIdx.x, tid); }
    for (int unit = blockIdx.x; unit < 2048; unit += gridDim.x) {
        const int bh = unit >> 7, h = bh & 3;
        float kk[16], bc[16], bmid, blast;
        hg_cols(flr, lbp[h * 128 + k], gs, tid, kk, bc, bmid, blast);
        const u4_t vcur = vr;
        { const int nu = unit + gridDim.x; if (nu < 2048) { hg_load_col(P, C_HGF, nu, tid, flr); vr = hg_load_v(P, nu, tid); } }
        { unsigned w[8];
#pragma unroll
          for (int i = 0; i < 8; ++i) w[i] = cvtpk(kk[2 * i] * __expf(blast - bc[2 * i]), kk[2 * i + 1] * __expf(blast - bc[2 * i + 1]));
          LAS u4_t* d = (LAS u4_t*)(KST + k * 72 + rg * 16);
          d[0] = (u4_t){w[0], w[1], w[2], w[3]}; d[1] = (u4_t){w[4], w[5], w[6], w[7]}; }
        hg_store_vt(VT, tid, vcur);
        if (tid < 128) DD[(size_t)unit * 128 + tid] = __expf(blast);
        __syncthreads();
        { const int ji = wave >> 2, ki = wave & 3;
          f32x16 acc;
#pragma unroll
          for (int r = 0; r < 16; ++r) acc[r] = 0.f;
          mma32(acc, VT + 32 * ji * 72, 72, KST + 32 * ki * 72, 72, 64, lane);
          float* o = LT + (size_t)unit * 8192 + 32 * ki + (lane & 31);
#pragma unroll
          for (int r = 0; r < 16; ++r) o[(size_t)(32 * ji + crow(r, lane >> 5)) * 128] = acc[r]; }
        __syncthreads();
    }
}
__device__ __forceinline__ void hg_scan(const Params& p) {
    const float* LT = (const float*)((unsigned char*)p.ws + HG_LT); const float* DD = (const float*)((unsigned char*)p.ws + HG_DD);
    bf16_t* SB = (bf16_t*)((unsigned char*)p.ws + HG_SB);
    for (int gt = blockIdx.x * NTHR + threadIdx.x; gt < 16 * 8192; gt += gridDim.x * NTHR) {
        const int bh = gt >> 13, e = gt & 8191, k = e & 127;
        float S = 0.f;
#pragma unroll 8
        for (int c = 0; c < 128; ++c) { const size_t u = (size_t)bh * 128 + c;
            const float L = LT[u * 8192 + e], D = DD[u * 128 + k];
            SB[u * 8192 + e] = cvt1(S); S = fmaf(D, S, L); }
    }
}
__device__ __forceinline__ void hg_out(const Params& p, unsigned char* ldsb) {
    const bf16_t* P = (const bf16_t*)(p.ws + WS_P); const float* lbp = (const float*)(p.ws + WS_LB);
    const bf16_t* SB = (const bf16_t*)((unsigned char*)p.ws + HG_SB);
    bf16_t* mixed = (bf16_t*)(p.ws + WS_MIXED);
    LAS unsigned char* l = (LAS unsigned char*)ldsb;
    LAS float* gs = (LAS float*)l;
    LAS bf16_t* QT = (LAS bf16_t*)(l + 2048); LAS bf16_t* KT = (LAS bf16_t*)(l + 19456); LAS bf16_t* QI = (LAS bf16_t*)(l + 36864);
    LAS bf16_t* VT = (LAS bf16_t*)(l + 54272); LAS bf16_t* SC = (LAS bf16_t*)(l + 63488); LAS bf16_t* ST = (LAS bf16_t*)(l + 72704);
    LAS float* OB = (LAS float*)(l + 90112);
    const int tid = threadIdx.x, lane = tid & 63, wave = tid >> 6, rg = tid >> 7, k = tid & 127;
    bf16_t flr[16], qr[16]; u4_t vr, gr, sr[2];
#define HGO_LOAD(u_) { hg_load_col(P, C_HGF, (u_), tid, flr); hg_load_col(P, C_HGQ, (u_), tid, qr); vr = hg_load_v(P, (u_), tid); \
        { const int bh_ = (u_) >> 7, c_ = (u_) & 127; gr = *(const u4_t*)(P + ((size_t)(bh_ >> 2) * SEQ + c_ * 64 + (tid >> 3)) * INW + C_HGG + (bh_ & 3) * 64 + (tid & 7) * 8); } \
        sr[0] = *(const u4_t*)(SB + (size_t)(u_) * 8192 + tid * 8); sr[1] = *(const u4_t*)(SB + (size_t)(u_) * 8192 + tid * 8 + 4096); }
    if ((int)blockIdx.x < 2048) HGO_LOAD((int)blockIdx.x);
    for (int unit = blockIdx.x; unit < 2048; unit += gridDim.x) {
        const int bh = unit >> 7, c = unit & 127, b_ = bh >> 2, h = bh & 3;
        const size_t tok0 = (size_t)b_ * SEQ + c * 64;
        float kk[16], bc[16], bmid, blast;
        hg_cols(flr, lbp[h * 128 + k], gs, tid, kk, bc, bmid, blast);
        float qf_[16];
#pragma unroll
        for (int i = 0; i < 16; ++i) qf_[i] = bf2f(qr[i]);
        const u4_t vcur = vr, gv_ = gr, s0_ = sr[0], s1_ = sr[1];
        { const int nu = unit + gridDim.x; if (nu < 2048) HGO_LOAD(nu); }
        {
#pragma unroll
          for (int i = 0; i < 16; ++i) { const float q = qf_[i]; const int o = (rg * 16 + i) * 136 + k;
              QT[o] = cvt1(q * __expf(fminf(bc[i] - bmid, 40.f))); KT[o] = cvt1(kk[i] * __expf(fminf(bmid - bc[i], 40.f))); QI[o] = cvt1(q * __expf(bc[i])); } }
        hg_store_vt(VT, tid, vcur);
        { const int idx0 = tid * 8, idx1 = tid * 8 + 4096;
          *(LAS u4_t*)(ST + (idx0 >> 7) * 136 + (idx0 & 127)) = s0_; *(LAS u4_t*)(ST + (idx1 >> 7) * 136 + (idx1 & 127)) = s1_; }
        __syncthreads();
        if (wave < 4) { const int ti = wave >> 1, si = wave & 1;
            f32x16 acc;
#pragma unroll
            for (int r = 0; r < 16; ++r) acc[r] = 0.f;
            if (si <= ti) mma32(acc, QT + 32 * ti * 136, 136, KT + 32 * si * 136, 136, 128, lane);
            const int s = 32 * si + (lane & 31);
#pragma unroll
            for (int r = 0; r < 16; ++r) { const int t = 32 * ti + crow(r, lane >> 5); SC[t * 72 + s] = cvt1((s <= t) ? acc[r] : 0.f); } }
        __syncthreads();
        if (wave < 4) { const int ti = wave >> 1, ji = wave & 1;
            f32x16 acc;
#pragma unroll
            for (int r = 0; r < 16; ++r) acc[r] = 0.f;
            mma32(acc, SC + 32 * ti * 72, 72, VT + 32 * ji * 72, 72, 64, lane);
            mma32(acc, QI + 32 * ti * 136, 136, ST + 32 * ji * 136, 136, 128, lane);
            const int j = 32 * ji + (lane & 31);
#pragma unroll
            for (int r = 0; r < 16; ++r) OB[(32 * ti + crow(r, lane >> 5)) * 65 + j] = acc[r]; }
        __syncthreads();
        { const int t = tid >> 3, jq = tid & 7;
          float o[8]; float ss = 0.f;
#pragma unroll
          for (int e = 0; e < 8; ++e) { o[e] = OB[t * 65 + jq * 8 + e]; ss = fmaf(o[e], o[e], ss); }
          ss += __shfl_xor(ss, 1); ss += __shfl_xor(ss, 2); ss += __shfl_xor(ss, 4);
          const float r = rsqrtf(ss * (1.f / 64.f) + EPS);
          const u4_t gv = gv_;
          const float* gn = p.hg_gain + h * 64 + jq * 8;
          uint4 w; w.x = cvtpk(o[0] * r * gn[0] * bflo(gv.x), o[1] * r * gn[1] * bfhi(gv.x)); w.y = cvtpk(o[2] * r * gn[2] * bflo(gv.y), o[3] * r * gn[3] * bfhi(gv.y));
          w.z = cvtpk(o[4] * r * gn[4] * bflo(gv.z), o[5] * r * gn[5] * bfhi(gv.z)); w.w = cvtpk(o[6] * r * gn[6] * bflo(gv.w), o[7] * r * gn[7] * bfhi(gv.w));
          *(uint4*)(mixed + (tok0 + t) * DM + 512 + h * 64 + jq * 8) = w; }
        __syncthreads();
    }
#undef HGO_LOAD
}

__device__ __forceinline__ sh8_t frag8(const float (&x)[8]) { const u4_t w = {cvtpk(x[0], x[1]), cvtpk(x[2], x[3]), cvtpk(x[4], x[5]), cvtpk(x[6], x[7])}; return __builtin_bit_cast(sh8_t, w); }
__device__ __forceinline__ int kperm(int key) { return (key & 16) | ((key & 4) << 1) | ((key & 8) >> 1) | (key & 3); }
__device__ __forceinline__ void vt_store(LAS bf16_t* VT, int pitch, int d0, int pos, const u4_t v) {
    LAS bf16_t* d = VT + d0 * pitch + pos;
    d[0 * pitch] = (bf16_t)(v.x & 0xffff); d[1 * pitch] = (bf16_t)(v.x >> 16); d[2 * pitch] = (bf16_t)(v.y & 0xffff); d[3 * pitch] = (bf16_t)(v.y >> 16);
    d[4 * pitch] = (bf16_t)(v.z & 0xffff); d[5 * pitch] = (bf16_t)(v.z >> 16); d[6 * pitch] = (bf16_t)(v.w & 0xffff); d[7 * pitch] = (bf16_t)(v.w >> 16);
}
__device__ __forceinline__ void sb_mfma(const Params& p, unsigned char* ldsb) {
    const bf16_t* P = (const bf16_t*)(p.ws + WS_P);
    bf16_t* mixed = (bf16_t*)(p.ws + WS_MIXED);
    const int tid = threadIdx.x, lane = tid & 63, wave = tid >> 6, r = lane & 31, hh = lane >> 5;
    LAS bf16_t* KL = (LAS bf16_t*)ldsb + wave * (32 * 72 + 64 * 40);
    LAS bf16_t* VT = KL + 32 * 72;
    sh8_t mf[2];
#pragma unroll
    for (int ks = 0; ks < 2; ++ks)
#pragma unroll
        for (int e = 0; e < 8; ++e) { const int j = 16 * ks + 8 * (e >> 2) + 4 * hh + (e & 3); mf[ks][e] = (j > r) ? (short)0x3F80 : (short)0; }
    for (int u = blockIdx.x * 8 + wave; u < 32 * 256; u += gridDim.x * 8) {
        const int bh = u >> 8, qt = u & 255, b = bh >> 3, h = bh & 7;
        const size_t tok0 = (size_t)b * SEQ + qt * 32;
        sh8_t qf[4];
        { const bf16_t* qp = P + (tok0 + r) * INW + C_SBQ + h * 64 + 8 * hh;
#pragma unroll
          for (int ks = 0; ks < 4; ++ks) qf[ks] = *(const sh8_t*)(qp + 16 * ks); }
        f32x16 o0, o1;
#pragma unroll
        for (int i = 0; i < 16; ++i) { o0[i] = 0.f; o1[i] = 0.f; }
        float R = 0.f;
        u4_t kraw[4], vraw[4];
        { const bf16_t* kvp = P + ((size_t)b * SEQ + qt * 32 + (lane >> 3)) * INW + h * 64 + (lane & 7) * 8;
#pragma unroll
          for (int i = 0; i < 4; ++i) { kraw[i] = *(const u4_t*)(kvp + (size_t)(8 * i) * INW + C_SBK); vraw[i] = *(const u4_t*)(kvp + (size_t)(8 * i) * INW + C_SBV); } }
        for (int kt = qt; kt >= 0; --kt) {
#pragma unroll
            for (int i = 0; i < 4; ++i) { const int key = (lane >> 3) + 8 * i, dq = lane & 7;
                *(LAS u4_t*)(KL + key * 72 + dq * 8) = kraw[i];
                vt_store(VT, 40, dq * 8, kperm(key), vraw[i]); }
            { const int ktn = kt > 0 ? kt - 1 : 0;
              const bf16_t* kvp = P + ((size_t)b * SEQ + ktn * 32 + (lane >> 3)) * INW + h * 64 + (lane & 7) * 8;
#pragma unroll
              for (int i = 0; i < 4; ++i) { kraw[i] = *(const u4_t*)(kvp + (size_t)(8 * i) * INW + C_SBK); vraw[i] = *(const u4_t*)(kvp + (size_t)(8 * i) * INW + C_SBV); } }
            f32x16 z;
#pragma unroll
            for (int i = 0; i < 16; ++i) z[i] = 0.f;
#pragma unroll
            for (int ks = 0; ks < 4; ++ks) z = __builtin_amdgcn_mfma_f32_32x32x16_bf16(*(const LAS sh8_t*)(KL + r * 72 + 16 * ks + 8 * hh), qf[ks], z, 0, 0, 0);
            const bool diag = (kt == qt);
            float sp[16]; f32x16 la; float tot = 0.f;
#pragma unroll
            for (int i = 0; i < 16; ++i) { const float zz = z[i];
                float s = fmaxf(zz, 0.f) + __builtin_amdgcn_logf(1.f + __builtin_amdgcn_exp2f(-fabsf(zz)));
                const bool valid = !diag || (crow(i, hh) < r);
                la[i] = zz - s + R; s = valid ? s : 0.f; sp[i] = s; tot += s; }
            tot += __shfl_xor(tot, 32);
#pragma unroll
            for (int ks = 0; ks < 2; ++ks) {
                unsigned hi[4], lo[4];
#pragma unroll
                for (int e = 0; e < 4; ++e) { const float x0 = -sp[8 * ks + 2 * e], x1 = -sp[8 * ks + 2 * e + 1]; hi[e] = cvtpk(x0, x1); lo[e] = cvtpk(x0 - bflo(hi[e]), x1 - bfhi(hi[e])); }
                const u4_t hv = {hi[0], hi[1], hi[2], hi[3]}, lv = {lo[0], lo[1], lo[2], lo[3]};
                la = __builtin_amdgcn_mfma_f32_32x32x16_bf16(mf[ks], __builtin_bit_cast(sh8_t, hv), la, 0, 0, 0);
                la = __builtin_amdgcn_mfma_f32_32x32x16_bf16(mf[ks], __builtin_bit_cast(sh8_t, lv), la, 0, 0, 0);
            }
            sh8_t af[2];
#pragma unroll
            for (int ks = 0; ks < 2; ++ks) { float a[8];
#pragma unroll
                for (int e = 0; e < 8; ++e) { const int i = 8 * ks + e; const bool valid = !diag || (crow(i, hh) < r); a[e] = valid ? __builtin_amdgcn_exp2f(la[i]) : 0.f; }
                af[ks] = frag8(a); }
            R -= tot;
#pragma unroll
            for (int ks = 0; ks < 2; ++ks) {
                o0 = __builtin_amdgcn_mfma_f32_32x32x16_bf16(*(const LAS sh8_t*)(VT + r * 40 + 16 * ks + 8 * hh), af[ks], o0, 0, 0, 0);
                o1 = __builtin_amdgcn_mfma_f32_32x32x16_bf16(*(const LAS sh8_t*)(VT + (32 + r) * 40 + 16 * ks + 8 * hh), af[ks], o1, 0, 0, 0);
            }
            if (__all(R < -48.f)) break;
        }
        float ss = 0.f;
#pragma unroll
        for (int i = 0; i < 16; ++i) { ss = fmaf(o0[i], o0[i], ss); ss = fmaf(o1[i], o1[i], ss); }
        ss += __shfl_xor(ss, 32);
        const float rn = rsqrtf(ss * (1.f / 64.f) + EPS);
        bf16_t* op = mixed + (tok0 + r) * DM + h * 64 + 4 * hh;
        const float* gp = p.sb_gain + h * 64 + 4 * hh;
#pragma unroll
        for (int q4 = 0; q4 < 4; ++q4) {
            const float4 g0 = *(const float4*)(gp + 8 * q4), g1 = *(const float4*)(gp + 32 + 8 * q4);
            uint2 w0, w1;
            w0.x = cvtpk(o0[4 * q4] * rn * g0.x, o0[4 * q4 + 1] * rn * g0.y); w0.y = cvtpk(o0[4 * q4 + 2] * rn * g0.z, o0[4 * q4 + 3] * rn * g0.w);
            w1.x = cvtpk(o1[4 * q4] * rn * g1.x, o1[4 * q4 + 1] * rn * g1.y); w1.y = cvtpk(o1[4 * q4 + 2] * rn * g1.z, o1[4 * q4 + 3] * rn * g1.w);
            *(uint2*)(op + 8 * q4) = w0; *(uint2*)(op + 32 + 8 * q4) = w1;
        }
    }
}
__device__ __forceinline__ void mem_attn_mfma(const Params& p, unsigned char* ldsb) {
    const bf16_t* P = (const bf16_t*)(p.ws + WS_P);
    const bf16_t* kvb = (const bf16_t*)(p.ws + WS_MEMKV);
    bf16_t* mixed = (bf16_t*)(p.ws + WS_MIXED);
    const int tid = threadIdx.x, lane = tid & 63, wave = tid >> 6, r = lane & 31, hh = lane >> 5;
    LAS bf16_t* VT = (LAS bf16_t*)ldsb;
    LAS bf16_t* KN = VT + 64 * 264;
    for (int unit = blockIdx.x; unit < NB * 4 * (SEQ / 256); unit += gridDim.x) {
        const int tb = unit & 31, hd = (unit >> 5) & 3, b = unit >> 7;
        __syncthreads();
#pragma unroll
        for (int i = 0; i < 4; ++i) { const int idx = tid + 512 * i, key = idx >> 3, dq = idx & 7;
            const u4_t v = *(const u4_t*)(kvb + ((size_t)b * NMEM + key) * 512 + 256 + hd * 64 + dq * 8);
            vt_store(VT, 264, dq * 8, (key & ~31) | kperm(key & 31), v); }
        { const bf16_t* kp = kvb + ((size_t)b * NMEM + wave * 32 + r) * 512 + hd * 64 + 8 * hh;
          u4_t kw[4]; float ssk = 0.f;
#pragma unroll
          for (int ks = 0; ks < 4; ++ks) { kw[ks] = *(const u4_t*)(kp + 16 * ks);
#pragma unroll
              for (int e = 0; e < 4; ++e) { const float lo = bflo(kw[ks][e]), hi = bfhi(kw[ks][e]); ssk = fmaf(lo, lo, ssk); ssk = fmaf(hi, hi, ssk); } }
          ssk += __shfl_xor(ssk, 32);
          const float rk = rsqrtf(ssk * (1.f / 64.f) + EPS);
#pragma unroll
          for (int ks = 0; ks < 4; ++ks) { float t8[8];
#pragma unroll
              for (int e = 0; e < 4; ++e) { t8[2 * e] = bflo(kw[ks][e]) * rk; t8[2 * e + 1] = bfhi(kw[ks][e]) * rk; }
              *(LAS sh8_t*)(KN + (wave * 32 + r) * 72 + 16 * ks + 8 * hh) = frag8(t8); } }
        __syncthreads();
        const size_t tok = (size_t)b * SEQ + tb * 256 + wave * 32 + r;
        sh8_t qf[4];
        { const bf16_t* qp = P + tok * INW + C_MQ + hd * 64 + 8 * hh;
          float qv[32]; float ss = 0.f;
#pragma unroll
          for (int ks = 0; ks < 4; ++ks) { const u4_t w = *(const u4_t*)(qp + 16 * ks);
              qv[8 * ks] = bflo(w.x); qv[8 * ks + 1] = bfhi(w.x); qv[8 * ks + 2] = bflo(w.y); qv[8 * ks + 3] = bfhi(w.y); qv[8 * ks + 4] = bflo(w.z); qv[8 * ks + 5] = bfhi(w.z); qv[8 * ks + 6] = bflo(w.w); qv[8 * ks + 7] = bfhi(w.w); }
#pragma unroll
          for (int i = 0; i < 32; ++i) ss = fmaf(qv[i], qv[i], ss);
          ss += __shfl_xor(ss, 32);
          const float rq = rsqrtf(ss * (1.f / 64.f) + EPS) * (0.125f * LOG2E);
#pragma unroll
          for (int ks = 0; ks < 4; ++ks) { float t8[8];
#pragma unroll
              for (int e = 0; e < 8; ++e) t8[e] = qv[8 * ks + e] * rq * p.mq_gain[16 * ks + 8 * hh + e] * p.mk_gain[16 * ks + 8 * hh + e];
              qf[ks] = frag8(t8); } }
        f32x16 s[8];
#pragma unroll
        for (int kt = 0; kt < 8; ++kt) {
#pragma unroll
            for (int i = 0; i < 16; ++i) s[kt][i] = 0.f;
#pragma unroll
            for (int ks = 0; ks < 4; ++ks) s[kt] = __builtin_amdgcn_mfma_f32_32x32x16_bf16(*(const LAS sh8_t*)(KN + (kt * 32 + r) * 72 + 16 * ks + 8 * hh), qf[ks], s[kt], 0, 0, 0);
        }
        float mx = -1e30f;
#pragma unroll
        for (int kt = 0; kt < 8; ++kt)
#pragma unroll
            for (int i = 0; i < 16; ++i) mx = fmaxf(mx, s[kt][i]);
        mx = fmaxf(mx, __shfl_xor(mx, 32));
        float lsum = 0.f;
        f32x16 o0, o1;
#pragma unroll
        for (int i = 0; i < 16; ++i) { o0[i] = 0.f; o1[i] = 0.f; }
#pragma unroll
        for (int kt = 0; kt < 8; ++kt)
#pragma unroll
            for (int ks = 0; ks < 2; ++ks) { float a[8];
#pragma unroll
                for (int e = 0; e < 8; ++e) { a[e] = __builtin_amdgcn_exp2f(s[kt][8 * ks + e] - mx); lsum += a[e]; }
                const sh8_t af = frag8(a);
                o0 = __builtin_amdgcn_mfma_f32_32x32x16_bf16(*(const LAS sh8_t*)(VT + r * 264 + 32 * kt + 16 * ks + 8 * hh), af, o0, 0, 0, 0);
                o1 = __builtin_amdgcn_mfma_f32_32x32x16_bf16(*(const LAS sh8_t*)(VT + (32 + r) * 264 + 32 * kt + 16 * ks + 8 * hh), af, o1, 0, 0, 0); }
        lsum += __shfl_xor(lsum, 32);
        const float il = 1.f / lsum;
        bf16_t* op = mixed + tok * DM + 768 + hd * 64 + 4 * hh;
#pragma unroll
        for (int q4 = 0; q4 < 4; ++q4) {
            uint2 w0, w1;
            w0.x = cvtpk(o0[4 * q4] * il, o0[4 * q4 + 1] * il); w0.y = cvtpk(o0[4 * q4 + 2] * il, o0[4 * q4 + 3] * il);
            w1.x = cvtpk(o1[4 * q4] * il, o1[4 * q4 + 1] * il); w1.y = cvtpk(o1[4 * q4 + 2] * il, o1[4 * q4 + 3] * il);
            *(uint2*)(op + 8 * q4) = w0; *(uint2*)(op + 32 + 8 * q4) = w1;
        }
    }
}

__device__ __forceinline__ int tk_pack(float s, int payload, int mask) { const int b = __float_as_int(s); const int m = b ^ ((b >> 31) & 0x7fffffff); return (m & ~mask) | payload; }
__device__ __forceinline__ float tk_unpack(int key, int mask) { const int m = key & ~mask; return __int_as_float(m ^ ((m >> 31) & 0x7fffffff)); }
template <int N> __device__ __forceinline__ void bitonic_sort_desc(int (&v)[N]) {
#pragma unroll
    for (int k = 2; k <= N; k <<= 1)
#pragma unroll
        for (int j = k >> 1; j > 0; j >>= 1)
#pragma unroll
            for (int i = 0; i < N; ++i) { const int l = i ^ j; if (l > i) { const bool desc = ((i & k) == 0); const int a = v[i], b = v[l]; const int hi = max(a, b), lo = min(a, b); v[i] = desc ? hi : lo; v[l] = desc ? lo : hi; } }
}
__device__ __forceinline__ void merge_top16(int (&A)[16], const int (&B)[16]) {
#pragma unroll
    for (int i = 0; i < 16; ++i) A[i] = max(A[i], B[15 - i]);
#pragma unroll
    for (int j = 8; j > 0; j >>= 1)
#pragma unroll
        for (int i = 0; i < 16; ++i) { const int l = i ^ j; if (l > i) { const int a = A[i], b = A[l]; A[i] = max(a, b); A[l] = min(a, b); } }
}
__device__ __forceinline__ void top16_of_64(int (&g0)[16], int (&g1)[16], int (&g2)[16], int (&g3)[16]) {
    bitonic_sort_desc<16>(g0); bitonic_sort_desc<16>(g1); bitonic_sort_desc<16>(g2); bitonic_sort_desc<16>(g3);
    merge_top16(g0, g1); merge_top16(g2, g3); merge_top16(g0, g2);
}
__device__ __forceinline__ void topk_mfma(const Params& p, unsigned char* ldsb) {
    const bf16_t* Q = (const bf16_t*)(p.ws + WS_Q);
    const bf16_t* SK = (const bf16_t*)(p.ws + WS_SKB);
    unsigned short* pidx16 = (unsigned short*)(p.ws + WS_PIDX); float* pg = (float*)(p.ws + WS_PG);
    const float* ssq = (const float*)(p.ws + WS_SSQ); float* rs2 = (float*)(p.ws + WS_RSTD2);
    LAS unsigned char* l = (LAS unsigned char*)ldsb;
    LAS bf16_t* SKL = (LAS bf16_t*)l;
    const int tid = threadIdx.x, lane = tid & 63, wave = tid >> 6, r = lane & 31, hh = lane >> 5;
    LAS unsigned char* ib = l + 69632 + (wave * 64 + lane) * 36;
    int cur_h = -1;
    for (int unit = blockIdx.x; unit < 8 * (T / 256); unit += gridDim.x) {
        const int h = unit & 7, tb = unit >> 3;
        if (h != cur_h) {
            __syncthreads();
#pragma unroll
            for (int it = 0; it < 8; ++it) { const int idx = tid + 512 * it, row = idx >> 4, cq = idx & 15;
                *(LAS u4_t*)(SKL + row * 136 + cq * 8) = *(const u4_t*)(SK + ((size_t)h * 256 + row) * 128 + cq * 8); }
            __syncthreads();
            cur_h = h;
        }
        const int tok = tb * 256 + wave * 32 + r;
        int sorted[2][16];
#pragma unroll
        for (int c = 0; c < 2; ++c) {
            sh8_t qf[8];
            { const sh8_t* qp = (const sh8_t*)(Q + (size_t)tok * 2048 + h * 256 + c * 128 + 8 * hh);
#pragma unroll
              for (int ks = 0; ks < 8; ++ks) qf[ks] = qp[2 * ks]; }
            int g[4][16];
#pragma unroll
            for (int mt = 0; mt < 4; ++mt) {
                f32x16 acc;
#pragma unroll
                for (int i = 0; i < 16; ++i) acc[i] = 0.f;
                const LAS bf16_t* ap = SKL + (c * 128 + 32 * mt + r) * 136 + 8 * hh;
#pragma unroll
                for (int ks = 0; ks < 8; ++ks) acc = __builtin_amdgcn_mfma_f32_32x32x16_bf16(*(const LAS sh8_t*)(ap + 16 * ks), qf[ks], acc, 0, 0, 0);
#pragma unroll
                for (int i = 0; i < 16; ++i) g[mt][i] = tk_pack(acc[i], (32 * mt + (i & 3) + 8 * (i >> 2)) | (hh << 2), 127);
            }
            top16_of_64(g[0], g[1], g[2], g[3]);
            int o[16];
#pragma unroll
            for (int i = 0; i < 16; ++i) o[i] = __shfl_xor(g[0][i], 32);
            merge_top16(g[0], o);
#pragma unroll
            for (int i = 0; i < 16; ++i) sorted[c][i] = g[0][i];
        }
#pragma unroll
        for (int c = 0; c < 2; ++c)
#pragma unroll
            for (int w = 0; w < 4; ++w)
                *(LAS unsigned*)(ib + c * 16 + w * 4) = (unsigned)(sorted[c][4 * w] & 127) | ((unsigned)(sorted[c][4 * w + 1] & 127) << 8) | ((unsigned)(sorted[c][4 * w + 2] & 127) << 16) | ((unsigned)(sorted[c][4 * w + 3] & 127) << 24);
        float av[16], bv[16];
#pragma unroll
        for (int i = 0; i < 16; ++i) { av[i] = tk_unpack(sorted[0][i], 127); bv[i] = tk_unpack(sorted[1][i], 127); }
        int cd[4][16];
        {
            int n = 0;
#pragma unroll
            for (int i = 0; i < 16; ++i)
#pragma unroll
                for (int j = 0; j < 16; ++j)
                    if ((i + 1) * (j + 1) <= 16) { cd[n >> 4][n & 15] = tk_pack(av[i] + bv[j], i * 16 + j, 255); ++n; }
#pragma unroll
            for (; n < 64; ++n) cd[n >> 4][n & 15] = (int)0x80000000;
        }
        top16_of_64(cd[0], cd[1], cd[2], cd[3]);
        float sv[16]; int ex[16];
        float rstd;
        { const f32x4_t* sp_ = (const f32x4_t*)(ssq + (size_t)tok * 16); const f32x4_t q0 = sp_[0], q1 = sp_[1], q2 = sp_[2], q3 = sp_[3];
          const float tot = ((q0[0] + q0[1]) + (q0[2] + q0[3])) + ((q1[0] + q1[1]) + (q1[2] + q1[3])) + ((q2[0] + q2[1]) + (q2[2] + q2[3])) + ((q3[0] + q3[1]) + (q3[2] + q3[3]));
          rstd = rsqrtf(tot * (1.f / DM) + EPS); if (h == 0 && hh == 0) rs2[tok] = rstd; }
        const float s0 = tk_unpack(cd[0][0], 255);
        float sum = 0.f;
#pragma unroll
        for (int q = 0; q < 16; ++q) { const int key = cd[0][q]; const int id = key & 255;
            const int ia = ib[id >> 4], ibx = ib[16 + (id & 15)];
            ex[q] = ia * 128 + ibx; sv[q] = __expf((tk_unpack(key, 255) - s0) * rstd); sum += sv[q]; }
        const float inv = 1.f / sum;
        if (hh == 0) { u4_t* d = (u4_t*)(pidx16 + (size_t)tok * PK + h * 16);
#pragma unroll
            for (int w = 0; w < 2; ++w) d[w] = (u4_t){(unsigned)ex[8 * w] | ((unsigned)ex[8 * w + 1] << 16), (unsigned)ex[8 * w + 2] | ((unsigned)ex[8 * w + 3] << 16), (unsigned)ex[8 * w + 4] | ((unsigned)ex[8 * w + 5] << 16), (unsigned)ex[8 * w + 6] | ((unsigned)ex[8 * w + 7] << 16)}; }
        else { float4* d = (float4*)(pg + (size_t)tok * PK + h * 16);
#pragma unroll
            for (int w = 0; w < 4; ++w) d[w] = make_float4(sv[4 * w] * inv, sv[4 * w + 1] * inv, sv[4 * w + 2] * inv, sv[4 * w + 3] * inv); }
    }
}

struct Sl { int vx, rank, nrank; };
__device__ __forceinline__ float dpp_xor1(float x) { return __int_as_float(__builtin_amdgcn_mov_dpp(__float_as_int(x), 0xB1, 0xF, 0xF, true)); }
__device__ __forceinline__ float dpp_xor2(float x) { return __int_as_float(__builtin_amdgcn_mov_dpp(__float_as_int(x), 0x4E, 0xF, 0xF, true)); }
__device__ __forceinline__ float dpp_ror8(float x) { return __int_as_float(__builtin_amdgcn_mov_dpp(__float_as_int(x), 0x128, 0xF, 0xF, true)); }
__device__ __forceinline__ float dpp_hmir(float x) { return __int_as_float(__builtin_amdgcn_mov_dpp(__float_as_int(x), 0x141, 0xF, 0xF, true)); }
__device__ __forceinline__ void peer_u_phase(const Params& p, const Sl sl) {
    const int lane = threadIdx.x & 63, wave = threadIdx.x >> 6, g8 = lane >> 3, c = lane & 7;
    const unsigned short* pidx = (const unsigned short*)(p.ws + WS_PIDX);
    const int per = (T + sl.nrank * 8 - 1) / (sl.nrank * 8), tbase = (sl.rank * 8 + wave) * per, stride = 1;
    const int nk = (tbase < T) ? ((T - tbase < per) ? (T - tbase) : per) : 0;
    const int S = sl.vx;
    const unsigned char* Ub = p.ws + WS_U16 + (size_t)S * NEXP * 128 + c * 16;
    const bf16_t* xbb = (const bf16_t*)(p.ws + WS_XB) + (size_t)(2 * S + (c >> 2)) * T * 64 + (c & 3) * 16;
    _Float16* PUs = (_Float16*)(p.ws + WS_PU) + (size_t)S * T * PK;
    if (nk == 0) return;
#define TK(k) (tbase + ((k) < nk ? (k) : nk - 1) * stride)
#define SBAR __builtin_amdgcn_sched_barrier(0)
#define U_LOAD_IDX(I, t) { const u4_t* ip_ = (const u4_t*)(pidx + (size_t)(t) * PK + g8 * 16); I[0] = __builtin_nontemporal_load(ip_); I[1] = __builtin_nontemporal_load(ip_ + 1); }
#define U_LOAD_H(H, t) { const u4_t* hp_ = (const u4_t*)(xbb + (size_t)(t) * 64); H[0] = __builtin_nontemporal_load(hp_); H[1] = __builtin_nontemporal_load(hp_ + 1); }
#define U_ISSUE(G, I) { const unsigned w0_ = I[(G) >> 1][(2 * (G)) & 3], w1_ = I[(G) >> 1][(2 * (G) + 1) & 3]; \
        rr[4 * (G)] = *(const u4_t*)(Ub + (size_t)(w0_ & 0xffffu) * 128); rr[4 * (G) + 1] = *(const u4_t*)(Ub + (size_t)(w0_ >> 16) * 128); \
        rr[4 * (G) + 2] = *(const u4_t*)(Ub + (size_t)(w1_ & 0xffffu) * 128); rr[4 * (G) + 3] = *(const u4_t*)(Ub + (size_t)(w1_ >> 16) * 128); }
#define U_DOT(G) { _Pragma("unroll") for (int i_ = 4 * (G); i_ < 4 * (G) + 4; ++i_) { float2_t a_ = {0.f, 0.f}; \
        _Pragma("unroll") for (int q_ = 0; q_ < 4; ++q_) { a_ = __builtin_amdgcn_cvt_pk_f32_fp8((int)rr[i_][q_], false) * X2[2 * q_] + a_; a_ = __builtin_amdgcn_cvt_pk_f32_fp8((int)rr[i_][q_], true) * X2[2 * q_ + 1] + a_; } \
        pr[i_] = a_.x + a_.y; } }
#define U_STEP(k, I1, I2, Hc, Hn) { float pr[16]; float2_t X2[8]; \
        _Pragma("unroll") for (int m_ = 0; m_ < 8; ++m_) { const unsigned hw_ = Hc[m_ >> 2][m_ & 3]; X2[m_] = (float2_t){bflo(hw_), bfhi(hw_)}; } \
        U_LOAD_IDX(I2, TK((k) + 2)); U_LOAD_H(Hn, TK((k) + 1)); SBAR; \
        U_DOT(0); SBAR; U_ISSUE(0, I1); SBAR; U_DOT(1); SBAR; U_ISSUE(1, I1); SBAR; U_DOT(2); SBAR; U_ISSUE(2, I1); SBAR; U_DOT(3); SBAR; U_ISSUE(3, I1); SBAR; \
        _Pragma("unroll") for (int j_ = 0; j_ < 8; ++j_) { const float keep_ = (c & 4) ? pr[j_ + 8] : pr[j_], send_ = (c & 4) ? pr[j_] : pr[j_ + 8]; pr[j_] = keep_ + dpp_hmir(send_); } \
        _Pragma("unroll") for (int j_ = 0; j_ < 4; ++j_) { const float keep_ = (c & 2) ? pr[j_ + 4] : pr[j_], send_ = (c & 2) ? pr[j_] : pr[j_ + 4]; pr[j_] = keep_ + dpp_xor2(send_); } \
        _Pragma("unroll") for (int j_ = 0; j_ < 2; ++j_) { const float keep_ = (c & 1) ? pr[j_ + 2] : pr[j_], send_ = (c & 1) ? pr[j_] : pr[j_ + 2]; pr[j_] = keep_ + dpp_xor1(send_); } \
        __builtin_nontemporal_store((h2_t){(_Float16)pr[0], (_Float16)pr[1]}, (h2_t*)(PUs + (size_t)TK(k) * PK + g8 * 16 + 2 * c)); }
    u4_t iA[2], iB[2], rr[16], hA[2], hB[2];
    U_LOAD_IDX(iA, TK(0)); U_LOAD_IDX(iB, TK(1)); U_LOAD_H(hA, TK(0)); SBAR;
    U_ISSUE(0, iA); SBAR; U_ISSUE(1, iA); SBAR; U_ISSUE(2, iA); SBAR; U_ISSUE(3, iA); SBAR;
    for (int k = 0; k < nk; k += 2) {
        U_STEP(k, iB, iA, hA, hB);
        if (k + 1 < nk) U_STEP(k + 1, iA, iB, hB, hA);
    }
#undef U_LOAD_IDX
#undef U_LOAD_H
#undef U_ISSUE
#undef U_DOT
#undef U_STEP
}
__device__ __forceinline__ void peer_w_phase(const Params& p) {
    const _Float16* PU = (const _Float16*)(p.ws + WS_PU); const float* pg = (const float*)(p.ws + WS_PG); const float* rs = (const float*)(p.ws + WS_RSTD2);
    _Float16* pw = (_Float16*)(p.ws + WS_PW);
    for (int i = blockIdx.x * NTHR + threadIdx.x; i < T * PK / 8; i += gridDim.x * NTHR) {
        float s[8];
#pragma unroll
        for (int e = 0; e < 8; ++e) s[e] = 0.f;
#pragma unroll
        for (int x = 0; x < 8; ++x) { const h8_t hv = __builtin_nontemporal_load((const h8_t*)(PU + (size_t)x * T * PK) + i);
#pragma unroll
            for (int e = 0; e < 8; ++e) s[e] += (float)hv[e]; }
        const float r = rs[i >> 4] * (1.f / PEER_US);
        const f32x4_t g0 = *((const f32x4_t*)pg + 2 * i), g1 = *((const f32x4_t*)pg + 2 * i + 1);
        h8_t wv;
#pragma unroll
        for (int e = 0; e < 4; ++e) { const float a = s[e] * r, b = s[4 + e] * r;
            wv[e] = (_Float16)(g0[e] * (0.5f / PEER_VS) * a * (1.f + erff(a * 0.70710678118654752f))); wv[4 + e] = (_Float16)(g1[e] * (0.5f / PEER_VS) * b * (1.f + erff(b * 0.70710678118654752f))); }
        *((h8_t*)pw + i) = wv;
    }
}
__device__ __forceinline__ void peer_v_phase(const Params& p, const Sl sl) {
    const int lane = threadIdx.x & 63, wave = threadIdx.x >> 6, g8 = lane >> 3, c = lane & 7;
    const unsigned short* pidx = (const unsigned short*)(p.ws + WS_PIDX); const _Float16* pw = (const _Float16*)(p.ws + WS_PW);
    const int per = (T + sl.nrank * 8 - 1) / (sl.nrank * 8), tbase = (sl.rank * 8 + wave) * per, stride = 1;
    const int nk = (tbase < T) ? ((T - tbase < per) ? (T - tbase) : per) : 0;
    const int S = sl.vx;
    const unsigned char* Vb = p.ws + WS_V16 + (size_t)S * NEXP * 128 + c * 16;
    const int jj = 16 * c + 2 * g8, s16 = 2 * S + (jj >> 6), j = jj & 63;
    float* ob = p.out + (j >> 5) * 512 + 32 * s16 + (j & 31);
    const bf16_t* xs = (const bf16_t*)(p.ws + WS_XB) + (size_t)s16 * T * 64 + j;
    if (nk == 0) return;
#define V_LOAD_IDX(I, t) { const u4_t* ip_ = (const u4_t*)(pidx + (size_t)(t) * PK + g8 * 16); I[0] = __builtin_nontemporal_load(ip_); I[1] = __builtin_nontemporal_load(ip_ + 1); }
#define V_LOAD_W(W, t) { const h8_t* wp_ = (const h8_t*)(pw + (size_t)(t) * PK + g8 * 16); W[0] = __builtin_nontemporal_load(wp_); W[1] = __builtin_nontemporal_load(wp_ + 1); }
#define V_ISSUE(G, I) { const unsigned w0_ = I[(G) >> 1][(2 * (G)) & 3], w1_ = I[(G) >> 1][(2 * (G) + 1) & 3]; \
        rr[4 * (G)] = *(const u4_t*)(Vb + (size_t)(w0_ & 0xffffu) * 128); rr[4 * (G) + 1] = *(const u4_t*)(Vb + (size_t)(w0_ >> 16) * 128); \
        rr[4 * (G) + 2] = *(const u4_t*)(Vb + (size_t)(w1_ & 0xffffu) * 128); rr[4 * (G) + 3] = *(const u4_t*)(Vb + (size_t)(w1_ >> 16) * 128); }
#define V_FMA(G, W) { _Pragma("unroll") for (int i_ = 4 * (G); i_ < 4 * (G) + 4; ++i_) { const float wv_ = (float)W[i_ >> 3][i_ & 7]; const float2_t ww_ = {wv_, wv_}; \
        _Pragma("unroll") for (int q_ = 0; q_ < 4; ++q_) { acc2[2 * q_] = __builtin_amdgcn_cvt_pk_f32_fp8((int)rr[i_][q_], false) * ww_ + acc2[2 * q_]; acc2[2 * q_ + 1] = __builtin_amdgcn_cvt_pk_f32_fp8((int)rr[i_][q_], true) * ww_ + acc2[2 * q_ + 1]; } } }
#define V_STEP(k, I1, I2, Wc, Wn) { float2_t acc2[8]; \
        _Pragma("unroll") for (int k_ = 0; k_ < 8; ++k_) acc2[k_] = (float2_t){0.f, 0.f}; \
        const unsigned oold_ = __builtin_nontemporal_load((const unsigned*)(xs + (size_t)TK(k) * 64)); \
        V_LOAD_IDX(I2, TK((k) + 2)); V_LOAD_W(Wn, TK((k) + 1)); SBAR; \
        V_FMA(0, Wc); SBAR; V_ISSUE(0, I1); SBAR; V_FMA(1, Wc); SBAR; V_ISSUE(1, I1); SBAR; V_FMA(2, Wc); SBAR; V_ISSUE(2, I1); SBAR; V_FMA(3, Wc); SBAR; V_ISSUE(3, I1); SBAR; \
        float a_[16]; \
        _Pragma("unroll") for (int k_ = 0; k_ < 8; ++k_) { a_[2 * k_] = acc2[k_].x; a_[2 * k_ + 1] = acc2[k_].y; } \
        _Pragma("unroll") for (int j_ = 0; j_ < 8; ++j_) { const float keep_ = (g8 & 4) ? a_[j_ + 8] : a_[j_], send_ = (g8 & 4) ? a_[j_] : a_[j_ + 8]; a_[j_] = keep_ + __shfl_xor(send_, 32); } \
        _Pragma("unroll") for (int j_ = 0; j_ < 4; ++j_) { const float keep_ = (g8 & 2) ? a_[j_ + 4] : a_[j_], send_ = (g8 & 2) ? a_[j_] : a_[j_ + 4]; a_[j_] = keep_ + __shfl_xor(send_, 16); } \
        _Pragma("unroll") for (int j_ = 0; j_ < 2; ++j_) { const float keep_ = (g8 & 1) ? a_[j_ + 2] : a_[j_], send_ = (g8 & 1) ? a_[j_] : a_[j_ + 2]; a_[j_] = keep_ + dpp_ror8(send_); } \
        __builtin_nontemporal_store((float2_t){bflo(oold_) + a_[0], bfhi(oold_) + a_[1]}, (float2_t*)(ob + (size_t)TK(k) * DM)); }
    u4_t iA[2], iB[2], rr[16]; h8_t wA[2], wB[2];
    V_LOAD_IDX(iA, TK(0)); V_LOAD_IDX(iB, TK(1)); V_LOAD_W(wA, TK(0)); SBAR;
    V_ISSUE(0, iA); SBAR; V_ISSUE(1, iA); SBAR; V_ISSUE(2, iA); SBAR; V_ISSUE(3, iA); SBAR;
    for (int k = 0; k < nk; k += 2) {
        V_STEP(k, iB, iA, wA, wB);
        if (k + 1 < nk) V_STEP(k + 1, iA, iB, wB, wA);
    }
#undef V_LOAD_IDX
#undef V_LOAD_W
#undef V_ISSUE
#undef V_FMA
#undef V_STEP
#undef TK
#undef SBAR
}

#ifndef PROBE_DBL
#define PROBE_DBL -1
#endif
#define REP(k) for (int rep_ = 0; rep_ < ((PROBE_DBL == (k)) ? 2 : 1); ++rep_)
typedef const __attribute__((address_space(4))) Params* KArgs;
#if defined(__HIP_DEVICE_COMPILE__)
#define LOADP(P) KArgs kq_ = (KArgs)__builtin_amdgcn_kernarg_segment_ptr(); asm volatile("" : "+s"(kq_)); Params P; __builtin_memcpy(&P, kq_, sizeof(Params))
#define BAR_WS() ((unsigned char*)((KArgs)__builtin_amdgcn_kernarg_segment_ptr())->ws)
#else
#define LOADP(P) const Params P = p_unused
#define BAR_WS() (p_unused.ws)
#endif
#ifndef PROBE_SPIN
#define PROBE_SPIN -1
#endif
#if PROBE_SPIN >= 0
#define STAMP(k) do { if (threadIdx.x == 0) { const unsigned long long t_ = __builtin_amdgcn_s_memrealtime(); ((volatile LAS unsigned*)(LAS unsigned char*)lds)[36800 + 2 * (k)] = (unsigned)t_; ((volatile LAS unsigned*)(LAS unsigned char*)lds)[36801 + 2 * (k)] = (unsigned)(t_ >> 32); } } while (0)
#else
#define STAMP(k) do { } while (0)
#endif
#define BAR() do { XcdBarrier xb_; xb_.bar = (unsigned*)(BAR_WS() + WS_CTL) + 4096; xb_.x = ((volatile LAS unsigned*)(LAS unsigned char*)lds)[36861]; xb_.st = (volatile LAS unsigned*)(LAS unsigned char*)lds + 36862; xcd_barrier(xb_); } while (0)
__global__ void __launch_bounds__(NTHR, 2) fwd_kernel(Params p_unused) {
    extern __shared__ __attribute__((aligned(16))) unsigned char lds[];
    PG8_LAS unsigned char* ldsl = (PG8_LAS unsigned char*)lds;
    STAMP(13);
    { LOADP(p);
      if (blockIdx.x == 0) { unsigned* ctl0 = (unsigned*)(p.ws + WS_CTL); for (int i = threadIdx.x; i < 16384; i += NTHR) ctl0[i] = 0u; }
      if (threadIdx.x < 2) ((volatile LAS unsigned*)(LAS unsigned char*)lds)[36862 + threadIdx.x] = 0u; }
    { cg::grid_group grid = cg::this_grid(); grid.sync(); }
    { LOADP(p);
      if (threadIdx.x == 0) { unsigned* ctl0 = (unsigned*)(p.ws + WS_CTL); const unsigned xcc0 = (unsigned)__builtin_amdgcn_s_getreg((3 << 11) | 20) & 7u;
        ((volatile unsigned*)lds)[36860] = __hip_atomic_fetch_add(&ctl0[64 * xcc0], 1u, __ATOMIC_RELAXED, __HIP_MEMORY_SCOPE_AGENT); ((volatile unsigned*)lds)[36861] = xcc0;
        (void)xb_add(&(ctl0 + 4096)[XB_XCNT(xcc0)], 1u); }
      __syncthreads(); }
    STAMP(0);
    { LOADP(p); REP(0) phase_prep(p, lds); }
    BAR(); STAMP(1);
    { LOADP(p); unsigned char* ws = p.ws;
      pg8::Gemm g{(const bf16_t*)(ws + WS_XB), (const bf16_t*)(ws + WS_WIN_T), T, INW, DM, DM, 128}; pg8::StaticOrder S; S.init(T, INW, gridDim.x, blockIdx.x); pg8::EpiProjM e{(bf16_t*)(ws + WS_P)};
      pg8::gemm_phase<pg8::EpiProjM, pg8::StaticOrder, true, true>(ldsl, g, S, e); }
    { LOADP(p); unsigned char* ws = p.ws;
      pg8::Gemm g{(const bf16_t*)(ws + WS_MEMN), (const bf16_t*)(ws + WS_WMKV_T), NB * NMEM, 512, DM, DM, 128}; pg8::StaticOrder S; S.init(NB * NMEM, 512, gridDim.x, (blockIdx.x + gridDim.x / 2) % gridDim.x); pg8::EpiQM e{(bf16_t*)(ws + WS_MEMKV), 512};
      pg8::gemm_phase<pg8::EpiQM, pg8::StaticOrder, true, true>(ldsl, g, S, e); }
    BAR(); STAMP(2);
    { LOADP(p); REP(2) { sb_mfma(p, lds); __syncthreads(); } REP(3) { hg_local(p, lds); } REP(5) mem_attn_mfma(p, lds); }
    BAR(); STAMP(3);
    { LOADP(p); REP(4) hg_scan(p); }
    BAR(); STAMP(4);
    { LOADP(p); REP(6) hg_out(p, lds); }
    BAR(); STAMP(5);
    { LOADP(p); unsigned char* ws = p.ws;
      pg8::Gemm g{(const bf16_t*)(ws + WS_MIXED), (const bf16_t*)(ws + WS_WOUT_T), T, DM, DM, DM, 128}; pg8::StaticOrder S; S.init(T, DM, gridDim.x, blockIdx.x); pg8::EpiWoutM e{p.x, (bf16_t*)(ws + WS_XB), (float*)(ws + WS_SSQ)};
      pg8::gemm_phase<pg8::EpiWoutM, pg8::StaticOrder, true, true>(ldsl, g, S, e); }
#if PROBE_DBL == 7
    { LOADP(p); unsigned char* ws = p.ws;
      pg8::Gemm g{(const bf16_t*)(ws + WS_MIXED), (const bf16_t*)(ws + WS_WOUT_T), T, DM, DM, DM, 128}; pg8::StaticOrder S; S.init(T, DM, gridDim.x, blockIdx.x); pg8::EpiWoutM e{p.x, (bf16_t*)(ws + WS_XB), (float*)(ws + WS_SSQ)};
      pg8::gemm_phase<pg8::EpiWoutM, pg8::StaticOrder, true, true>(ldsl, g, S, e); }
#endif
    BAR(); STAMP(6);
    { LOADP(p); unsigned char* ws = p.ws;
      pg8::Gemm g{(const bf16_t*)(ws + WS_XB), (const bf16_t*)(ws + WS_WQ_T), T, 2048, DM, 64, (size_t)T * 128}; pg8::StaticOrder S; S.init(T, 2048, gridDim.x, blockIdx.x); pg8::EpiQM e{(bf16_t*)(ws + WS_Q), 2048};
      pg8::gemm_phase<pg8::EpiQM, pg8::StaticOrder, true, true>(ldsl, g, S, e); }
#if PROBE_DBL == 9
    { LOADP(p); unsigned char* ws = p.ws;
      pg8::Gemm g{(const bf16_t*)(ws + WS_XB), (const bf16_t*)(ws + WS_WQ_T), T, 2048, DM, 64, (size_t)T * 128}; pg8::StaticOrder S; S.init(T, 2048, gridDim.x, blockIdx.x); pg8::EpiQM e{(bf16_t*)(ws + WS_Q), 2048};
      pg8::gemm_phase<pg8::EpiQM, pg8::StaticOrder, true, true>(ldsl, g, S, e); }
#endif
    BAR(); STAMP(7);
    { LOADP(p); REP(10) topk_mfma(p, lds); }
    BAR(); STAMP(8);
#define LOAD_SL(p) Sl sl; { const unsigned* ctl = (const unsigned*)(p.ws + WS_CTL); const int myrank = (int)((volatile unsigned*)lds)[36860]; const unsigned xcc = ((volatile unsigned*)lds)[36861]; \
      bool good = (gridDim.x % 8u) == 0u; \
      for (int j = 0; j < 8; ++j) good = good && (__hip_atomic_load(&ctl[64 * j], __ATOMIC_RELAXED, __HIP_MEMORY_SCOPE_AGENT) == gridDim.x / 8u); \
      if (good) { sl.vx = (int)xcc; sl.rank = myrank; sl.nrank = (int)(gridDim.x / 8u); } \
      else { sl.vx = (int)(blockIdx.x & 7u); sl.rank = (int)(blockIdx.x >> 3); sl.nrank = (int)((gridDim.x - (blockIdx.x & 7u) + 7u) / 8u); } }
    { LOADP(p); LOAD_SL(p); REP(11) peer_u_phase(p, sl); }
    BAR(); STAMP(9);
    { LOADP(p); REP(12) peer_w_phase(p); }
    BAR(); STAMP(10);
    if (PROBE_DBL == 100) { for (int i = 0; i < 10; ++i) BAR(); }
    { LOADP(p); LOAD_SL(p); peer_v_phase(p, sl); }
#if PROBE_SPIN >= 0
    __syncthreads(); STAMP(11);
    if (blockIdx.x == 0 && threadIdx.x == 0) {
        volatile LAS unsigned* tsw = (volatile LAS unsigned*)(LAS unsigned char*)lds + 36800;
        const int ia_ = (PROBE_SPIN == 14) ? 13 : PROBE_SPIN, ib_ = (PROBE_SPIN == 13) ? 0 : ((PROBE_SPIN == 14) ? 11 : PROBE_SPIN + 1);
        const unsigned long long t0 = (unsigned long long)tsw[2 * ia_] | ((unsigned long long)tsw[2 * ia_ + 1] << 32);
        const unsigned long long t1 = (unsigned long long)tsw[2 * ib_] | ((unsigned long long)tsw[2 * ib_ + 1] << 32);
        const unsigned long long until = __builtin_amdgcn_s_memrealtime() + (t1 - t0);
        while (__builtin_amdgcn_s_memrealtime() < until) __builtin_amdgcn_s_sleep(8);
    }
#endif
}

extern "C" void kernel_launch(void* const* d_in, const int* in_sizes, int n_in, void* d_out, int out_size, void* d_ws, size_t ws_size, hipStream_t stream) {
    static int grid_blocks = 0;
    if (grid_blocks == 0) {
        if (n_in != 17 || out_size != T * DM || ws_size < WS_END) { fprintf(stderr, "kernel_launch: unexpected shapes n_in %d out %d ws %zu\n", n_in, out_size, ws_size); grid_blocks = -1; return; }
        int dev = 0, cus = 0, per_cu = 0;
        (void)hipGetDevice(&dev);
        (void)hipDeviceGetAttribute(&cus, hipDeviceAttributeMultiprocessorCount, dev);
        (void)hipFuncSetAttribute((const void*)fwd_kernel, hipFuncAttributeMaxDynamicSharedMemorySize, LDS_BYTES);
        (void)hipOccupancyMaxActiveBlocksPerMultiprocessor(&per_cu, (const void*)fwd_kernel, NTHR, LDS_BYTES);
        if (per_cu < 1) { fprintf(stderr, "kernel_launch: occupancy query says %d blocks/CU\n", per_cu); per_cu = 1; }
        grid_blocks = cus * 1;
        (void)hipGetLastError();
    }
    if (grid_blocks < 0) return;
    Params p{};
    p.x = (const float*)d_in[0]; p.mem = (const float*)d_in[1]; p.g_mix = (const float*)d_in[2]; p.w_in = (const float*)d_in[3]; p.gamma_lb = (const float*)d_in[4];
    p.sb_gain = (const float*)d_in[5]; p.hg_gain = (const float*)d_in[6]; p.mem_gain = (const float*)d_in[7]; p.w_mkv = (const float*)d_in[8]; p.mq_gain = (const float*)d_in[9];
    p.mk_gain = (const float*)d_in[10]; p.w_out = (const float*)d_in[11]; p.g_ffn = (const float*)d_in[12]; p.w_q = (const float*)d_in[13]; p.sub_keys = (const float*)d_in[14];
    p.pu = (const float*)d_in[15]; p.pv = (const float*)d_in[16];
    p.out = (float*)d_out; p.ws = (unsigned char*)d_ws;
    void* args[] = {&p};
    hipError_t e = hipLaunchCooperativeKernel((const void*)fwd_kernel, dim3(grid_blocks), dim3(NTHR), args, LDS_BYTES, stream);
    if (e != hipSuccess) fprintf(stderr, "cooperative launch failed: %s (grid %d)\n", hipGetErrorString(e), grid_blocks);
}
```

```cpp
#include <hip/hip_runtime.h>
#include <hip/hip_cooperative_groups.h>
#include <cstdio>
#include <cstdint>
namespace cg = cooperative_groups;

constexpr int NB = 4, SEQ = 8192, DM = 1024, T = NB * SEQ;
constexpr int NMEM = 256, INW = 3328;
constexpr int C_SBQ = 0, C_SBK = 512, C_SBV = 1024, C_HGQ = 1536, C_HGF = 2048, C_HGI = 2560, C_HGG = 2816, C_MQ = 3072;
constexpr int NEXP = 16384, PK = 128;
constexpr float EPS = 1e-6f;
constexpr float LOG2E = 1.4426950408889634f;
constexpr float C2 = 0.125f * LOG2E;

constexpr float PEER_US = 64.f, PEER_VS = 8.f;
constexpr int NTHR = 512;
constexpr int LDS_BYTES = 147456;

constexpr size_t MiB = 1u << 20;
constexpr size_t WS_CTL = 0;
constexpr size_t WS_WIN_T = 1 * MiB;
constexpr size_t WS_WOUT_T = 8 * MiB;
constexpr size_t WS_WQ_T = 10 * MiB;
constexpr size_t WS_WMKV_T = 14 * MiB;
constexpr size_t WS_SKB = 15 * MiB;
constexpr size_t WS_LB = 15 * MiB + 512 * 1024;
constexpr size_t WS_MEMN = 16 * MiB;
constexpr size_t WS_MEMKV = 18 * MiB;
constexpr size_t WS_MEMK = 20 * MiB;
constexpr size_t WS_MEMV = 20 * MiB + 512 * 1024;
constexpr size_t WS_RSTD2 = 21 * MiB;
constexpr size_t WS_PIDX = 24 * MiB;
constexpr size_t WS_PG = 40 * MiB;
constexpr size_t WS_XB = 72 * MiB;
constexpr size_t WS_MIXED = 136 * MiB;
constexpr size_t WS_P = 200 * MiB;
constexpr size_t WS_Q = 136 * MiB;
constexpr size_t WS_X1S = 270 * MiB;
constexpr size_t WS_SSQ = 22 * MiB;
constexpr size_t WS_HGRAW = 408 * MiB;
constexpr size_t WS_PW = 56 * MiB;
constexpr size_t WS_PU = 136 * MiB;
constexpr size_t WS_U16 = 440 * MiB;
constexpr size_t WS_V16 = 472 * MiB;
constexpr size_t WS_END = 512 * MiB;

typedef unsigned short bf16_t;
__device__ __forceinline__ float bf2f(bf16_t v) { return __uint_as_float(((unsigned)v) << 16); }
__device__ __forceinline__ float bflo(unsigned w) { return __uint_as_float(w << 16); }
__device__ __forceinline__ float bfhi(unsigned w) { return __uint_as_float(w & 0xffff0000u); }
__device__ __forceinline__ bf16_t f2bf(float f) { unsigned u = __float_as_uint(f); return (bf16_t)((u + 0x7fffu + ((u >> 16) & 1u)) >> 16); }
__device__ __forceinline__ unsigned pk2(float lo, float hi) { return (unsigned)f2bf(lo) | ((unsigned)f2bf(hi) << 16); }
__device__ __forceinline__ float wave_sum(float v) {
#pragma unroll
    for (int o = 1; o < 64; o <<= 1) v += __shfl_xor(v, o);
    return v;
}
__device__ __forceinline__ float silu(float v) { return v / (1.f + __expf(-v)); }

typedef unsigned u4_t __attribute__((ext_vector_type(4)));
typedef float f32x4_t __attribute__((ext_vector_type(4)));
typedef float float2_t __attribute__((ext_vector_type(2)));
typedef _Float16 h8_t __attribute__((ext_vector_type(8)));
typedef _Float16 h2_t __attribute__((ext_vector_type(2)));
typedef _Float16 h4_t __attribute__((ext_vector_type(4)));
typedef unsigned u2_t __attribute__((ext_vector_type(2)));
typedef __bf16 bf16x2_v __attribute__((ext_vector_type(2)));
__device__ __forceinline__ float dot2bf(unsigned a, unsigned b, float c) { return __builtin_amdgcn_fdot2_f32_bf16(__builtin_bit_cast(bf16x2_v, a), __builtin_bit_cast(bf16x2_v, b), c, false); }

struct Params {
    const float *x, *mem, *g_mix, *w_in, *gamma_lb, *sb_gain, *hg_gain, *mem_gain, *w_mkv, *mq_gain, *mk_gain, *w_out, *g_ffn, *w_q, *sub_keys, *pu, *pv;
    float* out; unsigned char* ws;
};

namespace pg8 {
#define PG8_LAS __attribute__((address_space(3)))
typedef unsigned short bf16_t;
typedef short bf16x8 __attribute__((ext_vector_type(8)));
typedef float f32x4 __attribute__((ext_vector_type(4)));
typedef unsigned u32x4 __attribute__((ext_vector_type(4)));
constexpr int BM = 256, BK = 64, HALF = 128, HTB = HALF * BK * 2  , STAGE_BYTES = 8 * HTB, NXCD = 8, WGM = 8;

__host__ __device__ __forceinline__ int lds_byte(int r, int c) { const int st = (r >> 4) * 2 + (c >> 5), rr = r & 15, cc = c & 31, ob = rr * 64 + cc * 2; return st * 1024 + (ob ^ (((ob >> 9) & 1) << 5)); }
__host__ __device__ __forceinline__ void stage_rc(int b, int& R, int& C) { const int st = b / 1024, sb = b % 1024, swz = sb ^ (((sb >> 9) & 1) << 5); R = (st >> 1) * 16 + swz / 64; C = (st & 1) * 32 + (swz % 64) / 2; }
__host__ __device__ __forceinline__ int perm32(int rho) { const int n = rho >> 4, i = rho & 15; return 8 * (i >> 2) + 4 * n + (i & 3); }

struct Unit { int pm, pn; };
struct Gemm { const bf16_t* A; const bf16_t* Bt; int M, N, K; int lda; size_t kstepA; };

struct StaticOrder {
    int nM, nN, nwg, G, c;
    __host__ __device__ void init(int M, int N, int G_, int c_) { nM = M / BM; nN = N / BM; nwg = nM * nN; G = G_; c = c_; }
    __host__ __device__ bool next(int i, Unit& u) const {
        const long L = (long)i * G + c; if (L >= nwg) return false;
        int wgid = (int)L; { const int q = nwg / NXCD, r = nwg % NXCD, xcd = wgid % NXCD, off = wgid / NXCD; wgid = (xcd < r ? xcd * (q + 1) : r * (q + 1) + (xcd - r) * q) + off; }
        const int nig = WGM * nN, gid = wgid / nig, fm = gid * WGM, gsz = (nM - fm) < WGM ? (nM - fm) : WGM;
        u.pm = fm + ((wgid % nig) % gsz); u.pn = (wgid % nig) / gsz; return true;
    }
    __device__ __forceinline__ void a_ready(const Unit&) const {}
    __device__ __forceinline__ void done(const Unit&) const {}
};

typedef float cvf2_t __attribute__((ext_vector_type(2)));
typedef __bf16 cvb2_t __attribute__((ext_vector_type(2)));
__device__ __forceinline__ unsigned cvt_pk_bf16(float lo, float hi) { const cvf2_t v = {lo, hi}; const cvb2_t b = __builtin_convertvector(v, cvb2_t); return __builtin_bit_cast(unsigned, b); }
typedef float f32x2 __attribute__((ext_vector_type(2)));
template <class Epi, class Sched, bool ALIGN_EPI = false, bool SP2 = false>
__device__ __forceinline__ void gemm_phase(PG8_LAS unsigned char* lds, const Gemm g, const Sched& S, const Epi& E) {
    int tid_ = threadIdx.x; asm volatile("" : "+v"(tid_));
    const int tid = tid_, wid = __builtin_amdgcn_readfirstlane(tid >> 6), lane = tid & 63, wr = wid >> 2, wc = wid & 3, fr = lane & 15, fq = lane >> 4;
    const int K = g.K, nt = K / BK;
    unsigned voffA[2], voffB[2];
#pragma unroll
    for (int i = 0; i < 2; ++i) { int R, C; stage_rc(tid * 16 + i * 8192, R, C); const int Rb = Epi::PERM ? ((R & ~31) + perm32(R & 31)) : R;
        voffA[i] = (unsigned)(R * g.lda + C) * 2u; voffB[i] = (unsigned)(Rb * K + C) * 2u; }
    const size_t kstep = (size_t)(BK * 2);
    const size_t hstep = (size_t)HALF * K * 2;
    const size_t tstep = 2 * hstep;
    const size_t kstepA = g.kstepA, hstepA = (size_t)HALF * g.lda * 2, tstepA = 2 * hstepA;
    const unsigned ldsw = (unsigned)wid * 1024u;
    const int aoff = lds_byte(wr * 64 + fr, fq * 8), boff = lds_byte(wc * 32 + fr, fq * 8);
#define PG8_SA(b, h) (((b) * 2 + (h)) * HTB)
#define PG8_SB(b, h) ((4 + (b) * 2 + (h)) * HTB)
#define PG8_STAGE(bufoff, gbase, voff) do { _Pragma("unroll") for (int _i = 0; _i < 2; ++_i) \
        __builtin_amdgcn_global_load_lds((const unsigned*)((const char*)(gbase) + (voff)[_i]), (PG8_LAS unsigned*)(lds + (bufoff) + ldsw + _i * 8192), 16, 0, 0); } while (0)
#define PG8_LDA(dst, b, h) do { _Pragma("unroll") for (int m = 0; m < 4; ++m) _Pragma("unroll") for (int k = 0; k < 2; ++k) dst[m][k] = *(const PG8_LAS bf16x8*)(lds + PG8_SA(b, h) + aoff + m * 2048 + k * 1024); } while (0)
#define PG8_LDB(dst, b, h) do { _Pragma("unroll") for (int n = 0; n < 2; ++n) _Pragma("unroll") for (int k = 0; k < 2; ++k) dst[n][k] = *(const PG8_LAS bf16x8*)(lds + PG8_SB(b, h) + boff + n * 2048 + k * 1024); } while (0)
#define PG8_MMA(ai, bj, At, Bt) do { __builtin_amdgcn_s_setprio(1); _Pragma("unroll") for (int m = 0; m < 4; ++m) _Pragma("unroll") for (int n = 0; n < 2; ++n) _Pragma("unroll") for (int k = 0; k < 2; ++k) \
        acc[ai][bj][m][n] = __builtin_amdgcn_mfma_f32_16x16x32_bf16(Bt[n][k], At[m][k], acc[ai][bj][m][n], 0, 0, 0); __builtin_amdgcn_s_setprio(0); } while (0)
#define PG8_WAIT_V(n) asm volatile("s_waitcnt vmcnt(" #n ")" ::: "memory")
#define PG8_WAIT_L(n) asm volatile("s_waitcnt lgkmcnt(" #n ")" ::: "memory")
#define PG8_BAR __builtin_amdgcn_s_barrier()
#define PG8_SCHED __builtin_amdgcn_sched_barrier(0)
    Unit cur, nxt; int ui = 0;
    if (!S.next(0, cur)) return;
    f32x4 acc[2][2][4][2];
#pragma unroll
    for (int a = 0; a < 2; ++a)
#pragma unroll
        for (int b = 0; b < 2; ++b)
#pragma unroll
            for (int m = 0; m < 4; ++m)
#pragma unroll
                for (int n = 0; n < 2; ++n) acc[a][b][m][n] = (f32x4){0.f, 0.f, 0.f, 0.f};
    bf16x8 At[4][2], B0[2][2], B1[2][2];
    const char* cA = (const char*)g.A + (size_t)cur.pm * tstepA; const char* cB = (const char*)g.Bt + (size_t)cur.pn * tstep;
    S.a_ready(cur);
    if constexpr (SP2) {
        PG8_STAGE(PG8_SB(0, 0), cB, voffB); PG8_STAGE(PG8_SB(0, 1), cB + hstep, voffB); PG8_STAGE(PG8_SA(0, 0), cA, voffA); PG8_STAGE(PG8_SA(0, 1), cA + hstepA, voffA);
        if (wr == 1) PG8_BAR;
        PG8_WAIT_V(2); PG8_BAR;
        PG8_STAGE(PG8_SB(1, 0), cB + kstep, voffB); PG8_STAGE(PG8_SA(1, 0), cA + kstepA, voffA); PG8_STAGE(PG8_SB(1, 1), cB + hstep + kstep, voffB);
        PG8_WAIT_V(6); PG8_BAR;
    } else {
        PG8_STAGE(PG8_SB(0, 0), cB, voffB); PG8_STAGE(PG8_SA(0, 0), cA, voffA); PG8_STAGE(PG8_SB(0, 1), cB + hstep, voffB); PG8_STAGE(PG8_SA(0, 1), cA + hstepA, voffA);
        if (wr == 1) PG8_BAR;
        PG8_WAIT_V(4); PG8_BAR;
        PG8_STAGE(PG8_SB(1, 0), cB + kstep, voffB); PG8_STAGE(PG8_SA(1, 0), cA + kstepA, voffA); PG8_STAGE(PG8_SB(1, 1), cB + hstep + kstep, voffB);
        PG8_WAIT_V(6); PG8_BAR;
    }
    for (;;) {
        const bool has_next = S.next(ui + 1, nxt);
        const char* nA = has_next ? (const char*)g.A + (size_t)nxt.pm * tstepA : cA; const char* nB = has_next ? (const char*)g.Bt + (size_t)nxt.pn * tstep : cB;
        for (int t = 0; t < nt; t += 2) {
            const bool last = (t == nt - 2);
            const char* a1 = cA + (size_t)(t + 1) * kstepA;
            const char* a2 = last ? nA : cA + (size_t)(t + 2) * kstepA; const char* b2 = last ? nB : cB + (size_t)(t + 2) * kstep;
            const char* a3 = a2 + kstepA; const char* b3 = b2 + kstep;
            if (last && has_next) S.a_ready(nxt);
            if constexpr (SP2) {
            PG8_LDB(B0, 0, 0); PG8_LDB(B1, 0, 1); PG8_SCHED; PG8_LDA(At, 0, 0); PG8_STAGE(PG8_SA(1, 1), a1 + hstepA, voffA);
            PG8_WAIT_V(8); PG8_WAIT_L(0); PG8_BAR; PG8_MMA(0, 0, At, B0); PG8_MMA(0, 1, At, B1); PG8_BAR; PG8_SCHED;
            PG8_LDA(At, 0, 1); PG8_STAGE(PG8_SB(0, 0), b2, voffB); PG8_STAGE(PG8_SB(0, 1), b2 + hstep, voffB); PG8_STAGE(PG8_SA(0, 0), a2, voffA);
            PG8_WAIT_V(8); PG8_WAIT_L(0); PG8_BAR; PG8_MMA(1, 0, At, B0); PG8_MMA(1, 1, At, B1); PG8_BAR; PG8_SCHED;
            PG8_LDB(B0, 1, 0); PG8_LDB(B1, 1, 1); PG8_SCHED; PG8_LDA(At, 1, 0); PG8_STAGE(PG8_SA(0, 1), a2 + hstepA, voffA);
            PG8_WAIT_V(8); PG8_WAIT_L(0); PG8_BAR; PG8_MMA(0, 0, At, B0); PG8_MMA(0, 1, At, B1); PG8_BAR; PG8_SCHED;
            PG8_LDA(At, 1, 1); PG8_STAGE(PG8_SB(1, 0), b3, voffB); PG8_STAGE(PG8_SB(1, 1), b3 + hstep, voffB); PG8_STAGE(PG8_SA(1, 0), a3, voffA);
            PG8_WAIT_V(8); PG8_WAIT_L(0); PG8_BAR; PG8_MMA(1, 0, At, B0); PG8_MMA(1, 1, At, B1); PG8_BAR; PG8_SCHED;
            } else {
            PG8_LDB(B0, 0, 0); PG8_SCHED; PG8_LDA(At, 0, 0); PG8_STAGE(PG8_SA(1, 1), a1 + hstepA, voffA);
            PG8_WAIT_L(8); PG8_BAR; PG8_WAIT_L(0); PG8_MMA(0, 0, At, B0); PG8_BAR; PG8_SCHED;
            PG8_LDB(B1, 0, 1); PG8_STAGE(PG8_SB(0, 0), b2, voffB);
            PG8_BAR; PG8_WAIT_L(0); PG8_MMA(0, 1, At, B1); PG8_BAR;
            PG8_LDA(At, 0, 1); PG8_STAGE(PG8_SA(0, 0), a2, voffA);
            PG8_BAR; PG8_WAIT_L(0); PG8_MMA(1, 0, At, B0); PG8_BAR; PG8_SCHED;
            PG8_STAGE(PG8_SB(0, 1), b2 + hstep, voffB);
            PG8_WAIT_V(6); PG8_BAR; PG8_MMA(1, 1, At, B1); PG8_BAR;
            PG8_LDB(B0, 1, 0); PG8_SCHED; PG8_LDA(At, 1, 0); PG8_STAGE(PG8_SA(0, 1), a2 + hstepA, voffA);
            PG8_WAIT_L(8); PG8_BAR; PG8_WAIT_L(0); PG8_MMA(0, 0, At, B0); PG8_BAR; PG8_SCHED;
            PG8_LDB(B1, 1, 1); PG8_STAGE(PG8_SB(1, 0), b3, voffB);
            PG8_BAR; PG8_WAIT_L(0); PG8_MMA(0, 1, At, B1); PG8_BAR;
            PG8_LDA(At, 1, 1); PG8_STAGE(PG8_SA(1, 0), a3, voffA);
            PG8_BAR; PG8_WAIT_L(0); PG8_MMA(1, 0, At, B0); PG8_BAR; PG8_SCHED;
            PG8_STAGE(PG8_SB(1, 1), b3 + hstep, voffB);
            PG8_WAIT_V(6); PG8_BAR; PG8_MMA(1, 1, At, B1); PG8_BAR;
            }
        }
        if constexpr (ALIGN_EPI) { if (wr == 0) PG8_BAR; }
        if constexpr (!Epi::AFTER_DRAIN) { E(acc, cur, wr, wc, fr, fq); S.done(cur); }
        if (!has_next) break;
#pragma unroll
        for (int a = 0; a < 2; ++a)
#pragma unroll
            for (int b = 0; b < 2; ++b)
#pragma unroll
                for (int m = 0; m < 4; ++m)
#pragma unroll
                    for (int n = 0; n < 2; ++n) acc[a][b][m][n] = (f32x4){0.f, 0.f, 0.f, 0.f};
        cur = nxt; cA = nA; cB = nB; ++ui;
        if constexpr (ALIGN_EPI) { if (wr == 1) PG8_BAR; }
    }
    PG8_WAIT_V(0);
    if constexpr (!ALIGN_EPI) { if (wr == 0) PG8_BAR; }
    PG8_BAR;
    if constexpr (Epi::AFTER_DRAIN) { E.fused(acc, cur, wr, wc, fr, fq, lds, wid, lane); S.done(cur); }
#undef PG8_SA
#undef PG8_SB
#undef PG8_STAGE
#undef PG8_LDA
#undef PG8_LDB
#undef PG8_MMA
#undef PG8_WAIT_V
#undef PG8_WAIT_L
#undef PG8_BAR
#undef PG8_SCHED
}
}


namespace pg8 {
typedef unsigned u32x4 __attribute__((ext_vector_type(4)));
__device__ __forceinline__ float permf(float v, int addr) { return __int_as_float(__builtin_amdgcn_ds_bpermute(addr, __float_as_int(v))); }
__device__ __forceinline__ unsigned permu(unsigned v, int addr) { return (unsigned)__builtin_amdgcn_ds_bpermute(addr, (int)v); }
struct EpiProjM {
    static constexpr bool PERM = true, AFTER_DRAIN = false;
    bf16_t* P;
    __device__ __forceinline__ void operator()(const f32x4 (&acc)[2][2][4][2], const Unit& u, int wr, int wc, int fr, int fq) const {
        const int L = fr + 16 * fq, frp = L >> 2, fqp = L & 3, pa = 4 * (frp + 16 * fqp);
        const int row0 = u.pm * BM + wr * 64 + frp, col0 = u.pn * BM + wc * 32 + 8 * fqp;
        const int pn = u.pn; const int mode = (pn < 2) ? 1 : ((pn == 6 || pn == 7 || pn == 11) ? 2 : 0);
#pragma unroll
        for (int ai = 0; ai < 2; ++ai)
#pragma unroll
            for (int m = 0; m < 4; ++m) { bf16_t* rowp = P + (size_t)(row0 + ai * HALF + m * 16) * INW + col0;
#pragma unroll
                for (int bj = 0; bj < 2; ++bj) { f32x4 v0 = acc[ai][bj][m][0], v1 = acc[ai][bj][m][1];
                    if (mode == 1) { v0 = v0 * C2; v1 = v1 * C2; }
                    else if (mode == 2) {
#pragma unroll
                        for (int e = 0; e < 4; ++e) { v0[e] = silu(v0[e]); v1[e] = silu(v1[e]); } }
                    u32x4 w; w.x = permu(cvt_pk_bf16(v0[0], v0[1]), pa); w.y = permu(cvt_pk_bf16(v0[2], v0[3]), pa); w.z = permu(cvt_pk_bf16(v1[0], v1[1]), pa); w.w = permu(cvt_pk_bf16(v1[2], v1[3]), pa);
                    *(u32x4*)(rowp + bj * HALF) = w; } }
    }
};
struct EpiWoutM {
    static constexpr bool PERM = true, AFTER_DRAIN = false;
    const float* x; bf16_t* x1bs; float* ssq;
    __device__ __forceinline__ void operator()(const f32x4 (&acc)[2][2][4][2], const Unit& u, int wr, int wc, int fr, int fq) const {
        const int L = fr + 16 * fq, frp = L >> 2, fqp = L & 3, pa = 4 * (frp + 16 * fqp);
        const int row0 = u.pm * BM + wr * 64 + frp, col0 = u.pn * BM + wc * 32 + 8 * fqp;
#pragma unroll
        for (int ai = 0; ai < 2; ++ai)
#pragma unroll
            for (int m = 0; m < 4; ++m) { const int row = row0 + ai * HALF + m * 16; const size_t rb = (size_t)row * DM + col0; float sq = 0.f;
#pragma unroll
                for (int bj = 0; bj < 2; ++bj) { const size_t i = rb + bj * HALF;
                    const f32x4 x0 = *(const f32x4*)(x + i), x1 = *(const f32x4*)(x + i + 4);
                    f32x4 v0, v1;
#pragma unroll
                    for (int e = 0; e < 4; ++e) { v0[e] = permf(acc[ai][bj][m][0][e], pa) + x0[e]; v1[e] = permf(acc[ai][bj][m][1][e], pa) + x1[e]; }
                    sq += (v0[0] * v0[0] + v0[1] * v0[1]) + (v0[2] * v0[2] + v0[3] * v0[3]) + (v1[0] * v1[0] + v1[1] * v1[1]) + (v1[2] * v1[2] + v1[3] * v1[3]);
                    const int col = col0 + bj * HALF, s = (col >> 5) & 15, j = ((col >> 9) << 5) | (col & 31);
                    const size_t o = ((size_t)s * T + row) * 64 + j;
                    u32x4 w; w.x = cvt_pk_bf16(v0[0], v0[1]); w.y = cvt_pk_bf16(v0[2], v0[3]); w.z = cvt_pk_bf16(v1[0], v1[1]); w.w = cvt_pk_bf16(v1[2], v1[3]);
                    *(u32x4*)(x1bs + o) = w; }
                sq += __shfl_xor(sq, 1); sq += __shfl_xor(sq, 2);
                if (fqp == 0) ssq[(size_t)row * 16 + u.pn * 4 + wc] = sq; }
    }
};
struct EpiQM {
    static constexpr bool PERM = true, AFTER_DRAIN = false;
    bf16_t* Q; int ld;
    __device__ __forceinline__ void operator()(const f32x4 (&acc)[2][2][4][2], const Unit& u, int wr, int wc, int fr, int fq) const {
        const int L = fr + 16 * fq, frp = L >> 2, fqp = L & 3, pa = 4 * (frp + 16 * fqp);
        const int row0 = u.pm * BM + wr * 64 + frp, col0 = u.pn * BM + wc * 32 + 8 * fqp;
#pragma unroll
        for (int ai = 0; ai < 2; ++ai)
#pragma unroll
            for (int m = 0; m < 4; ++m) { const int row = row0 + ai * HALF + m * 16; bf16_t* rowp = Q + (size_t)row * ld + col0;
#pragma unroll
                for (int bj = 0; bj < 2; ++bj) { const f32x4 v0 = acc[ai][bj][m][0], v1 = acc[ai][bj][m][1];
                    u32x4 w; w.x = permu(cvt_pk_bf16(v0[0], v0[1]), pa); w.y = permu(cvt_pk_bf16(v0[2], v0[3]), pa); w.z = permu(cvt_pk_bf16(v1[0], v1[1]), pa); w.w = permu(cvt_pk_bf16(v1[2], v1[3]), pa);
                    *(u32x4*)(rowp + bj * HALF) = w; } }
    }
};
}

#define LAS __attribute__((address_space(3)))
#define XB_TMO      128
#define XB_XCNT(j)  (256  + 64 * (j))
#define XB_XSUB(j)  (1280 + 64 * (j))
#define XB_XGEN(j)  (2304 + 64 * (j))
#define XB_TOP      3328
#define XB_TOPGEN   3392
#define XCD_BAR_WORDS 3456
#define XB_SPIN_CAP (1u << 18)

__device__ __forceinline__ unsigned xb_ld(unsigned* p)              { return __hip_atomic_load(p, __ATOMIC_RELAXED, __HIP_MEMORY_SCOPE_AGENT); }
__device__ __forceinline__ unsigned xb_add(unsigned* p, unsigned v) { return __hip_atomic_fetch_add(p, v, __ATOMIC_RELAXED, __HIP_MEMORY_SCOPE_AGENT); }
__device__ __forceinline__ unsigned xb_xcc_id() { return (unsigned)__builtin_amdgcn_s_getreg((3 << 11) | 20) & 0xFu; }
#define XB_SPIN(cond, bar) do { unsigned _sp = 0; while (cond) { __builtin_amdgcn_s_sleep(1); \
    if ((++_sp & 255u) == 0u) { if (xb_ld(&(bar)[XB_TMO])) break; if (_sp > XB_SPIN_CAP) { atomicAdd(&(bar)[XB_TMO], 1u); break; } } } } while (0)

struct XcdBarrier {
    unsigned* bar; unsigned x;
    volatile LAS unsigned* st;
};

__device__ __forceinline__ XcdBarrier xcd_barrier_post(unsigned* bar, volatile LAS unsigned* st) {
    XcdBarrier b; b.bar = bar; b.x = xb_xcc_id(); b.st = st;
    if (threadIdx.x == 0) (void)xb_add(&bar[XB_XCNT(b.x)], 1u);
    return b;
}
__device__ __forceinline__ void xcd_barrier_complete(unsigned* bar, unsigned x, unsigned& nloc, unsigned& nx) {
    const unsigned G = gridDim.x * gridDim.y * gridDim.z;
    unsigned sum, cnt, mine, sp = 0u;
    for (;;) {
        sum = 0u; cnt = 0u; mine = 0u;
#pragma unroll
        for (unsigned j = 0; j < 16; ++j) { const unsigned c = xb_ld(&bar[XB_XCNT(j)]); sum += c; cnt += (c > 0u) ? 1u : 0u; mine = (j == x) ? c : mine; }
        if (sum == G) break;
        __builtin_amdgcn_s_sleep(1);
        if ((++sp & 255u) == 0u) { if (xb_ld(&bar[XB_TMO])) break; if (sp > XB_SPIN_CAP) { atomicAdd(&bar[XB_TMO], 1u); break; } }
    }
    nloc = mine > 0u ? mine : 1u; nx = cnt > 0u ? cnt : 1u;
}

__device__ __forceinline__ void xcd_barrier(const XcdBarrier& b) {
    asm volatile("s_waitcnt vmcnt(0)" ::: "memory");
    __syncthreads();
    if (threadIdx.x == 0) {
        unsigned* bar = b.bar;
        __builtin_amdgcn_s_waitcnt(0);
        unsigned nloc = b.st[0], nx = b.st[1];
        if (nloc == 0u) { xcd_barrier_complete(bar, b.x, nloc, nx); b.st[0] = nloc; b.st[1] = nx; }
        const unsigned old = xb_add(&bar[XB_XSUB(b.x)], 1u);
        const unsigned gen = old / nloc;
        if (old + 1u == (gen + 1u) * nloc) {
            __builtin_amdgcn_fence(__ATOMIC_RELEASE, "agent");
            asm volatile("s_waitcnt vmcnt(0)" ::: "memory");
            const unsigned og = xb_add(&bar[XB_TOP], 1u);
            const unsigned tg = og / nx;
            if (og + 1u == (tg + 1u) * nx) xb_add(&bar[XB_TOPGEN], 1u);
            else XB_SPIN(xb_ld(&bar[XB_TOPGEN]) == tg, bar);
            __builtin_amdgcn_fence(__ATOMIC_ACQUIRE, "agent");
            xb_add(&bar[XB_XGEN(b.x)], 1u);
            asm volatile("s_waitcnt vmcnt(0)" ::: "memory");
        } else {
            XB_SPIN(xb_ld(&bar[XB_XGEN(b.x)]) == gen, bar);
            __builtin_amdgcn_fence(__ATOMIC_ACQUIRE, "agent");
            asm volatile("s_waitcnt vmcnt(0)" ::: "memory");
        }
    }
    __syncthreads();
}

template <bool SLICEK = false> __device__ __forceinline__ void transpose_item(const float* W, const float* gain, int K, int N, bf16_t* WT, float* scr, int item, int lane) {
    const int nblk = N / 32, kb = item / nblk, nb = item % nblk, k0 = 64 * kb, n0 = 32 * nb;
#pragma unroll 16
    for (int i = 0; i < 32; ++i) { const int kk = 2 * i + (lane >> 5); const int ks = SLICEK ? ((kk >> 5) * 512 + 32 * kb + (kk & 31)) : (k0 + kk); float g = gain ? gain[ks] : 1.f; scr[kk * 33 + (lane & 31)] = W[(size_t)ks * N + n0 + (lane & 31)] * g; }
    __builtin_amdgcn_s_waitcnt(0); __builtin_amdgcn_wave_barrier();
    const int c = lane & 7;
#pragma unroll
    for (int j = 0; j < 4; ++j) { const int n = (lane >> 3) + 8 * j; const float* s = scr + (8 * c) * 33 + n;
        uint4 o; o.x = pk2(s[0 * 33], s[1 * 33]); o.y = pk2(s[2 * 33], s[3 * 33]); o.z = pk2(s[4 * 33], s[5 * 33]); o.w = pk2(s[6 * 33], s[7 * 33]);
        *(uint4*)(WT + (size_t)(n0 + n) * K + k0 + 8 * c) = o; }
    __builtin_amdgcn_s_waitcnt(0); __builtin_amdgcn_wave_barrier();
}
__device__ __forceinline__ void norm_row_to_bf16(const float* xrow, bf16_t* orow, int lane) {
    const float4* xr = (const float4*)xrow + lane;
    float4 v[4]; float s = 0.f;
#pragma unroll
    for (int j = 0; j < 4; ++j) { v[j] = xr[64 * j]; s += (v[j].x * v[j].x + v[j].y * v[j].y) + (v[j].z * v[j].z + v[j].w * v[j].w); }
    const float rstd = rsqrtf(wave_sum(s) * (1.f / DM) + EPS);
    unsigned long long* o8 = (unsigned long long*)orow + lane;
#pragma unroll
    for (int j = 0; j < 4; ++j) o8[64 * j] = (unsigned long long)pk2(v[j].x * rstd, v[j].y * rstd) | ((unsigned long long)pk2(v[j].z * rstd, v[j].w * rstd) << 32);
}
__device__ __forceinline__ void phase_prep(const Params& p, unsigned char* lds) {
    const int tid = threadIdx.x, lane = tid & 63, wave = tid >> 6;
    const int gw = blockIdx.x * 8 + wave, NGW = gridDim.x * 8;
    const int gt = blockIdx.x * NTHR + tid, NGT = gridDim.x * NTHR;
    unsigned char* ws = p.ws;
    float* scr = (float*)lds + wave * (64 * 33);
    constexpr int I_IN = (DM / 64) * (INW / 32), I_OUT = (DM / 64) * (DM / 32), I_Q = (DM / 64) * (2048 / 32), I_MKV = (DM / 64) * (512 / 32);
    for (int it = gw; it < I_IN + I_OUT + I_Q + I_MKV; it += NGW) {
        int r = it;
        if (r < I_IN) { transpose_item(p.w_in, p.g_mix, DM, INW, (bf16_t*)(ws + WS_WIN_T), scr, r, lane); continue; } r -= I_IN;
        if (r < I_OUT) { transpose_item(p.w_out, nullptr, DM, DM, (bf16_t*)(ws + WS_WOUT_T), scr, r, lane); continue; } r -= I_OUT;
        if (r < I_Q) { transpose_item<true>(p.w_q, p.g_ffn, DM, 2048, (bf16_t*)(ws + WS_WQ_T), scr, r, lane); continue; } r -= I_Q;
        transpose_item(p.w_mkv, p.mem_gain, DM, 512, (bf16_t*)(ws + WS_WMKV_T), scr, r, lane);
    }
    for (int m0 = gw * 4; m0 < T; m0 += NGW * 4) {
        f32x4_t v[4][4]; float s[4];
#pragma unroll
        for (int q = 0; q < 4; ++q) { const f32x4_t* xr = (const f32x4_t*)(p.x + (size_t)(m0 + q) * DM) + lane;
#pragma unroll
            for (int j = 0; j < 4; ++j) v[q][j] = __builtin_nontemporal_load(xr + 64 * j); }
#pragma unroll
        for (int q = 0; q < 4; ++q) { float a = 0.f;
#pragma unroll
            for (int j = 0; j < 4; ++j) a += (v[q][j][0] * v[q][j][0] + v[q][j][1] * v[q][j][1]) + (v[q][j][2] * v[q][j][2] + v[q][j][3] * v[q][j][3]);
            s[q] = a; }
#pragma unroll
        for (int o = 1; o < 64; o <<= 1) {
#pragma unroll
            for (int q = 0; q < 4; ++q) s[q] += __shfl_xor(s[q], o); }
#pragma unroll
        for (int q = 0; q < 4; ++q) { const float rstd = rsqrtf(s[q] * (1.f / DM) + EPS);
            unsigned long long* o8 = (unsigned long long*)((bf16_t*)(ws + WS_XB) + (size_t)(m0 + q) * DM) + lane;
#pragma unroll
            for (int j = 0; j < 4; ++j) o8[64 * j] = (unsigned long long)pk2(v[q][j][0] * rstd, v[q][j][1] * rstd) | ((unsigned long long)pk2(v[q][j][2] * rstd, v[q][j][3] * rstd) << 32); }
    }
    for (int m = gw; m < NB * NMEM; m += NGW) norm_row_to_bf16(p.mem + (size_t)m * DM, (bf16_t*)(ws + WS_MEMN) + (size_t)m * DM, lane);
    for (int i = gt; i < 8 * 2 * 128 * 128; i += NGT) ((bf16_t*)(ws + WS_SKB))[i] = f2bf(p.sub_keys[i]);
#pragma unroll 2
    for (int i = gt; i < NEXP * 8 * 8; i += NGT) {
        const int c = i & 7, S = (i >> 3) & 7, e = i >> 6;
        const int s16 = 2 * S + (c >> 2), j0 = (c & 3) * 16, d0 = (j0 >> 5) * 512 + 32 * s16 + (j0 & 31);
        const f32x4_t* up = (const f32x4_t*)(p.pu + (size_t)e * DM + d0); const f32x4_t* vp = (const f32x4_t*)(p.pv + (size_t)e * DM + d0); const f32x4_t* gp = (const f32x4_t*)(p.g_ffn + d0);
        u4_t uo, vo;
#pragma unroll
        for (int q = 0; q < 4; ++q) { const f32x4_t a = __builtin_nontemporal_load(up + q), g = gp[q], b = __builtin_nontemporal_load(vp + q);
            int w = 0; w = __builtin_amdgcn_cvt_pk_fp8_f32(a.x * g.x * PEER_US, a.y * g.y * PEER_US, w, false); w = __builtin_amdgcn_cvt_pk_fp8_f32(a.z * g.z * PEER_US, a.w * g.w * PEER_US, w, true); uo[q] = (unsigned)w;
            int z = 0; z = __builtin_amdgcn_cvt_pk_fp8_f32(b.x * PEER_VS, b.y * PEER_VS, z, false); z = __builtin_amdgcn_cvt_pk_fp8_f32(b.z * PEER_VS, b.w * PEER_VS, z, true); vo[q] = (unsigned)z; }
        *(u4_t*)(ws + WS_U16 + ((size_t)S * NEXP + e) * 128 + 16 * c) = uo;
        *(u4_t*)(ws + WS_V16 + ((size_t)S * NEXP + e) * 128 + 16 * c) = vo;
    }
    for (int i = gt; i < 512; i += NGT) ((float*)(ws + WS_LB))[i] = 1.f / (1.f + expf(p.gamma_lb[512 + i] - p.gamma_lb[i]));
}

typedef float f32x16 __attribute__((ext_vector_type(16)));
typedef short sh8_t __attribute__((ext_vector_type(8)));
typedef float cvt_f32x2_t __attribute__((ext_vector_type(2)));
typedef __bf16 cvt_bf16x2_t __attribute__((ext_vector_type(2)));
__device__ __forceinline__ unsigned cvtpk(float lo, float hi) { const cvt_f32x2_t v = {lo, hi}; const cvt_bf16x2_t b = __builtin_convertvector(v, cvt_bf16x2_t); return __builtin_bit_cast(unsigned, b); }
__device__ __forceinline__ bf16_t cvt1(float x) { return (bf16_t)(cvtpk(x, x) & 0xffffu); }
__device__ __forceinline__ void mma32(f32x16& acc, const LAS bf16_t* A, int lda, const LAS bf16_t* Bt, int ldb, int K, int lane) {
    const int r = lane & 31, h = lane >> 5;
    const LAS bf16_t* ap = A + r * lda + 8 * h; const LAS bf16_t* bp = Bt + r * ldb + 8 * h;
    for (int k0 = 0; k0 < K; k0 += 16) {
        const sh8_t a = *(const LAS sh8_t*)(ap + k0), b = *(const LAS sh8_t*)(bp + k0);
        acc = __builtin_amdgcn_mfma_f32_32x32x16_bf16(a, b, acc, 0, 0, 0);
    }
}
__device__ __forceinline__ int crow(int r, int hh) { return (r & 3) + 8 * (r >> 2) + 4 * hh; }
constexpr size_t HG_LT = WS_XB;
constexpr size_t HG_SB = 408 * MiB;
constexpr size_t HG_DD = 456 * MiB;
__device__ __forceinline__ void hg_load_col(const bf16_t* P, int col0, int unit, int tid, bf16_t (&raw)[16]) {
    const int bh = unit >> 7, c = unit & 127, b_ = bh >> 2, h = bh & 3, rg = tid >> 7, k = tid & 127;
    const bf16_t* pr = P + ((size_t)b_ * SEQ + c * 64 + rg * 16) * INW + col0 + h * 128 + k;
#pragma unroll
    for (int i = 0; i < 16; ++i) raw[i] = pr[(size_t)i * INW];
}
__device__ __forceinline__ u4_t hg_load_v(const bf16_t* P, int unit, int tid) {
    const int bh = unit >> 7, c = unit & 127, b_ = bh >> 2, h = bh & 3;
    return *(const u4_t*)(P + ((size_t)b_ * SEQ + c * 64 + (tid >> 3)) * INW + C_HGI + h * 64 + (tid & 7) * 8);
}
__device__ __forceinline__ void hg_cols(const bf16_t (&fl)[16], float lb, LAS float* gs, int tid, float (&kk)[16], float (&bc)[16], float& bmid, float& blast) {
    const int rg = tid >> 7, k = tid & 127;
    float run = 0.f;
#pragma unroll
    for (int i = 0; i < 16; ++i) { const float kv = (1.f - lb) / (1.f + __expf(bf2f(fl[i]))); kk[i] = kv; run += __logf(1.f - kv); bc[i] = run; }
    gs[rg * 128 + k] = run;
    __syncthreads();
    const float g0 = gs[k], g1 = gs[128 + k], g2 = gs[256 + k], g3 = gs[384 + k];
    const float off = (rg > 0 ? g0 : 0.f) + (rg > 1 ? g1 : 0.f) + (rg > 2 ? g2 : 0.f);
#pragma unroll
    for (int i = 0; i < 16; ++i) bc[i] += off;
    bmid = g0 + g1; blast = (g0 + g1) + (g2 + g3);
}
__device__ __forceinline__ void hg_store_vt(LAS bf16_t* VT, int tid, const u4_t v) {
    const int s = tid >> 3, jq = tid & 7;
    LAS bf16_t* d = VT + (jq * 8) * 72 + s;
    d[0 * 72] = (bf16_t)(v.x & 0xffff); d[1 * 72] = (bf16_t)(v.x >> 16); d[2 * 72] = (bf16_t)(v.y & 0xffff); d[3 * 72] = (bf16_t)(v.y >> 16);
    d[4 * 72] = (bf16_t)(v.z & 0xffff); d[5 * 72] = (bf16_t)(v.z >> 16); d[6 * 72] = (bf16_t)(v.w & 0xffff); d[7 * 72] = (bf16_t)(v.w >> 16);
}
__device__ __forceinline__ void hg_local(const Params& p, unsigned char* ldsb) {
    const bf16_t* P = (const bf16_t*)(p.ws + WS_P); const float* lbp = (const float*)(p.ws + WS_LB);
    bf16_t* LT = (bf16_t*)((unsigned char*)p.ws + HG_LT); float* DD = (float*)((unsigned char*)p.ws + HG_DD);
    LAS unsigned char* l = (LAS unsigned char*)ldsb;
    LAS float* gs = (LAS float*)l; LAS bf16_t* KST = (LAS bf16_t*)(l + 2048); LAS bf16_t* VT = (LAS bf16_t*)(l + 20480);
    const int tid = threadIdx.x, lane = tid & 63, wave = tid >> 6, rg = tid >> 7, k = tid & 127;
    bf16_t flr[16]; u4_t vr;
    if ((int)blockIdx.x < 2048) { hg_load_col(P, C_HGF, blockIdx.x, tid, flr); vr = hg_load_v(P, blockIdx.x, tid); }
    for (int unit = blockIdx.x; unit < 2048; unit += gridDim.x) {
        const int bh = unit >> 7, h = bh & 3;
        float kk[16], bc[16], bmid, blast;
        hg_cols(flr, lbp[h * 128 + k], gs, tid, kk, bc, bmid, blast);
        const u4_t vcur = vr;
        { const int nu = unit + gridDim.x; if (nu < 2048) { hg_load_col(P, C_HGF, nu, tid, flr); vr = hg_load_v(P, nu, tid); } }
        { unsigned w[8];
#pragma unroll
          for (int i = 0; i < 8; ++i) w[i] = cvtpk(kk[2 * i] * __expf(blast - bc[2 * i]), kk[2 * i + 1] * __expf(blast - bc[2 * i + 1]));
          LAS u4_t* d = (LAS u4_t*)(KST + k * 72 + rg * 16);
          d[0] = (u4_t){w[0], w[1], w[2], w[3]}; d[1] = (u4_t){w[4], w[5], w[6], w[7]}; }
        hg_store_vt(VT, tid, vcur);
        if (tid < 128) DD[(size_t)unit * 128 + tid] = __expf(blast);
        __syncthreads();
        { const int ji = wave >> 2, ki = wave & 3;
          f32x16 acc;
#pragma unroll
          for (int r = 0; r < 16; ++r) acc[r] = 0.f;
          mma32(acc, VT + 32 * ji * 72, 72, KST + 32 * ki * 72, 72, 64, lane);
          bf16_t* o = LT + (size_t)unit * 8192 + 32 * ki + (lane & 31);
#pragma unroll
          for (int r = 0; r < 16; ++r) o[(size_t)(32 * ji + crow(r, lane >> 5)) * 128] = cvt1(acc[r]); }
        __syncthreads();
    }
}
__device__ __forceinline__ void hg_scan(const Params& p) {
    const bf16_t* LT = (const bf16_t*)((unsigned char*)p.ws + HG_LT); const float* DD = (const float*)((unsigned char*)p.ws + HG_DD);
    bf16_t* SB = (bf16_t*)((unsigned char*)p.ws + HG_SB);
    for (int gt = blockIdx.x * NTHR + threadIdx.x; gt < 16 * 8192; gt += gridDim.x * NTHR) {
        const int bh = gt >> 13, e = gt & 8191, k = e & 127;
        float S = 0.f;
#pragma unroll 8
        for (int c = 0; c < 128; ++c) { const size_t u = (size_t)bh * 128 + c;
            const float L = bf2f(LT[u * 8192 + e]), D = DD[u * 128 + k];
            SB[u * 8192 + e] = cvt1(S); S = fmaf(D, S, L); }
    }
}
__device__ __forceinline__ void hg_out(const Params& p, unsigned char* ldsb) {
    const bf16_t* P = (const bf16_t*)(p.ws + WS_P); const float* lbp = (const float*)(p.ws + WS_LB);
    const bf16_t* SB = (const bf16_t*)((unsigned char*)p.ws + HG_SB);
    bf16_t* mixed = (bf16_t*)(p.ws + WS_MIXED);
    LAS unsigned char* l = (LAS unsigned char*)ldsb;
    LAS float* gs = (LAS float*)l;
    LAS bf16_t* QT = (LAS bf16_t*)(l + 2048); LAS bf16_t* KT = (LAS bf16_t*)(l + 19456); LAS bf16_t* QI = (LAS bf16_t*)(l + 36864);
    LAS bf16_t* VT = (LAS bf16_t*)(l + 54272); LAS bf16_t* SC = (LAS bf16_t*)(l + 63488); LAS bf16_t* ST = (LAS bf16_t*)(l + 72704);
    LAS float* OB = (LAS float*)(l + 90112);
    const int tid = threadIdx.x, lane = tid & 63, wave = tid >> 6, rg = tid >> 7, k = tid & 127;
    bf16_t flr[16], qr[16]; u4_t vr, gr, sr[2];
#define HGO_LOAD(u_) { hg_load_col(P, C_HGF, (u_), tid, flr); hg_load_col(P, C_HGQ, (u_), tid, qr); vr = hg_load_v(P, (u_), tid); \
        { const int bh_ = (u_) >> 7, c_ = (u_) & 127; gr = *(const u4_t*)(P + ((size_t)(bh_ >> 2) * SEQ + c_ * 64 + (tid >> 3)) * INW + C_HGG + (bh_ & 3) * 64 + (tid & 7) * 8); } \
        sr[0] = *(const u4_t*)(SB + (size_t)(u_) * 8192 + tid * 8); sr[1] = *(const u4_t*)(SB + (size_t)(u_) * 8192 + tid * 8 + 4096); }
    if ((int)blockIdx.x < 2048) HGO_LOAD((int)blockIdx.x);
    for (int unit = blockIdx.x; unit < 2048; unit += gridDim.x) {
        const int bh = unit >> 7, c = unit & 127, b_ = bh >> 2, h = bh & 3;
        const size_t tok0 = (size_t)b_ * SEQ + c * 64;
        float kk[16], bc[16], bmid, blast;
        hg_cols(flr, lbp[h * 128 + k], gs, tid, kk, bc, bmid, blast);
        float qf_[16];
#pragma unroll
        for (int i = 0; i < 16; ++i) qf_[i] = bf2f(qr[i]);
        const u4_t vcur = vr, gv_ = gr, s0_ = sr[0], s1_ = sr[1];
        { const int nu = unit + gridDim.x; if (nu < 2048) HGO_LOAD(nu); }
        {
#pragma unroll
          for (int i = 0; i < 16; ++i) { const float q = qf_[i]; const int o = (rg * 16 + i) * 136 + k;
              QT[o] = cvt1(q * __expf(fminf(bc[i] - bmid, 40.f))); KT[o] = cvt1(kk[i] * __expf(fminf(bmid - bc[i], 40.f))); QI[o] = cvt1(q * __expf(bc[i])); } }
        hg_store_vt(VT, tid, vcur);
        { const int idx0 = tid * 8, idx1 = tid * 8 + 4096;
          *(LAS u4_t*)(ST + (idx0 >> 7) * 136 + (idx0 & 127)) = s0_; *(LAS u4_t*)(ST + (idx1 >> 7) * 136 + (idx1 & 127)) = s1_; }
        __syncthreads();
        if (wave < 4) { const int ti = wave >> 1, si = wave & 1;
            f32x16 acc;
#pragma unroll
            for (int r = 0; r < 16; ++r) acc[r] = 0.f;
            if (si <= ti) mma32(acc, QT + 32 * ti * 136, 136, KT + 32 * si * 136, 136, 128, lane);
            const int s = 32 * si + (lane & 31);
#pragma unroll
            for (int r = 0; r < 16; ++r) { const int t = 32 * ti + crow(r, lane >> 5); SC[t * 72 + s] = cvt1((s <= t) ? acc[r] : 0.f); } }
        __syncthreads();
        if (wave < 4) { const int ti = wave >> 1, ji = wave & 1;
            f32x16 acc;
#pragma unroll
            for (int r = 0; r < 16; ++r) acc[r] = 0.f;
            mma32(acc, SC + 32 * ti * 72, 72, VT + 32 * ji * 72, 72, 64, lane);
            mma32(acc, QI + 32 * ti * 136, 136, ST + 32 * ji * 136, 136, 128, lane);
            const int j = 32 * ji + (lane & 31);
#pragma unroll
            for (int r = 0; r < 16; ++r) OB[(32 * ti + crow(r, lane >> 5)) * 65 + j] = acc[r]; }
        __syncthreads();
        { const int t = tid >> 3, jq = tid & 7;
          float o[8]; float ss = 0.f;
#pragma unroll
          for (int e = 0; e < 8; ++e) { o[e] = OB[t * 65 + jq * 8 + e]; ss = fmaf(o[e], o[e], ss); }
          ss += __shfl_xor(ss, 1); ss += __shfl_xor(ss, 2); ss += __shfl_xor(ss, 4);
          const float r = rsqrtf(ss * (1.f / 64.f) + EPS);
          const u4_t gv = gv_;
          const float* gn = p.hg_gain + h * 64 + jq * 8;
          uint4 w; w.x = cvtpk(o[0] * r * gn[0] * bflo(gv.x), o[1] * r * gn[1] * bfhi(gv.x)); w.y = cvtpk(o[2] * r * gn[2] * bflo(gv.y), o[3] * r * gn[3] * bfhi(gv.y));
          w.z = cvtpk(o[4] * r * gn[4] * bflo(gv.z), o[5] * r * gn[5] * bfhi(gv.z)); w.w = cvtpk(o[6] * r * gn[6] * bflo(gv.w), o[7] * r * gn[7] * bfhi(gv.w));
          *(uint4*)(mixed + (tok0 + t) * DM + 512 + h * 64 + jq * 8) = w; }
        __syncthreads();
    }
#undef HGO_LOAD
}

__device__ __forceinline__ sh8_t frag8(const float (&x)[8]) { const u4_t w = {cvtpk(x[0], x[1]), cvtpk(x[2], x[3]), cvtpk(x[4], x[5]), cvtpk(x[6], x[7])}; return __builtin_bit_cast(sh8_t, w); }
__device__ __forceinline__ int kperm(int key) { return (key & 16) | ((key & 4) << 1) | ((key & 8) >> 1) | (key & 3); }
__device__ __forceinline__ void vt_store(LAS bf16_t* VT, int pitch, int d0, int pos, const u4_t v) {
    LAS bf16_t* d = VT + d0 * pitch + pos;
    d[0 * pitch] = (bf16_t)(v.x & 0xffff); d[1 * pitch] = (bf16_t)(v.x >> 16); d[2 * pitch] = (bf16_t)(v.y & 0xffff); d[3 * pitch] = (bf16_t)(v.y >> 16);
    d[4 * pitch] = (bf16_t)(v.z & 0xffff); d[5 * pitch] = (bf16_t)(v.z >> 16); d[6 * pitch] = (bf16_t)(v.w & 0xffff); d[7 * pitch] = (bf16_t)(v.w >> 16);
}
__device__ __forceinline__ void sb_mfma(const Params& p, unsigned char* ldsb) {
    const bf16_t* P = (const bf16_t*)(p.ws + WS_P);
    bf16_t* mixed = (bf16_t*)(p.ws + WS_MIXED);
    const int tid = threadIdx.x, lane = tid & 63, wave = tid >> 6, r = lane & 31, hh = lane >> 5;
    LAS bf16_t* KL = (LAS bf16_t*)ldsb + wave * (32 * 72 + 64 * 40);
    LAS bf16_t* VT = KL + 32 * 72;
    sh8_t mf[2];
#pragma unroll
    for (int ks = 0; ks < 2; ++ks)
#pragma unroll
        for (int e = 0; e < 8; ++e) { const int j = 16 * ks + 8 * (e >> 2) + 4 * hh + (e & 3); mf[ks][e] = (j > r) ? (short)0x3F80 : (short)0; }
    for (int u = blockIdx.x * 8 + wave; u < 32 * 256; u += gridDim.x * 8) {
        const int bh = u >> 8, qt = u & 255, b = bh >> 3, h = bh & 7;
        const size_t tok0 = (size_t)b * SEQ + qt * 32;
        sh8_t qf[4];
        { const bf16_t* qp = P + (tok0 + r) * INW + C_SBQ + h * 64 + 8 * hh;
#pragma unroll
          for (int ks = 0; ks < 4; ++ks) qf[ks] = *(const sh8_t*)(qp + 16 * ks); }
        f32x16 o0, o1;
#pragma unroll
        for (int i = 0; i < 16; ++i) { o0[i] = 0.f; o1[i] = 0.f; }
        float R = 0.f;
        u4_t kraw[4], vraw[4];
        { const bf16_t* kvp = P + ((size_t)b * SEQ + qt * 32 + (lane >> 3)) * INW + h * 64 + (lane & 7) * 8;
#pragma unroll
          for (int i = 0; i < 4; ++i) { kraw[i] = *(const u4_t*)(kvp + (size_t)(8 * i) * INW + C_SBK); vraw[i] = *(const u4_t*)(kvp + (size_t)(8 * i) * INW + C_SBV); } }
        for (int kt = qt; kt >= 0; --kt) {
#pragma unroll
            for (int i = 0; i < 4; ++i) { const int key = (lane >> 3) + 8 * i, dq = lane & 7;
                *(LAS u4_t*)(KL + key * 72 + dq * 8) = kraw[i];
                vt_store(VT, 40, dq * 8, kperm(key), vraw[i]); }
            { const int ktn = kt > 0 ? kt - 1 : 0;
              const bf16_t* kvp = P + ((size_t)b * SEQ + ktn * 32 + (lane >> 3)) * INW + h * 64 + (lane & 7) * 8;
#pragma unroll
              for (int i = 0; i < 4; ++i) { kraw[i] = *(const u4_t*)(kvp + (size_t)(8 * i) * INW + C_SBK); vraw[i] = *(const u4_t*)(kvp + (size_t)(8 * i) * INW + C_SBV); } }
            f32x16 z;
#pragma unroll
            for (int i = 0; i < 16; ++i) z[i] = 0.f;
#pragma unroll
            for (int ks = 0; ks < 4; ++ks) z = __builtin_amdgcn_mfma_f32_32x32x16_bf16(*(const LAS sh8_t*)(KL + r * 72 + 16 * ks + 8 * hh), qf[ks], z, 0, 0, 0);
            const bool diag = (kt == qt);
            float sp[16]; f32x16 la; float tot = 0.f;
#pragma unroll
            for (int i = 0; i < 16; ++i) { const float zz = z[i];
                float s = fmaxf(zz, 0.f) + __builtin_amdgcn_logf(1.f + __builtin_amdgcn_exp2f(-fabsf(zz)));
                const bool valid = !diag || (crow(i, hh) < r);
                la[i] = zz - s + R; s = valid ? s : 0.f; sp[i] = s; tot += s; }
            tot += __shfl_xor(tot, 32);
#pragma unroll
            for (int ks = 0; ks < 2; ++ks) {
                unsigned hi[4], lo[4];
#pragma unroll
                for (int e = 0; e < 4; ++e) { const float x0 = -sp[8 * ks + 2 * e], x1 = -sp[8 * ks + 2 * e + 1]; hi[e] = cvtpk(x0, x1); lo[e] = cvtpk(x0 - bflo(hi[e]), x1 - bfhi(hi[e])); }
                const u4_t hv = {hi[0], hi[1], hi[2], hi[3]}, lv = {lo[0], lo[1], lo[2], lo[3]};
                la = __builtin_amdgcn_mfma_f32_32x32x16_bf16(mf[ks], __builtin_bit_cast(sh8_t, hv), la, 0, 0, 0);
                la = __builtin_amdgcn_mfma_f32_32x32x16_bf16(mf[ks], __builtin_bit_cast(sh8_t, lv), la, 0, 0, 0);
            }
            sh8_t af[2];
#pragma unroll
            for (int ks = 0; ks < 2; ++ks) { float a[8];
#pragma unroll
                for (int e = 0; e < 8; ++e) { const int i = 8 * ks + e; const bool valid = !diag || (crow(i, hh) < r); a[e] = valid ? __builtin_amdgcn_exp2f(la[i]) : 0.f; }
                af[ks] = frag8(a); }
            R -= tot;
#pragma unroll
            for (int ks = 0; ks < 2; ++ks) {
                o0 = __builtin_amdgcn_mfma_f32_32x32x16_bf16(*(const LAS sh8_t*)(VT + r * 40 + 16 * ks + 8 * hh), af[ks], o0, 0, 0, 0);
                o1 = __builtin_amdgcn_mfma_f32_32x32x16_bf16(*(const LAS sh8_t*)(VT + (32 + r) * 40 + 16 * ks + 8 * hh), af[ks], o1, 0, 0, 0);
            }
            if (__all(R < -48.f)) break;
        }
        float ss = 0.f;
#pragma unroll
        for (int i = 0; i < 16; ++i) { ss = fmaf(o0[i], o0[i], ss); ss = fmaf(o1[i], o1[i], ss); }
        ss += __shfl_xor(ss, 32);
        const float rn = rsqrtf(ss * (1.f / 64.f) + EPS);
        bf16_t* op = mixed + (tok0 + r) * DM + h * 64 + 4 * hh;
        const float* gp = p.sb_gain + h * 64 + 4 * hh;
#pragma unroll
        for (int q4 = 0; q4 < 4; ++q4) {
            const float4 g0 = *(const float4*)(gp + 8 * q4), g1 = *(const float4*)(gp + 32 + 8 * q4);
            uint2 w0, w1;
            w0.x = cvtpk(o0[4 * q4] * rn * g0.x, o0[4 * q4 + 1] * rn * g0.y); w0.y = cvtpk(o0[4 * q4 + 2] * rn * g0.z, o0[4 * q4 + 3] * rn * g0.w);
            w1.x = cvtpk(o1[4 * q4] * rn * g1.x, o1[4 * q4 + 1] * rn * g1.y); w1.y = cvtpk(o1[4 * q4 + 2] * rn * g1.z, o1[4 * q4 + 3] * rn * g1.w);
            *(uint2*)(op + 8 * q4) = w0; *(uint2*)(op + 32 + 8 * q4) = w1;
        }
    }
}
__device__ __forceinline__ void mem_attn_mfma(const Params& p, unsigned char* ldsb) {
    const bf16_t* P = (const bf16_t*)(p.ws + WS_P);
    const bf16_t* kvb = (const bf16_t*)(p.ws + WS_MEMKV);
    bf16_t* mixed = (bf16_t*)(p.ws + WS_MIXED);
    const int tid = threadIdx.x, lane = tid & 63, wave = tid >> 6, r = lane & 31, hh = lane >> 5;
    LAS bf16_t* VT = (LAS bf16_t*)ldsb;
    LAS bf16_t* KN = VT + 64 * 264;
    for (int unit = blockIdx.x; unit < NB * 4 * (SEQ / 256); unit += gridDim.x) {
        const int tb = unit & 31, hd = (unit >> 5) & 3, b = unit >> 7;
        __syncthreads();
#pragma unroll
        for (int i = 0; i < 4; ++i) { const int idx = tid + 512 * i, key = idx >> 3, dq = idx & 7;
            const u4_t v = *(const u4_t*)(kvb + ((size_t)b * NMEM + key) * 512 + 256 + hd * 64 + dq * 8);
            vt_store(VT, 264, dq * 8, (key & ~31) | kperm(key & 31), v); }
        { const bf16_t* kp = kvb + ((size_t)b * NMEM + wave * 32 + r) * 512 + hd * 64 + 8 * hh;
          u4_t kw[4]; float ssk = 0.f;
#pragma unroll
          for (int ks = 0; ks < 4; ++ks) { kw[ks] = *(const u4_t*)(kp + 16 * ks);
#pragma unroll
              for (int e = 0; e < 4; ++e) { const float lo = bflo(kw[ks][e]), hi = bfhi(kw[ks][e]); ssk = fmaf(lo, lo, ssk); ssk = fmaf(hi, hi, ssk); } }
          ssk += __shfl_xor(ssk, 32);
          const float rk = rsqrtf(ssk * (1.f / 64.f) + EPS);
#pragma unroll
          for (int ks = 0; ks < 4; ++ks) { float t8[8];
#pragma unroll
              for (int e = 0; e < 4; ++e) { t8[2 * e] = bflo(kw[ks][e]) * rk; t8[2 * e + 1] = bfhi(kw[ks][e]) * rk; }
              *(LAS sh8_t*)(KN + (wave * 32 + r) * 72 + 16 * ks + 8 * hh) = frag8(t8); } }
        __syncthreads();
        const size_t tok = (size_t)b * SEQ + tb * 256 + wave * 32 + r;
        sh8_t qf[4];
        { const bf16_t* qp = P + tok * INW + C_MQ + hd * 64 + 8 * hh;
          float qv[32]; float ss = 0.f;
#pragma unroll
          for (int ks = 0; ks < 4; ++ks) { const u4_t w = *(const u4_t*)(qp + 16 * ks);
              qv[8 * ks] = bflo(w.x); qv[8 * ks + 1] = bfhi(w.x); qv[8 * ks + 2] = bflo(w.y); qv[8 * ks + 3] = bfhi(w.y); qv[8 * ks + 4] = bflo(w.z); qv[8 * ks + 5] = bfhi(w.z); qv[8 * ks + 6] = bflo(w.w); qv[8 * ks + 7] = bfhi(w.w); }
#pragma unroll
          for (int i = 0; i < 32; ++i) ss = fmaf(qv[i], qv[i], ss);
          ss += __shfl_xor(ss, 32);
          const float rq = rsqrtf(ss * (1.f / 64.f) + EPS) * (0.125f * LOG2E);
#pragma unroll
          for (int ks = 0; ks < 4; ++ks) { float t8[8];
#pragma unroll
              for (int e = 0; e < 8; ++e) t8[e] = qv[8 * ks + e] * rq * p.mq_gain[16 * ks + 8 * hh + e] * p.mk_gain[16 * ks + 8 * hh + e];
              qf[ks] = frag8(t8); } }
        f32x16 s[8];
#pragma unroll
        for (int kt = 0; kt < 8; ++kt) {
#pragma unroll
            for (int i = 0; i < 16; ++i) s[kt][i] = 0.f;
#pragma unroll
            for (int ks = 0; ks < 4; ++ks) s[kt] = __builtin_amdgcn_mfma_f32_32x32x16_bf16(*(const LAS sh8_t*)(KN + (kt * 32 + r) * 72 + 16 * ks + 8 * hh), qf[ks], s[kt], 0, 0, 0);
        }
        float mx = -1e30f;
#pragma unroll
        for (int kt = 0; kt < 8; ++kt)
#pragma unroll
            for (int i = 0; i < 16; ++i) mx = fmaxf(mx, s[kt][i]);
        mx = fmaxf(mx, __shfl_xor(mx, 32));
        float lsum = 0.f;
        f32x16 o0, o1;
#pragma unroll
        for (int i = 0; i < 16; ++i) { o0[i] = 0.f; o1[i] = 0.f; }
#pragma unroll
        for (int kt = 0; kt < 8; ++kt)
#pragma unroll
            for (int ks = 0; ks < 2; ++ks) { float a[8];
#pragma unroll
                for (int e = 0; e < 8; ++e) { a[e] = __builtin_amdgcn_exp2f(s[kt][8 * ks + e] - mx); lsum += a[e]; }
                const sh8_t af = frag8(a);
                o0 = __builtin_amdgcn_mfma_f32_32x32x16_bf16(*(const LAS sh8_t*)(VT + r * 264 + 32 * kt + 16 * ks + 8 * hh), af, o0, 0, 0, 0);
                o1 = __builtin_amdgcn_mfma_f32_32x32x16_bf16(*(const LAS sh8_t*)(VT + (32 + r) * 264 + 32 * kt + 16 * ks + 8 * hh), af, o1, 0, 0, 0); }
        lsum += __shfl_xor(lsum, 32);
        const float il = 1.f / lsum;
        bf16_t* op = mixed + tok * DM + 768 + hd * 64 + 4 * hh;
#pragma unroll
        for (int q4 = 0; q4 < 4; ++q4) {
            uint2 w0, w1;
            w0.x = cvtpk(o0[4 * q4] * il, o0[4 * q4 + 1] * il); w0.y = cvtpk(o0[4 * q4 + 2] * il, o0[4 * q4 + 3] * il);
            w1.x = cvtpk(o1[4 * q4] * il, o1[4 * q4 + 1] * il); w1.y = cvtpk(o1[4 * q4 + 2] * il, o1[4 * q4 + 3] * il);
            *(uint2*)(op + 8 * q4) = w0; *(uint2*)(op + 32 + 8 * q4) = w1;
        }
    }
}

__device__ __forceinline__ int tk_pack(float s, int payload, int mask) { const int b = __float_as_int(s); const int m = b ^ ((b >> 31) & 0x7fffffff); return (m & ~mask) | payload; }
__device__ __forceinline__ float tk_unpack(int key, int mask) { const int m = key & ~mask; return __int_as_float(m ^ ((m >> 31) & 0x7fffffff)); }
template <int N> __device__ __forceinline__ void bitonic_sort_desc(int (&v)[N]) {
#pragma unroll
    for (int k = 2; k <= N; k <<= 1)
#pragma unroll
        for (int j = k >> 1; j > 0; j >>= 1)
#pragma unroll
            for (int i = 0; i < N; ++i) { const int l = i ^ j; if (l > i) { const bool desc = ((i & k) == 0); const int a = v[i], b = v[l]; const int hi = max(a, b), lo = min(a, b); v[i] = desc ? hi : lo; v[l] = desc ? lo : hi; } }
}
__device__ __forceinline__ void merge_top16(int (&A)[16], const int (&B)[16]) {
#pragma unroll
    for (int i = 0; i < 16; ++i) A[i] = max(A[i], B[15 - i]);
#pragma unroll
    for (int j = 8; j > 0; j >>= 1)
#pragma unroll
        for (int i = 0; i < 16; ++i) { const int l = i ^ j; if (l > i) { const int a = A[i], b = A[l]; A[i] = max(a, b); A[l] = min(a, b); } }
}
__device__ __forceinline__ void top16_of_64(int (&g0)[16], int (&g1)[16], int (&g2)[16], int (&g3)[16]) {
    bitonic_sort_desc<16>(g0); bitonic_sort_desc<16>(g1); bitonic_sort_desc<16>(g2); bitonic_sort_desc<16>(g3);
    merge_top16(g0, g1); merge_top16(g2, g3); merge_top16(g0, g2);
}
__device__ __forceinline__ void topk_mfma(const Params& p, unsigned char* ldsb) {
    const bf16_t* Q = (const bf16_t*)(p.ws + WS_Q);
    const bf16_t* SK = (const bf16_t*)(p.ws + WS_SKB);
    unsigned short* pidx16 = (unsigned short*)(p.ws + WS_PIDX); float* pg = (float*)(p.ws + WS_PG);
    const float* ssq = (const float*)(p.ws + WS_SSQ); float* rs2 = (float*)(p.ws + WS_RSTD2);
    LAS unsigned char* l = (LAS unsigned char*)ldsb;
    LAS bf16_t* SKL = (LAS bf16_t*)l;
    const int tid = threadIdx.x, lane = tid & 63, wave = tid >> 6, r = lane & 31, hh = lane >> 5;
    LAS unsigned char* ib = l + 69632 + (wave * 64 + lane) * 36;
    int cur_h = -1;
    for (int unit = blockIdx.x; unit < 8 * (T / 256); unit += gridDim.x) {
        const int h = unit & 7, tb = unit >> 3;
        if (h != cur_h) {
            __syncthreads();
#pragma unroll
            for (int it = 0; it < 8; ++it) { const int idx = tid + 512 * it, row = idx >> 4, cq = idx & 15;
                *(LAS u4_t*)(SKL + row * 136 + cq * 8) = *(const u4_t*)(SK + ((size_t)h * 256 + row) * 128 + cq * 8); }
            __syncthreads();
            cur_h = h;
        }
        const int tok = tb * 256 + wave * 32 + r;
        int sorted[2][16];
#pragma unroll
        for (int c = 0; c < 2; ++c) {
            sh8_t qf[8];
            { const sh8_t* qp = (const sh8_t*)(Q + (size_t)tok * 2048 + h * 256 + c * 128 + 8 * hh);
#pragma unroll
              for (int ks = 0; ks < 8; ++ks) qf[ks] = qp[2 * ks]; }
            int g[4][16];
#pragma unroll
            for (int mt = 0; mt < 4; ++mt) {
                f32x16 acc;
#pragma unroll
                for (int i = 0; i < 16; ++i) acc[i] = 0.f;
                const LAS bf16_t* ap = SKL + (c * 128 + 32 * mt + r) * 136 + 8 * hh;
#pragma unroll
                for (int ks = 0; ks < 8; ++ks) acc = __builtin_amdgcn_mfma_f32_32x32x16_bf16(*(const LAS sh8_t*)(ap + 16 * ks), qf[ks], acc, 0, 0, 0);
#pragma unroll
                for (int i = 0; i < 16; ++i) g[mt][i] = tk_pack(acc[i], (32 * mt + (i & 3) + 8 * (i >> 2)) | (hh << 2), 127);
            }
            top16_of_64(g[0], g[1], g[2], g[3]);
            int o[16];
#pragma unroll
            for (int i = 0; i < 16; ++i) o[i] = __shfl_xor(g[0][i], 32);
            merge_top16(g[0], o);
#pragma unroll
            for (int i = 0; i < 16; ++i) sorted[c][i] = g[0][i];
        }
#pragma unroll
        for (int c = 0; c < 2; ++c)
#pragma unroll
            for (int w = 0; w < 4; ++w)
                *(LAS unsigned*)(ib + c * 16 + w * 4) = (unsigned)(sorted[c][4 * w] & 127) | ((unsigned)(sorted[c][4 * w + 1] & 127) << 8) | ((unsigned)(sorted[c][4 * w + 2] & 127) << 16) | ((unsigned)(sorted[c][4 * w + 3] & 127) << 24);
        float av[16], bv[16];
#pragma unroll
        for (int i = 0; i < 16; ++i) { av[i] = tk_unpack(sorted[0][i], 127); bv[i] = tk_unpack(sorted[1][i], 127); }
        int cd[4][16];
        {
            int n = 0;
#pragma unroll
            for (int i = 0; i < 16; ++i)
#pragma unroll
                for (int j = 0; j < 16; ++j)
                    if ((i + 1) * (j + 1) <= 16) { cd[n >> 4][n & 15] = tk_pack(av[i] + bv[j], i * 16 + j, 255); ++n; }
#pragma unroll
            for (; n < 64; ++n) cd[n >> 4][n & 15] = (int)0x80000000;
        }
        top16_of_64(cd[0], cd[1], cd[2], cd[3]);
        float sv[16]; int ex[16];
        float rstd;
        { const f32x4_t* sp_ = (const f32x4_t*)(ssq + (size_t)tok * 16); const f32x4_t q0 = sp_[0], q1 = sp_[1], q2 = sp_[2], q3 = sp_[3];
          const float tot = ((q0[0] + q0[1]) + (q0[2] + q0[3])) + ((q1[0] + q1[1]) + (q1[2] + q1[3])) + ((q2[0] + q2[1]) + (q2[2] + q2[3])) + ((q3[0] + q3[1]) + (q3[2] + q3[3]));
          rstd = rsqrtf(tot * (1.f / DM) + EPS); if (h == 0 && hh == 0) rs2[tok] = rstd; }
        const float s0 = tk_unpack(cd[0][0], 255);
        float sum = 0.f;
#pragma unroll
        for (int q = 0; q < 16; ++q) { const int key = cd[0][q]; const int id = key & 255;
            const int ia = ib[id >> 4], ibx = ib[16 + (id & 15)];
            ex[q] = ia * 128 + ibx; sv[q] = __expf((tk_unpack(key, 255) - s0) * rstd); sum += sv[q]; }
        const float inv = 1.f / sum;
        if (hh == 0) { u4_t* d = (u4_t*)(pidx16 + (size_t)tok * PK + h * 16);
#pragma unroll
            for (int w = 0; w < 2; ++w) d[w] = (u4_t){(unsigned)ex[8 * w] | ((unsigned)ex[8 * w + 1] << 16), (unsigned)ex[8 * w + 2] | ((unsigned)ex[8 * w + 3] << 16), (unsigned)ex[8 * w + 4] | ((unsigned)ex[8 * w + 5] << 16), (unsigned)ex[8 * w + 6] | ((unsigned)ex[8 * w + 7] << 16)}; }
        else { float4* d = (float4*)(pg + (size_t)tok * PK + h * 16);
#pragma unroll
            for (int w = 0; w < 4; ++w) d[w] = make_float4(sv[4 * w] * inv, sv[4 * w + 1] * inv, sv[4 * w + 2] * inv, sv[4 * w + 3] * inv); }
    }
}

struct Sl { int vx, rank, nrank; };
__device__ __forceinline__ float dpp_xor1(float x) { return __int_as_float(__builtin_amdgcn_mov_dpp(__float_as_int(x), 0xB1, 0xF, 0xF, true)); }
__device__ __forceinline__ float dpp_xor2(float x) { return __int_as_float(__builtin_amdgcn_mov_dpp(__float_as_int(x), 0x4E, 0xF, 0xF, true)); }
__device__ __forceinline__ float dpp_ror8(float x) { return __int_as_float(__builtin_amdgcn_mov_dpp(__float_as_int(x), 0x128, 0xF, 0xF, true)); }
__device__ __forceinline__ float dpp_hmir(float x) { return __int_as_float(__builtin_amdgcn_mov_dpp(__float_as_int(x), 0x141, 0xF, 0xF, true)); }
__device__ __forceinline__ void peer_u_phase(const Params& p, const Sl sl) {
    const int lane = threadIdx.x & 63, wave = threadIdx.x >> 6, g8 = lane >> 3, c = lane & 7;
    const unsigned short* pidx = (const unsigned short*)(p.ws + WS_PIDX);
    const int per = (T + sl.nrank * 8 - 1) / (sl.nrank * 8), tbase = (sl.rank * 8 + wave) * per, stride = 1;
    const int nk = (tbase < T) ? ((T - tbase < per) ? (T - tbase) : per) : 0;
    const int S = sl.vx;
    const unsigned char* Ub = p.ws + WS_U16 + (size_t)S * NEXP * 128 + c * 16;
    const bf16_t* xbb = (const bf16_t*)(p.ws + WS_XB) + (size_t)(2 * S + (c >> 2)) * T * 64 + (c & 3) * 16;
    _Float16* PUs = (_Float16*)(p.ws + WS_PU) + (size_t)S * T * PK;
    if (nk == 0) return;
#define TK(k) (tbase + ((k) < nk ? (k) : nk - 1) * stride)
#define SBAR __builtin_amdgcn_sched_barrier(0)
#define U_LOAD_IDX(I, t) { const u4_t* ip_ = (const u4_t*)(pidx + (size_t)(t) * PK + g8 * 16); I[0] = __builtin_nontemporal_load(ip_); I[1] = __builtin_nontemporal_load(ip_ + 1); }
#define U_LOAD_H(H, t) { const u4_t* hp_ = (const u4_t*)(xbb + (size_t)(t) * 64); H[0] = __builtin_nontemporal_load(hp_); H[1] = __builtin_nontemporal_load(hp_ + 1); }
#define U_ISSUE(G, I) { const unsigned w0_ = I[(G) >> 1][(2 * (G)) & 3], w1_ = I[(G) >> 1][(2 * (G) + 1) & 3]; \
        rr[4 * (G)] = *(const u4_t*)(Ub + (size_t)(w0_ & 0xffffu) * 128); rr[4 * (G) + 1] = *(const u4_t*)(Ub + (size_t)(w0_ >> 16) * 128); \
        rr[4 * (G) + 2] = *(const u4_t*)(Ub + (size_t)(w1_ & 0xffffu) * 128); rr[4 * (G) + 3] = *(const u4_t*)(Ub + (size_t)(w1_ >> 16) * 128); }
#define U_DOT(G) { _Pragma("unroll") for (int i_ = 4 * (G); i_ < 4 * (G) + 4; ++i_) { float2_t a_ = {0.f, 0.f}; \
        _Pragma("unroll") for (int q_ = 0; q_ < 4; ++q_) { a_ = __builtin_amdgcn_cvt_pk_f32_fp8((int)rr[i_][q_], false) * X2[2 * q_] + a_; a_ = __builtin_amdgcn_cvt_pk_f32_fp8((int)rr[i_][q_], true) * X2[2 * q_ + 1] + a_; } \
        pr[i_] = a_.x + a_.y; } }
#define U_STEP(k, I1, I2, Hc, Hn) { float pr[16]; float2_t X2[8]; \
        _Pragma("unroll") for (int m_ = 0; m_ < 8; ++m_) { const unsigned hw_ = Hc[m_ >> 2][m_ & 3]; X2[m_] = (float2_t){bflo(hw_), bfhi(hw_)}; } \
        U_LOAD_IDX(I2, TK((k) + 2)); U_LOAD_H(Hn, TK((k) + 1)); SBAR; \
        U_DOT(0); SBAR; U_ISSUE(0, I1); SBAR; U_DOT(1); SBAR; U_ISSUE(1, I1); SBAR; U_DOT(2); SBAR; U_ISSUE(2, I1); SBAR; U_DOT(3); SBAR; U_ISSUE(3, I1); SBAR; \
        _Pragma("unroll") for (int j_ = 0; j_ < 8; ++j_) { const float keep_ = (c & 4) ? pr[j_ + 8] : pr[j_], send_ = (c & 4) ? pr[j_] : pr[j_ + 8]; pr[j_] = keep_ + dpp_hmir(send_); } \
        _Pragma("unroll") for (int j_ = 0; j_ < 4; ++j_) { const float keep_ = (c & 2) ? pr[j_ + 4] : pr[j_], send_ = (c & 2) ? pr[j_] : pr[j_ + 4]; pr[j_] = keep_ + dpp_xor2(send_); } \
        _Pragma("unroll") for (int j_ = 0; j_ < 2; ++j_) { const float keep_ = (c & 1) ? pr[j_ + 2] : pr[j_], send_ = (c & 1) ? pr[j_] : pr[j_ + 2]; pr[j_] = keep_ + dpp_xor1(send_); } \
        __builtin_nontemporal_store((h2_t){(_Float16)pr[0], (_Float16)pr[1]}, (h2_t*)(PUs + (size_t)TK(k) * PK + g8 * 16 + 2 * c)); }
    u4_t iA[2], iB[2], rr[16], hA[2], hB[2];
    U_LOAD_IDX(iA, TK(0)); U_LOAD_IDX(iB, TK(1)); U_LOAD_H(hA, TK(0)); SBAR;
    U_ISSUE(0, iA); SBAR; U_ISSUE(1, iA); SBAR; U_ISSUE(2, iA); SBAR; U_ISSUE(3, iA); SBAR;
    for (int k = 0; k < nk; k += 2) {
        U_STEP(k, iB, iA, hA, hB);
        if (k + 1 < nk) U_STEP(k + 1, iA, iB, hB, hA);
    }
#undef U_LOAD_IDX
#undef U_LOAD_H
#undef U_ISSUE
#undef U_DOT
#undef U_STEP
}
__device__ __forceinline__ void peer_w_phase(const Params& p) {
    const _Float16* PU = (const _Float16*)(p.ws + WS_PU); const float* pg = (const float*)(p.ws + WS_PG); const float* rs = (const float*)(p.ws + WS_RSTD2);
    _Float16* pw = (_Float16*)(p.ws + WS_PW);
    for (int i = blockIdx.x * NTHR + threadIdx.x; i < T * PK / 8; i += gridDim.x * NTHR) {
        float s[8];
#pragma unroll
        for (int e = 0; e < 8; ++e) s[e] = 0.f;
#pragma unroll
        for (int x = 0; x < 8; ++x) { const h8_t hv = __builtin_nontemporal_load((const h8_t*)(PU + (size_t)x * T * PK) + i);
#pragma unroll
            for (int e = 0; e < 8; ++e) s[e] += (float)hv[e]; }
        const float r = rs[i >> 4] * (1.f / PEER_US);
        const f32x4_t g0 = *((const f32x4_t*)pg + 2 * i), g1 = *((const f32x4_t*)pg + 2 * i + 1);
        h8_t wv;
#pragma unroll
        for (int e = 0; e < 4; ++e) { const float a = s[e] * r, b = s[4 + e] * r;
            wv[e] = (_Float16)(g0[e] * (0.5f / PEER_VS) * a * (1.f + erff(a * 0.70710678118654752f))); wv[4 + e] = (_Float16)(g1[e] * (0.5f / PEER_VS) * b * (1.f + erff(b * 0.70710678118654752f))); }
        *((h8_t*)pw + i) = wv;
    }
}
__device__ __forceinline__ void peer_v_phase(const Params& p, const Sl sl) {
    const int lane = threadIdx.x & 63, wave = threadIdx.x >> 6, g8 = lane >> 3, c = lane & 7;
    const unsigned short* pidx = (const unsigned short*)(p.ws + WS_PIDX); const _Float16* pw = (const _Float16*)(p.ws + WS_PW);
    const int per = (T + sl.nrank * 8 - 1) / (sl.nrank * 8), tbase = (sl.rank * 8 + wave) * per, stride = 1;
    const int nk = (tbase < T) ? ((T - tbase < per) ? (T - tbase) : per) : 0;
    const int S = sl.vx;
    const unsigned char* Vb = p.ws + WS_V16 + (size_t)S * NEXP * 128 + c * 16;
    const int jj = 16 * c + 2 * g8, s16 = 2 * S + (jj >> 6), j = jj & 63;
    float* ob = p.out + (j >> 5) * 512 + 32 * s16 + (j & 31);
    const bf16_t* xs = (const bf16_t*)(p.ws + WS_XB) + (size_t)s16 * T * 64 + j;
    if (nk == 0) return;
#define V_LOAD_IDX(I, t) { const u4_t* ip_ = (const u4_t*)(pidx + (size_t)(t) * PK + g8 * 16); I[0] = __builtin_nontemporal_load(ip_); I[1] = __builtin_nontemporal_load(ip_ + 1); }
#define V_LOAD_W(W, t) { const h8_t* wp_ = (const h8_t*)(pw + (size_t)(t) * PK + g8 * 16); W[0] = __builtin_nontemporal_load(wp_); W[1] = __builtin_nontemporal_load(wp_ + 1); }
#define V_ISSUE(G, I) { const unsigned w0_ = I[(G) >> 1][(2 * (G)) & 3], w1_ = I[(G) >> 1][(2 * (G) + 1) & 3]; \
        rr[4 * (G)] = *(const u4_t*)(Vb + (size_t)(w0_ & 0xffffu) * 128); rr[4 * (G) + 1] = *(const u4_t*)(Vb + (size_t)(w0_ >> 16) * 128); \
        rr[4 * (G) + 2] = *(const u4_t*)(Vb + (size_t)(w1_ & 0xffffu) * 128); rr[4 * (G) + 3] = *(const u4_t*)(Vb + (size_t)(w1_ >> 16) * 128); }
#define V_FMA(G, W) { _Pragma("unroll") for (int i_ = 4 * (G); i_ < 4 * (G) + 4; ++i_) { const float wv_ = (float)W[i_ >> 3][i_ & 7]; const float2_t ww_ = {wv_, wv_}; \
        _Pragma("unroll") for (int q_ = 0; q_ < 4; ++q_) { acc2[2 * q_] = __builtin_amdgcn_cvt_pk_f32_fp8((int)rr[i_][q_], false) * ww_ + acc2[2 * q_]; acc2[2 * q_ + 1] = __builtin_amdgcn_cvt_pk_f32_fp8((int)rr[i_][q_], true) * ww_ + acc2[2 * q_ + 1]; } } }
#define V_STEP(k, I1, I2, Wc, Wn) { float2_t acc2[8]; \
        _Pragma("unroll") for (int k_ = 0; k_ < 8; ++k_) acc2[k_] = (float2_t){0.f, 0.f}; \
        const unsigned oold_ = __builtin_nontemporal_load((const unsigned*)(xs + (size_t)TK(k) * 64)); \
        V_LOAD_IDX(I2, TK((k) + 2)); V_LOAD_W(Wn, TK((k) + 1)); SBAR; \
        V_FMA(0, Wc); SBAR; V_ISSUE(0, I1); SBAR; V_FMA(1, Wc); SBAR; V_ISSUE(1, I1); SBAR; V_FMA(2, Wc); SBAR; V_ISSUE(2, I1); SBAR; V_FMA(3, Wc); SBAR; V_ISSUE(3, I1); SBAR; \
        float a_[16]; \
        _Pragma("unroll") for (int k_ = 0; k_ < 8; ++k_) { a_[2 * k_] = acc2[k_].x; a_[2 * k_ + 1] = acc2[k_].y; } \
        _Pragma("unroll") for (int j_ = 0; j_ < 8; ++j_) { const float keep_ = (g8 & 4) ? a_[j_ + 8] : a_[j_], send_ = (g8 & 4) ? a_[j_] : a_[j_ + 8]; a_[j_] = keep_ + __shfl_xor(send_, 32); } \
        _Pragma("unroll") for (int j_ = 0; j_ < 4; ++j_) { const float keep_ = (g8 & 2) ? a_[j_ + 4] : a_[j_], send_ = (g8 & 2) ? a_[j_] : a_[j_ + 4]; a_[j_] = keep_ + __shfl_xor(send_, 16); } \
        _Pragma("unroll") for (int j_ = 0; j_ < 2; ++j_) { const float keep_ = (g8 & 1) ? a_[j_ + 2] : a_[j_], send_ = (g8 & 1) ? a_[j_] : a_[j_ + 2]; a_[j_] = keep_ + dpp_ror8(send_); } \
        __builtin_nontemporal_store((float2_t){bflo(oold_) + a_[0], bfhi(oold_) + a_[1]}, (float2_t*)(ob + (size_t)TK(k) * DM)); }
    u4_t iA[2], iB[2], rr[16]; h8_t wA[2], wB[2];
    V_LOAD_IDX(iA, TK(0)); V_LOAD_IDX(iB, TK(1)); V_LOAD_W(wA, TK(0)); SBAR;
    V_ISSUE(0, iA); SBAR; V_ISSUE(1, iA); SBAR; V_ISSUE(2, iA); SBAR; V_ISSUE(3, iA); SBAR;
    for (int k = 0; k < nk; k += 2) {
        V_STEP(k, iB, iA, wA, wB);
        if (k + 1 < nk) V_STEP(k + 1, iA, iB, wB, wA);
    }
#undef V_LOAD_IDX
#undef V_LOAD_W
#undef V_ISSUE
#undef V_FMA
#undef V_STEP
#undef TK
#undef SBAR
}

#ifndef PROBE_DBL
#define PROBE_DBL -1
#endif
#define REP(k) for (int rep_ = 0; rep_ < ((PROBE_DBL == (k)) ? 2 : 1); ++rep_)
typedef const __attribute__((address_space(4))) Params* KArgs;
#if defined(__HIP_DEVICE_COMPILE__)
#define LOADP(P) KArgs kq_ = (KArgs)__builtin_amdgcn_kernarg_segment_ptr(); asm volatile("" : "+s"(kq_)); Params P; __builtin_memcpy(&P, kq_, sizeof(Params))
#define BAR_WS() ((unsigned char*)((KArgs)__builtin_amdgcn_kernarg_segment_ptr())->ws)
#else
#define LOADP(P) const Params P = p_unused
#define BAR_WS() (p_unused.ws)
#endif
#ifndef PROBE_SPIN
#define PROBE_SPIN -1
#endif
#if PROBE_SPIN >= 0
#define STAMP(k) do { if (threadIdx.x == 0) { const unsigned long long t_ = __builtin_amdgcn_s_memrealtime(); ((volatile LAS unsigned*)(LAS unsigned char*)lds)[36800 + 2 * (k)] = (unsigned)t_; ((volatile LAS unsigned*)(LAS unsigned char*)lds)[36801 + 2 * (k)] = (unsigned)(t_ >> 32); } } while (0)
#else
#define STAMP(k) do { } while (0)
#endif
#define BAR() do { XcdBarrier xb_; xb_.bar = (unsigned*)(BAR_WS() + WS_CTL) + 4096; xb_.x = ((volatile LAS unsigned*)(LAS unsigned char*)lds)[36861]; xb_.st = (volatile LAS unsigned*)(LAS unsigned char*)lds + 36862; xcd_barrier(xb_); } while (0)
__global__ void __launch_bounds__(NTHR, 2) fwd_kernel(Params p_unused) {
    extern __shared__ __attribute__((aligned(16))) unsigned char lds[];
    PG8_LAS unsigned char* ldsl = (PG8_LAS unsigned char*)lds;
    STAMP(13);
    { LOADP(p);
      if (blockIdx.x == 0) { unsigned* ctl0 = (unsigned*)(p.ws + WS_CTL); for (int i = threadIdx.x; i < 16384; i += NTHR) ctl0[i] = 0u; }
      if (threadIdx.x < 2) ((volatile LAS unsigned*)(LAS unsigned char*)lds)[36862 + threadIdx.x] = 0u; }
    { cg::grid_group grid = cg::this_grid(); grid.sync(); }
    { LOADP(p);
      if (threadIdx.x == 0) { unsigned* ctl0 = (unsigned*)(p.ws + WS_CTL); const unsigned xcc0 = (unsigned)__builtin_amdgcn_s_getreg((3 << 11) | 20) & 7u;
        ((volatile unsigned*)lds)[36860] = __hip_atomic_fetch_add(&ctl0[64 * xcc0], 1u, __ATOMIC_RELAXED, __HIP_MEMORY_SCOPE_AGENT); ((volatile unsigned*)lds)[36861] = xcc0;
        (void)xb_add(&(ctl0 + 4096)[XB_XCNT(xcc0)], 1u); }
      __syncthreads(); }
    STAMP(0);
    { LOADP(p); REP(0) phase_prep(p, lds); }
    BAR(); STAMP(1);
    { LOADP(p); unsigned char* ws = p.ws;
      pg8::Gemm g{(const bf16_t*)(ws + WS_XB), (const bf16_t*)(ws + WS_WIN_T), T, INW, DM, DM, 128}; pg8::StaticOrder S; S.init(T, INW, gridDim.x, blockIdx.x); pg8::EpiProjM e{(bf16_t*)(ws + WS_P)};
      pg8::gemm_phase<pg8::EpiProjM, pg8::StaticOrder, true, true>(ldsl, g, S, e); }
    { LOADP(p); unsigned char* ws = p.ws;
      pg8::Gemm g{(const bf16_t*)(ws + WS_MEMN), (const bf16_t*)(ws + WS_WMKV_T), NB * NMEM, 512, DM, DM, 128}; pg8::StaticOrder S; S.init(NB * NMEM, 512, gridDim.x, (blockIdx.x + gridDim.x / 2) % gridDim.x); pg8::EpiQM e{(bf16_t*)(ws + WS_MEMKV), 512};
      pg8::gemm_phase<pg8::EpiQM, pg8::StaticOrder, true, true>(ldsl, g, S, e); }
    BAR(); STAMP(2);
    { LOADP(p); REP(2) { sb_mfma(p, lds); __syncthreads(); } REP(3) { hg_local(p, lds); } REP(5) mem_attn_mfma(p, lds); }
    BAR(); STAMP(3);
    { LOADP(p); REP(4) hg_scan(p); }
    BAR(); STAMP(4);
    { LOADP(p); REP(6) hg_out(p, lds); }
    BAR(); STAMP(5);
    { LOADP(p); unsigned char* ws = p.ws;
      pg8::Gemm g{(const bf16_t*)(ws + WS_MIXED), (const bf16_t*)(ws + WS_WOUT_T), T, DM, DM, DM, 128}; pg8::StaticOrder S; S.init(T, DM, gridDim.x, blockIdx.x); pg8::EpiWoutM e{p.x, (bf16_t*)(ws + WS_XB), (float*)(ws + WS_SSQ)};
      pg8::gemm_phase<pg8::EpiWoutM, pg8::StaticOrder, true, true>(ldsl, g, S, e); }
#if PROBE_DBL == 7
    { LOADP(p); unsigned char* ws = p.ws;
      pg8::Gemm g{(const bf16_t*)(ws + WS_MIXED), (const bf16_t*)(ws + WS_WOUT_T), T, DM, DM, DM, 128}; pg8::StaticOrder S; S.init(T, DM, gridDim.x, blockIdx.x); pg8::EpiWoutM e{p.x, (bf16_t*)(ws + WS_XB), (float*)(ws + WS_SSQ)};
      pg8::gemm_phase<pg8::EpiWoutM, pg8::StaticOrder, true, true>(ldsl, g, S, e); }
#endif
    BAR(); STAMP(6);
    { LOADP(p); unsigned char* ws = p.ws;
      pg8::Gemm g{(const bf16_t*)(ws + WS_XB), (const bf16_t*)(ws + WS_WQ_T), T, 2048, DM, 64, (size_t)T * 128}; pg8::StaticOrder S; S.init(T, 2048, gridDim.x, blockIdx.x); pg8::EpiQM e{(bf16_t*)(ws + WS_Q), 2048};
      pg8::gemm_phase<pg8::EpiQM, pg8::StaticOrder, true, true>(ldsl, g, S, e); }
#if PROBE_DBL == 9
    { LOADP(p); unsigned char* ws = p.ws;
      pg8::Gemm g{(const bf16_t*)(ws + WS_XB), (const bf16_t*)(ws + WS_WQ_T), T, 2048, DM, 64, (size_t)T * 128}; pg8::StaticOrder S; S.init(T, 2048, gridDim.x, blockIdx.x); pg8::EpiQM e{(bf16_t*)(ws + WS_Q), 2048};
      pg8::gemm_phase<pg8::EpiQM, pg8::StaticOrder, true, true>(ldsl, g, S, e); }
#endif
    BAR(); STAMP(7);
    { LOADP(p); REP(10) topk_mfma(p, lds); }
    BAR(); STAMP(8);
#define LOAD_SL(p) Sl sl; { const unsigned* ctl = (const unsigned*)(p.ws + WS_CTL); const int myrank = (int)((volatile unsigned*)lds)[36860]; const unsigned xcc = ((volatile unsigned*)lds)[36861]; \
      bool good = (gridDim.x % 8u) == 0u; \
      for (int j = 0; j < 8; ++j) good = good && (__hip_atomic_load(&ctl[64 * j], __ATOMIC_RELAXED, __HIP_MEMORY_SCOPE_AGENT) == gridDim.x / 8u); \
      if (good) { sl.vx = (int)xcc; sl.rank = myrank; sl.nrank = (int)(gridDim.x / 8u); } \
      else { sl.vx = (int)(blockIdx.x & 7u); sl.rank = (int)(blockIdx.x >> 3); sl.nrank = (int)((gridDim.x - (blockIdx.x & 7u) + 7u) / 8u); } }
    { LOADP(p); LOAD_SL(p); REP(11) peer_u_phase(p, sl); }
    BAR(); STAMP(9);
    { LOADP(p); REP(12) peer_w_phase(p); }
    BAR(); STAMP(10);
    if (PROBE_DBL == 100) { for (int i = 0; i < 10; ++i) BAR(); }
    { LOADP(p); LOAD_SL(p); peer_v_phase(p, sl); }
#if PROBE_SPIN >= 0
    __syncthreads(); STAMP(11);
    if (blockIdx.x == 0 && threadIdx.x == 0) {
        volatile LAS unsigned* tsw = (volatile LAS unsigned*)(LAS unsigned char*)lds + 36800;
        const int ia_ = (PROBE_SPIN == 14) ? 13 : PROBE_SPIN, ib_ = (PROBE_SPIN == 13) ? 0 : ((PROBE_SPIN == 14) ? 11 : PROBE_SPIN + 1);
        const unsigned long long t0 = (unsigned long long)tsw[2 * ia_] | ((unsigned long long)tsw[2 * ia_ + 1] << 32);
        const unsigned long long t1 = (unsigned long long)tsw[2 * ib_] | ((unsigned long long)tsw[2 * ib_ + 1] << 32);
        const unsigned long long until = __builtin_amdgcn_s_memrealtime() + (t1 - t0);
        while (__builtin_amdgcn_s_memrealtime() < until) __builtin_amdgcn_s_sleep(8);
    }
#endif
}

extern "C" void kernel_launch(void* const* d_in, const int* in_sizes, int n_in, void* d_out, int out_size, void* d_ws, size_t ws_size, hipStream_t stream) {
    static int grid_blocks = 0;
    if (grid_blocks == 0) {
        if (n_in != 17 || out_size != T * DM || ws_size < WS_END) { fprintf(stderr, "kernel_launch: unexpected shapes n_in %d out %d ws %zu\n", n_in, out_size, ws_size); grid_blocks = -1; return; }
        int dev = 0, cus = 0, per_cu = 0;
        (void)hipGetDevice(&dev);
        (void)hipDeviceGetAttribute(&cus, hipDeviceAttributeMultiprocessorCount, dev);
        (void)hipFuncSetAttribute((const void*)fwd_kernel, hipFuncAttributeMaxDynamicSharedMemorySize, LDS_BYTES);
        (void)hipOccupancyMaxActiveBlocksPerMultiprocessor(&per_cu, (const void*)fwd_kernel, NTHR, LDS_BYTES);
        if (per_cu < 1) { fprintf(stderr, "kernel_launch: occupancy query says %d blocks/CU\n", per_cu); per_cu = 1; }
        grid_blocks = cus * 1;
        (void)hipGetLastError();
    }
    if (grid_blocks < 0) return;
    Params p{};
    p.x = (const float*)d_in[0]; p.mem = (const float*)d_in[1]; p.g_mix = (const float*)d_in[2]; p.w_in = (const float*)d_in[3]; p.gamma_lb = (const float*)d_in[4];
    p.sb_gain = (const float*)d_in[5]; p.hg_gain = (const float*)d_in[6]; p.mem_gain = (const float*)d_in[7]; p.w_mkv = (const float*)d_in[8]; p.mq_gain = (const float*)d_in[9];
    p.mk_gain = (const float*)d_in[10]; p.w_out = (const float*)d_in[11]; p.g_ffn = (const float*)d_in[12]; p.w_q = (const float*)d_in[13]; p.sub_keys = (const float*)d_in[14];
    p.pu = (const float*)d_in[15]; p.pv = (const float*)d_in[16];
    p.out = (float*)d_out; p.ws = (unsigned char*)d_ws;
    void* args[] = {&p};
    hipError_t e = hipLaunchCooperativeKernel((const void*)fwd_kernel, dim3(grid_blocks), dim3(NTHR), args, LDS_BYTES, stream);
    if (e != hipSuccess) fprintf(stderr, "cooperative launch failed: %s (grid %d)\n", hipGetErrorString(e), grid_blocks);
}
```

```cpp
#include <hip/hip_runtime.h>
#include <hip/hip_cooperative_groups.h>
#include <cstdio>
#include <cstdint>
namespace cg = cooperative_groups;

constexpr int NB = 4, SEQ = 8192, DM = 1024, T = NB * SEQ;
constexpr int NMEM = 256, INW = 3328;
constexpr int C_SBQ = 0, C_SBK = 512, C_SBV = 1024, C_HGQ = 1536, C_HGF = 2048, C_HGI = 2560, C_HGG = 2816, C_MQ = 3072;
constexpr int NEXP = 16384, PK = 128;
constexpr float EPS = 1e-6f;
constexpr float LOG2E = 1.4426950408889634f;
constexpr float C2 = 0.125f * LOG2E;

constexpr float PEER_US = 64.f, PEER_VS = 8.f;
constexpr int NTHR = 512;
constexpr int LDS_BYTES = 147456;

constexpr size_t MiB = 1u << 20;
constexpr size_t WS_CTL = 0;
constexpr size_t WS_WIN_T = 1 * MiB;
constexpr size_t WS_WOUT_T = 8 * MiB;
constexpr size_t WS_WQ_T = 10 * MiB;
constexpr size_t WS_WMKV_T = 14 * MiB;
constexpr size_t WS_SKB = 15 * MiB;
constexpr size_t WS_LB = 15 * MiB + 512 * 1024;
constexpr size_t WS_MEMN = 16 * MiB;
constexpr size_t WS_MEMKV = 18 * MiB;
constexpr size_t WS_MEMK = 20 * MiB;
constexpr size_t WS_MEMV = 20 * MiB + 512 * 1024;
constexpr size_t WS_RSTD2 = 21 * MiB;
constexpr size_t WS_PIDX = 24 * MiB;
constexpr size_t WS_PG = 40 * MiB;
constexpr size_t WS_XB = 72 * MiB;
constexpr size_t WS_MIXED = 136 * MiB;
constexpr size_t WS_P = 200 * MiB;
constexpr size_t WS_Q = 136 * MiB;
constexpr size_t WS_X1S = 270 * MiB;
constexpr size_t WS_SSQ = 22 * MiB;
constexpr size_t WS_HGRAW = 408 * MiB;
constexpr size_t WS_PW = 56 * MiB;
constexpr size_t WS_PU = 136 * MiB;
constexpr size_t WS_U16 = 440 * MiB;
constexpr size_t WS_V16 = 472 * MiB;
constexpr size_t WS_END = 512 * MiB;

typedef unsigned short bf16_t;
__device__ __forceinline__ float bf2f(bf16_t v) { return __uint_as_float(((unsigned)v) << 16); }
__device__ __forceinline__ float bflo(unsigned w) { return __uint_as_float(w << 16); }
__device__ __forceinline__ float bfhi(unsigned w) { return __uint_as_float(w & 0xffff0000u); }
__device__ __forceinline__ bf16_t f2bf(float f) { unsigned u = __float_as_uint(f); return (bf16_t)((u + 0x7fffu + ((u >> 16) & 1u)) >> 16); }
__device__ __forceinline__ unsigned pk2(float lo, float hi) { return (unsigned)f2bf(lo) | ((unsigned)f2bf(hi) << 16); }
__device__ __forceinline__ float wave_sum(float v) {
#pragma unroll
    for (int o = 1; o < 64; o <<= 1) v += __shfl_xor(v, o);
    return v;
}
__device__ __forceinline__ float silu(float v) { return v / (1.f + __expf(-v)); }

typedef unsigned u4_t __attribute__((ext_vector_type(4)));
typedef float f32x4_t __attribute__((ext_vector_type(4)));
typedef float float2_t __attribute__((ext_vector_type(2)));
typedef _Float16 h8_t __attribute__((ext_vector_type(8)));
typedef _Float16 h2_t __attribute__((ext_vector_type(2)));
typedef _Float16 h4_t __attribute__((ext_vector_type(4)));
typedef unsigned u2_t __attribute__((ext_vector_type(2)));
typedef __bf16 bf16x2_v __attribute__((ext_vector_type(2)));
__device__ __forceinline__ float dot2bf(unsigned a, unsigned b, float c) { return __builtin_amdgcn_fdot2_f32_bf16(__builtin_bit_cast(bf16x2_v, a), __builtin_bit_cast(bf16x2_v, b), c, false); }

struct Params {
    const float *x, *mem, *g_mix, *w_in, *gamma_lb, *sb_gain, *hg_gain, *mem_gain, *w_mkv, *mq_gain, *mk_gain, *w_out, *g_ffn, *w_q, *sub_keys, *pu, *pv;
    float* out; unsigned char* ws;
};

namespace pg8 {
#define PG8_LAS __attribute__((address_space(3)))
typedef unsigned short bf16_t;
typedef short bf16x8 __attribute__((ext_vector_type(8)));
typedef float f32x4 __attribute__((ext_vector_type(4)));
typedef unsigned u32x4 __attribute__((ext_vector_type(4)));
constexpr int BM = 256, BK = 64, HALF = 128, HTB = HALF * BK * 2  , STAGE_BYTES = 8 * HTB, NXCD = 8, WGM = 8;

__host__ __device__ __forceinline__ int lds_byte(int r, int c) { const int st = (r >> 4) * 2 + (c >> 5), rr = r & 15, cc = c & 31, ob = rr * 64 + cc * 2; return st * 1024 + (ob ^ (((ob >> 9) & 1) << 5)); }
__host__ __device__ __forceinline__ void stage_rc(int b, int& R, int& C) { const int st = b / 1024, sb = b % 1024, swz = sb ^ (((sb >> 9) & 1) << 5); R = (st >> 1) * 16 + swz / 64; C = (st & 1) * 32 + (swz % 64) / 2; }
__host__ __device__ __forceinline__ int perm32(int rho) { const int n = rho >> 4, i = rho & 15; return 8 * (i >> 2) + 4 * n + (i & 3); }

struct Unit { int pm, pn; };
struct Gemm { const bf16_t* A; const bf16_t* Bt; int M, N, K; int lda; size_t kstepA; };

struct StaticOrder {
    int nM, nN, nwg, G, c;
    __host__ __device__ void init(int M, int N, int G_, int c_) { nM = M / BM; nN = N / BM; nwg = nM * nN; G = G_; c = c_; }
    __host__ __device__ bool next(int i, Unit& u) const {
        const long L = (long)i * G + c; if (L >= nwg) return false;
        int wgid = (int)L; { const int q = nwg / NXCD, r = nwg % NXCD, xcd = wgid % NXCD, off = wgid / NXCD; wgid = (xcd < r ? xcd * (q + 1) : r * (q + 1) + (xcd - r) * q) + off; }
        const int nig = WGM * nN, gid = wgid / nig, fm = gid * WGM, gsz = (nM - fm) < WGM ? (nM - fm) : WGM;
        u.pm = fm + ((wgid % nig) % gsz); u.pn = (wgid % nig) / gsz; return true;
    }
    __device__ __forceinline__ void a_ready(const Unit&) const {}
    __device__ __forceinline__ void done(const Unit&) const {}
};

typedef float cvf2_t __attribute__((ext_vector_type(2)));
typedef __bf16 cvb2_t __attribute__((ext_vector_type(2)));
__device__ __forceinline__ unsigned cvt_pk_bf16(float lo, float hi) { const cvf2_t v = {lo, hi}; const cvb2_t b = __builtin_convertvector(v, cvb2_t); return __builtin_bit_cast(unsigned, b); }
typedef float f32x2 __attribute__((ext_vector_type(2)));
template <class Epi, class Sched, bool ALIGN_EPI = false, bool SP2 = false>
__device__ __forceinline__ void gemm_phase(PG8_LAS unsigned char* lds, const Gemm g, const Sched& S, const Epi& E) {
    int tid_ = threadIdx.x; asm volatile("" : "+v"(tid_));
    const int tid = tid_, wid = __builtin_amdgcn_readfirstlane(tid >> 6), lane = tid & 63, wr = wid >> 2, wc = wid & 3, fr = lane & 15, fq = lane >> 4;
    const int K = g.K, nt = K / BK;
    unsigned voffA[2], voffB[2];
#pragma unroll
    for (int i = 0; i < 2; ++i) { int R, C; stage_rc(tid * 16 + i * 8192, R, C); const int Rb = Epi::PERM ? ((R & ~31) + perm32(R & 31)) : R;
        voffA[i] = (unsigned)(R * g.lda + C) * 2u; voffB[i] = (unsigned)(Rb * K + C) * 2u; }
    const size_t kstep = (size_t)(BK * 2);
    const size_t hstep = (size_t)HALF * K * 2;
    const size_t tstep = 2 * hstep;
    const size_t kstepA = g.kstepA, hstepA = (size_t)HALF * g.lda * 2, tstepA = 2 * hstepA;
    const unsigned ldsw = (unsigned)wid * 1024u;
    const int aoff = lds_byte(wr * 64 + fr, fq * 8), boff = lds_byte(wc * 32 + fr, fq * 8);
#define PG8_SA(b, h) (((b) * 2 + (h)) * HTB)
#define PG8_SB(b, h) ((4 + (b) * 2 + (h)) * HTB)
#define PG8_STAGE(bufoff, gbase, voff) do { _Pragma("unroll") for (int _i = 0; _i < 2; ++_i) \
        __builtin_amdgcn_global_load_lds((const unsigned*)((const char*)(gbase) + (voff)[_i]), (PG8_LAS unsigned*)(lds + (bufoff) + ldsw + _i * 8192), 16, 0, 0); } while (0)
#define PG8_LDA(dst, b, h) do { _Pragma("unroll") for (int m = 0; m < 4; ++m) _Pragma("unroll") for (int k = 0; k < 2; ++k) dst[m][k] = *(const PG8_LAS bf16x8*)(lds + PG8_SA(b, h) + aoff + m * 2048 + k * 1024); } while (0)
#define PG8_LDB(dst, b, h) do { _Pragma("unroll") for (int n = 0; n < 2; ++n) _Pragma("unroll") for (int k = 0; k < 2; ++k) dst[n][k] = *(const PG8_LAS bf16x8*)(lds + PG8_SB(b, h) + boff + n * 2048 + k * 1024); } while (0)
#define PG8_MMA(ai, bj, At, Bt) do { __builtin_amdgcn_s_setprio(1); _Pragma("unroll") for (int m = 0; m < 4; ++m) _Pragma("unroll") for (int n = 0; n < 2; ++n) _Pragma("unroll") for (int k = 0; k < 2; ++k) \
        acc[ai][bj][m][n] = __builtin_amdgcn_mfma_f32_16x16x32_bf16(Bt[n][k], At[m][k], acc[ai][bj][m][n], 0, 0, 0); __builtin_amdgcn_s_setprio(0); } while (0)
#define PG8_WAIT_V(n) asm volatile("s_waitcnt vmcnt(" #n ")" ::: "memory")
#define PG8_WAIT_L(n) asm volatile("s_waitcnt lgkmcnt(" #n ")" ::: "memory")
#define PG8_BAR __builtin_amdgcn_s_barrier()
#define PG8_SCHED __builtin_amdgcn_sched_barrier(0)
    Unit cur, nxt; int ui = 0;
    if (!S.next(0, cur)) return;
    f32x4 acc[2][2][4][2];
#pragma unroll
    for (int a = 0; a < 2; ++a)
#pragma unroll
        for (int b = 0; b < 2; ++b)
#pragma unroll
            for (int m = 0; m < 4; ++m)
#pragma unroll
                for (int n = 0; n < 2; ++n) acc[a][b][m][n] = (f32x4){0.f, 0.f, 0.f, 0.f};
    bf16x8 At[4][2], B0[2][2], B1[2][2];
    const char* cA = (const char*)g.A + (size_t)cur.pm * tstepA; const char* cB = (const char*)g.Bt + (size_t)cur.pn * tstep;
    S.a_ready(cur);
    if constexpr (SP2) {
        PG8_STAGE(PG8_SB(0, 0), cB, voffB); PG8_STAGE(PG8_SB(0, 1), cB + hstep, voffB); PG8_STAGE(PG8_SA(0, 0), cA, voffA); PG8_STAGE(PG8_SA(0, 1), cA + hstepA, voffA);
        if (wr == 1) PG8_BAR;
        PG8_WAIT_V(2); PG8_BAR;
        PG8_STAGE(PG8_SB(1, 0), cB + kstep, voffB); PG8_STAGE(PG8_SA(1, 0), cA + kstepA, voffA); PG8_STAGE(PG8_SB(1, 1), cB + hstep + kstep, voffB);
        PG8_WAIT_V(6); PG8_BAR;
    } else {
        PG8_STAGE(PG8_SB(0, 0), cB, voffB); PG8_STAGE(PG8_SA(0, 0), cA, voffA); PG8_STAGE(PG8_SB(0, 1), cB + hstep, voffB); PG8_STAGE(PG8_SA(0, 1), cA + hstepA, voffA);
        if (wr == 1) PG8_BAR;
        PG8_WAIT_V(4); PG8_BAR;
        PG8_STAGE(PG8_SB(1, 0), cB + kstep, voffB); PG8_STAGE(PG8_SA(1, 0), cA + kstepA, voffA); PG8_STAGE(PG8_SB(1, 1), cB + hstep + kstep, voffB);
        PG8_WAIT_V(6); PG8_BAR;
    }
    for (;;) {
        const bool has_next = S.next(ui + 1, nxt);
        const char* nA = has_next ? (const char*)g.A + (size_t)nxt.pm * tstepA : cA; const char* nB = has_next ? (const char*)g.Bt + (size_t)nxt.pn * tstep : cB;
        for (int t = 0; t < nt; t += 2) {
            const bool last = (t == nt - 2);
            const char* a1 = cA + (size_t)(t + 1) * kstepA;
            const char* a2 = last ? nA : cA + (size_t)(t + 2) * kstepA; const char* b2 = last ? nB : cB + (size_t)(t + 2) * kstep;
            const char* a3 = a2 + kstepA; const char* b3 = b2 + kstep;
            if (last && has_next) S.a_ready(nxt);
            if constexpr (SP2) {
            PG8_LDB(B0, 0, 0); PG8_LDB(B1, 0, 1); PG8_SCHED; PG8_LDA(At, 0, 0); PG8_STAGE(PG8_SA(1, 1), a1 + hstepA, voffA);
            PG8_WAIT_V(8); PG8_WAIT_L(0); PG8_BAR; PG8_MMA(0, 0, At, B0); PG8_MMA(0, 1, At, B1); PG8_BAR; PG8_SCHED;
            PG8_LDA(At, 0, 1); PG8_STAGE(PG8_SB(0, 0), b2, voffB); PG8_STAGE(PG8_SB(0, 1), b2 + hstep, voffB); PG8_STAGE(PG8_SA(0, 0), a2, voffA);
            PG8_WAIT_V(8); PG8_WAIT_L(0); PG8_BAR; PG8_MMA(1, 0, At, B0); PG8_MMA(1, 1, At, B1); PG8_BAR; PG8_SCHED;
            PG8_LDB(B0, 1, 0); PG8_LDB(B1, 1, 1); PG8_SCHED; PG8_LDA(At, 1, 0); PG8_STAGE(PG8_SA(0, 1), a2 + hstepA, voffA);
            PG8_WAIT_V(8); PG8_WAIT_L(0); PG8_BAR; PG8_MMA(0, 0, At, B0); PG8_MMA(0, 1, At, B1); PG8_BAR; PG8_SCHED;
            PG8_LDA(At, 1, 1); PG8_STAGE(PG8_SB(1, 0), b3, voffB); PG8_STAGE(PG8_SB(1, 1), b3 + hstep, voffB); PG8_STAGE(PG8_SA(1, 0), a3, voffA);
            PG8_WAIT_V(8); PG8_WAIT_L(0); PG8_BAR; PG8_MMA(1, 0, At, B0); PG8_MMA(1, 1, At, B1); PG8_BAR; PG8_SCHED;
            } else {
            PG8_LDB(B0, 0, 0); PG8_SCHED; PG8_LDA(At, 0, 0); PG8_STAGE(PG8_SA(1, 1), a1 + hstepA, voffA);
            PG8_WAIT_L(8); PG8_BAR; PG8_WAIT_L(0); PG8_MMA(0, 0, At, B0); PG8_BAR; PG8_SCHED;
            PG8_LDB(B1, 0, 1); PG8_STAGE(PG8_SB(0, 0), b2, voffB);
            PG8_BAR; PG8_WAIT_L(0); PG8_MMA(0, 1, At, B1); PG8_BAR;
            PG8_LDA(At, 0, 1); PG8_STAGE(PG8_SA(0, 0), a2, voffA);
            PG8_BAR; PG8_WAIT_L(0); PG8_MMA(1, 0, At, B0); PG8_BAR; PG8_SCHED;
            PG8_STAGE(PG8_SB(0, 1), b2 + hstep, voffB);
            PG8_WAIT_V(6); PG8_BAR; PG8_MMA(1, 1, At, B1); PG8_BAR;
            PG8_LDB(B0, 1, 0); PG8_SCHED; PG8_LDA(At, 1, 0); PG8_STAGE(PG8_SA(0, 1), a2 + hstepA, voffA);
            PG8_WAIT_L(8); PG8_BAR; PG8_WAIT_L(0); PG8_MMA(0, 0, At, B0); PG8_BAR; PG8_SCHED;
            PG8_LDB(B1, 1, 1); PG8_STAGE(PG8_SB(1, 0), b3, voffB);
            PG8_BAR; PG8_WAIT_L(0); PG8_MMA(0, 1, At, B1); PG8_BAR;
            PG8_LDA(At, 1, 1); PG8_STAGE(PG8_SA(1, 0), a3, voffA);
            PG8_BAR; PG8_WAIT_L(0); PG8_MMA(1, 0, At, B0); PG8_BAR; PG8_SCHED;
            PG8_STAGE(PG8_SB(1, 1), b3 + hstep, voffB);
            PG8_WAIT_V(6); PG8_BAR; PG8_MMA(1, 1, At, B1); PG8_BAR;
            }
        }
        if constexpr (ALIGN_EPI) { if (wr == 0) PG8_BAR; }
        if constexpr (!Epi::AFTER_DRAIN) { E(acc, cur, wr, wc, fr, fq); S.done(cur); }
        if (!has_next) break;
#pragma unroll
        for (int a = 0; a < 2; ++a)
#pragma unroll
            for (int b = 0; b < 2; ++b)
#pragma unroll
                for (int m = 0; m < 4; ++m)
#pragma unroll
                    for (int n = 0; n < 2; ++n) acc[a][b][m][n] = (f32x4){0.f, 0.f, 0.f, 0.f};
        cur = nxt; cA = nA; cB = nB; ++ui;
        if constexpr (ALIGN_EPI) { if (wr == 1) PG8_BAR; }
    }
    PG8_WAIT_V(0);
    if constexpr (!ALIGN_EPI) { if (wr == 0) PG8_BAR; }
    PG8_BAR;
    if constexpr (Epi::AFTER_DRAIN) { E.fused(acc, cur, wr, wc, fr, fq, lds, wid, lane); S.done(cur); }
#undef PG8_SA
#undef PG8_SB
#undef PG8_STAGE
#undef PG8_LDA
#undef PG8_LDB
#undef PG8_MMA
#undef PG8_WAIT_V
#undef PG8_WAIT_L
#undef PG8_BAR
#undef PG8_SCHED
}
}


namespace pg8 {
typedef unsigned u32x4 __attribute__((ext_vector_type(4)));
__device__ __forceinline__ float permf(float v, int addr) { return __int_as_float(__builtin_amdgcn_ds_bpermute(addr, __float_as_int(v))); }
__device__ __forceinline__ unsigned permu(unsigned v, int addr) { return (unsigned)__builtin_amdgcn_ds_bpermute(addr, (int)v); }
struct EpiProjM {
    static constexpr bool PERM = true, AFTER_DRAIN = false;
    bf16_t* P;
    __device__ __forceinline__ void operator()(const f32x4 (&acc)[2][2][4][2], const Unit& u, int wr, int wc, int fr, int fq) const {
        const int L = fr + 16 * fq, frp = L >> 2, fqp = L & 3, pa = 4 * (frp + 16 * fqp);
        const int row0 = u.pm * BM + wr * 64 + frp, col0 = u.pn * BM + wc * 32 + 8 * fqp;
        const int pn = u.pn; const int mode = (pn < 2) ? 1 : ((pn == 6 || pn == 7 || pn == 11) ? 2 : 0);
#pragma unroll
        for (int ai = 0; ai < 2; ++ai)
#pragma unroll
            for (int m = 0; m < 4; ++m) { bf16_t* rowp = P + (size_t)(row0 + ai * HALF + m * 16) * INW + col0;
#pragma unroll
                for (int bj = 0; bj < 2; ++bj) { f32x4 v0 = acc[ai][bj][m][0], v1 = acc[ai][bj][m][1];
                    if (mode == 1) { v0 = v0 * C2; v1 = v1 * C2; }
                    else if (mode == 2) {
#pragma unroll
                        for (int e = 0; e < 4; ++e) { v0[e] = silu(v0[e]); v1[e] = silu(v1[e]); } }
                    u32x4 w; w.x = permu(cvt_pk_bf16(v0[0], v0[1]), pa); w.y = permu(cvt_pk_bf16(v0[2], v0[3]), pa); w.z = permu(cvt_pk_bf16(v1[0], v1[1]), pa); w.w = permu(cvt_pk_bf16(v1[2], v1[3]), pa);
                    *(u32x4*)(rowp + bj * HALF) = w; } }
    }
};
struct EpiWoutM {
    static constexpr bool PERM = true, AFTER_DRAIN = false;
    const float* x; bf16_t* x1bs; float* ssq;
    __device__ __forceinline__ void operator()(const f32x4 (&acc)[2][2][4][2], const Unit& u, int wr, int wc, int fr, int fq) const {
        const int L = fr + 16 * fq, frp = L >> 2, fqp = L & 3, pa = 4 * (frp + 16 * fqp);
        const int row0 = u.pm * BM + wr * 64 + frp, col0 = u.pn * BM + wc * 32 + 8 * fqp;
#pragma unroll
        for (int ai = 0; ai < 2; ++ai)
#pragma unroll
            for (int m = 0; m < 4; ++m) { const int row = row0 + ai * HALF + m * 16; const size_t rb = (size_t)row * DM + col0; float sq = 0.f;
#pragma unroll
                for (int bj = 0; bj < 2; ++bj) { const size_t i = rb + bj * HALF;
                    const f32x4 x0 = *(const f32x4*)(x + i), x1 = *(const f32x4*)(x + i + 4);
                    f32x4 v0, v1;
#pragma unroll
                    for (int e = 0; e < 4; ++e) { v0[e] = permf(acc[ai][bj][m][0][e], pa) + x0[e]; v1[e] = permf(acc[ai][bj][m][1][e], pa) + x1[e]; }
                    sq += (v0[0] * v0[0] + v0[1] * v0[1]) + (v0[2] * v0[2] + v0[3] * v0[3]) + (v1[0] * v1[0] + v1[1] * v1[1]) + (v1[2] * v1[2] + v1[3] * v1[3]);
                    const int col = col0 + bj * HALF, s = (col >> 5) & 15, j = ((col >> 9) << 5) | (col & 31);
                    const size_t o = ((size_t)s * T + row) * 64 + j;
                    u32x4 w; w.x = cvt_pk_bf16(v0[0], v0[1]); w.y = cvt_pk_bf16(v0[2], v0[3]); w.z = cvt_pk_bf16(v1[0], v1[1]); w.w = cvt_pk_bf16(v1[2], v1[3]);
                    *(u32x4*)(x1bs + o) = w; }
                sq += __shfl_xor(sq, 1); sq += __shfl_xor(sq, 2);
                if (fqp == 0) ssq[(size_t)row * 16 + u.pn * 4 + wc] = sq; }
    }
};
struct EpiQM {
    static constexpr bool PERM = true, AFTER_DRAIN = false;
    bf16_t* Q; int ld;
    __device__ __forceinline__ void operator()(const f32x4 (&acc)[2][2][4][2], const Unit& u, int wr, int wc, int fr, int fq) const {
        const int L = fr + 16 * fq, frp = L >> 2, fqp = L & 3, pa = 4 * (frp + 16 * fqp);
        const int row0 = u.pm * BM + wr * 64 + frp, col0 = u.pn * BM + wc * 32 + 8 * fqp;
#pragma unroll
        for (int ai = 0; ai < 2; ++ai)
#pragma unroll
            for (int m = 0; m < 4; ++m) { const int row = row0 + ai * HALF + m * 16; bf16_t* rowp = Q + (size_t)row * ld + col0;
#pragma unroll
                for (int bj = 0; bj < 2; ++bj) { const f32x4 v0 = acc[ai][bj][m][0], v1 = acc[ai][bj][m][1];
                    u32x4 w; w.x = permu(cvt_pk_bf16(v0[0], v0[1]), pa); w.y = permu(cvt_pk_bf16(v0[2], v0[3]), pa); w.z = permu(cvt_pk_bf16(v1[0], v1[1]), pa); w.w = permu(cvt_pk_bf16(v1[2], v1[3]), pa);
                    *(u32x4*)(rowp + bj * HALF) = w; } }
    }
};
}

#define LAS __attribute__((address_space(3)))
#define XB_TMO      128
#define XB_XCNT(j)  (256  + 64 * (j))
#define XB_XSUB(j)  (1280 + 64 * (j))
#define XB_XGEN(j)  (2304 + 64 * (j))
#define XB_TOP      3328
#define XB_TOPGEN   3392
#define XCD_BAR_WORDS 3456
#define XB_SPIN_CAP (1u << 18)

__device__ __forceinline__ unsigned xb_ld(unsigned* p)              { return __hip_atomic_load(p, __ATOMIC_RELAXED, __HIP_MEMORY_SCOPE_AGENT); }
__device__ __forceinline__ unsigned xb_add(unsigned* p, unsigned v) { return __hip_atomic_fetch_add(p, v, __ATOMIC_RELAXED, __HIP_MEMORY_SCOPE_AGENT); }
__device__ __forceinline__ unsigned xb_xcc_id() { return (unsigned)__builtin_amdgcn_s_getreg((3 << 11) | 20) & 0xFu; }
#define XB_SPIN(cond, bar) do { unsigned _sp = 0; while (cond) { __builtin_amdgcn_s_sleep(1); \
    if ((++_sp & 255u) == 0u) { if (xb_ld(&(bar)[XB_TMO])) break; if (_sp > XB_SPIN_CAP) { atomicAdd(&(bar)[XB_TMO], 1u); break; } } } } while (0)

struct XcdBarrier {
    unsigned* bar; unsigned x;
    volatile LAS unsigned* st;
};

__device__ __forceinline__ XcdBarrier xcd_barrier_post(unsigned* bar, volatile LAS unsigned* st) {
    XcdBarrier b; b.bar = bar; b.x = xb_xcc_id(); b.st = st;
    if (threadIdx.x == 0) (void)xb_add(&bar[XB_XCNT(b.x)], 1u);
    return b;
}
__device__ __forceinline__ void xcd_barrier_complete(unsigned* bar, unsigned x, unsigned& nloc, unsigned& nx) {
    const unsigned G = gridDim.x * gridDim.y * gridDim.z;
    unsigned sum, cnt, mine, sp = 0u;
    for (;;) {
        sum = 0u; cnt = 0u; mine = 0u;
#pragma unroll
        for (unsigned j = 0; j < 16; ++j) { const unsigned c = xb_ld(&bar[XB_XCNT(j)]); sum += c; cnt += (c > 0u) ? 1u : 0u; mine = (j == x) ? c : mine; }
        if (sum == G) break;
        __builtin_amdgcn_s_sleep(1);
        if ((++sp & 255u) == 0u) { if (xb_ld(&bar[XB_TMO])) break; if (sp > XB_SPIN_CAP) { atomicAdd(&bar[XB_TMO], 1u); break; } }
    }
    nloc = mine > 0u ? mine : 1u; nx = cnt > 0u ? cnt : 1u;
}

__device__ __forceinline__ void xcd_barrier(const XcdBarrier& b) {
    asm volatile("s_waitcnt vmcnt(0)" ::: "memory");
    __syncthreads();
    if (threadIdx.x == 0) {
        unsigned* bar = b.bar;
        __builtin_amdgcn_s_waitcnt(0);
        unsigned nloc = b.st[0], nx = b.st[1];
        if (nloc == 0u) { xcd_barrier_complete(bar, b.x, nloc, nx); b.st[0] = nloc; b.st[1] = nx; }
        const unsigned old = xb_add(&bar[XB_XSUB(b.x)], 1u);
        const unsigned gen = old / nloc;
        if (old + 1u == (gen + 1u) * nloc) {
            __builtin_amdgcn_fence(__ATOMIC_RELEASE, "agent");
            asm volatile("s_waitcnt vmcnt(0)" ::: "memory");
            const unsigned og = xb_add(&bar[XB_TOP], 1u);
            const unsigned tg = og / nx;
            if (og + 1u == (tg + 1u) * nx) xb_add(&bar[XB_TOPGEN], 1u);
            else XB_SPIN(xb_ld(&bar[XB_TOPGEN]) == tg, bar);
            __builtin_amdgcn_fence(__ATOMIC_ACQUIRE, "agent");
            xb_add(&bar[XB_XGEN(b.x)], 1u);
            asm volatile("s_waitcnt vmcnt(0)" ::: "memory");
        } else {
            XB_SPIN(xb_ld(&bar[XB_XGEN(b.x)]) == gen, bar);
            __builtin_amdgcn_fence(__ATOMIC_ACQUIRE, "agent");
            asm volatile("s_waitcnt vmcnt(0)" ::: "memory");
        }
    }
    __syncthreads();
}

template <bool SLICEK = false> __device__ __forceinline__ void transpose_item(const float* W, const float* gain, int K, int N, bf16_t* WT, float* scr, int item, int lane) {
    const int nblk = N / 32, kb = item / nblk, nb = item % nblk, k0 = 64 * kb, n0 = 32 * nb;
#pragma unroll 16
    for (int i = 0; i < 32; ++i) { const int kk = 2 * i + (lane >> 5); const int ks = SLICEK ? ((kk >> 5) * 512 + 32 * kb + (kk & 31)) : (k0 + kk); float g = gain ? gain[ks] : 1.f; scr[kk * 33 + (lane & 31)] = W[(size_t)ks * N + n0 + (lane & 31)] * g; }
    __builtin_amdgcn_s_waitcnt(0); __builtin_amdgcn_wave_barrier();
    const int c = lane & 7;
#pragma unroll
    for (int j = 0; j < 4; ++j) { const int n = (lane >> 3) + 8 * j; const float* s = scr + (8 * c) * 33 + n;
        uint4 o; o.x = pk2(s[0 * 33], s[1 * 33]); o.y = pk2(s[2 * 33], s[3 * 33]); o.z = pk2(s[4 * 33], s[5 * 33]); o.w = pk2(s[6 * 33], s[7 * 33]);
        *(uint4*)(WT + (size_t)(n0 + n) * K + k0 + 8 * c) = o; }
    __builtin_amdgcn_s_waitcnt(0); __builtin_amdgcn_wave_barrier();
}
__device__ __forceinline__ void norm_row_to_bf16(const float* xrow, bf16_t* orow, int lane) {
    const float4* xr = (const float4*)xrow + lane;
    float4 v[4]; float s = 0.f;
#pragma unroll
    for (int j = 0; j < 4; ++j) { v[j] = xr[64 * j]; s += (v[j].x * v[j].x + v[j].y * v[j].y) + (v[j].z * v[j].z + v[j].w * v[j].w); }
    const float rstd = rsqrtf(wave_sum(s) * (1.f / DM) + EPS);
    unsigned long long* o8 = (unsigned long long*)orow + lane;
#pragma unroll
    for (int j = 0; j < 4; ++j) o8[64 * j] = (unsigned long long)pk2(v[j].x * rstd, v[j].y * rstd) | ((unsigned long long)pk2(v[j].z * rstd, v[j].w * rstd) << 32);
}
__device__ __forceinline__ void phase_prep(const Params& p, unsigned char* lds) {
    const int tid = threadIdx.x, lane = tid & 63, wave = tid >> 6;
    const int gw = blockIdx.x * 8 + wave, NGW = gridDim.x * 8;
    const int gt = blockIdx.x * NTHR + tid, NGT = gridDim.x * NTHR;
    unsigned char* ws = p.ws;
    float* scr = (float*)lds + wave * (64 * 33);
    constexpr int I_IN = (DM / 64) * (INW / 32), I_OUT = (DM / 64) * (DM / 32), I_Q = (DM / 64) * (2048 / 32), I_MKV = (DM / 64) * (512 / 32);
    for (int it = gw; it < I_IN + I_OUT + I_Q + I_MKV; it += NGW) {
        int r = it;
        if (r < I_IN) { transpose_item(p.w_in, p.g_mix, DM, INW, (bf16_t*)(ws + WS_WIN_T), scr, r, lane); continue; } r -= I_IN;
        if (r < I_OUT) { transpose_item(p.w_out, nullptr, DM, DM, (bf16_t*)(ws + WS_WOUT_T), scr, r, lane); continue; } r -= I_OUT;
        if (r < I_Q) { transpose_item<true>(p.w_q, p.g_ffn, DM, 2048, (bf16_t*)(ws + WS_WQ_T), scr, r, lane); continue; } r -= I_Q;
        transpose_item(p.w_mkv, p.mem_gain, DM, 512, (bf16_t*)(ws + WS_WMKV_T), scr, r, lane);
    }
    for (int m0 = gw * 4; m0 < T; m0 += NGW * 4) {
        f32x4_t v[4][4]; float s[4];
#pragma unroll
        for (int q = 0; q < 4; ++q) { const f32x4_t* xr = (const f32x4_t*)(p.x + (size_t)(m0 + q) * DM) + lane;
#pragma unroll
            for (int j = 0; j < 4; ++j) v[q][j] = __builtin_nontemporal_load(xr + 64 * j); }
#pragma unroll
        for (int q = 0; q < 4; ++q) { float a = 0.f;
#pragma unroll
            for (int j = 0; j < 4; ++j) a += (v[q][j][0] * v[q][j][0] + v[q][j][1] * v[q][j][1]) + (v[q][j][2] * v[q][j][2] + v[q][j][3] * v[q][j][3]);
            s[q] = a; }
#pragma unroll
        for (int o = 1; o < 64; o <<= 1) {
#pragma unroll
            for (int q = 0; q < 4; ++q) s[q] += __shfl_xor(s[q], o); }
#pragma unroll
        for (int q = 0; q < 4; ++q) { const float rstd = rsqrtf(s[q] * (1.f / DM) + EPS);
            unsigned long long* o8 = (unsigned long long*)((bf16_t*)(ws + WS_XB) + (size_t)(m0 + q) * DM) + lane;
#pragma unroll
            for (int j = 0; j < 4; ++j) o8[64 * j] = (unsigned long long)pk2(v[q][j][0] * rstd, v[q][j][1] * rstd) | ((unsigned long long)pk2(v[q][j][2] * rstd, v[q][j][3] * rstd) << 32); }
    }
    for (int m = gw; m < NB * NMEM; m += NGW) norm_row_to_bf16(p.mem + (size_t)m * DM, (bf16_t*)(ws + WS_MEMN) + (size_t)m * DM, lane);
    for (int i = gt; i < 8 * 2 * 128 * 128; i += NGT) ((bf16_t*)(ws + WS_SKB))[i] = f2bf(p.sub_keys[i]);
#pragma unroll 2
    for (int i = gt; i < NEXP * 8 * 8; i += NGT) {
        const int c = i & 7, S = (i >> 3) & 7, e = i >> 6;
        const int s16 = 2 * S + (c >> 2), j0 = (c & 3) * 16, d0 = (j0 >> 5) * 512 + 32 * s16 + (j0 & 31);
        const f32x4_t* up = (const f32x4_t*)(p.pu + (size_t)e * DM + d0); const f32x4_t* vp = (const f32x4_t*)(p.pv + (size_t)e * DM + d0); const f32x4_t* gp = (const f32x4_t*)(p.g_ffn + d0);
        u4_t uo, vo;
#pragma unroll
        for (int q = 0; q < 4; ++q) { const f32x4_t a = __builtin_nontemporal_load(up + q), g = gp[q], b = __builtin_nontemporal_load(vp + q);
            int w = 0; w = __builtin_amdgcn_cvt_pk_fp8_f32(a.x * g.x * PEER_US, a.y * g.y * PEER_US, w, false); w = __builtin_amdgcn_cvt_pk_fp8_f32(a.z * g.z * PEER_US, a.w * g.w * PEER_US, w, true); uo[q] = (unsigned)w;
            int z = 0; z = __builtin_amdgcn_cvt_pk_fp8_f32(b.x * PEER_VS, b.y * PEER_VS, z, false); z = __builtin_amdgcn_cvt_pk_fp8_f32(b.z * PEER_VS, b.w * PEER_VS, z, true); vo[q] = (unsigned)z; }
        *(u4_t*)(ws + WS_U16 + ((size_t)S * NEXP + e) * 128 + 16 * c) = uo;
        *(u4_t*)(ws + WS_V16 + ((size_t)S * NEXP + e) * 128 + 16 * c) = vo;
    }
    for (int i = gt; i < 512; i += NGT) ((float*)(ws + WS_LB))[i] = 1.f / (1.f + expf(p.gamma_lb[512 + i] - p.gamma_lb[i]));
}

typedef float f32x16 __attribute__((ext_vector_type(16)));
typedef short sh8_t __attribute__((ext_vector_type(8)));
typedef float cvt_f32x2_t __attribute__((ext_vector_type(2)));
typedef __bf16 cvt_bf16x2_t __attribute__((ext_vector_type(2)));
__device__ __forceinline__ unsigned cvtpk(float lo, float hi) { const cvt_f32x2_t v = {lo, hi}; const cvt_bf16x2_t b = __builtin_convertvector(v, cvt_bf16x2_t); return __builtin_bit_cast(unsigned, b); }
__device__ __forceinline__ bf16_t cvt1(float x) { return (bf16_t)(cvtpk(x, x) & 0xffffu); }
__device__ __forceinline__ void mma32(f32x16& acc, const LAS bf16_t* A, int lda, const LAS bf16_t* Bt, int ldb, int K, int lane) {
    const int r = lane & 31, h = lane >> 5;
    const LAS bf16_t* ap = A + r * lda + 8 * h; const LAS bf16_t* bp = Bt + r * ldb + 8 * h;
    for (int k0 = 0; k0 < K; k0 += 16) {
        const sh8_t a = *(const LAS sh8_t*)(ap + k0), b = *(const LAS sh8_t*)(bp + k0);
        acc = __builtin_amdgcn_mfma_f32_32x32x16_bf16(a, b, acc, 0, 0, 0);
    }
}
__device__ __forceinline__ int crow(int r, int hh) { return (r & 3) + 8 * (r >> 2) + 4 * hh; }
constexpr size_t HG_LT = WS_XB;
constexpr size_t HG_SB = 408 * MiB;
constexpr size_t HG_DD = 456 * MiB;
__device__ __forceinline__ void hg_load_col(const bf16_t* P, int col0, int unit, int tid, bf16_t (&raw)[16]) {
    const int bh = unit >> 7, c = unit & 127, b_ = bh >> 2, h = bh & 3, rg = tid >> 7, k = tid & 127;
    const bf16_t* pr = P + ((size_t)b_ * SEQ + c * 64 + rg * 16) * INW + col0 + h * 128 + k;
#pragma unroll
    for (int i = 0; i < 16; ++i) raw[i] = pr[(size_t)i * INW];
}
__device__ __forceinline__ u4_t hg_load_v(const bf16_t* P, int unit, int tid) {
    const int bh = unit >> 7, c = unit & 127, b_ = bh >> 2, h = bh & 3;
    return *(const u4_t*)(P + ((size_t)b_ * SEQ + c * 64 + (tid >> 3)) * INW + C_HGI + h * 64 + (tid & 7) * 8);
}
__device__ __forceinline__ void hg_cols(const bf16_t (&fl)[16], float lb, LAS float* gs, int tid, float (&kk)[16], float (&bc)[16], float& bmid, float& blast) {
    const int rg = tid >> 7, k = tid & 127;
    float run = 0.f;
#pragma unroll
    for (int i = 0; i < 16; ++i) { const float kv = (1.f - lb) / (1.f + __expf(bf2f(fl[i]))); kk[i] = kv; run += __logf(1.f - kv); bc[i] = run; }
    gs[rg * 128 + k] = run;
    __syncthreads();
    const float g0 = gs[k], g1 = gs[128 + k], g2 = gs[256 + k], g3 = gs[384 + k];
    const float off = (rg > 0 ? g0 : 0.f) + (rg > 1 ? g1 : 0.f) + (rg > 2 ? g2 : 0.f);
#pragma unroll
    for (int i = 0; i < 16; ++i) bc[i] += off;
    bmid = g0 + g1; blast = (g0 + g1) + (g2 + g3);
}
__device__ __forceinline__ void hg_store_vt(LAS bf16_t* VT, int tid, const u4_t v) {
    const int s = tid >> 3, jq = tid & 7;
    LAS bf16_t* d = VT + (jq * 8) * 72 + s;
    d[0 * 72] = (bf16_t)(v.x & 0xffff); d[1 * 72] = (bf16_t)(v.x >> 16); d[2 * 72] = (bf16_t)(v.y & 0xffff); d[3 * 72] = (bf16_t)(v.y >> 16);
    d[4 * 72] = (bf16_t)(v.z & 0xffff); d[5 * 72] = (bf16_t)(v.z >> 16); d[6 * 72] = (bf16_t)(v.w & 0xffff); d[7 * 72] = (bf16_t)(v.w >> 16);
}
__device__ __forceinline__ void hg_local(const Params& p, unsigned char* ldsb) {
    const bf16_t* P = (const bf16_t*)(p.ws + WS_P); const float* lbp = (const float*)(p.ws + WS_LB);
    bf16_t* LT = (bf16_t*)((unsigned char*)p.ws + HG_LT); float* DD = (float*)((unsigned char*)p.ws + HG_DD);
    LAS unsigned char* l = (LAS unsigned char*)ldsb;
    LAS float* gs = (LAS float*)l; LAS bf16_t* KST = (LAS bf16_t*)(l + 2048); LAS bf16_t* VT = (LAS bf16_t*)(l + 20480);
    const int tid = threadIdx.x, lane = tid & 63, wave = tid >> 6, rg = tid >> 7, k = tid & 127;
    bf16_t flr[16]; u4_t vr;
    if ((int)blockIdx.x < 2048) { hg_load_col(P, C_HGF, blockIdx.x, tid, flr); vr = hg_load_v(P, blockIdx.x, tid); }
    for (int unit = blockIdx.x; unit < 2048; unit += gridDim.x) {
        const int bh = unit >> 7, h = bh & 3;
        float kk[16], bc[16], bmid, blast;
        hg_cols(flr, lbp[h * 128 + k], gs, tid, kk, bc, bmid, blast);
        const u4_t vcur = vr;
        { const int nu = unit + gridDim.x; if (nu < 2048) { hg_load_col(P, C_HGF, nu, tid, flr); vr = hg_load_v(P, nu, tid); } }
        { unsigned w[8];
#pragma unroll
          for (int i = 0; i < 8; ++i) w[i] = cvtpk(kk[2 * i] * __expf(blast - bc[2 * i]), kk[2 * i + 1] * __expf(blast - bc[2 * i + 1]));
          LAS u4_t* d = (LAS u4_t*)(KST + k * 72 + rg * 16);
          d[0] = (u4_t){w[0], w[1], w[2], w[3]}; d[1] = (u4_t){w[4], w[5], w[6], w[7]}; }
        hg_store_vt(VT, tid, vcur);
        if (tid < 128) DD[(size_t)unit * 128 + tid] = __expf(blast);
        __syncthreads();
        { const int ji = wave >> 2, ki = wave & 3;
          f32x16 acc;
#pragma unroll
          for (int r = 0; r < 16; ++r) acc[r] = 0.f;
          mma32(acc, VT + 32 * ji * 72, 72, KST + 32 * ki * 72, 72, 64, lane);
          bf16_t* o = LT + (size_t)unit * 8192 + 32 * ki + (lane & 31);
#pragma unroll
          for (int r = 0; r < 16; ++r) o[(size_t)(32 * ji + crow(r, lane >> 5)) * 128] = cvt1(acc[r]); }
        __syncthreads();
    }
}
__device__ __forceinline__ void hg_scan(const Params& p) {
    const bf16_t* LT = (const bf16_t*)((unsigned char*)p.ws + HG_LT); const float* DD = (const float*)((unsigned char*)p.ws + HG_DD);
    bf16_t* SB = (bf16_t*)((unsigned char*)p.ws + HG_SB);
    for (int gt = blockIdx.x * NTHR + threadIdx.x; gt < 16 * 8192; gt += gridDim.x * NTHR) {
        const int bh = gt >> 13, e = gt & 8191, k = e & 127;
        float S = 0.f;
#pragma unroll 8
        for (int c = 0; c < 128; ++c) { const size_t u = (size_t)bh * 128 + c;
            const float L = bf2f(LT[u * 8192 + e]), D = DD[u * 128 + k];
            SB[u * 8192 + e] = cvt1(S); S = fmaf(D, S, L); }
    }
}
__device__ __forceinline__ void hg_out(const Params& p, unsigned char* ldsb) {
    const bf16_t* P = (const bf16_t*)(p.ws + WS_P); const float* lbp = (const float*)(p.ws + WS_LB);
    const bf16_t* SB = (const bf16_t*)((unsigned char*)p.ws + HG_SB);
    bf16_t* mixed = (bf16_t*)(p.ws + WS_MIXED);
    LAS unsigned char* l = (LAS unsigned char*)ldsb;
    LAS float* gs = (LAS float*)l;
    LAS bf16_t* QT = (LAS bf16_t*)(l + 2048); LAS bf16_t* KT = (LAS bf16_t*)(l + 19456); LAS bf16_t* QI = (LAS bf16_t*)(l + 36864);
    LAS bf16_t* VT = (LAS bf16_t*)(l + 54272); LAS bf16_t* SC = (LAS bf16_t*)(l + 63488); LAS bf16_t* ST = (LAS bf16_t*)(l + 72704);
    LAS float* OB = (LAS float*)(l + 90112);
    const int tid = threadIdx.x, lane = tid & 63, wave = tid >> 6, rg = tid >> 7, k = tid & 127;
    bf16_t flr[16], qr[16]; u4_t vr, gr, sr[2];
#define HGO_LOAD(u_) { hg_load_col(P, C_HGF, (u_), tid, flr); hg_load_col(P, C_HGQ, (u_), tid, qr); vr = hg_load_v(P, (u_), tid); \
        { const int bh_ = (u_) >> 7, c_ = (u_) & 127; gr = *(const u4_t*)(P + ((size_t)(bh_ >> 2) * SEQ + c_ * 64 + (tid >> 3)) * INW + C_HGG + (bh_ & 3) * 64 + (tid & 7) * 8); } \
        sr[0] = *(const u4_t*)(SB + (size_t)(u_) * 8192 + tid * 8); sr[1] = *(const u4_t*)(SB + (size_t)(u_) * 8192 + tid * 8 + 4096); }
    if ((int)blockIdx.x < 2048) HGO_LOAD((int)blockIdx.x);
    for (int unit = blockIdx.x; unit < 2048; unit += gridDim.x) {
        const int bh = unit >> 7, c = unit & 127, b_ = bh >> 2, h = bh & 3;
        const size_t tok0 = (size_t)b_ * SEQ + c * 64;
        float kk[16], bc[16], bmid, blast;
        hg_cols(flr, lbp[h * 128 + k], gs, tid, kk, bc, bmid, blast);
        float qf_[16];
#pragma unroll
        for (int i = 0; i < 16; ++i) qf_[i] = bf2f(qr[i]);
        const u4_t vcur = vr, gv_ = gr, s0_ = sr[0], s1_ = sr[1];
        { const int nu = unit + gridDim.x; if (nu < 2048) HGO_LOAD(nu); }
        {
#pragma unroll
          for (int i = 0; i < 16; ++i) { const float q = qf_[i]; const int o = (rg * 16 + i) * 136 + k;
              QT[o] = cvt1(q * __expf(fminf(bc[i] - bmid, 40.f))); KT[o] = cvt1(kk[i] * __expf(fminf(bmid - bc[i], 40.f))); QI[o] = cvt1(q * __expf(bc[i])); } }
        hg_store_vt(VT, tid, vcur);
        { const int idx0 = tid * 8, idx1 = tid * 8 + 4096;
          *(LAS u4_t*)(ST + (idx0 >> 7) * 136 + (idx0 & 127)) = s0_; *(LAS u4_t*)(ST + (idx1 >> 7) * 136 + (idx1 & 127)) = s1_; }
        __syncthreads();
        if (wave < 4) { const int ti = wave >> 1, si = wave & 1;
            f32x16 acc;
#pragma unroll
            for (int r = 0; r < 16; ++r) acc[r] = 0.f;
            if (si <= ti) mma32(acc, QT + 32 * ti * 136, 136, KT + 32 * si * 136, 136, 128, lane);
            const int s = 32 * si + (lane & 31);
#pragma unroll
            for (int r = 0; r < 16; ++r) { const int t = 32 * ti + crow(r, lane >> 5); SC[t * 72 + s] = cvt1((s <= t) ? acc[r] : 0.f); } }
        __syncthreads();
        if (wave < 4) { const int ti = wave >> 1, ji = wave & 1;
            f32x16 acc;
#pragma unroll
            for (int r = 0; r < 16; ++r) acc[r] = 0.f;
            mma32(acc, SC + 32 * ti * 72, 72, VT + 32 * ji * 72, 72, 64, lane);
            mma32(acc, QI + 32 * ti * 136, 136, ST + 32 * ji * 136, 136, 128, lane);
            const int j = 32 * ji + (lane & 31);
#pragma unroll
            for (int r = 0; r < 16; ++r) OB[(32 * ti + crow(r, lane >> 5)) * 65 + j] = acc[r]; }
        __syncthreads();
        { const int t = tid >> 3, jq = tid & 7;
          float o[8]; float ss = 0.f;
#pragma unroll
          for (int e = 0; e < 8; ++e) { o[e] = OB[t * 65 + jq * 8 + e]; ss = fmaf(o[e], o[e], ss); }
          ss += __shfl_xor(ss, 1); ss += __shfl_xor(ss, 2); ss += __shfl_xor(ss, 4);
          const float r = rsqrtf(ss * (1.f / 64.f) + EPS);
          const u4_t gv = gv_;
          const float* gn = p.hg_gain + h * 64 + jq * 8;
          uint4 w; w.x = cvtpk(o[0] * r * gn[0] * bflo(gv.x), o[1] * r * gn[1] * bfhi(gv.x)); w.y = cvtpk(o[2] * r * gn[2] * bflo(gv.y), o[3] * r * gn[3] * bfhi(gv.y));
          w.z = cvtpk(o[4] * r * gn[4] * bflo(gv.z), o[5] * r * gn[5] * bfhi(gv.z)); w.w = cvtpk(o[6] * r * gn[6] * bflo(gv.w), o[7] * r * gn[7] * bfhi(gv.w));
          *(uint4*)(mixed + (tok0 + t) * DM + 512 + h * 64 + jq * 8) = w; }
        __syncthreads();
    }
#undef HGO_LOAD
}

__device__ __forceinline__ sh8_t frag8(const float (&x)[8]) { const u4_t w = {cvtpk(x[0], x[1]), cvtpk(x[2], x[3]), cvtpk(x[4], x[5]), cvtpk(x[6], x[7])}; return __builtin_bit_cast(sh8_t, w); }
__device__ __forceinline__ int kperm(int key) { return (key & 16) | ((key & 4) << 1) | ((key & 8) >> 1) | (key & 3); }
__device__ __forceinline__ void vt_store(LAS bf16_t* VT, int pitch, int d0, int pos, const u4_t v) {
    LAS bf16_t* d = VT + d0 * pitch + pos;
    d[0 * pitch] = (bf16_t)(v.x & 0xffff); d[1 * pitch] = (bf16_t)(v.x >> 16); d[2 * pitch] = (bf16_t)(v.y & 0xffff); d[3 * pitch] = (bf16_t)(v.y >> 16);
    d[4 * pitch] = (bf16_t)(v.z & 0xffff); d[5 * pitch] = (bf16_t)(v.z >> 16); d[6 * pitch] = (bf16_t)(v.w & 0xffff); d[7 * pitch] = (bf16_t)(v.w >> 16);
}
__device__ __forceinline__ void sb_mfma(const Params& p, unsigned char* ldsb) {
    const bf16_t* P = (const bf16_t*)(p.ws + WS_P);
    bf16_t* mixed = (bf16_t*)(p.ws + WS_MIXED);
    const int tid = threadIdx.x, lane = tid & 63, wave = tid >> 6, r = lane & 31, hh = lane >> 5;
    LAS bf16_t* KL = (LAS bf16_t*)ldsb + wave * (32 * 72 + 64 * 40);
    LAS bf16_t* VT = KL + 32 * 72;
    sh8_t mf[2];
#pragma unroll
    for (int ks = 0; ks < 2; ++ks)
#pragma unroll
        for (int e = 0; e < 8; ++e) { const int j = 16 * ks + 8 * (e >> 2) + 4 * hh + (e & 3); mf[ks][e] = (j > r) ? (short)0x3F80 : (short)0; }
    for (int u = blockIdx.x * 8 + wave; u < 32 * 256; u += gridDim.x * 8) {
        const int bh = u >> 8, qt = u & 255, b = bh >> 3, h = bh & 7;
        const size_t tok0 = (size_t)b * SEQ + qt * 32;
        sh8_t qf[4];
        { const bf16_t* qp = P + (tok0 + r) * INW + C_SBQ + h * 64 + 8 * hh;
#pragma unroll
          for (int ks = 0; ks < 4; ++ks) qf[ks] = *(const sh8_t*)(qp + 16 * ks); }
        f32x16 o0, o1;
#pragma unroll
        for (int i = 0; i < 16; ++i) { o0[i] = 0.f; o1[i] = 0.f; }
        float R = 0.f;
        u4_t kraw[4], vraw[4];
        { const bf16_t* kvp = P + ((size_t)b * SEQ + qt * 32 + (lane >> 3)) * INW + h * 64 + (lane & 7) * 8;
#pragma unroll
          for (int i = 0; i < 4; ++i) { kraw[i] = *(const u4_t*)(kvp + (size_t)(8 * i) * INW + C_SBK); vraw[i] = *(const u4_t*)(kvp + (size_t)(8 * i) * INW + C_SBV); } }
        for (int kt = qt; kt >= 0; --kt) {
#pragma unroll
            for (int i = 0; i < 4; ++i) { const int key = (lane >> 3) + 8 * i, dq = lane & 7;
                *(LAS u4_t*)(KL + key * 72 + dq * 8) = kraw[i];
                vt_store(VT, 40, dq * 8, kperm(key), vraw[i]); }
            { const int ktn = kt > 0 ? kt - 1 : 0;
              const bf16_t* kvp = P + ((size_t)b * SEQ + ktn * 32 + (lane >> 3)) * INW + h * 64 + (lane & 7) * 8;
#pragma unroll
              for (int i = 0; i < 4; ++i) { kraw[i] = *(const u4_t*)(kvp + (size_t)(8 * i) * INW + C_SBK); vraw[i] = *(const u4_t*)(kvp + (size_t)(8 * i) * INW + C_SBV); } }
            f32x16 z;
#pragma unroll
            for (int i = 0; i < 16; ++i) z[i] = 0.f;
#pragma unroll
            for (int ks = 0; ks < 4; ++ks) z = __builtin_amdgcn_mfma_f32_32x32x16_bf16(*(const LAS sh8_t*)(KL + r * 72 + 16 * ks + 8 * hh), qf[ks], z, 0, 0, 0);
            const bool diag = (kt == qt);
            float sp[16]; f32x16 la; float tot = 0.f;
#pragma unroll
            for (int i = 0; i < 16; ++i) { const float zz = z[i];
                float s = fmaxf(zz, 0.f) + __builtin_amdgcn_logf(1.f + __builtin_amdgcn_exp2f(-fabsf(zz)));
                const bool valid = !diag || (crow(i, hh) < r);
                la[i] = zz - s + R; s = valid ? s : 0.f; sp[i] = s; tot += s; }
            tot += __shfl_xor(tot, 32);
#pragma unroll
            for (int ks = 0; ks < 2; ++ks) {
                unsigned hi[4], lo[4];
#pragma unroll
                for (int e = 0; e < 4; ++e) { const float x0 = -sp[8 * ks + 2 * e], x1 = -sp[8 * ks + 2 * e + 1]; hi[e] = cvtpk(x0, x1); lo[e] = cvtpk(x0 - bflo(hi[e]), x1 - bfhi(hi[e])); }
                const u4_t hv = {hi[0], hi[1], hi[2], hi[3]}, lv = {lo[0], lo[1], lo[2], lo[3]};
                la = __builtin_amdgcn_mfma_f32_32x32x16_bf16(mf[ks], __builtin_bit_cast(sh8_t, hv), la, 0, 0, 0);
                la = __builtin_amdgcn_mfma_f32_32x32x16_bf16(mf[ks], __builtin_bit_cast(sh8_t, lv), la, 0, 0, 0);
            }
            sh8_t af[2];
#pragma unroll
            for (int ks = 0; ks < 2; ++ks) { float a[8];
#pragma unroll
                for (int e = 0; e < 8; ++e) { const int i = 8 * ks + e; const bool valid = !diag || (crow(i, hh) < r); a[e] = valid ? __builtin_amdgcn_exp2f(la[i]) : 0.f; }
                af[ks] = frag8(a); }
            R -= tot;
#pragma unroll
            for (int ks = 0; ks < 2; ++ks) {
                o0 = __builtin_amdgcn_mfma_f32_32x32x16_bf16(*(const LAS sh8_t*)(VT + r * 40 + 16 * ks + 8 * hh), af[ks], o0, 0, 0, 0);
                o1 = __builtin_amdgcn_mfma_f32_32x32x16_bf16(*(const LAS sh8_t*)(VT + (32 + r) * 40 + 16 * ks + 8 * hh), af[ks], o1, 0, 0, 0);
            }
            if (__all(R < -48.f)) break;
        }
        float ss = 0.f;
#pragma unroll
        for (int i = 0; i < 16; ++i) { ss = fmaf(o0[i], o0[i], ss); ss = fmaf(o1[i], o1[i], ss); }
        ss += __shfl_xor(ss, 32);
        const float rn = rsqrtf(ss * (1.f / 64.f) + EPS);
        bf16_t* op = mixed + (tok0 + r) * DM + h * 64 + 4 * hh;
        const float* gp = p.sb_gain + h * 64 + 4 * hh;
#pragma unroll
        for (int q4 = 0; q4 < 4; ++q4) {
            const float4 g0 = *(const float4*)(gp + 8 * q4), g1 = *(const float4*)(gp + 32 + 8 * q4);
            uint2 w0, w1;
            w0.x = cvtpk(o0[4 * q4] * rn * g0.x, o0[4 * q4 + 1] * rn * g0.y); w0.y = cvtpk(o0[4 * q4 + 2] * rn * g0.z, o0[4 * q4 + 3] * rn * g0.w);
            w1.x = cvtpk(o1[4 * q4] * rn * g1.x, o1[4 * q4 + 1] * rn * g1.y); w1.y = cvtpk(o1[4 * q4 + 2] * rn * g1.z, o1[4 * q4 + 3] * rn * g1.w);
            *(uint2*)(op + 8 * q4) = w0; *(uint2*)(op + 32 + 8 * q4) = w1;
        }
    }
}
__device__ __forceinline__ void mem_attn_mfma(const Params& p, unsigned char* ldsb) {
    const bf16_t* P = (const bf16_t*)(p.ws + WS_P);
    const bf16_t* kvb = (const bf16_t*)(p.ws + WS_MEMKV);
    bf16_t* mixed = (bf16_t*)(p.ws + WS_MIXED);
    const int tid = threadIdx.x, lane = tid & 63, wave = tid >> 6, r = lane & 31, hh = lane >> 5;
    LAS bf16_t* VT = (LAS bf16_t*)ldsb;
    LAS bf16_t* KN = VT + 64 * 264;
    for (int unit = blockIdx.x; unit < NB * 4 * (SEQ / 256); unit += gridDim.x) {
        const int tb = unit & 31, hd = (unit >> 5) & 3, b = unit >> 7;
        __syncthreads();
#pragma unroll
        for (int i = 0; i < 4; ++i) { const int idx = tid + 512 * i, key = idx >> 3, dq = idx & 7;
            const u4_t v = *(const u4_t*)(kvb + ((size_t)b * NMEM + key) * 512 + 256 + hd * 64 + dq * 8);
            vt_store(VT, 264, dq * 8, (key & ~31) | kperm(key & 31), v); }
        { const bf16_t* kp = kvb + ((size_t)b * NMEM + wave * 32 + r) * 512 + hd * 64 + 8 * hh;
          u4_t kw[4]; float ssk = 0.f;
#pragma unroll
          for (int ks = 0; ks < 4; ++ks) { kw[ks] = *(const u4_t*)(kp + 16 * ks);
#pragma unroll
              for (int e = 0; e < 4; ++e) { const float lo = bflo(kw[ks][e]), hi = bfhi(kw[ks][e]); ssk = fmaf(lo, lo, ssk); ssk = fmaf(hi, hi, ssk); } }
          ssk += __shfl_xor(ssk, 32);
          const float rk = rsqrtf(ssk * (1.f / 64.f) + EPS);
#pragma unroll
          for (int ks = 0; ks < 4; ++ks) { float t8[8];
#pragma unroll
              for (int e = 0; e < 4; ++e) { t8[2 * e] = bflo(kw[ks][e]) * rk; t8[2 * e + 1] = bfhi(kw[ks][e]) * rk; }
              *(LAS sh8_t*)(KN + (wave * 32 + r) * 72 + 16 * ks + 8 * hh) = frag8(t8); } }
        __syncthreads();
        const size_t tok = (size_t)b * SEQ + tb * 256 + wave * 32 + r;
        sh8_t qf[4];
        { const bf16_t* qp = P + tok * INW + C_MQ + hd * 64 + 8 * hh;
          float qv[32]; float ss = 0.f;
#pragma unroll
          for (int ks = 0; ks < 4; ++ks) { const u4_t w = *(const u4_t*)(qp + 16 * ks);
              qv[8 * ks] = bflo(w.x); qv[8 * ks + 1] = bfhi(w.x); qv[8 * ks + 2] = bflo(w.y); qv[8 * ks + 3] = bfhi(w.y); qv[8 * ks + 4] = bflo(w.z); qv[8 * ks + 5] = bfhi(w.z); qv[8 * ks + 6] = bflo(w.w); qv[8 * ks + 7] = bfhi(w.w); }
#pragma unroll
          for (int i = 0; i < 32; ++i) ss = fmaf(qv[i], qv[i], ss);
          ss += __shfl_xor(ss, 32);
          const float rq = rsqrtf(ss * (1.f / 64.f) + EPS) * (0.125f * LOG2E);
#pragma unroll
          for (int ks = 0; ks < 4; ++ks) { float t8[8];
#pragma unroll
              for (int e = 0; e < 8; ++e) t8[e] = qv[8 * ks + e] * rq * p.mq_gain[16 * ks + 8 * hh + e] * p.mk_gain[16 * ks + 8 * hh + e];
              qf[ks] = frag8(t8); } }
        f32x16 s[8];
#pragma unroll
        for (int kt = 0; kt < 8; ++kt) {
#pragma unroll
            for (int i = 0; i < 16; ++i) s[kt][i] = 0.f;
#pragma unroll
            for (int ks = 0; ks < 4; ++ks) s[kt] = __builtin_amdgcn_mfma_f32_32x32x16_bf16(*(const LAS sh8_t*)(KN + (kt * 32 + r) * 72 + 16 * ks + 8 * hh), qf[ks], s[kt], 0, 0, 0);
        }
        float mx = -1e30f;
#pragma unroll
        for (int kt = 0; kt < 8; ++kt)
#pragma unroll
            for (int i = 0; i < 16; ++i) mx = fmaxf(mx, s[kt][i]);
        mx = fmaxf(mx, __shfl_xor(mx, 32));
        float lsum = 0.f;
        f32x16 o0, o1;
#pragma unroll
        for (int i = 0; i < 16; ++i) { o0[i] = 0.f; o1[i] = 0.f; }
#pragma unroll
        for (int kt = 0; kt < 8; ++kt)
#pragma unroll
            for (int ks = 0; ks < 2; ++ks) { float a[8];
#pragma unroll
                for (int e = 0; e < 8; ++e) { a[e] = __builtin_amdgcn_exp2f(s[kt][8 * ks + e] - mx); lsum += a[e]; }
                const sh8_t af = frag8(a);
                o0 = __builtin_amdgcn_mfma_f32_32x32x16_bf16(*(const LAS sh8_t*)(VT + r * 264 + 32 * kt + 16 * ks + 8 * hh), af, o0, 0, 0, 0);
                o1 = __builtin_amdgcn_mfma_f32_32x32x16_bf16(*(const LAS sh8_t*)(VT + (32 + r) * 264 + 32 * kt + 16 * ks + 8 * hh), af, o1, 0, 0, 0); }
        lsum += __shfl_xor(lsum, 32);
        const float il = 1.f / lsum;
        bf16_t* op = mixed + tok * DM + 768 + hd * 64 + 4 * hh;
#pragma unroll
        for (int q4 = 0; q4 < 4; ++q4) {
            uint2 w0, w1;
            w0.x = cvtpk(o0[4 * q4] * il, o0[4 * q4 + 1] * il); w0.y = cvtpk(o0[4 * q4 + 2] * il, o0[4 * q4 + 3] * il);
            w1.x = cvtpk(o1[4 * q4] * il, o1[4 * q4 + 1] * il); w1.y = cvtpk(o1[4 * q4 + 2] * il, o1[4 * q4 + 3] * il);
            *(uint2*)(op + 8 * q4) = w0; *(uint2*)(op + 32 + 8 * q4) = w1;
        }
    }
}

__device__ __forceinline__ int tk_pack(float s, int payload, int mask) { const int b = __float_as_int(s); const int m = b ^ ((b >> 31) & 0x7fffffff); return (m & ~mask) | payload; }
__device__ __forceinline__ float tk_unpack(int key, int mask) { const int m = key & ~mask; return __int_as_float(m ^ ((m >> 31) & 0x7fffffff)); }
template <int N> __device__ __forceinline__ void bitonic_sort_desc(int (&v)[N]) {
#pragma unroll
    for (int k = 2; k <= N; k <<= 1)
#pragma unroll
        for (int j = k >> 1; j > 0; j >>= 1)
#pragma unroll
            for (int i = 0; i < N; ++i) { const int l = i ^ j; if (l > i) { const bool desc = ((i & k) == 0); const int a = v[i], b = v[l]; const int hi = max(a, b), lo = min(a, b); v[i] = desc ? hi : lo; v[l] = desc ? lo : hi; } }
}
__device__ __forceinline__ void merge_top16(int (&A)[16], const int (&B)[16]) {
#pragma unroll
    for (int i = 0; i < 16; ++i) A[i] = max(A[i], B[15 - i]);
#pragma unroll
    for (int j = 8; j > 0; j >>= 1)
#pragma unroll
        for (int i = 0; i < 16; ++i) { const int l = i ^ j; if (l > i) { const int a = A[i], b = A[l]; A[i] = max(a, b); A[l] = min(a, b); } }
}
__device__ __forceinline__ void top16_of_64(int (&g0)[16], int (&g1)[16], int (&g2)[16], int (&g3)[16]) {
    bitonic_sort_desc<16>(g0); bitonic_sort_desc<16>(g1); bitonic_sort_desc<16>(g2); bitonic_sort_desc<16>(g3);
    merge_top16(g0, g1); merge_top16(g2, g3); merge_top16(g0, g2);
}
__device__ __forceinline__ void topk_mfma(const Params& p, unsigned char* ldsb) {
    const bf16_t* Q = (const bf16_t*)(p.ws + WS_Q);
    const bf16_t* SK = (const bf16_t*)(p.ws + WS_SKB);
    unsigned short* pidx16 = (unsigned short*)(p.ws + WS_PIDX); float* pg = (float*)(p.ws + WS_PG);
    const float* ssq = (const float*)(p.ws + WS_SSQ); float* rs2 = (float*)(p.ws + WS_RSTD2);
    LAS unsigned char* l = (LAS unsigned char*)ldsb;
    LAS bf16_t* SKL = (LAS bf16_t*)l;
    const int tid = threadIdx.x, lane = tid & 63, wave = tid >> 6, r = lane & 31, hh = lane >> 5;
    LAS unsigned char* ib = l + 69632 + (wave * 64 + lane) * 36;
    int cur_h = -1;
    for (int unit = blockIdx.x; unit < 8 * (T / 256); unit += gridDim.x) {
        const int h = unit & 7, tb = unit >> 3;
        if (h != cur_h) {
            __syncthreads();
#pragma unroll
            for (int it = 0; it < 8; ++it) { const int idx = tid + 512 * it, row = idx >> 4, cq = idx & 15;
                *(LAS u4_t*)(SKL + row * 136 + cq * 8) = *(const u4_t*)(SK + ((size_t)h * 256 + row) * 128 + cq * 8); }
            __syncthreads();
            cur_h = h;
        }
        const int tok = tb * 256 + wave * 32 + r;
        int sorted[2][16];
#pragma unroll
        for (int c = 0; c < 2; ++c) {
            sh8_t qf[8];
            { const sh8_t* qp = (const sh8_t*)(Q + (size_t)tok * 2048 + h * 256 + c * 128 + 8 * hh);
#pragma unroll
              for (int ks = 0; ks < 8; ++ks) qf[ks] = qp[2 * ks]; }
            int g[4][16];
#pragma unroll
            for (int mt = 0; mt < 4; ++mt) {
                f32x16 acc;
#pragma unroll
                for (int i = 0; i < 16; ++i) acc[i] = 0.f;
                const LAS bf16_t* ap = SKL + (c * 128 + 32 * mt + r) * 136 + 8 * hh;
#pragma unroll
                for (int ks = 0; ks < 8; ++ks) acc = __builtin_amdgcn_mfma_f32_32x32x16_bf16(*(const LAS sh8_t*)(ap + 16 * ks), qf[ks], acc, 0, 0, 0);
#pragma unroll
                for (int i = 0; i < 16; ++i) g[mt][i] = tk_pack(acc[i], (32 * mt + (i & 3) + 8 * (i >> 2)) | (hh << 2), 127);
            }
            top16_of_64(g[0], g[1], g[2], g[3]);
            int o[16];
#pragma unroll
            for (int i = 0; i < 16; ++i) o[i] = __shfl_xor(g[0][i], 32);
            merge_top16(g[0], o);
#pragma unroll
            for (int i = 0; i < 16; ++i) sorted[c][i] = g[0][i];
        }
#pragma unroll
        for (int c = 0; c < 2; ++c)
#pragma unroll
            for (int w = 0; w < 4; ++w)
                *(LAS unsigned*)(ib + c * 16 + w * 4) = (unsigned)(sorted[c][4 * w] & 127) | ((unsigned)(sorted[c][4 * w + 1] & 127) << 8) | ((unsigned)(sorted[c][4 * w + 2] & 127) << 16) | ((unsigned)(sorted[c][4 * w + 3] & 127) << 24);
        float av[16], bv[16];
#pragma unroll
        for (int i = 0; i < 16; ++i) { av[i] = tk_unpack(sorted[0][i], 127); bv[i] = tk_unpack(sorted[1][i], 127); }
        int cd[4][16];
        {
            int n = 0;
#pragma unroll
            for (int i = 0; i < 16; ++i)
#pragma unroll
                for (int j = 0; j < 16; ++j)
                    if ((i + 1) * (j + 1) <= 16) { cd[n >> 4][n & 15] = tk_pack(av[i] + bv[j], i * 16 + j, 255); ++n; }
#pragma unroll
            for (; n < 64; ++n) cd[n >> 4][n & 15] = (int)0x80000000;
        }
        top16_of_64(cd[0], cd[1], cd[2], cd[3]);
        float sv[16]; int ex[16];
        float rstd;
        { const f32x4_t* sp_ = (const f32x4_t*)(ssq + (size_t)tok * 16); const f32x4_t q0 = sp_[0], q1 = sp_[1], q2 = sp_[2], q3 = sp_[3];
          const float tot = ((q0[0] + q0[1]) + (q0[2] + q0[3])) + ((q1[0] + q1[1]) + (q1[2] + q1[3])) + ((q2[0] + q2[1]) + (q2[2] + q2[3])) + ((q3[0] + q3[1]) + (q3[2] + q3[3]));
          rstd = rsqrtf(tot * (1.f / DM) + EPS); if (h == 0 && hh == 0) rs2[tok] = rstd; }
        const float s0 = tk_unpack(cd[0][0], 255);
        float sum = 0.f;
#pragma unroll
        for (int q = 0; q < 16; ++q) { const int key = cd[0][q]; const int id = key & 255;
            const int ia = ib[id >> 4], ibx = ib[16 + (id & 15)];
            ex[q] = ia * 128 + ibx; sv[q] = __expf((tk_unpack(key, 255) - s0) * rstd); sum += sv[q]; }
        const float inv = 1.f / sum;
        if (hh == 0) { u4_t* d = (u4_t*)(pidx16 + (size_t)tok * PK + h * 16);
#pragma unroll
            for (int w = 0; w < 2; ++w) d[w] = (u4_t){(unsigned)ex[8 * w] | ((unsigned)ex[8 * w + 1] << 16), (unsigned)ex[8 * w + 2] | ((unsigned)ex[8 * w + 3] << 16), (unsigned)ex[8 * w + 4] | ((unsigned)ex[8 * w + 5] << 16), (unsigned)ex[8 * w + 6] | ((unsigned)ex[8 * w + 7] << 16)}; }
        else { float4* d = (float4*)(pg + (size_t)tok * PK + h * 16);
#pragma unroll
            for (int w = 0; w < 4; ++w) d[w] = make_float4(sv[4 * w] * inv, sv[4 * w + 1] * inv, sv[4 * w + 2] * inv, sv[4 * w + 3] * inv); }
    }
}

struct Sl { int vx, rank, nrank; };
__device__ __forceinline__ float dpp_xor1(float x) { return __int_as_float(__builtin_amdgcn_mov_dpp(__float_as_int(x), 0xB1, 0xF, 0xF, true)); }
__device__ __forceinline__ float dpp_xor2(float x) { return __int_as_float(__builtin_amdgcn_mov_dpp(__float_as_int(x), 0x4E, 0xF, 0xF, true)); }
__device__ __forceinline__ float dpp_ror8(float x) { return __int_as_float(__builtin_amdgcn_mov_dpp(__float_as_int(x), 0x128, 0xF, 0xF, true)); }
__device__ __forceinline__ float dpp_hmir(float x) { return __int_as_float(__builtin_amdgcn_mov_dpp(__float_as_int(x), 0x141, 0xF, 0xF, true)); }
__device__ __forceinline__ void peer_u_phase(const Params& p, const Sl sl) {
    const int lane = threadIdx.x & 63, wave = threadIdx.x >> 6, g8 = lane >> 3, c = lane & 7;
    const unsigned short* pidx = (const unsigned short*)(p.ws + WS_PIDX);
    const int per = (T + sl.nrank * 8 - 1) / (sl.nrank * 8), tbase = (sl.rank * 8 + wave) * per, stride = 1;
    const int nk = (tbase < T) ? ((T - tbase < per) ? (T - tbase) : per) : 0;
    const int S = sl.vx;
    const unsigned char* Ub = p.ws + WS_U16 + (size_t)S * NEXP * 128 + c * 16;
    const bf16_t* xbb = (const bf16_t*)(p.ws + WS_XB) + (size_t)(2 * S + (c >> 2)) * T * 64 + (c & 3) * 16;
    _Float16* PUs = (_Float16*)(p.ws + WS_PU) + (size_t)S * T * PK;
    if (nk == 0) return;
#define TK(k) (tbase + ((k) < nk ? (k) : nk - 1) * stride)
#define SBAR __builtin_amdgcn_sched_barrier(0)
#define U_LOAD_IDX(I, t) { const u4_t* ip_ = (const u4_t*)(pidx + (size_t)(t) * PK + g8 * 16); I[0] = *(ip_); I[1] = *(ip_ + 1); }
#define U_LOAD_H(H, t) { const u4_t* hp_ = (const u4_t*)(xbb + (size_t)(t) * 64); H[0] = *(hp_); H[1] = *(hp_ + 1); }
#define U_ISSUE(G, I) { const unsigned w0_ = I[(G) >> 1][(2 * (G)) & 3], w1_ = I[(G) >> 1][(2 * (G) + 1) & 3]; \
        rr[4 * (G)] = *(const u4_t*)(Ub + (size_t)(w0_ & 0xffffu) * 128); rr[4 * (G) + 1] = *(const u4_t*)(Ub + (size_t)(w0_ >> 16) * 128); \
        rr[4 * (G) + 2] = *(const u4_t*)(Ub + (size_t)(w1_ & 0xffffu) * 128); rr[4 * (G) + 3] = *(const u4_t*)(Ub + (size_t)(w1_ >> 16) * 128); }
#define U_DOT(G) { _Pragma("unroll") for (int i_ = 4 * (G); i_ < 4 * (G) + 4; ++i_) { float2_t a_ = {0.f, 0.f}; \
        _Pragma("unroll") for (int q_ = 0; q_ < 4; ++q_) { a_ = __builtin_amdgcn_cvt_pk_f32_fp8((int)rr[i_][q_], false) * X2[2 * q_] + a_; a_ = __builtin_amdgcn_cvt_pk_f32_fp8((int)rr[i_][q_], true) * X2[2 * q_ + 1] + a_; } \
        pr[i_] = a_.x + a_.y; } }
#define U_STEP(k, I1, I2, Hc, Hn) { float pr[16]; float2_t X2[8]; \
        _Pragma("unroll") for (int m_ = 0; m_ < 8; ++m_) { const unsigned hw_ = Hc[m_ >> 2][m_ & 3]; X2[m_] = (float2_t){bflo(hw_), bfhi(hw_)}; } \
        U_LOAD_IDX(I2, TK((k) + 2)); U_LOAD_H(Hn, TK((k) + 1)); SBAR; \
        U_DOT(0); SBAR; U_ISSUE(0, I1); SBAR; U_DOT(1); SBAR; U_ISSUE(1, I1); SBAR; U_DOT(2); SBAR; U_ISSUE(2, I1); SBAR; U_DOT(3); SBAR; U_ISSUE(3, I1); SBAR; \
        _Pragma("unroll") for (int j_ = 0; j_ < 8; ++j_) { const float keep_ = (c & 4) ? pr[j_ + 8] : pr[j_], send_ = (c & 4) ? pr[j_] : pr[j_ + 8]; pr[j_] = keep_ + dpp_hmir(send_); } \
        _Pragma("unroll") for (int j_ = 0; j_ < 4; ++j_) { const float keep_ = (c & 2) ? pr[j_ + 4] : pr[j_], send_ = (c & 2) ? pr[j_] : pr[j_ + 4]; pr[j_] = keep_ + dpp_xor2(send_); } \
        _Pragma("unroll") for (int j_ = 0; j_ < 2; ++j_) { const float keep_ = (c & 1) ? pr[j_ + 2] : pr[j_], send_ = (c & 1) ? pr[j_] : pr[j_ + 2]; pr[j_] = keep_ + dpp_xor1(send_); } \
        __builtin_nontemporal_store((h2_t){(_Float16)pr[0], (_Float16)pr[1]}, (h2_t*)(PUs + (size_t)TK(k) * PK + g8 * 16 + 2 * c)); }
    u4_t iA[2], iB[2], rr[16], hA[2], hB[2];
    U_LOAD_IDX(iA, TK(0)); U_LOAD_IDX(iB, TK(1)); U_LOAD_H(hA, TK(0)); SBAR;
    U_ISSUE(0, iA); SBAR; U_ISSUE(1, iA); SBAR; U_ISSUE(2, iA); SBAR; U_ISSUE(3, iA); SBAR;
    for (int k = 0; k < nk; k += 2) {
        U_STEP(k, iB, iA, hA, hB);
        if (k + 1 < nk) U_STEP(k + 1, iA, iB, hB, hA);
    }
#undef U_LOAD_IDX
#undef U_LOAD_H
#undef U_ISSUE
#undef U_DOT
#undef U_STEP
}
__device__ __forceinline__ void peer_w_phase(const Params& p) {
    const _Float16* PU = (const _Float16*)(p.ws + WS_PU); const float* pg = (const float*)(p.ws + WS_PG); const float* rs = (const float*)(p.ws + WS_RSTD2);
    _Float16* pw = (_Float16*)(p.ws + WS_PW);
    for (int i = blockIdx.x * NTHR + threadIdx.x; i < T * PK / 8; i += gridDim.x * NTHR) {
        float s[8];
#pragma unroll
        for (int e = 0; e < 8; ++e) s[e] = 0.f;
#pragma unroll
        for (int x = 0; x < 8; ++x) { const h8_t hv = *((const h8_t*)(PU + (size_t)x * T * PK) + i);
#pragma unroll
            for (int e = 0; e < 8; ++e) s[e] += (float)hv[e]; }
        const float r = rs[i >> 4] * (1.f / PEER_US);
        const f32x4_t g0 = *((const f32x4_t*)pg + 2 * i), g1 = *((const f32x4_t*)pg + 2 * i + 1);
        h8_t wv;
#pragma unroll
        for (int e = 0; e < 4; ++e) { const float a = s[e] * r, b = s[4 + e] * r;
            wv[e] = (_Float16)(g0[e] * (0.5f / PEER_VS) * a * (1.f + erff(a * 0.70710678118654752f))); wv[4 + e] = (_Float16)(g1[e] * (0.5f / PEER_VS) * b * (1.f + erff(b * 0.70710678118654752f))); }
        *((h8_t*)pw + i) = wv;
    }
}
__device__ __forceinline__ void peer_v_phase(const Params& p, const Sl sl) {
    const int lane = threadIdx.x & 63, wave = threadIdx.x >> 6, g8 = lane >> 3, c = lane & 7;
    const unsigned short* pidx = (const unsigned short*)(p.ws + WS_PIDX); const _Float16* pw = (const _Float16*)(p.ws + WS_PW);
    const int per = (T + sl.nrank * 8 - 1) / (sl.nrank * 8), tbase = (sl.rank * 8 + wave) * per, stride = 1;
    const int nk = (tbase < T) ? ((T - tbase < per) ? (T - tbase) : per) : 0;
    const int S = sl.vx;
    const unsigned char* Vb = p.ws + WS_V16 + (size_t)S * NEXP * 128 + c * 16;
    const int jj = 16 * c + 2 * g8, s16 = 2 * S + (jj >> 6), j = jj & 63;
    float* ob = p.out + (j >> 5) * 512 + 32 * s16 + (j & 31);
    const bf16_t* xs = (const bf16_t*)(p.ws + WS_XB) + (size_t)s16 * T * 64 + j;
    if (nk == 0) return;
#define V_LOAD_IDX(I, t) { const u4_t* ip_ = (const u4_t*)(pidx + (size_t)(t) * PK + g8 * 16); I[0] = *(ip_); I[1] = *(ip_ + 1); }
#define V_LOAD_W(W, t) { const h8_t* wp_ = (const h8_t*)(pw + (size_t)(t) * PK + g8 * 16); W[0] = *(wp_); W[1] = *(wp_ + 1); }
#define V_ISSUE(G, I) { const unsigned w0_ = I[(G) >> 1][(2 * (G)) & 3], w1_ = I[(G) >> 1][(2 * (G) + 1) & 3]; \
        rr[4 * (G)] = *(const u4_t*)(Vb + (size_t)(w0_ & 0xffffu) * 128); rr[4 * (G) + 1] = *(const u4_t*)(Vb + (size_t)(w0_ >> 16) * 128); \
        rr[4 * (G) + 2] = *(const u4_t*)(Vb + (size_t)(w1_ & 0xffffu) * 128); rr[4 * (G) + 3] = *(const u4_t*)(Vb + (size_t)(w1_ >> 16) * 128); }
#define V_FMA(G, W) { _Pragma("unroll") for (int i_ = 4 * (G); i_ < 4 * (G) + 4; ++i_) { const float wv_ = (float)W[i_ >> 3][i_ & 7]; const float2_t ww_ = {wv_, wv_}; \
        _Pragma("unroll") for (int q_ = 0; q_ < 4; ++q_) { acc2[2 * q_] = __builtin_amdgcn_cvt_pk_f32_fp8((int)rr[i_][q_], false) * ww_ + acc2[2 * q_]; acc2[2 * q_ + 1] = __builtin_amdgcn_cvt_pk_f32_fp8((int)rr[i_][q_], true) * ww_ + acc2[2 * q_ + 1]; } } }
#define V_STEP(k, I1, I2, Wc, Wn) { float2_t acc2[8]; \
        _Pragma("unroll") for (int k_ = 0; k_ < 8; ++k_) acc2[k_] = (float2_t){0.f, 0.f}; \
        const unsigned oold_ = *((const unsigned*)(xs + (size_t)TK(k) * 64)); \
        V_LOAD_IDX(I2, TK((k) + 2)); V_LOAD_W(Wn, TK((k) + 1)); SBAR; \
        V_FMA(0, Wc); SBAR; V_ISSUE(0, I1); SBAR; V_FMA(1, Wc); SBAR; V_ISSUE(1, I1); SBAR; V_FMA(2, Wc); SBAR; V_ISSUE(2, I1); SBAR; V_FMA(3, Wc); SBAR; V_ISSUE(3, I1); SBAR; \
        float a_[16]; \
        _Pragma("unroll") for (int k_ = 0; k_ < 8; ++k_) { a_[2 * k_] = acc2[k_].x; a_[2 * k_ + 1] = acc2[k_].y; } \
        _Pragma("unroll") for (int j_ = 0; j_ < 8; ++j_) { const float keep_ = (g8 & 4) ? a_[j_ + 8] : a_[j_], send_ = (g8 & 4) ? a_[j_] : a_[j_ + 8]; a_[j_] = keep_ + __shfl_xor(send_, 32); } \
        _Pragma("unroll") for (int j_ = 0; j_ < 4; ++j_) { const float keep_ = (g8 & 2) ? a_[j_ + 4] : a_[j_], send_ = (g8 & 2) ? a_[j_] : a_[j_ + 4]; a_[j_] = keep_ + __shfl_xor(send_, 16); } \
        _Pragma("unroll") for (int j_ = 0; j_ < 2; ++j_) { const float keep_ = (g8 & 1) ? a_[j_ + 2] : a_[j_], send_ = (g8 & 1) ? a_[j_] : a_[j_ + 2]; a_[j_] = keep_ + dpp_ror8(send_); } \
        __builtin_nontemporal_store((float2_t){bflo(oold_) + a_[0], bfhi(oold_) + a_[1]}, (float2_t*)(ob + (size_t)TK(k) * DM)); }
    u4_t iA[2], iB[2], rr[16]; h8_t wA[2], wB[2];
    V_LOAD_IDX(iA, TK(0)); V_LOAD_IDX(iB, TK(1)); V_LOAD_W(wA, TK(0)); SBAR;
    V_ISSUE(0, iA); SBAR; V_ISSUE(1, iA); SBAR; V_ISSUE(2, iA); SBAR; V_ISSUE(3, iA); SBAR;
    for (int k = 0; k < nk; k += 2) {
        V_STEP(k, iB, iA, wA, wB);
        if (k + 1 < nk) V_STEP(k + 1, iA, iB, wB, wA);
    }
#undef V_LOAD_IDX
#undef V_LOAD_W
#undef V_ISSUE
#undef V_FMA
#undef V_STEP
#undef TK
#undef SBAR
}

#ifndef PROBE_DBL
#define PROBE_DBL -1
#endif
#define REP(k) for (int rep_ = 0; rep_ < ((PROBE_DBL == (k)) ? 2 : 1); ++rep_)
typedef const __attribute__((address_space(4))) Params* KArgs;
#if defined(__HIP_DEVICE_COMPILE__)
#define LOADP(P) KArgs kq_ = (KArgs)__builtin_amdgcn_kernarg_segment_ptr(); asm volatile("" : "+s"(kq_)); Params P; __builtin_memcpy(&P, kq_, sizeof(Params))
#define BAR_WS() ((unsigned char*)((KArgs)__builtin_amdgcn_kernarg_segment_ptr())->ws)
#else
#define LOADP(P) const Params P = p_unused
#define BAR_WS() (p_unused.ws)
#endif
#ifndef PROBE_SPIN
#define PROBE_SPIN -1
#endif
#if PROBE_SPIN >= 0
#define STAMP(k) do { if (threadIdx.x == 0) { const unsigned long long t_ = __builtin_amdgcn_s_memrealtime(); ((volatile LAS unsigned*)(LAS unsigned char*)lds)[36800 + 2 * (k)] = (unsigned)t_; ((volatile LAS unsigned*)(LAS unsigned char*)lds)[36801 + 2 * (k)] = (unsigned)(t_ >> 32); } } while (0)
#else
#define STAMP(k) do { } while (0)
#endif
#define BAR() do { XcdBarrier xb_; xb_.bar = (unsigned*)(BAR_WS() + WS_CTL) + 4096; xb_.x = ((volatile LAS unsigned*)(LAS unsigned char*)lds)[36861]; xb_.st = (volatile LAS unsigned*)(LAS unsigned char*)lds + 36862; xcd_barrier(xb_); } while (0)
__global__ void __launch_bounds__(NTHR, 2) fwd_kernel(Params p_unused) {
    extern __shared__ __attribute__((aligned(16))) unsigned char lds[];
    PG8_LAS unsigned char* ldsl = (PG8_LAS unsigned char*)lds;
    STAMP(13);
    { LOADP(p);
      if (blockIdx.x == 0) { unsigned* ctl0 = (unsigned*)(p.ws + WS_CTL); for (int i = threadIdx.x; i < 16384; i += NTHR) ctl0[i] = 0u; }
      if (threadIdx.x < 2) ((volatile LAS unsigned*)(LAS unsigned char*)lds)[36862 + threadIdx.x] = 0u; }
    { cg::grid_group grid = cg::this_grid(); grid.sync(); }
    { LOADP(p);
      if (threadIdx.x == 0) { unsigned* ctl0 = (unsigned*)(p.ws + WS_CTL); const unsigned xcc0 = (unsigned)__builtin_amdgcn_s_getreg((3 << 11) | 20) & 7u;
        ((volatile unsigned*)lds)[36860] = __hip_atomic_fetch_add(&ctl0[64 * xcc0], 1u, __ATOMIC_RELAXED, __HIP_MEMORY_SCOPE_AGENT); ((volatile unsigned*)lds)[36861] = xcc0;
        (void)xb_add(&(ctl0 + 4096)[XB_XCNT(xcc0)], 1u); }
      __syncthreads(); }
    STAMP(0);
    { LOADP(p); REP(0) phase_prep(p, lds); }
    BAR(); STAMP(1);
    { LOADP(p); unsigned char* ws = p.ws;
      pg8::Gemm g{(const bf16_t*)(ws + WS_XB), (const bf16_t*)(ws + WS_WIN_T), T, INW, DM, DM, 128}; pg8::StaticOrder S; S.init(T, INW, gridDim.x, blockIdx.x); pg8::EpiProjM e{(bf16_t*)(ws + WS_P)};
      pg8::gemm_phase<pg8::EpiProjM, pg8::StaticOrder, true, true>(ldsl, g, S, e); }
    { LOADP(p); unsigned char* ws = p.ws;
      pg8::Gemm g{(const bf16_t*)(ws + WS_MEMN), (const bf16_t*)(ws + WS_WMKV_T), NB * NMEM, 512, DM, DM, 128}; pg8::StaticOrder S; S.init(NB * NMEM, 512, gridDim.x, (blockIdx.x + gridDim.x / 2) % gridDim.x); pg8::EpiQM e{(bf16_t*)(ws + WS_MEMKV), 512};
      pg8::gemm_phase<pg8::EpiQM, pg8::StaticOrder, true, true>(ldsl, g, S, e); }
    BAR(); STAMP(2);
    { LOADP(p); REP(2) { sb_mfma(p, lds); __syncthreads(); } REP(3) { hg_local(p, lds); } REP(5) mem_attn_mfma(p, lds); }
    BAR(); STAMP(3);
    { LOADP(p); REP(4) hg_scan(p); }
    BAR(); STAMP(4);
    { LOADP(p); REP(6) hg_out(p, lds); }
    BAR(); STAMP(5);
    { LOADP(p); unsigned char* ws = p.ws;
      pg8::Gemm g{(const bf16_t*)(ws + WS_MIXED), (const bf16_t*)(ws + WS_WOUT_T), T, DM, DM, DM, 128}; pg8::StaticOrder S; S.init(T, DM, gridDim.x, blockIdx.x); pg8::EpiWoutM e{p.x, (bf16_t*)(ws + WS_XB), (float*)(ws + WS_SSQ)};
      pg8::gemm_phase<pg8::EpiWoutM, pg8::StaticOrder, true, true>(ldsl, g, S, e); }
#if PROBE_DBL == 7
    { LOADP(p); unsigned char* ws = p.ws;
      pg8::Gemm g{(const bf16_t*)(ws + WS_MIXED), (const bf16_t*)(ws + WS_WOUT_T), T, DM, DM, DM, 128}; pg8::StaticOrder S; S.init(T, DM, gridDim.x, blockIdx.x); pg8::EpiWoutM e{p.x, (bf16_t*)(ws + WS_XB), (float*)(ws + WS_SSQ)};
      pg8::gemm_phase<pg8::EpiWoutM, pg8::StaticOrder, true, true>(ldsl, g, S, e); }
#endif
    BAR(); STAMP(6);
    { LOADP(p); unsigned char* ws = p.ws;
      pg8::Gemm g{(const bf16_t*)(ws + WS_XB), (const bf16_t*)(ws + WS_WQ_T), T, 2048, DM, 64, (size_t)T * 128}; pg8::StaticOrder S; S.init(T, 2048, gridDim.x, blockIdx.x); pg8::EpiQM e{(bf16_t*)(ws + WS_Q), 2048};
      pg8::gemm_phase<pg8::EpiQM, pg8::StaticOrder, true, true>(ldsl, g, S, e); }
#if PROBE_DBL == 9
    { LOADP(p); unsigned char* ws = p.ws;
      pg8::Gemm g{(const bf16_t*)(ws + WS_XB), (const bf16_t*)(ws + WS_WQ_T), T, 2048, DM, 64, (size_t)T * 128}; pg8::StaticOrder S; S.init(T, 2048, gridDim.x, blockIdx.x); pg8::EpiQM e{(bf16_t*)(ws + WS_Q), 2048};
      pg8::gemm_phase<pg8::EpiQM, pg8::StaticOrder, true, true>(ldsl, g, S, e); }
#endif
    BAR(); STAMP(7);
    { LOADP(p); REP(10) topk_mfma(p, lds); }
    BAR(); STAMP(8);
#define LOAD_SL(p) Sl sl; { const unsigned* ctl = (const unsigned*)(p.ws + WS_CTL); const int myrank = (int)((volatile unsigned*)lds)[36860]; const unsigned xcc = ((volatile unsigned*)lds)[36861]; \
      bool good = (gridDim.x % 8u) == 0u; \
      for (int j = 0; j < 8; ++j) good = good && (__hip_atomic_load(&ctl[64 * j], __ATOMIC_RELAXED, __HIP_MEMORY_SCOPE_AGENT) == gridDim.x / 8u); \
      if (good) { sl.vx = (int)xcc; sl.rank = myrank; sl.nrank = (int)(gridDim.x / 8u); } \
      else { sl.vx = (int)(blockIdx.x & 7u); sl.rank = (int)(blockIdx.x >> 3); sl.nrank = (int)((gridDim.x - (blockIdx.x & 7u) + 7u) / 8u); } }
    { LOADP(p); LOAD_SL(p); REP(11) peer_u_phase(p, sl); }
    BAR(); STAMP(9);
    { LOADP(p); REP(12) peer_w_phase(p); }
    BAR(); STAMP(10);
    if (PROBE_DBL == 100) { for (int i = 0; i < 10; ++i) BAR(); }
    { LOADP(p); LOAD_SL(p); peer_v_phase(p, sl); }
#if PROBE_SPIN >= 0
    __syncthreads(); STAMP(11);
    if (blockIdx.x == 0 && threadIdx.x == 0) {
        volatile LAS unsigned* tsw = (volatile LAS unsigned*)(LAS unsigned char*)lds + 36800;
        const int ia_ = (PROBE_SPIN == 14) ? 13 : PROBE_SPIN, ib_ = (PROBE_SPIN == 13) ? 0 : ((PROBE_SPIN == 14) ? 11 : PROBE_SPIN + 1);
        const unsigned long long t0 = (unsigned long long)tsw[2 * ia_] | ((unsigned long long)tsw[2 * ia_ + 1] << 32);
        const unsigned long long t1 = (unsigned long long)tsw[2 * ib_] | ((unsigned long long)tsw[2 * ib_ + 1] << 32);
        const unsigned long long until = __builtin_amdgcn_s_memrealtime() + (t1 - t0);
        while (__builtin_amdgcn_s_memrealtime() < until) __builtin_amdgcn_s_sleep(8);
    }
#endif
}

extern "C" void kernel_launch(void* const* d_in, const int* in_sizes, int n_in, void* d_out, int out_size, void* d_ws, size_t ws_size, hipStream_t stream) {
    static int grid_blocks = 0;
    if (grid_blocks == 0) {
        if (n_in != 17 || out_size != T * DM || ws_size < WS_END) { fprintf(stderr, "kernel_launch: unexpected shapes n_in %d out %d ws %zu\n", n_in, out_size, ws_size); grid_blocks = -1; return; }
        int dev = 0, cus = 0, per_cu = 0;
        (void)hipGetDevice(&dev);
        (void)hipDeviceGetAttribute(&cus, hipDeviceAttributeMultiprocessorCount, dev);
        (void)hipFuncSetAttribute((const void*)fwd_kernel, hipFuncAttributeMaxDynamicSharedMemorySize, LDS_BYTES);
        (void)hipOccupancyMaxActiveBlocksPerMultiprocessor(&per_cu, (const void*)fwd_kernel, NTHR, LDS_BYTES);
        if (per_cu < 1) { fprintf(stderr, "kernel_launch: occupancy query says %d blocks/CU\n", per_cu); per_cu = 1; }
        grid_blocks = cus * 1;
        (void)hipGetLastError();
    }
    if (grid_blocks < 0) return;
    Params p{};
    p.x = (const float*)d_in[0]; p.mem = (const float*)d_in[1]; p.g_mix = (const float*)d_in[2]; p.w_in = (const float*)d_in[3]; p.gamma_lb = (const float*)d_in[4];
    p.sb_gain = (const float*)d_in[5]; p.hg_gain = (const float*)d_in[6]; p.mem_gain = (const float*)d_in[7]; p.w_mkv = (const float*)d_in[8]; p.mq_gain = (const float*)d_in[9];
    p.mk_gain = (const float*)d_in[10]; p.w_out = (const float*)d_in[11]; p.g_ffn = (const float*)d_in[12]; p.w_q = (const float*)d_in[13]; p.sub_keys = (const float*)d_in[14];
    p.pu = (const float*)d_in[15]; p.pv = (const float*)d_in[16];
    p.out = (float*)d_out; p.ws = (unsigned char*)d_ws;
    void* args[] = {&p};
    hipError_t e = hipLaunchCooperativeKernel((const void*)fwd_kernel, dim3(grid_blocks), dim3(NTHR), args, LDS_BYTES, stream);
    if (e != hipSuccess) fprintf(stderr, "cooperative launch failed: %s (grid %d)\n", hipGetErrorString(e), grid_blocks);
}
```

```cpp
#include <hip/hip_runtime.h>
#include <hip/hip_cooperative_groups.h>
#include <cstdio>
#include <cstdint>
namespace cg = cooperative_groups;

constexpr int NB = 4, SEQ = 8192, DM = 1024, T = NB * SEQ;
constexpr int NMEM = 256, INW = 3328;
constexpr int C_SBQ = 0, C_SBK = 512, C_SBV = 1024, C_HGQ = 1536, C_HGF = 2048, C_HGI = 2560, C_HGG = 2816, C_MQ = 3072;
constexpr int NEXP = 16384, PK = 128;
constexpr float EPS = 1e-6f;
constexpr float LOG2E = 1.4426950408889634f;
constexpr float C2 = 0.125f * LOG2E;

constexpr float PEER_US = 64.f, PEER_VS = 8.f;
constexpr int NTHR = 512;
constexpr int LDS_BYTES = 147456;

constexpr size_t MiB = 1u << 20;
constexpr size_t WS_CTL = 0;
constexpr size_t WS_WIN_T = 1 * MiB;
constexpr size_t WS_WOUT_T = 8 * MiB;
constexpr size_t WS_WQ_T = 10 * MiB;
constexpr size_t WS_WMKV_T = 14 * MiB;
constexpr size_t WS_SKB = 15 * MiB;
constexpr size_t WS_LB = 15 * MiB + 512 * 1024;
constexpr size_t WS_MEMN = 16 * MiB;
constexpr size_t WS_MEMKV = 18 * MiB;
constexpr size_t WS_MEMK = 20 * MiB;
constexpr size_t WS_MEMV = 20 * MiB + 512 * 1024;
constexpr size_t WS_RSTD2 = 21 * MiB;
constexpr size_t WS_PIDX = 24 * MiB;
constexpr size_t WS_PG = 40 * MiB;
constexpr size_t WS_XB = 72 * MiB;
constexpr size_t WS_MIXED = 136 * MiB;
constexpr size_t WS_P = 200 * MiB;
constexpr size_t WS_Q = 136 * MiB;
constexpr size_t WS_X1S = 270 * MiB;
constexpr size_t WS_SSQ = 22 * MiB;
constexpr size_t WS_HGRAW = 408 * MiB;
constexpr size_t WS_PW = 56 * MiB;
constexpr size_t WS_PU = 136 * MiB;
constexpr size_t WS_U16 = 440 * MiB;
constexpr size_t WS_V16 = 472 * MiB;
constexpr size_t WS_END = 512 * MiB;

typedef unsigned short bf16_t;
__device__ __forceinline__ float bf2f(bf16_t v) { return __uint_as_float(((unsigned)v) << 16); }
__device__ __forceinline__ float bflo(unsigned w) { return __uint_as_float(w << 16); }
__device__ __forceinline__ float bfhi(unsigned w) { return __uint_as_float(w & 0xffff0000u); }
__device__ __forceinline__ bf16_t f2bf(float f) { unsigned u = __float_as_uint(f); return (bf16_t)((u + 0x7fffu + ((u >> 16) & 1u)) >> 16); }
__device__ __forceinline__ unsigned pk2(float lo, float hi) { return (unsigned)f2bf(lo) | ((unsigned)f2bf(hi) << 16); }
__device__ __forceinline__ float wave_sum(float v) {
#pragma unroll
    for (int o = 1; o < 64; o <<= 1) v += __shfl_xor(v, o);
    return v;
}
__device__ __forceinline__ float silu(float v) { return v / (1.f + __expf(-v)); }

typedef unsigned u4_t __attribute__((ext_vector_type(4)));
typedef float f32x4_t __attribute__((ext_vector_type(4)));
typedef float float2_t __attribute__((ext_vector_type(2)));
typedef _Float16 h8_t __attribute__((ext_vector_type(8)));
typedef _Float16 h2_t __attribute__((ext_vector_type(2)));
typedef _Float16 h4_t __attribute__((ext_vector_type(4)));
typedef unsigned u2_t __attribute__((ext_vector_type(2)));
typedef __bf16 bf16x2_v __attribute__((ext_vector_type(2)));
__device__ __forceinline__ float dot2bf(unsigned a, unsigned b, float c) { return __builtin_amdgcn_fdot2_f32_bf16(__builtin_bit_cast(bf16x2_v, a), __builtin_bit_cast(bf16x2_v, b), c, false); }

struct Params {
    const float *x, *mem, *g_mix, *w_in, *gamma_lb, *sb_gain, *hg_gain, *mem_gain, *w_mkv, *mq_gain, *mk_gain, *w_out, *g_ffn, *w_q, *sub_keys, *pu, *pv;
    float* out; unsigned char* ws;
};

namespace pg8 {
#define PG8_LAS __attribute__((address_space(3)))
typedef unsigned short bf16_t;
typedef short bf16x8 __attribute__((ext_vector_type(8)));
typedef float f32x4 __attribute__((ext_vector_type(4)));
typedef unsigned u32x4 __attribute__((ext_vector_type(4)));
constexpr int BM = 256, BK = 64, HALF = 128, HTB = HALF * BK * 2  , STAGE_BYTES = 8 * HTB, NXCD = 8, WGM = 8;

__host__ __device__ __forceinline__ int lds_byte(int r, int c) { const int st = (r >> 4) * 2 + (c >> 5), rr = r & 15, cc = c & 31, ob = rr * 64 + cc * 2; return st * 1024 + (ob ^ (((ob >> 9) & 1) << 5)); }
__host__ __device__ __forceinline__ void stage_rc(int b, int& R, int& C) { const int st = b / 1024, sb = b % 1024, swz = sb ^ (((sb >> 9) & 1) << 5); R = (st >> 1) * 16 + swz / 64; C = (st & 1) * 32 + (swz % 64) / 2; }
__host__ __device__ __forceinline__ int perm32(int rho) { const int n = rho >> 4, i = rho & 15; return 8 * (i >> 2) + 4 * n + (i & 3); }

struct Unit { int pm, pn; };
struct Gemm { const bf16_t* A; const bf16_t* Bt; int M, N, K; int lda; size_t kstepA; };

struct StaticOrder {
    int nM, nN, nwg, G, c;
    __host__ __device__ void init(int M, int N, int G_, int c_) { nM = M / BM; nN = N / BM; nwg = nM * nN; G = G_; c = c_; }
    __host__ __device__ bool next(int i, Unit& u) const {
        const long L = (long)i * G + c; if (L >= nwg) return false;
        int wgid = (int)L; { const int q = nwg / NXCD, r = nwg % NXCD, xcd = wgid % NXCD, off = wgid / NXCD; wgid = (xcd < r ? xcd * (q + 1) : r * (q + 1) + (xcd - r) * q) + off; }
        const int nig = WGM * nN, gid = wgid / nig, fm = gid * WGM, gsz = (nM - fm) < WGM ? (nM - fm) : WGM;
        u.pm = fm + ((wgid % nig) % gsz); u.pn = (wgid % nig) / gsz; return true;
    }
    __device__ __forceinline__ void a_ready(const Unit&) const {}
    __device__ __forceinline__ void done(const Unit&) const {}
};

typedef float cvf2_t __attribute__((ext_vector_type(2)));
typedef __bf16 cvb2_t __attribute__((ext_vector_type(2)));
__device__ __forceinline__ unsigned cvt_pk_bf16(float lo, float hi) { const cvf2_t v = {lo, hi}; const cvb2_t b = __builtin_convertvector(v, cvb2_t); return __builtin_bit_cast(unsigned, b); }
typedef float f32x2 __attribute__((ext_vector_type(2)));
template <class Epi, class Sched, bool ALIGN_EPI = false, bool SP2 = false>
__device__ __forceinline__ void gemm_phase(PG8_LAS unsigned char* lds, const Gemm g, const Sched& S, const Epi& E) {
    int tid_ = threadIdx.x; asm volatile("" : "+v"(tid_));
    const int tid = tid_, wid = __builtin_amdgcn_readfirstlane(tid >> 6), lane = tid & 63, wr = wid >> 2, wc = wid & 3, fr = lane & 15, fq = lane >> 4;
    const int K = g.K, nt = K / BK;
    unsigned voffA[2], voffB[2];
#pragma unroll
    for (int i = 0; i < 2; ++i) { int R, C; stage_rc(tid * 16 + i * 8192, R, C); const int Rb = Epi::PERM ? ((R & ~31) + perm32(R & 31)) : R;
        voffA[i] = (unsigned)(R * g.lda + C) * 2u; voffB[i] = (unsigned)(Rb * K + C) * 2u; }
    const size_t kstep = (size_t)(BK * 2);
    const size_t hstep = (size_t)HALF * K * 2;
    const size_t tstep = 2 * hstep;
    const size_t kstepA = g.kstepA, hstepA = (size_t)HALF * g.lda * 2, tstepA = 2 * hstepA;
    const unsigned ldsw = (unsigned)wid * 1024u;
    const int aoff = lds_byte(wr * 64 + fr, fq * 8), boff = lds_byte(wc * 32 + fr, fq * 8);
#define PG8_SA(b, h) (((b) * 2 + (h)) * HTB)
#define PG8_SB(b, h) ((4 + (b) * 2 + (h)) * HTB)
#define PG8_STAGE(bufoff, gbase, voff) do { _Pragma("unroll") for (int _i = 0; _i < 2; ++_i) \
        __builtin_amdgcn_global_load_lds((const unsigned*)((const char*)(gbase) + (voff)[_i]), (PG8_LAS unsigned*)(lds + (bufoff) + ldsw + _i * 8192), 16, 0, 0); } while (0)
#define PG8_LDA(dst, b, h) do { _Pragma("unroll") for (int m = 0; m < 4; ++m) _Pragma("unroll") for (int k = 0; k < 2; ++k) dst[m][k] = *(const PG8_LAS bf16x8*)(lds + PG8_SA(b, h) + aoff + m * 2048 + k * 1024); } while (0)
#define PG8_LDB(dst, b, h) do { _Pragma("unroll") for (int n = 0; n < 2; ++n) _Pragma("unroll") for (int k = 0; k < 2; ++k) dst[n][k] = *(const PG8_LAS bf16x8*)(lds + PG8_SB(b, h) + boff + n * 2048 + k * 1024); } while (0)
#define PG8_MMA(ai, bj, At, Bt) do { __builtin_amdgcn_s_setprio(1); _Pragma("unroll") for (int m = 0; m < 4; ++m) _Pragma("unroll") for (int n = 0; n < 2; ++n) _Pragma("unroll") for (int k = 0; k < 2; ++k) \
        acc[ai][bj][m][n] = __builtin_amdgcn_mfma_f32_16x16x32_bf16(Bt[n][k], At[m][k], acc[ai][bj][m][n], 0, 0, 0); __builtin_amdgcn_s_setprio(0); } while (0)
#define PG8_WAIT_V(n) asm volatile("s_waitcnt vmcnt(" #n ")" ::: "memory")
#define PG8_WAIT_L(n) asm volatile("s_waitcnt lgkmcnt(" #n ")" ::: "memory")
#define PG8_BAR __builtin_amdgcn_s_barrier()
#define PG8_SCHED __builtin_amdgcn_sched_barrier(0)
    Unit cur, nxt; int ui = 0;
    if (!S.next(0, cur)) return;
    f32x4 acc[2][2][4][2];
#pragma unroll
    for (int a = 0; a < 2; ++a)
#pragma unroll
        for (int b = 0; b < 2; ++b)
#pragma unroll
            for (int m = 0; m < 4; ++m)
#pragma unroll
                for (int n = 0; n < 2; ++n) acc[a][b][m][n] = (f32x4){0.f, 0.f, 0.f, 0.f};
    bf16x8 At[4][2], B0[2][2], B1[2][2];
    const char* cA = (const char*)g.A + (size_t)cur.pm * tstepA; const char* cB = (const char*)g.Bt + (size_t)cur.pn * tstep;
    S.a_ready(cur);
    if constexpr (SP2) {
        PG8_STAGE(PG8_SB(0, 0), cB, voffB); PG8_STAGE(PG8_SB(0, 1), cB + hstep, voffB); PG8_STAGE(PG8_SA(0, 0), cA, voffA); PG8_STAGE(PG8_SA(0, 1), cA + hstepA, voffA);
        if (wr == 1) PG8_BAR;
        PG8_WAIT_V(2); PG8_BAR;
        PG8_STAGE(PG8_SB(1, 0), cB + kstep, voffB); PG8_STAGE(PG8_SA(1, 0), cA + kstepA, voffA); PG8_STAGE(PG8_SB(1, 1), cB + hstep + kstep, voffB);
        PG8_WAIT_V(6); PG8_BAR;
    } else {
        PG8_STAGE(PG8_SB(0, 0), cB, voffB); PG8_STAGE(PG8_SA(0, 0), cA, voffA); PG8_STAGE(PG8_SB(0, 1), cB + hstep, voffB); PG8_STAGE(PG8_SA(0, 1), cA + hstepA, voffA);
        if (wr == 1) PG8_BAR;
        PG8_WAIT_V(4); PG8_BAR;
        PG8_STAGE(PG8_SB(1, 0), cB + kstep, voffB); PG8_STAGE(PG8_SA(1, 0), cA + kstepA, voffA); PG8_STAGE(PG8_SB(1, 1), cB + hstep + kstep, voffB);
        PG8_WAIT_V(6); PG8_BAR;
    }
    for (;;) {
        const bool has_next = S.next(ui + 1, nxt);
        const char* nA = has_next ? (const char*)g.A + (size_t)nxt.pm * tstepA : cA; const char* nB = has_next ? (const char*)g.Bt + (size_t)nxt.pn * tstep : cB;
        for (int t = 0; t < nt; t += 2) {
            const bool last = (t == nt - 2);
            const char* a1 = cA + (size_t)(t + 1) * kstepA;
            const char* a2 = last ? nA : cA + (size_t)(t + 2) * kstepA; const char* b2 = last ? nB : cB + (size_t)(t + 2) * kstep;
            const char* a3 = a2 + kstepA; const char* b3 = b2 + kstep;
            if (last && has_next) S.a_ready(nxt);
            if constexpr (SP2) {
            PG8_LDB(B0, 0, 0); PG8_LDB(B1, 0, 1); PG8_SCHED; PG8_LDA(At, 0, 0); PG8_STAGE(PG8_SA(1, 1), a1 + hstepA, voffA);
            PG8_WAIT_V(8); PG8_WAIT_L(0); PG8_BAR; PG8_MMA(0, 0, At, B0); PG8_MMA(0, 1, At, B1); PG8_BAR; PG8_SCHED;
            PG8_LDA(At, 0, 1); PG8_STAGE(PG8_SB(0, 0), b2, voffB); PG8_STAGE(PG8_SB(0, 1), b2 + hstep, voffB); PG8_STAGE(PG8_SA(0, 0), a2, voffA);
            PG8_WAIT_V(8); PG8_WAIT_L(0); PG8_BAR; PG8_MMA(1, 0, At, B0); PG8_MMA(1, 1, At, B1); PG8_BAR; PG8_SCHED;
            PG8_LDB(B0, 1, 0); PG8_LDB(B1, 1, 1); PG8_SCHED; PG8_LDA(At, 1, 0); PG8_STAGE(PG8_SA(0, 1), a2 + hstepA, voffA);
            PG8_WAIT_V(8); PG8_WAIT_L(0); PG8_BAR; PG8_MMA(0, 0, At, B0); PG8_MMA(0, 1, At, B1); PG8_BAR; PG8_SCHED;
            PG8_LDA(At, 1, 1); PG8_STAGE(PG8_SB(1, 0), b3, voffB); PG8_STAGE(PG8_SB(1, 1), b3 + hstep, voffB); PG8_STAGE(PG8_SA(1, 0), a3, voffA);
            PG8_WAIT_V(8); PG8_WAIT_L(0); PG8_BAR; PG8_MMA(1, 0, At, B0); PG8_MMA(1, 1, At, B1); PG8_BAR; PG8_SCHED;
            } else {
            PG8_LDB(B0, 0, 0); PG8_SCHED; PG8_LDA(At, 0, 0); PG8_STAGE(PG8_SA(1, 1), a1 + hstepA, voffA);
            PG8_WAIT_L(8); PG8_BAR; PG8_WAIT_L(0); PG8_MMA(0, 0, At, B0); PG8_BAR; PG8_SCHED;
            PG8_LDB(B1, 0, 1); PG8_STAGE(PG8_SB(0, 0), b2, voffB);
            PG8_BAR; PG8_WAIT_L(0); PG8_MMA(0, 1, At, B1); PG8_BAR;
            PG8_LDA(At, 0, 1); PG8_STAGE(PG8_SA(0, 0), a2, voffA);
            PG8_BAR; PG8_WAIT_L(0); PG8_MMA(1, 0, At, B0); PG8_BAR; PG8_SCHED;
            PG8_STAGE(PG8_SB(0, 1), b2 + hstep, voffB);
            PG8_WAIT_V(6); PG8_BAR; PG8_MMA(1, 1, At, B1); PG8_BAR;
            PG8_LDB(B0, 1, 0); PG8_SCHED; PG8_LDA(At, 1, 0); PG8_STAGE(PG8_SA(0, 1), a2 + hstepA, voffA);
            PG8_WAIT_L(8); PG8_BAR; PG8_WAIT_L(0); PG8_MMA(0, 0, At, B0); PG8_BAR; PG8_SCHED;
            PG8_LDB(B1, 1, 1); PG8_STAGE(PG8_SB(1, 0), b3, voffB);
            PG8_BAR; PG8_WAIT_L(0); PG8_MMA(0, 1, At, B1); PG8_BAR;
            PG8_LDA(At, 1, 1); PG8_STAGE(PG8_SA(1, 0), a3, voffA);
            PG8_BAR; PG8_WAIT_L(0); PG8_MMA(1, 0, At, B0); PG8_BAR; PG8_SCHED;
            PG8_STAGE(PG8_SB(1, 1), b3 + hstep, voffB);
            PG8_WAIT_V(6); PG8_BAR; PG8_MMA(1, 1, At, B1); PG8_BAR;
            }
        }
        if constexpr (ALIGN_EPI) { if (wr == 0) PG8_BAR; }
        if constexpr (!Epi::AFTER_DRAIN) { E(acc, cur, wr, wc, fr, fq); S.done(cur); }
        if (!has_next) break;
#pragma unroll
        for (int a = 0; a < 2; ++a)
#pragma unroll
            for (int b = 0; b < 2; ++b)
#pragma unroll
                for (int m = 0; m < 4; ++m)
#pragma unroll
                    for (int n = 0; n < 2; ++n) acc[a][b][m][n] = (f32x4){0.f, 0.f, 0.f, 0.f};
        cur = nxt; cA = nA; cB = nB; ++ui;
        if constexpr (ALIGN_EPI) { if (wr == 1) PG8_BAR; }
    }
    PG8_WAIT_V(0);
    if constexpr (!ALIGN_EPI) { if (wr == 0) PG8_BAR; }
    PG8_BAR;
    if constexpr (Epi::AFTER_DRAIN) { E.fused(acc, cur, wr, wc, fr, fq, lds, wid, lane); S.done(cur); }
#undef PG8_SA
#undef PG8_SB
#undef PG8_STAGE
#undef PG8_LDA
#undef PG8_LDB
#undef PG8_MMA
#undef PG8_WAIT_V
#undef PG8_WAIT_L
#undef PG8_BAR
#undef PG8_SCHED
}
}


namespace pg8 {
typedef unsigned u32x4 __attribute__((ext_vector_type(4)));
__device__ __forceinline__ float permf(float v, int addr) { return __int_as_float(__builtin_amdgcn_ds_bpermute(addr, __float_as_int(v))); }
__device__ __forceinline__ unsigned permu(unsigned v, int addr) { return (unsigned)__builtin_amdgcn_ds_bpermute(addr, (int)v); }
struct EpiProjM {
    static constexpr bool PERM = true, AFTER_DRAIN = false;
    bf16_t* P;
    __device__ __forceinline__ void operator()(const f32x4 (&acc)[2][2][4][2], const Unit& u, int wr, int wc, int fr, int fq) const {
        const int L = fr + 16 * fq, frp = L >> 2, fqp = L & 3, pa = 4 * (frp + 16 * fqp);
        const int row0 = u.pm * BM + wr * 64 + frp, col0 = u.pn * BM + wc * 32 + 8 * fqp;
        const int pn = u.pn; const int mode = (pn < 2) ? 1 : ((pn == 6 || pn == 7 || pn == 11) ? 2 : 0);
#pragma unroll
        for (int ai = 0; ai < 2; ++ai)
#pragma unroll
            for (int m = 0; m < 4; ++m) { bf16_t* rowp = P + (size_t)(row0 + ai * HALF + m * 16) * INW + col0;
#pragma unroll
                for (int bj = 0; bj < 2; ++bj) { f32x4 v0 = acc[ai][bj][m][0], v1 = acc[ai][bj][m][1];
                    if (mode == 1) { v0 = v0 * C2; v1 = v1 * C2; }
                    else if (mode == 2) {
#pragma unroll
                        for (int e = 0; e < 4; ++e) { v0[e] = silu(v0[e]); v1[e] = silu(v1[e]); } }
                    u32x4 w; w.x = permu(cvt_pk_bf16(v0[0], v0[1]), pa); w.y = permu(cvt_pk_bf16(v0[2], v0[3]), pa); w.z = permu(cvt_pk_bf16(v1[0], v1[1]), pa); w.w = permu(cvt_pk_bf16(v1[2], v1[3]), pa);
                    *(u32x4*)(rowp + bj * HALF) = w; } }
    }
};
struct EpiWoutM {
    static constexpr bool PERM = true, AFTER_DRAIN = false;
    const float* x; bf16_t* x1bs; float* ssq;
    __device__ __forceinline__ void operator()(const f32x4 (&acc)[2][2][4][2], const Unit& u, int wr, int wc, int fr, int fq) const {
        const int L = fr + 16 * fq, frp = L >> 2, fqp = L & 3, pa = 4 * (frp + 16 * fqp);
        const int row0 = u.pm * BM + wr * 64 + frp, col0 = u.pn * BM + wc * 32 + 8 * fqp;
#pragma unroll
        for (int ai = 0; ai < 2; ++ai)
#pragma unroll
            for (int m = 0; m < 4; ++m) { const int row = row0 + ai * HALF + m * 16; const size_t rb = (size_t)row * DM + col0; float sq = 0.f;
#pragma unroll
                for (int bj = 0; bj < 2; ++bj) { const size_t i = rb + bj * HALF;
                    const f32x4 x0 = *(const f32x4*)(x + i), x1 = *(const f32x4*)(x + i + 4);
                    f32x4 v0, v1;
#pragma unroll
                    for (int e = 0; e < 4; ++e) { v0[e] = permf(acc[ai][bj][m][0][e], pa) + x0[e]; v1[e] = permf(acc[ai][bj][m][1][e], pa) + x1[e]; }
                    sq += (v0[0] * v0[0] + v0[1] * v0[1]) + (v0[2] * v0[2] + v0[3] * v0[3]) + (v1[0] * v1[0] + v1[1] * v1[1]) + (v1[2] * v1[2] + v1[3] * v1[3]);
                    const int col = col0 + bj * HALF, s = (col >> 5) & 15, j = ((col >> 9) << 5) | (col & 31);
                    const size_t o = ((size_t)s * T + row) * 64 + j;
                    u32x4 w; w.x = cvt_pk_bf16(v0[0], v0[1]); w.y = cvt_pk_bf16(v0[2], v0[3]); w.z = cvt_pk_bf16(v1[0], v1[1]); w.w = cvt_pk_bf16(v1[2], v1[3]);
                    *(u32x4*)(x1bs + o) = w; }
                sq += __shfl_xor(sq, 1); sq += __shfl_xor(sq, 2);
                if (fqp == 0) ssq[(size_t)row * 16 + u.pn * 4 + wc] = sq; }
    }
};
struct EpiQM {
    static constexpr bool PERM = true, AFTER_DRAIN = false;
    bf16_t* Q; int ld;
    __device__ __forceinline__ void operator()(const f32x4 (&acc)[2][2][4][2], const Unit& u, int wr, int wc, int fr, int fq) const {
        const int L = fr + 16 * fq, frp = L >> 2, fqp = L & 3, pa = 4 * (frp + 16 * fqp);
        const int row0 = u.pm * BM + wr * 64 + frp, col0 = u.pn * BM + wc * 32 + 8 * fqp;
#pragma unroll
        for (int ai = 0; ai < 2; ++ai)
#pragma unroll
            for (int m = 0; m < 4; ++m) { const int row = row0 + ai * HALF + m * 16; bf16_t* rowp = Q + (size_t)row * ld + col0;
#pragma unroll
                for (int bj = 0; bj < 2; ++bj) { const f32x4 v0 = acc[ai][bj][m][0], v1 = acc[ai][bj][m][1];
                    u32x4 w; w.x = permu(cvt_pk_bf16(v0[0], v0[1]), pa); w.y = permu(cvt_pk_bf16(v0[2], v0[3]), pa); w.z = permu(cvt_pk_bf16(v1[0], v1[1]), pa); w.w = permu(cvt_pk_bf16(v1[2], v1[3]), pa);
                    *(u32x4*)(rowp + bj * HALF) = w; } }
    }
};
}

#define LAS __attribute__((address_space(3)))
#define XB_TMO      128
#define XB_XCNT(j)  (256  + 64 * (j))
#define XB_XSUB(j)  (1280 + 64 * (j))
#define XB_XGEN(j)  (2304 + 64 * (j))
#define XB_TOP      3328
#define XB_TOPGEN   3392
#define XCD_BAR_WORDS 3456
#define XB_SPIN_CAP (1u << 18)

__device__ __forceinline__ unsigned xb_ld(unsigned* p)              { return __hip_atomic_load(p, __ATOMIC_RELAXED, __HIP_MEMORY_SCOPE_AGENT); }
__device__ __forceinline__ unsigned xb_add(unsigned* p, unsigned v) { return __hip_atomic_fetch_add(p, v, __ATOMIC_RELAXED, __HIP_MEMORY_SCOPE_AGENT); }
__device__ __forceinline__ unsigned xb_xcc_id() { return (unsigned)__builtin_amdgcn_s_getreg((3 << 11) | 20) & 0xFu; }
#define XB_SPIN(cond, bar) do { unsigned _sp = 0; while (cond) { __builtin_amdgcn_s_sleep(1); \
    if ((++_sp & 255u) == 0u) { if (xb_ld(&(bar)[XB_TMO])) break; if (_sp > XB_SPIN_CAP) { atomicAdd(&(bar)[XB_TMO], 1u); break; } } } } while (0)

struct XcdBarrier {
    unsigned* bar; unsigned x;
    volatile LAS unsigned* st;
};

__device__ __forceinline__ XcdBarrier xcd_barrier_post(unsigned* bar, volatile LAS unsigned* st) {
    XcdBarrier b; b.bar = bar; b.x = xb_xcc_id(); b.st = st;
    if (threadIdx.x == 0) (void)xb_add(&bar[XB_XCNT(b.x)], 1u);
    return b;
}
__device__ __forceinline__ void xcd_barrier_complete(unsigned* bar, unsigned x, unsigned& nloc, unsigned& nx) {
    const unsigned G = gridDim.x * gridDim.y * gridDim.z;
    unsigned sum, cnt, mine, sp = 0u;
    for (;;) {
        sum = 0u; cnt = 0u; mine = 0u;
#pragma unroll
        for (unsigned j = 0; j < 16; ++j) { const unsigned c = xb_ld(&bar[XB_XCNT(j)]); sum += c; cnt += (c > 0u) ? 1u : 0u; mine = (j == x) ? c : mine; }
        if (sum == G) break;
        __builtin_amdgcn_s_sleep(1);
        if ((++sp & 255u) == 0u) { if (xb_ld(&bar[XB_TMO])) break; if (sp > XB_SPIN_CAP) { atomicAdd(&bar[XB_TMO], 1u); break; } }
    }
    nloc = mine > 0u ? mine : 1u; nx = cnt > 0u ? cnt : 1u;
}

__device__ __forceinline__ void xcd_barrier(const XcdBarrier& b) {
    asm volatile("s_waitcnt vmcnt(0)" ::: "memory");
    __syncthreads();
    if (threadIdx.x == 0) {
        unsigned* bar = b.bar;
        __builtin_amdgcn_s_waitcnt(0);
        unsigned nloc = b.st[0], nx = b.st[1];
        if (nloc == 0u) { xcd_barrier_complete(bar, b.x, nloc, nx); b.st[0] = nloc; b.st[1] = nx; }
        const unsigned old = xb_add(&bar[XB_XSUB(b.x)], 1u);
        const unsigned gen = old / nloc;
        if (old + 1u == (gen + 1u) * nloc) {
            __builtin_amdgcn_fence(__ATOMIC_RELEASE, "agent");
            asm volatile("s_waitcnt vmcnt(0)" ::: "memory");
            const unsigned og = xb_add(&bar[XB_TOP], 1u);
            const unsigned tg = og / nx;
            if (og + 1u == (tg + 1u) * nx) xb_add(&bar[XB_TOPGEN], 1u);
            else XB_SPIN(xb_ld(&bar[XB_TOPGEN]) == tg, bar);
            __builtin_amdgcn_fence(__ATOMIC_ACQUIRE, "agent");
            xb_add(&bar[XB_XGEN(b.x)], 1u);
            asm volatile("s_waitcnt vmcnt(0)" ::: "memory");
        } else {
            XB_SPIN(xb_ld(&bar[XB_XGEN(b.x)]) == gen, bar);
            __builtin_amdgcn_fence(__ATOMIC_ACQUIRE, "agent");
            asm volatile("s_waitcnt vmcnt(0)" ::: "memory");
        }
    }
    __syncthreads();
}

template <bool SLICEK = false> __device__ __forceinline__ void transpose_item(const float* W, const float* gain, int K, int N, bf16_t* WT, float* scr, int item, int lane) {
    const int nblk = N / 32, kb = item / nblk, nb = item % nblk, k0 = 64 * kb, n0 = 32 * nb;
#pragma unroll 16
    for (int i = 0; i < 32; ++i) { const int kk = 2 * i + (lane >> 5); const int ks = SLICEK ? ((kk >> 5) * 512 + 32 * kb + (kk & 31)) : (k0 + kk); float g = gain ? gain[ks] : 1.f; scr[kk * 33 + (lane & 31)] = W[(size_t)ks * N + n0 + (lane & 31)] * g; }
    __builtin_amdgcn_s_waitcnt(0); __builtin_amdgcn_wave_barrier();
    const int c = lane & 7;
#pragma unroll
    for (int j = 0; j < 4; ++j) { const int n = (lane >> 3) + 8 * j; const float* s = scr + (8 * c) * 33 + n;
        uint4 o; o.x = pk2(s[0 * 33], s[1 * 33]); o.y = pk2(s[2 * 33], s[3 * 33]); o.z = pk2(s[4 * 33], s[5 * 33]); o.w = pk2(s[6 * 33], s[7 * 33]);
        *(uint4*)(WT + (size_t)(n0 + n) * K + k0 + 8 * c) = o; }
    __builtin_amdgcn_s_waitcnt(0); __builtin_amdgcn_wave_barrier();
}
__device__ __forceinline__ void norm_row_to_bf16(const float* xrow, bf16_t* orow, int lane) {
    const float4* xr = (const float4*)xrow + lane;
    float4 v[4]; float s = 0.f;
#pragma unroll
    for (int j = 0; j < 4; ++j) { v[j] = xr[64 * j]; s += (v[j].x * v[j].x + v[j].y * v[j].y) + (v[j].z * v[j].z + v[j].w * v[j].w); }
    const float rstd = rsqrtf(wave_sum(s) * (1.f / DM) + EPS);
    unsigned long long* o8 = (unsigned long long*)orow + lane;
#pragma unroll
    for (int j = 0; j < 4; ++j) o8[64 * j] = (unsigned long long)pk2(v[j].x * rstd, v[j].y * rstd) | ((unsigned long long)pk2(v[j].z * rstd, v[j].w * rstd) << 32);
}
__device__ __forceinline__ void phase_prep(const Params& p, unsigned char* lds) {
    const int tid = threadIdx.x, lane = tid & 63, wave = tid >> 6;
    const int gw = blockIdx.x * 8 + wave, NGW = gridDim.x * 8;
    const int gt = blockIdx.x * NTHR + tid, NGT = gridDim.x * NTHR;
    unsigned char* ws = p.ws;
    float* scr = (float*)lds + wave * (64 * 33);
    constexpr int I_IN = (DM / 64) * (INW / 32), I_OUT = (DM / 64) * (DM / 32), I_Q = (DM / 64) * (2048 / 32), I_MKV = (DM / 64) * (512 / 32);
    for (int it = gw; it < I_IN + I_OUT + I_Q + I_MKV; it += NGW) {
        int r = it;
        if (r < I_IN) { transpose_item(p.w_in, p.g_mix, DM, INW, (bf16_t*)(ws + WS_WIN_T), scr, r, lane); continue; } r -= I_IN;
        if (r < I_OUT) { transpose_item(p.w_out, nullptr, DM, DM, (bf16_t*)(ws + WS_WOUT_T), scr, r, lane); continue; } r -= I_OUT;
        if (r < I_Q) { transpose_item<true>(p.w_q, p.g_ffn, DM, 2048, (bf16_t*)(ws + WS_WQ_T), scr, r, lane); continue; } r -= I_Q;
        transpose_item(p.w_mkv, p.mem_gain, DM, 512, (bf16_t*)(ws + WS_WMKV_T), scr, r, lane);
    }
    for (int m0 = gw * 4; m0 < T; m0 += NGW * 4) {
        f32x4_t v[4][4]; float s[4];
#pragma unroll
        for (int q = 0; q < 4; ++q) { const f32x4_t* xr = (const f32x4_t*)(p.x + (size_t)(m0 + q) * DM) + lane;
#pragma unroll
            for (int j = 0; j < 4; ++j) v[q][j] = __builtin_nontemporal_load(xr + 64 * j); }
#pragma unroll
        for (int q = 0; q < 4; ++q) { float a = 0.f;
#pragma unroll
            for (int j = 0; j < 4; ++j) a += (v[q][j][0] * v[q][j][0] + v[q][j][1] * v[q][j][1]) + (v[q][j][2] * v[q][j][2] + v[q][j][3] * v[q][j][3]);
            s[q] = a; }
#pragma unroll
        for (int o = 1; o < 64; o <<= 1) {
#pragma unroll
            for (int q = 0; q < 4; ++q) s[q] += __shfl_xor(s[q], o); }
#pragma unroll
        for (int q = 0; q < 4; ++q) { const float rstd = rsqrtf(s[q] * (1.f / DM) + EPS);
            unsigned long long* o8 = (unsigned long long*)((bf16_t*)(ws + WS_XB) + (size_t)(m0 + q) * DM) + lane;
#pragma unroll
            for (int j = 0; j < 4; ++j) o8[64 * j] = (unsigned long long)pk2(v[q][j][0] * rstd, v[q][j][1] * rstd) | ((unsigned long long)pk2(v[q][j][2] * rstd, v[q][j][3] * rstd) << 32); }
    }
    for (int m = gw; m < NB * NMEM; m += NGW) norm_row_to_bf16(p.mem + (size_t)m * DM, (bf16_t*)(ws + WS_MEMN) + (size_t)m * DM, lane);
    for (int i = gt; i < 8 * 2 * 128 * 128; i += NGT) ((bf16_t*)(ws + WS_SKB))[i] = f2bf(p.sub_keys[i]);
#pragma unroll 2
    for (int e = gw; e < NEXP; e += NGW) {
        const f32x4_t* up = (const f32x4_t*)(p.pu + (size_t)e * DM) + lane; const f32x4_t* vp = (const f32x4_t*)(p.pv + (size_t)e * DM) + lane; const f32x4_t* gp = (const f32x4_t*)p.g_ffn + lane;
        f32x4_t a[4], b[4];
#pragma unroll
        for (int q = 0; q < 4; ++q) { a[q] = __builtin_nontemporal_load(up + 64 * q); b[q] = __builtin_nontemporal_load(vp + 64 * q); }
#pragma unroll
        for (int q = 0; q < 4; ++q) { const f32x4_t g = gp[64 * q];
            int w = 0; w = __builtin_amdgcn_cvt_pk_fp8_f32(a[q][0] * g[0] * PEER_US, a[q][1] * g[1] * PEER_US, w, false); w = __builtin_amdgcn_cvt_pk_fp8_f32(a[q][2] * g[2] * PEER_US, a[q][3] * g[3] * PEER_US, w, true);
            int z = 0; z = __builtin_amdgcn_cvt_pk_fp8_f32(b[q][0] * PEER_VS, b[q][1] * PEER_VS, z, false); z = __builtin_amdgcn_cvt_pk_fp8_f32(b[q][2] * PEER_VS, b[q][3] * PEER_VS, z, true);
            const int s16 = (8 * q + (lane >> 3)) & 15, j = (q >> 1) * 32 + 4 * (lane & 7), S = s16 >> 1, jj = (s16 & 1) * 64 + j;
            *(unsigned*)(ws + WS_U16 + ((size_t)S * NEXP + e) * 128 + jj) = (unsigned)w;
            *(unsigned*)(ws + WS_V16 + ((size_t)S * NEXP + e) * 128 + jj) = (unsigned)z; }
    }
    for (int i = gt; i < 512; i += NGT) ((float*)(ws + WS_LB))[i] = 1.f / (1.f + expf(p.gamma_lb[512 + i] - p.gamma_lb[i]));
}

typedef float f32x16 __attribute__((ext_vector_type(16)));
typedef short sh8_t __attribute__((ext_vector_type(8)));
typedef float cvt_f32x2_t __attribute__((ext_vector_type(2)));
typedef __bf16 cvt_bf16x2_t __attribute__((ext_vector_type(2)));
__device__ __forceinline__ unsigned cvtpk(float lo, float hi) { const cvt_f32x2_t v = {lo, hi}; const cvt_bf16x2_t b = __builtin_convertvector(v, cvt_bf16x2_t); return __builtin_bit_cast(unsigned, b); }
__device__ __forceinline__ bf16_t cvt1(float x) { return (bf16_t)(cvtpk(x, x) & 0xffffu); }
__device__ __forceinline__ void mma32(f32x16& acc, const LAS bf16_t* A, int lda, const LAS bf16_t* Bt, int ldb, int K, int lane) {
    const int r = lane & 31, h = lane >> 5;
    const LAS bf16_t* ap = A + r * lda + 8 * h; const LAS bf16_t* bp = Bt + r * ldb + 8 * h;
    for (int k0 = 0; k0 < K; k0 += 16) {
        const sh8_t a = *(const LAS sh8_t*)(ap + k0), b = *(const LAS sh8_t*)(bp + k0);
        acc = __builtin_amdgcn_mfma_f32_32x32x16_bf16(a, b, acc, 0, 0, 0);
    }
}
__device__ __forceinline__ int crow(int r, int hh) { return (r & 3) + 8 * (r >> 2) + 4 * hh; }
constexpr size_t HG_LT = WS_XB;
constexpr size_t HG_SB = 408 * MiB;
constexpr size_t HG_DD = 456 * MiB;
__device__ __forceinline__ void hg_load_col(const bf16_t* P, int col0, int unit, int tid, bf16_t (&raw)[16]) {
    const int bh = unit >> 7, c = unit & 127, b_ = bh >> 2, h = bh & 3, rg = tid >> 7, k = tid & 127;
    const bf16_t* pr = P + ((size_t)b_ * SEQ + c * 64 + rg * 16) * INW + col0 + h * 128 + k;
#pragma unroll
    for (int i = 0; i < 16; ++i) raw[i] = pr[(size_t)i * INW];
}
__device__ __forceinline__ u4_t hg_load_v(const bf16_t* P, int unit, int tid) {
    const int bh = unit >> 7, c = unit & 127, b_ = bh >> 2, h = bh & 3;
    return *(const u4_t*)(P + ((size_t)b_ * SEQ + c * 64 + (tid >> 3)) * INW + C_HGI + h * 64 + (tid & 7) * 8);
}
__device__ __forceinline__ void hg_cols(const bf16_t (&fl)[16], float lb, LAS float* gs, int tid, float (&kk)[16], float (&bc)[16], float& bmid, float& blast) {
    const int rg = tid >> 7, k = tid & 127;
    float run = 0.f;
#pragma unroll
    for (int i = 0; i < 16; ++i) { const float kv = (1.f - lb) / (1.f + __expf(bf2f(fl[i]))); kk[i] = kv; run += __logf(1.f - kv); bc[i] = run; }
    gs[rg * 128 + k] = run;
    __syncthreads();
    const float g0 = gs[k], g1 = gs[128 + k], g2 = gs[256 + k], g3 = gs[384 + k];
    const float off = (rg > 0 ? g0 : 0.f) + (rg > 1 ? g1 : 0.f) + (rg > 2 ? g2 : 0.f);
#pragma unroll
    for (int i = 0; i < 16; ++i) bc[i] += off;
    bmid = g0 + g1; blast = (g0 + g1) + (g2 + g3);
}
__device__ __forceinline__ void hg_store_vt(LAS bf16_t* VT, int tid, const u4_t v) {
    const int s = tid >> 3, jq = tid & 7;
    LAS bf16_t* d = VT + (jq * 8) * 72 + s;
    d[0 * 72] = (bf16_t)(v.x & 0xffff); d[1 * 72] = (bf16_t)(v.x >> 16); d[2 * 72] = (bf16_t)(v.y & 0xffff); d[3 * 72] = (bf16_t)(v.y >> 16);
    d[4 * 72] = (bf16_t)(v.z & 0xffff); d[5 * 72] = (bf16_t)(v.z >> 16); d[6 * 72] = (bf16_t)(v.w & 0xffff); d[7 * 72] = (bf16_t)(v.w >> 16);
}
__device__ __forceinline__ void hg_local(const Params& p, unsigned char* ldsb) {
    const bf16_t* P = (const bf16_t*)(p.ws + WS_P); const float* lbp = (const float*)(p.ws + WS_LB);
    bf16_t* LT = (bf16_t*)((unsigned char*)p.ws + HG_LT); float* DD = (float*)((unsigned char*)p.ws + HG_DD);
    LAS unsigned char* l = (LAS unsigned char*)ldsb;
    LAS float* gs = (LAS float*)l; LAS bf16_t* KST = (LAS bf16_t*)(l + 2048); LAS bf16_t* VT = (LAS bf16_t*)(l + 20480);
    const int tid = threadIdx.x, lane = tid & 63, wave = tid >> 6, rg = tid >> 7, k = tid & 127;
    bf16_t flr[16]; u4_t vr;
    if ((int)blockIdx.x < 2048) { hg_load_col(P, C_HGF, blockIdx.x, tid, flr); vr = hg_load_v(P, blockIdx.x, tid); }
    for (int unit = blockIdx.x; unit < 2048; unit += gridDim.x) {
        const int bh = unit >> 7, h = bh & 3;
        float kk[16], bc[16], bmid, blast;
        hg_cols(flr, lbp[h * 128 + k], gs, tid, kk, bc, bmid, blast);
        const u4_t vcur = vr;
        { const int nu = unit + gridDim.x; if (nu < 2048) { hg_load_col(P, C_HGF, nu, tid, flr); vr = hg_load_v(P, nu, tid); } }
        { unsigned w[8];
#pragma unroll
          for (int i = 0; i < 8; ++i) w[i] = cvtpk(kk[2 * i] * __expf(blast - bc[2 * i]), kk[2 * i + 1] * __expf(blast - bc[2 * i + 1]));
          LAS u4_t* d = (LAS u4_t*)(KST + k * 72 + rg * 16);
          d[0] = (u4_t){w[0], w[1], w[2], w[3]}; d[1] = (u4_t){w[4], w[5], w[6], w[7]}; }
        hg_store_vt(VT, tid, vcur);
        if (tid < 128) DD[(size_t)unit * 128 + tid] = __expf(blast);
        __syncthreads();
        { const int ji = wave >> 2, ki = wave & 3;
          f32x16 acc;
#pragma unroll
          for (int r = 0; r < 16; ++r) acc[r] = 0.f;
          mma32(acc, VT + 32 * ji * 72, 72, KST + 32 * ki * 72, 72, 64, lane);
          bf16_t* o = LT + (size_t)unit * 8192 + 32 * ki + (lane & 31);
#pragma unroll
          for (int r = 0; r < 16; ++r) o[(size_t)(32 * ji + crow(r, lane >> 5)) * 128] = cvt1(acc[r]); }
        __syncthreads();
    }
}
__device__ __forceinline__ void hg_scan(const Params& p) {
    const bf16_t* LT = (const bf16_t*)((unsigned char*)p.ws + HG_LT); const float* DD = (const float*)((unsigned char*)p.ws + HG_DD);
    bf16_t* SB = (bf16_t*)((unsigned char*)p.ws + HG_SB);
    for (int gt = blockIdx.x * NTHR + threadIdx.x; gt < 16 * 8192; gt += gridDim.x * NTHR) {
        const int bh = gt >> 13, e = gt & 8191, k = e & 127;
        float S = 0.f;
#pragma unroll 8
        for (int c = 0; c < 128; ++c) { const size_t u = (size_t)bh * 128 + c;
            const float L = bf2f(LT[u * 8192 + e]), D = DD[u * 128 + k];
            SB[u * 8192 + e] = cvt1(S); S = fmaf(D, S, L); }
    }
}
__device__ __forceinline__ void hg_out(const Params& p, unsigned char* ldsb) {
    const bf16_t* P = (const bf16_t*)(p.ws + WS_P); const float* lbp = (const float*)(p.ws + WS_LB);
    const bf16_t* SB = (const bf16_t*)((unsigned char*)p.ws + HG_SB);
    bf16_t* mixed = (bf16_t*)(p.ws + WS_MIXED);
    LAS unsigned char* l = (LAS unsigned char*)ldsb;
    LAS float* gs = (LAS float*)l;
    LAS bf16_t* QT = (LAS bf16_t*)(l + 2048); LAS bf16_t* KT = (LAS bf16_t*)(l + 19456); LAS bf16_t* QI = (LAS bf16_t*)(l + 36864);
    LAS bf16_t* VT = (LAS bf16_t*)(l + 54272); LAS bf16_t* SC = (LAS bf16_t*)(l + 63488); LAS bf16_t* ST = (LAS bf16_t*)(l + 72704);
    LAS float* OB = (LAS float*)(l + 90112);
    const int tid = threadIdx.x, lane = tid & 63, wave = tid >> 6, rg = tid >> 7, k = tid & 127;
    bf16_t flr[16], qr[16]; u4_t vr, gr, sr[2];
#define HGO_LOAD(u_) { hg_load_col(P, C_HGF, (u_), tid, flr); hg_load_col(P, C_HGQ, (u_), tid, qr); vr = hg_load_v(P, (u_), tid); \
        { const int bh_ = (u_) >> 7, c_ = (u_) & 127; gr = *(const u4_t*)(P + ((size_t)(bh_ >> 2) * SEQ + c_ * 64 + (tid >> 3)) * INW + C_HGG + (bh_ & 3) * 64 + (tid & 7) * 8); } \
        sr[0] = *(const u4_t*)(SB + (size_t)(u_) * 8192 + tid * 8); sr[1] = *(const u4_t*)(SB + (size_t)(u_) * 8192 + tid * 8 + 4096); }
    if ((int)blockIdx.x < 2048) HGO_LOAD((int)blockIdx.x);
    for (int unit = blockIdx.x; unit < 2048; unit += gridDim.x) {
        const int bh = unit >> 7, c = unit & 127, b_ = bh >> 2, h = bh & 3;
        const size_t tok0 = (size_t)b_ * SEQ + c * 64;
        float kk[16], bc[16], bmid, blast;
        hg_cols(flr, lbp[h * 128 + k], gs, tid, kk, bc, bmid, blast);
        float qf_[16];
#pragma unroll
        for (int i = 0; i < 16; ++i) qf_[i] = bf2f(qr[i]);
        const u4_t vcur = vr, gv_ = gr, s0_ = sr[0], s1_ = sr[1];
        { const int nu = unit + gridDim.x; if (nu < 2048) HGO_LOAD(nu); }
        {
#pragma unroll
          for (int i = 0; i < 16; ++i) { const float q = qf_[i]; const int o = (rg * 16 + i) * 136 + k;
              QT[o] = cvt1(q * __expf(fminf(bc[i] - bmid, 40.f))); KT[o] = cvt1(kk[i] * __expf(fminf(bmid - bc[i], 40.f))); QI[o] = cvt1(q * __expf(bc[i])); } }
        hg_store_vt(VT, tid, vcur);
        { const int idx0 = tid * 8, idx1 = tid * 8 + 4096;
          *(LAS u4_t*)(ST + (idx0 >> 7) * 136 + (idx0 & 127)) = s0_; *(LAS u4_t*)(ST + (idx1 >> 7) * 136 + (idx1 & 127)) = s1_; }
        __syncthreads();
        if (wave < 4) { const int ti = wave >> 1, si = wave & 1;
            f32x16 acc;
#pragma unroll
            for (int r = 0; r < 16; ++r) acc[r] = 0.f;
            if (si <= ti) mma32(acc, QT + 32 * ti * 136, 136, KT + 32 * si * 136, 136, 128, lane);
            const int s = 32 * si + (lane & 31);
#pragma unroll
            for (int r = 0; r < 16; ++r) { const int t = 32 * ti + crow(r, lane >> 5); SC[t * 72 + s] = cvt1((s <= t) ? acc[r] : 0.f); } }
        __syncthreads();
        if (wave < 4) { const int ti = wave >> 1, ji = wave & 1;
            f32x16 acc;
#pragma unroll
            for (int r = 0; r < 16; ++r) acc[r] = 0.f;
            mma32(acc, SC + 32 * ti * 72, 72, VT + 32 * ji * 72, 72, 64, lane);
            mma32(acc, QI + 32 * ti * 136, 136, ST + 32 * ji * 136, 136, 128, lane);
            const int j = 32 * ji + (lane & 31);
#pragma unroll
            for (int r = 0; r < 16; ++r) OB[(32 * ti + crow(r, lane >> 5)) * 65 + j] = acc[r]; }
        __syncthreads();
        { const int t = tid >> 3, jq = tid & 7;
          float o[8]; float ss = 0.f;
#pragma unroll
          for (int e = 0; e < 8; ++e) { o[e] = OB[t * 65 + jq * 8 + e]; ss = fmaf(o[e], o[e], ss); }
          ss += __shfl_xor(ss, 1); ss += __shfl_xor(ss, 2); ss += __shfl_xor(ss, 4);
          const float r = rsqrtf(ss * (1.f / 64.f) + EPS);
          const u4_t gv = gv_;
          const float* gn = p.hg_gain + h * 64 + jq * 8;
          uint4 w; w.x = cvtpk(o[0] * r * gn[0] * bflo(gv.x), o[1] * r * gn[1] * bfhi(gv.x)); w.y = cvtpk(o[2] * r * gn[2] * bflo(gv.y), o[3] * r * gn[3] * bfhi(gv.y));
          w.z = cvtpk(o[4] * r * gn[4] * bflo(gv.z), o[5] * r * gn[5] * bfhi(gv.z)); w.w = cvtpk(o[6] * r * gn[6] * bflo(gv.w), o[7] * r * gn[7] * bfhi(gv.w));
          *(uint4*)(mixed + (tok0 + t) * DM + 512 + h * 64 + jq * 8) = w; }
        __syncthreads();
    }
#undef HGO_LOAD
}

__device__ __forceinline__ sh8_t frag8(const float (&x)[8]) { const u4_t w = {cvtpk(x[0], x[1]), cvtpk(x[2], x[3]), cvtpk(x[4], x[5]), cvtpk(x[6], x[7])}; return __builtin_bit_cast(sh8_t, w); }
__device__ __forceinline__ int kperm(int key) { return (key & 16) | ((key & 4) << 1) | ((key & 8) >> 1) | (key & 3); }
__device__ __forceinline__ void vt_store(LAS bf16_t* VT, int pitch, int d0, int pos, const u4_t v) {
    LAS bf16_t* d = VT + d0 * pitch + pos;
    d[0 * pitch] = (bf16_t)(v.x & 0xffff); d[1 * pitch] = (bf16_t)(v.x >> 16); d[2 * pitch] = (bf16_t)(v.y & 0xffff); d[3 * pitch] = (bf16_t)(v.y >> 16);
    d[4 * pitch] = (bf16_t)(v.z & 0xffff); d[5 * pitch] = (bf16_t)(v.z >> 16); d[6 * pitch] = (bf16_t)(v.w & 0xffff); d[7 * pitch] = (bf16_t)(v.w >> 16);
}
__device__ __forceinline__ void sb_mfma(const Params& p, unsigned char* ldsb) {
    const bf16_t* P = (const bf16_t*)(p.ws + WS_P);
    bf16_t* mixed = (bf16_t*)(p.ws + WS_MIXED);
    const int tid = threadIdx.x, lane = tid & 63, wave = tid >> 6, r = lane & 31, hh = lane >> 5;
    LAS bf16_t* KL = (LAS bf16_t*)ldsb + wave * (32 * 72 + 64 * 40);
    LAS bf16_t* VT = KL + 32 * 72;
    sh8_t mf[2];
#pragma unroll
    for (int ks = 0; ks < 2; ++ks)
#pragma unroll
        for (int e = 0; e < 8; ++e) { const int j = 16 * ks + 8 * (e >> 2) + 4 * hh + (e & 3); mf[ks][e] = (j > r) ? (short)0x3F80 : (short)0; }
    for (int u = blockIdx.x * 8 + wave; u < 32 * 256; u += gridDim.x * 8) {
        const int bh = u >> 8, qt = u & 255, b = bh >> 3, h = bh & 7;
        const size_t tok0 = (size_t)b * SEQ + qt * 32;
        sh8_t qf[4];
        { const bf16_t* qp = P + (tok0 + r) * INW + C_SBQ + h * 64 + 8 * hh;
#pragma unroll
          for (int ks = 0; ks < 4; ++ks) qf[ks] = *(const sh8_t*)(qp + 16 * ks); }
        f32x16 o0, o1;
#pragma unroll
        for (int i = 0; i < 16; ++i) { o0[i] = 0.f; o1[i] = 0.f; }
        float R = 0.f;
        u4_t kraw[4], vraw[4];
        { const bf16_t* kvp = P + ((size_t)b * SEQ + qt * 32 + (lane >> 3)) * INW + h * 64 + (lane & 7) * 8;
#pragma unroll
          for (int i = 0; i < 4; ++i) { kraw[i] = *(const u4_t*)(kvp + (size_t)(8 * i) * INW + C_SBK); vraw[i] = *(const u4_t*)(kvp + (size_t)(8 * i) * INW + C_SBV); } }
        for (int kt = qt; kt >= 0; --kt) {
#pragma unroll
            for (int i = 0; i < 4; ++i) { const int key = (lane >> 3) + 8 * i, dq = lane & 7;
                *(LAS u4_t*)(KL + key * 72 + dq * 8) = kraw[i];
                vt_store(VT, 40, dq * 8, kperm(key), vraw[i]); }
            { const int ktn = kt > 0 ? kt - 1 : 0;
              const bf16_t* kvp = P + ((size_t)b * SEQ + ktn * 32 + (lane >> 3)) * INW + h * 64 + (lane & 7) * 8;
#pragma unroll
              for (int i = 0; i < 4; ++i) { kraw[i] = *(const u4_t*)(kvp + (size_t)(8 * i) * INW + C_SBK); vraw[i] = *(const u4_t*)(kvp + (size_t)(8 * i) * INW + C_SBV); } }
            f32x16 z;
#pragma unroll
            for (int i = 0; i < 16; ++i) z[i] = 0.f;
#pragma unroll
            for (int ks = 0; ks < 4; ++ks) z = __builtin_amdgcn_mfma_f32_32x32x16_bf16(*(const LAS sh8_t*)(KL + r * 72 + 16 * ks + 8 * hh), qf[ks], z, 0, 0, 0);
            const bool diag = (kt == qt);
            float sp[16]; f32x16 la; float tot = 0.f;
#pragma unroll
            for (int i = 0; i < 16; ++i) { const float zz = z[i];
                float s = fmaxf(zz, 0.f) + __builtin_amdgcn_logf(1.f + __builtin_amdgcn_exp2f(-fabsf(zz)));
                const bool valid = !diag || (crow(i, hh) < r);
                la[i] = zz - s + R; s = valid ? s : 0.f; sp[i] = s; tot += s; }
            tot += __shfl_xor(tot, 32);
#pragma unroll
            for (int ks = 0; ks < 2; ++ks) {
                unsigned hi[4], lo[4];
#pragma unroll
                for (int e = 0; e < 4; ++e) { const float x0 = -sp[8 * ks + 2 * e], x1 = -sp[8 * ks + 2 * e + 1]; hi[e] = cvtpk(x0, x1); lo[e] = cvtpk(x0 - bflo(hi[e]), x1 - bfhi(hi[e])); }
                const u4_t hv = {hi[0], hi[1], hi[2], hi[3]}, lv = {lo[0], lo[1], lo[2], lo[3]};
                la = __builtin_amdgcn_mfma_f32_32x32x16_bf16(mf[ks], __builtin_bit_cast(sh8_t, hv), la, 0, 0, 0);
                la = __builtin_amdgcn_mfma_f32_32x32x16_bf16(mf[ks], __builtin_bit_cast(sh8_t, lv), la, 0, 0, 0);
            }
            sh8_t af[2];
#pragma unroll
            for (int ks = 0; ks < 2; ++ks) { float a[8];
#pragma unroll
                for (int e = 0; e < 8; ++e) { const int i = 8 * ks + e; const bool valid = !diag || (crow(i, hh) < r); a[e] = valid ? __builtin_amdgcn_exp2f(la[i]) : 0.f; }
                af[ks] = frag8(a); }
            R -= tot;
#pragma unroll
            for (int ks = 0; ks < 2; ++ks) {
                o0 = __builtin_amdgcn_mfma_f32_32x32x16_bf16(*(const LAS sh8_t*)(VT + r * 40 + 16 * ks + 8 * hh), af[ks], o0, 0, 0, 0);
                o1 = __builtin_amdgcn_mfma_f32_32x32x16_bf16(*(const LAS sh8_t*)(VT + (32 + r) * 40 + 16 * ks + 8 * hh), af[ks], o1, 0, 0, 0);
            }
            if (__all(R < -48.f)) break;
        }
        float ss = 0.f;
#pragma unroll
        for (int i = 0; i < 16; ++i) { ss = fmaf(o0[i], o0[i], ss); ss = fmaf(o1[i], o1[i], ss); }
        ss += __shfl_xor(ss, 32);
        const float rn = rsqrtf(ss * (1.f / 64.f) + EPS);
        bf16_t* op = mixed + (tok0 + r) * DM + h * 64 + 4 * hh;
        const float* gp = p.sb_gain + h * 64 + 4 * hh;
#pragma unroll
        for (int q4 = 0; q4 < 4; ++q4) {
            const float4 g0 = *(const float4*)(gp + 8 * q4), g1 = *(const float4*)(gp + 32 + 8 * q4);
            uint2 w0, w1;
            w0.x = cvtpk(o0[4 * q4] * rn * g0.x, o0[4 * q4 + 1] * rn * g0.y); w0.y = cvtpk(o0[4 * q4 + 2] * rn * g0.z, o0[4 * q4 + 3] * rn * g0.w);
            w1.x = cvtpk(o1[4 * q4] * rn * g1.x, o1[4 * q4 + 1] * rn * g1.y); w1.y = cvtpk(o1[4 * q4 + 2] * rn * g1.z, o1[4 * q4 + 3] * rn * g1.w);
            *(uint2*)(op + 8 * q4) = w0; *(uint2*)(op + 32 + 8 * q4) = w1;
        }
    }
}
__device__ __forceinline__ void mem_attn_mfma(const Params& p, unsigned char* ldsb) {
    const bf16_t* P = (const bf16_t*)(p.ws + WS_P);
    const bf16_t* kvb = (const bf16_t*)(p.ws + WS_MEMKV);
    bf16_t* mixed = (bf16_t*)(p.ws + WS_MIXED);
    const int tid = threadIdx.x, lane = tid & 63, wave = tid >> 6, r = lane & 31, hh = lane >> 5;
    LAS bf16_t* VT = (LAS bf16_t*)ldsb;
    LAS bf16_t* KN = VT + 64 * 264;
    for (int unit = blockIdx.x; unit < NB * 4 * (SEQ / 256); unit += gridDim.x) {
        const int tb = unit & 31, hd = (unit >> 5) & 3, b = unit >> 7;
        __syncthreads();
#pragma unroll
        for (int i = 0; i < 4; ++i) { const int idx = tid + 512 * i, key = idx >> 3, dq = idx & 7;
            const u4_t v = *(const u4_t*)(kvb + ((size_t)b * NMEM + key) * 512 + 256 + hd * 64 + dq * 8);
            vt_store(VT, 264, dq * 8, (key & ~31) | kperm(key & 31), v); }
        { const bf16_t* kp = kvb + ((size_t)b * NMEM + wave * 32 + r) * 512 + hd * 64 + 8 * hh;
          u4_t kw[4]; float ssk = 0.f;
#pragma unroll
          for (int ks = 0; ks < 4; ++ks) { kw[ks] = *(const u4_t*)(kp + 16 * ks);
#pragma unroll
              for (int e = 0; e < 4; ++e) { const float lo = bflo(kw[ks][e]), hi = bfhi(kw[ks][e]); ssk = fmaf(lo, lo, ssk); ssk = fmaf(hi, hi, ssk); } }
          ssk += __shfl_xor(ssk, 32);
          const float rk = rsqrtf(ssk * (1.f / 64.f) + EPS);
#pragma unroll
          for (int ks = 0; ks < 4; ++ks) { float t8[8];
#pragma unroll
              for (int e = 0; e < 4; ++e) { t8[2 * e] = bflo(kw[ks][e]) * rk; t8[2 * e + 1] = bfhi(kw[ks][e]) * rk; }
              *(LAS sh8_t*)(KN + (wave * 32 + r) * 72 + 16 * ks + 8 * hh) = frag8(t8); } }
        __syncthreads();
        const size_t tok = (size_t)b * SEQ + tb * 256 + wave * 32 + r;
        sh8_t qf[4];
        { const bf16_t* qp = P + tok * INW + C_MQ + hd * 64 + 8 * hh;
          float qv[32]; float ss = 0.f;
#pragma unroll
          for (int ks = 0; ks < 4; ++ks) { const u4_t w = *(const u4_t*)(qp + 16 * ks);
              qv[8 * ks] = bflo(w.x); qv[8 * ks + 1] = bfhi(w.x); qv[8 * ks + 2] = bflo(w.y); qv[8 * ks + 3] = bfhi(w.y); qv[8 * ks + 4] = bflo(w.z); qv[8 * ks + 5] = bfhi(w.z); qv[8 * ks + 6] = bflo(w.w); qv[8 * ks + 7] = bfhi(w.w); }
#pragma unroll
          for (int i = 0; i < 32; ++i) ss = fmaf(qv[i], qv[i], ss);
          ss += __shfl_xor(ss, 32);
          const float rq = rsqrtf(ss * (1.f / 64.f) + EPS) * (0.125f * LOG2E);
#pragma unroll
          for (int ks = 0; ks < 4; ++ks) { float t8[8];
#pragma unroll
              for (int e = 0; e < 8; ++e) t8[e] = qv[8 * ks + e] * rq * p.mq_gain[16 * ks + 8 * hh + e] * p.mk_gain[16 * ks + 8 * hh + e];
              qf[ks] = frag8(t8); } }
        f32x16 s[8];
#pragma unroll
        for (int kt = 0; kt < 8; ++kt) {
#pragma unroll
            for (int i = 0; i < 16; ++i) s[kt][i] = 0.f;
#pragma unroll
            for (int ks = 0; ks < 4; ++ks) s[kt] = __builtin_amdgcn_mfma_f32_32x32x16_bf16(*(const LAS sh8_t*)(KN + (kt * 32 + r) * 72 + 16 * ks + 8 * hh), qf[ks], s[kt], 0, 0, 0);
        }
        float mx = -1e30f;
#pragma unroll
        for (int kt = 0; kt < 8; ++kt)
#pragma unroll
            for (int i = 0; i < 16; ++i) mx = fmaxf(mx, s[kt][i]);
        mx = fmaxf(mx, __shfl_xor(mx, 32));
        float lsum = 0.f;
        f32x16 o0, o1;
#pragma unroll
        for (int i = 0; i < 16; ++i) { o0[i] = 0.f; o1[i] = 0.f; }
#pragma unroll
        for (int kt = 0; kt < 8; ++kt)
#pragma unroll
            for (int ks = 0; ks < 2; ++ks) { float a[8];
#pragma unroll
                for (int e = 0; e < 8; ++e) { a[e] = __builtin_amdgcn_exp2f(s[kt][8 * ks + e] - mx); lsum += a[e]; }
                const sh8_t af = frag8(a);
                o0 = __builtin_amdgcn_mfma_f32_32x32x16_bf16(*(const LAS sh8_t*)(VT + r * 264 + 32 * kt + 16 * ks + 8 * hh), af, o0, 0, 0, 0);
                o1 = __builtin_amdgcn_mfma_f32_32x32x16_bf16(*(const LAS sh8_t*)(VT + (32 + r) * 264 + 32 * kt + 16 * ks + 8 * hh), af, o1, 0, 0, 0); }
        lsum += __shfl_xor(lsum, 32);
        const float il = 1.f / lsum;
        bf16_t* op = mixed + tok * DM + 768 + hd * 64 + 4 * hh;
#pragma unroll
        for (int q4 = 0; q4 < 4; ++q4) {
            uint2 w0, w1;
            w0.x = cvtpk(o0[4 * q4] * il, o0[4 * q4 + 1] * il); w0.y = cvtpk(o0[4 * q4 + 2] * il, o0[4 * q4 + 3] * il);
            w1.x = cvtpk(o1[4 * q4] * il, o1[4 * q4 + 1] * il); w1.y = cvtpk(o1[4 * q4 + 2] * il, o1[4 * q4 + 3] * il);
            *(uint2*)(op + 8 * q4) = w0; *(uint2*)(op + 32 + 8 * q4) = w1;
        }
    }
}

__device__ __forceinline__ int tk_pack(float s, int payload, int mask) { const int b = __float_as_int(s); const int m = b ^ ((b >> 31) & 0x7fffffff); return (m & ~mask) | payload; }
__device__ __forceinline__ float tk_unpack(int key, int mask) { const int m = key & ~mask; return __int_as_float(m ^ ((m >> 31) & 0x7fffffff)); }
template <int N> __device__ __forceinline__ void bitonic_sort_desc(int (&v)[N]) {
#pragma unroll
    for (int k = 2; k <= N; k <<= 1)
#pragma unroll
        for (int j = k >> 1; j > 0; j >>= 1)
#pragma unroll
            for (int i = 0; i < N; ++i) { const int l = i ^ j; if (l > i) { const bool desc = ((i & k) == 0); const int a = v[i], b = v[l]; const int hi = max(a, b), lo = min(a, b); v[i] = desc ? hi : lo; v[l] = desc ? lo : hi; } }
}
__device__ __forceinline__ void merge_top16(int (&A)[16], const int (&B)[16]) {
#pragma unroll
    for (int i = 0; i < 16; ++i) A[i] = max(A[i], B[15 - i]);
#pragma unroll
    for (int j = 8; j > 0; j >>= 1)
#pragma unroll
        for (int i = 0; i < 16; ++i) { const int l = i ^ j; if (l > i) { const int a = A[i], b = A[l]; A[i] = max(a, b); A[l] = min(a, b); } }
}
__device__ __forceinline__ void top16_of_64(int (&g0)[16], int (&g1)[16], int (&g2)[16], int (&g3)[16]) {
    bitonic_sort_desc<16>(g0); bitonic_sort_desc<16>(g1); bitonic_sort_desc<16>(g2); bitonic_sort_desc<16>(g3);
    merge_top16(g0, g1); merge_top16(g2, g3); merge_top16(g0, g2);
}
__device__ __forceinline__ void topk_mfma(const Params& p, unsigned char* ldsb) {
    const bf16_t* Q = (const bf16_t*)(p.ws + WS_Q);
    const bf16_t* SK = (const bf16_t*)(p.ws + WS_SKB);
    unsigned short* pidx16 = (unsigned short*)(p.ws + WS_PIDX); float* pg = (float*)(p.ws + WS_PG);
    const float* ssq = (const float*)(p.ws + WS_SSQ); float* rs2 = (float*)(p.ws + WS_RSTD2);
    LAS unsigned char* l = (LAS unsigned char*)ldsb;
    LAS bf16_t* SKL = (LAS bf16_t*)l;
    const int tid = threadIdx.x, lane = tid & 63, wave = tid >> 6, r = lane & 31, hh = lane >> 5;
    LAS unsigned char* ib = l + 69632 + (wave * 64 + lane) * 36;
    int cur_h = -1;
    pg8::StaticOrder SO; SO.init(T, 2048, gridDim.x, blockIdx.x);
    pg8::Unit un;
    for (int ui = 0; ui < 8; ++ui) {
        const int uo = (ui < 4) ? 2 * ui : 2 * (ui - 4) + 1;
        if (!SO.next(uo, un)) continue;
        const int h = un.pn, tb = un.pm;
        if (h != cur_h) {
            __syncthreads();
#pragma unroll
            for (int it = 0; it < 8; ++it) { const int idx = tid + 512 * it, row = idx >> 4, cq = idx & 15;
                *(LAS u4_t*)(SKL + row * 136 + cq * 8) = *(const u4_t*)(SK + ((size_t)h * 256 + row) * 128 + cq * 8); }
            __syncthreads();
            cur_h = h;
        }
        const int tok = tb * 256 + wave * 32 + r;
        int sorted[2][16];
#pragma unroll
        for (int c = 0; c < 2; ++c) {
            sh8_t qf[8];
            { const sh8_t* qp = (const sh8_t*)(Q + (size_t)tok * 2048 + h * 256 + c * 128 + 8 * hh);
#pragma unroll
              for (int ks = 0; ks < 8; ++ks) qf[ks] = qp[2 * ks]; }
            int g[4][16];
#pragma unroll
            for (int mt = 0; mt < 4; ++mt) {
                f32x16 acc;
#pragma unroll
                for (int i = 0; i < 16; ++i) acc[i] = 0.f;
                const LAS bf16_t* ap = SKL + (c * 128 + 32 * mt + r) * 136 + 8 * hh;
#pragma unroll
                for (int ks = 0; ks < 8; ++ks) acc = __builtin_amdgcn_mfma_f32_32x32x16_bf16(*(const LAS sh8_t*)(ap + 16 * ks), qf[ks], acc, 0, 0, 0);
#pragma unroll
                for (int i = 0; i < 16; ++i) g[mt][i] = tk_pack(acc[i], (32 * mt + (i & 3) + 8 * (i >> 2)) | (hh << 2), 127);
            }
            top16_of_64(g[0], g[1], g[2], g[3]);
            int o[16];
#pragma unroll
            for (int i = 0; i < 16; ++i) o[i] = __shfl_xor(g[0][i], 32);
            merge_top16(g[0], o);
#pragma unroll
            for (int i = 0; i < 16; ++i) sorted[c][i] = g[0][i];
        }
#pragma unroll
        for (int c = 0; c < 2; ++c)
#pragma unroll
            for (int w = 0; w < 4; ++w)
                *(LAS unsigned*)(ib + c * 16 + w * 4) = (unsigned)(sorted[c][4 * w] & 127) | ((unsigned)(sorted[c][4 * w + 1] & 127) << 8) | ((unsigned)(sorted[c][4 * w + 2] & 127) << 16) | ((unsigned)(sorted[c][4 * w + 3] & 127) << 24);
        float av[16], bv[16];
#pragma unroll
        for (int i = 0; i < 16; ++i) { av[i] = tk_unpack(sorted[0][i], 127); bv[i] = tk_unpack(sorted[1][i], 127); }
        int cd[4][16];
        {
            int n = 0;
#pragma unroll
            for (int i = 0; i < 16; ++i)
#pragma unroll
                for (int j = 0; j < 16; ++j)
                    if ((i + 1) * (j + 1) <= 16) { cd[n >> 4][n & 15] = tk_pack(av[i] + bv[j], i * 16 + j, 255); ++n; }
#pragma unroll
            for (; n < 64; ++n) cd[n >> 4][n & 15] = (int)0x80000000;
        }
        top16_of_64(cd[0], cd[1], cd[2], cd[3]);
        float sv[16]; int ex[16];
        float rstd;
        { const f32x4_t* sp_ = (const f32x4_t*)(ssq + (size_t)tok * 16); const f32x4_t q0 = sp_[0], q1 = sp_[1], q2 = sp_[2], q3 = sp_[3];
          const float tot = ((q0[0] + q0[1]) + (q0[2] + q0[3])) + ((q1[0] + q1[1]) + (q1[2] + q1[3])) + ((q2[0] + q2[1]) + (q2[2] + q2[3])) + ((q3[0] + q3[1]) + (q3[2] + q3[3]));
          rstd = rsqrtf(tot * (1.f / DM) + EPS); if (h == 0 && hh == 0) rs2[tok] = rstd; }
        const float s0 = tk_unpack(cd[0][0], 255);
        float sum = 0.f;
#pragma unroll
        for (int q = 0; q < 16; ++q) { const int key = cd[0][q]; const int id = key & 255;
            const int ia = ib[id >> 4], ibx = ib[16 + (id & 15)];
            ex[q] = ia * 128 + ibx; sv[q] = __expf((tk_unpack(key, 255) - s0) * rstd); sum += sv[q]; }
        const float inv = 1.f / sum;
        if (hh == 0) { u4_t* d = (u4_t*)(pidx16 + (size_t)tok * PK + h * 16);
#pragma unroll
            for (int w = 0; w < 2; ++w) d[w] = (u4_t){(unsigned)ex[8 * w] | ((unsigned)ex[8 * w + 1] << 16), (unsigned)ex[8 * w + 2] | ((unsigned)ex[8 * w + 3] << 16), (unsigned)ex[8 * w + 4] | ((unsigned)ex[8 * w + 5] << 16), (unsigned)ex[8 * w + 6] | ((unsigned)ex[8 * w + 7] << 16)}; }
        else { float4* d = (float4*)(pg + (size_t)tok * PK + h * 16);
#pragma unroll
            for (int w = 0; w < 4; ++w) d[w] = make_float4(sv[4 * w] * inv, sv[4 * w + 1] * inv, sv[4 * w + 2] * inv, sv[4 * w + 3] * inv); }
    }
}

struct Sl { int vx, rank, nrank; };
__device__ __forceinline__ float dpp_xor1(float x) { return __int_as_float(__builtin_amdgcn_mov_dpp(__float_as_int(x), 0xB1, 0xF, 0xF, true)); }
__device__ __forceinline__ float dpp_xor2(float x) { return __int_as_float(__builtin_amdgcn_mov_dpp(__float_as_int(x), 0x4E, 0xF, 0xF, true)); }
__device__ __forceinline__ float dpp_ror8(float x) { return __int_as_float(__builtin_amdgcn_mov_dpp(__float_as_int(x), 0x128, 0xF, 0xF, true)); }
__device__ __forceinline__ float dpp_hmir(float x) { return __int_as_float(__builtin_amdgcn_mov_dpp(__float_as_int(x), 0x141, 0xF, 0xF, true)); }
__device__ __forceinline__ void peer_u_phase(const Params& p, const Sl sl) {
    const int lane = threadIdx.x & 63, wave = threadIdx.x >> 6, g8 = lane >> 3, c = lane & 7;
    const unsigned short* pidx = (const unsigned short*)(p.ws + WS_PIDX);
    const int per = (T + sl.nrank * 8 - 1) / (sl.nrank * 8), tbase = (sl.rank * 8 + wave) * per, stride = 1;
    const int nk = (tbase < T) ? ((T - tbase < per) ? (T - tbase) : per) : 0;
    const int S = sl.vx;
    const unsigned char* Ub = p.ws + WS_U16 + (size_t)S * NEXP * 128 + c * 16;
    const bf16_t* xbb = (const bf16_t*)(p.ws + WS_XB) + (size_t)(2 * S + (c >> 2)) * T * 64 + (c & 3) * 16;
    _Float16* PUs = (_Float16*)(p.ws + WS_PU) + (size_t)S * T * PK;
    if (nk == 0) return;
#define TK(k) (tbase + ((k) < nk ? (k) : nk - 1) * stride)
#define SBAR __builtin_amdgcn_sched_barrier(0)
#define U_LOAD_IDX(I, t) { const u4_t* ip_ = (const u4_t*)(pidx + (size_t)(t) * PK + g8 * 16); I[0] = *(ip_); I[1] = *(ip_ + 1); }
#define U_LOAD_H(H, t) { const u4_t* hp_ = (const u4_t*)(xbb + (size_t)(t) * 64); H[0] = *(hp_); H[1] = *(hp_ + 1); }
#define U_ISSUE(G, I) { const unsigned w0_ = I[(G) >> 1][(2 * (G)) & 3], w1_ = I[(G) >> 1][(2 * (G) + 1) & 3]; \
        rr[4 * (G)] = *(const u4_t*)(Ub + (size_t)(w0_ & 0xffffu) * 128); rr[4 * (G) + 1] = *(const u4_t*)(Ub + (size_t)(w0_ >> 16) * 128); \
        rr[4 * (G) + 2] = *(const u4_t*)(Ub + (size_t)(w1_ & 0xffffu) * 128); rr[4 * (G) + 3] = *(const u4_t*)(Ub + (size_t)(w1_ >> 16) * 128); }
#define U_DOT(G) { _Pragma("unroll") for (int i_ = 4 * (G); i_ < 4 * (G) + 4; ++i_) { float2_t a_ = {0.f, 0.f}; \
        _Pragma("unroll") for (int q_ = 0; q_ < 4; ++q_) { a_ = __builtin_amdgcn_cvt_pk_f32_fp8((int)rr[i_][q_], false) * X2[2 * q_] + a_; a_ = __builtin_amdgcn_cvt_pk_f32_fp8((int)rr[i_][q_], true) * X2[2 * q_ + 1] + a_; } \
        pr[i_] = a_.x + a_.y; } }
#define U_STEP(k, I1, I2, Hc, Hn) { float pr[16]; float2_t X2[8]; \
        _Pragma("unroll") for (int m_ = 0; m_ < 8; ++m_) { const unsigned hw_ = Hc[m_ >> 2][m_ & 3]; X2[m_] = (float2_t){bflo(hw_), bfhi(hw_)}; } \
        U_LOAD_IDX(I2, TK((k) + 2)); U_LOAD_H(Hn, TK((k) + 1)); SBAR; \
        U_DOT(0); SBAR; U_ISSUE(0, I1); SBAR; U_DOT(1); SBAR; U_ISSUE(1, I1); SBAR; U_DOT(2); SBAR; U_ISSUE(2, I1); SBAR; U_DOT(3); SBAR; U_ISSUE(3, I1); SBAR; \
        _Pragma("unroll") for (int j_ = 0; j_ < 8; ++j_) { const float keep_ = (c & 4) ? pr[j_ + 8] : pr[j_], send_ = (c & 4) ? pr[j_] : pr[j_ + 8]; pr[j_] = keep_ + dpp_hmir(send_); } \
        _Pragma("unroll") for (int j_ = 0; j_ < 4; ++j_) { const float keep_ = (c & 2) ? pr[j_ + 4] : pr[j_], send_ = (c & 2) ? pr[j_] : pr[j_ + 4]; pr[j_] = keep_ + dpp_xor2(send_); } \
        _Pragma("unroll") for (int j_ = 0; j_ < 2; ++j_) { const float keep_ = (c & 1) ? pr[j_ + 2] : pr[j_], send_ = (c & 1) ? pr[j_] : pr[j_ + 2]; pr[j_] = keep_ + dpp_xor1(send_); } \
        __builtin_nontemporal_store((h2_t){(_Float16)pr[0], (_Float16)pr[1]}, (h2_t*)(PUs + (size_t)TK(k) * PK + g8 * 16 + 2 * c)); }
    u4_t iA[2], iB[2], rr[16], hA[2], hB[2];
    U_LOAD_IDX(iA, TK(0)); U_LOAD_IDX(iB, TK(1)); U_LOAD_H(hA, TK(0)); SBAR;
    U_ISSUE(0, iA); SBAR; U_ISSUE(1, iA); SBAR; U_ISSUE(2, iA); SBAR; U_ISSUE(3, iA); SBAR;
    for (int k = 0; k < nk; k += 2) {
        U_STEP(k, iB, iA, hA, hB);
        if (k + 1 < nk) U_STEP(k + 1, iA, iB, hB, hA);
    }
#undef U_LOAD_IDX
#undef U_LOAD_H
#undef U_ISSUE
#undef U_DOT
#undef U_STEP
}
__device__ __forceinline__ void peer_w_phase(const Params& p) {
    const _Float16* PU = (const _Float16*)(p.ws + WS_PU); const float* pg = (const float*)(p.ws + WS_PG); const float* rs = (const float*)(p.ws + WS_RSTD2);
    _Float16* pw = (_Float16*)(p.ws + WS_PW);
    for (int i = blockIdx.x * NTHR + threadIdx.x; i < T * PK / 8; i += gridDim.x * NTHR) {
        float s[8];
#pragma unroll
        for (int e = 0; e < 8; ++e) s[e] = 0.f;
#pragma unroll
        for (int x = 0; x < 8; ++x) { const h8_t hv = *((const h8_t*)(PU + (size_t)x * T * PK) + i);
#pragma unroll
            for (int e = 0; e < 8; ++e) s[e] += (float)hv[e]; }
        const float r = rs[i >> 4] * (1.f / PEER_US);
        const f32x4_t g0 = *((const f32x4_t*)pg + 2 * i), g1 = *((const f32x4_t*)pg + 2 * i + 1);
        h8_t wv;
#pragma unroll
        for (int e = 0; e < 4; ++e) { const float a = s[e] * r, b = s[4 + e] * r;
            wv[e] = (_Float16)(g0[e] * (0.5f / PEER_VS) * a * (1.f + erff(a * 0.70710678118654752f))); wv[4 + e] = (_Float16)(g1[e] * (0.5f / PEER_VS) * b * (1.f + erff(b * 0.70710678118654752f))); }
        *((h8_t*)pw + i) = wv;
    }
}
__device__ __forceinline__ void peer_v_phase(const Params& p, const Sl sl) {
    const int lane = threadIdx.x & 63, wave = threadIdx.x >> 6, g8 = lane >> 3, c = lane & 7;
    const unsigned short* pidx = (const unsigned short*)(p.ws + WS_PIDX); const _Float16* pw = (const _Float16*)(p.ws + WS_PW);
    const int per = (T + sl.nrank * 8 - 1) / (sl.nrank * 8), tbase = (sl.rank * 8 + wave) * per, stride = 1;
    const int nk = (tbase < T) ? ((T - tbase < per) ? (T - tbase) : per) : 0;
    const int S = sl.vx;
    const unsigned char* Vb = p.ws + WS_V16 + (size_t)S * NEXP * 128 + c * 16;
    const int jj = 16 * c + 2 * g8, s16 = 2 * S + (jj >> 6), j = jj & 63;
    float* ob = p.out + (j >> 5) * 512 + 32 * s16 + (j & 31);
    const bf16_t* xs = (const bf16_t*)(p.ws + WS_XB) + (size_t)s16 * T * 64 + j;
    if (nk == 0) return;
#define V_LOAD_IDX(I, t) { const u4_t* ip_ = (const u4_t*)(pidx + (size_t)(t) * PK + g8 * 16); I[0] = *(ip_); I[1] = *(ip_ + 1); }
#define V_LOAD_W(W, t) { const h8_t* wp_ = (const h8_t*)(pw + (size_t)(t) * PK + g8 * 16); W[0] = *(wp_); W[1] = *(wp_ + 1); }
#define V_ISSUE(G, I) { const unsigned w0_ = I[(G) >> 1][(2 * (G)) & 3], w1_ = I[(G) >> 1][(2 * (G) + 1) & 3]; \
        rr[4 * (G)] = *(const u4_t*)(Vb + (size_t)(w0_ & 0xffffu) * 128); rr[4 * (G) + 1] = *(const u4_t*)(Vb + (size_t)(w0_ >> 16) * 128); \
        rr[4 * (G) + 2] = *(const u4_t*)(Vb + (size_t)(w1_ & 0xffffu) * 128); rr[4 * (G) + 3] = *(const u4_t*)(Vb + (size_t)(w1_ >> 16) * 128); }
#define V_FMA(G, W) { _Pragma("unroll") for (int i_ = 4 * (G); i_ < 4 * (G) + 4; ++i_) { const float wv_ = (float)W[i_ >> 3][i_ & 7]; const float2_t ww_ = {wv_, wv_}; \
        _Pragma("unroll") for (int q_ = 0; q_ < 4; ++q_) { acc2[2 * q_] = __builtin_amdgcn_cvt_pk_f32_fp8((int)rr[i_][q_], false) * ww_ + acc2[2 * q_]; acc2[2 * q_ + 1] = __builtin_amdgcn_cvt_pk_f32_fp8((int)rr[i_][q_], true) * ww_ + acc2[2 * q_ + 1]; } } }
#define V_STEP(k, I1, I2, Wc, Wn) { float2_t acc2[8]; \
        _Pragma("unroll") for (int k_ = 0; k_ < 8; ++k_) acc2[k_] = (float2_t){0.f, 0.f}; \
        const unsigned oold_ = *((const unsigned*)(xs + (size_t)TK(k) * 64)); \
        V_LOAD_IDX(I2, TK((k) + 2)); V_LOAD_W(Wn, TK((k) + 1)); SBAR; \
        V_FMA(0, Wc); SBAR; V_ISSUE(0, I1); SBAR; V_FMA(1, Wc); SBAR; V_ISSUE(1, I1); SBAR; V_FMA(2, Wc); SBAR; V_ISSUE(2, I1); SBAR; V_FMA(3, Wc); SBAR; V_ISSUE(3, I1); SBAR; \
        float a_[16]; \
        _Pragma("unroll") for (int k_ = 0; k_ < 8; ++k_) { a_[2 * k_] = acc2[k_].x; a_[2 * k_ + 1] = acc2[k_].y; } \
        _Pragma("unroll") for (int j_ = 0; j_ < 8; ++j_) { const float keep_ = (g8 & 4) ? a_[j_ + 8] : a_[j_], send_ = (g8 & 4) ? a_[j_] : a_[j_ + 8]; a_[j_] = keep_ + __shfl_xor(send_, 32); } \
        _Pragma("unroll") for (int j_ = 0; j_ < 4; ++j_) { const float keep_ = (g8 & 2) ? a_[j_ + 4] : a_[j_], send_ = (g8 & 2) ? a_[j_] : a_[j_ + 4]; a_[j_] = keep_ + __shfl_xor(send_, 16); } \
        _Pragma("unroll") for (int j_ = 0; j_ < 2; ++j_) { const float keep_ = (g8 & 1) ? a_[j_ + 2] : a_[j_], send_ = (g8 & 1) ? a_[j_] : a_[j_ + 2]; a_[j_] = keep_ + dpp_ror8(send_); } \
        __builtin_nontemporal_store((float2_t){bflo(oold_) + a_[0], bfhi(oold_) + a_[1]}, (float2_t*)(ob + (size_t)TK(k) * DM)); }
    u4_t iA[2], iB[2], rr[16]; h8_t wA[2], wB[2];
    V_LOAD_IDX(iA, TK(0)); V_LOAD_IDX(iB, TK(1)); V_LOAD_W(wA, TK(0)); SBAR;
    V_ISSUE(0, iA); SBAR; V_ISSUE(1, iA); SBAR; V_ISSUE(2, iA); SBAR; V_ISSUE(3, iA); SBAR;
    for (int k = 0; k < nk; k += 2) {
        V_STEP(k, iB, iA, wA, wB);
        if (k + 1 < nk) V_STEP(k + 1, iA, iB, wB, wA);
    }
#undef V_LOAD_IDX
#undef V_LOAD_W
#undef V_ISSUE
#undef V_FMA
#undef V_STEP
#undef TK
#undef SBAR
}

#ifndef PROBE_DBL
#define PROBE_DBL -1
#endif
#define REP(k) for (int rep_ = 0; rep_ < ((PROBE_DBL == (k)) ? 2 : 1); ++rep_)
typedef const __attribute__((address_space(4))) Params* KArgs;
#if defined(__HIP_DEVICE_COMPILE__)
#define LOADP(P) KArgs kq_ = (KArgs)__builtin_amdgcn_kernarg_segment_ptr(); asm volatile("" : "+s"(kq_)); Params P; __builtin_memcpy(&P, kq_, sizeof(Params))
#define BAR_WS() ((unsigned char*)((KArgs)__builtin_amdgcn_kernarg_segment_ptr())->ws)
#else
#define LOADP(P) const Params P = p_unused
#define BAR_WS() (p_unused.ws)
#endif
#ifndef PROBE_SPIN
#define PROBE_SPIN -1
#endif
#if PROBE_SPIN >= 0
#define STAMP(k) do { if (threadIdx.x == 0) { const unsigned long long t_ = __builtin_amdgcn_s_memrealtime(); ((volatile LAS unsigned*)(LAS unsigned char*)lds)[36800 + 2 * (k)] = (unsigned)t_; ((volatile LAS unsigned*)(LAS unsigned char*)lds)[36801 + 2 * (k)] = (unsigned)(t_ >> 32); } } while (0)
#else
#define STAMP(k) do { } while (0)
#endif
#define BAR() do { XcdBarrier xb_; xb_.bar = (unsigned*)(BAR_WS() + WS_CTL) + 4096; xb_.x = ((volatile LAS unsigned*)(LAS unsigned char*)lds)[36861]; xb_.st = (volatile LAS unsigned*)(LAS unsigned char*)lds + 36862; xcd_barrier(xb_); } while (0)
__global__ void __launch_bounds__(NTHR, 2) fwd_kernel(Params p_unused) {
    extern __shared__ __attribute__((aligned(16))) unsigned char lds[];
    PG8_LAS unsigned char* ldsl = (PG8_LAS unsigned char*)lds;
    STAMP(13);
    { LOADP(p);
      if (blockIdx.x == 0) { unsigned* ctl0 = (unsigned*)(p.ws + WS_CTL); for (int i = threadIdx.x; i < 16384; i += NTHR) ctl0[i] = 0u; }
      if (threadIdx.x < 2) ((volatile LAS unsigned*)(LAS unsigned char*)lds)[36862 + threadIdx.x] = 0u; }
    { cg::grid_group grid = cg::this_grid(); grid.sync(); }
    { LOADP(p);
      if (threadIdx.x == 0) { unsigned* ctl0 = (unsigned*)(p.ws + WS_CTL); const unsigned xcc0 = (unsigned)__builtin_amdgcn_s_getreg((3 << 11) | 20) & 7u;
        ((volatile unsigned*)lds)[36860] = __hip_atomic_fetch_add(&ctl0[64 * xcc0], 1u, __ATOMIC_RELAXED, __HIP_MEMORY_SCOPE_AGENT); ((volatile unsigned*)lds)[36861] = xcc0;
        (void)xb_add(&(ctl0 + 4096)[XB_XCNT(xcc0)], 1u); }
      __syncthreads(); }
    STAMP(0);
    { LOADP(p); REP(0) phase_prep(p, lds); }
    BAR(); STAMP(1);
    { LOADP(p); unsigned char* ws = p.ws;
      pg8::Gemm g{(const bf16_t*)(ws + WS_XB), (const bf16_t*)(ws + WS_WIN_T), T, INW, DM, DM, 128}; pg8::StaticOrder S; S.init(T, INW, gridDim.x, blockIdx.x); pg8::EpiProjM e{(bf16_t*)(ws + WS_P)};
      pg8::gemm_phase<pg8::EpiProjM, pg8::StaticOrder, true, true>(ldsl, g, S, e); }
    { LOADP(p); unsigned char* ws = p.ws;
      pg8::Gemm g{(const bf16_t*)(ws + WS_MEMN), (const bf16_t*)(ws + WS_WMKV_T), NB * NMEM, 512, DM, DM, 128}; pg8::StaticOrder S; S.init(NB * NMEM, 512, gridDim.x, (blockIdx.x + gridDim.x / 2) % gridDim.x); pg8::EpiQM e{(bf16_t*)(ws + WS_MEMKV), 512};
      pg8::gemm_phase<pg8::EpiQM, pg8::StaticOrder, true, true>(ldsl, g, S, e); }
    BAR(); STAMP(2);
    { LOADP(p); REP(2) { sb_mfma(p, lds); __syncthreads(); } REP(3) { hg_local(p, lds); } REP(5) mem_attn_mfma(p, lds); }
    BAR(); STAMP(3);
    { LOADP(p); REP(4) hg_scan(p); }
    BAR(); STAMP(4);
    { LOADP(p); REP(6) hg_out(p, lds); }
    BAR(); STAMP(5);
    { LOADP(p); unsigned char* ws = p.ws;
      pg8::Gemm g{(const bf16_t*)(ws + WS_MIXED), (const bf16_t*)(ws + WS_WOUT_T), T, DM, DM, DM, 128}; pg8::StaticOrder S; S.init(T, DM, gridDim.x, blockIdx.x); pg8::EpiWoutM e{p.x, (bf16_t*)(ws + WS_XB), (float*)(ws + WS_SSQ)};
      pg8::gemm_phase<pg8::EpiWoutM, pg8::StaticOrder, true, true>(ldsl, g, S, e); }
#if PROBE_DBL == 7
    { LOADP(p); unsigned char* ws = p.ws;
      pg8::Gemm g{(const bf16_t*)(ws + WS_MIXED), (const bf16_t*)(ws + WS_WOUT_T), T, DM, DM, DM, 128}; pg8::StaticOrder S; S.init(T, DM, gridDim.x, blockIdx.x); pg8::EpiWoutM e{p.x, (bf16_t*)(ws + WS_XB), (float*)(ws + WS_SSQ)};
      pg8::gemm_phase<pg8::EpiWoutM, pg8::StaticOrder, true, true>(ldsl, g, S, e); }
#endif
    BAR(); STAMP(6);
    { LOADP(p); unsigned char* ws = p.ws;
      pg8::Gemm g{(const bf16_t*)(ws + WS_XB), (const bf16_t*)(ws + WS_WQ_T), T, 2048, DM, 64, (size_t)T * 128}; pg8::StaticOrder S; S.init(T, 2048, gridDim.x, blockIdx.x); pg8::EpiQM e{(bf16_t*)(ws + WS_Q), 2048};
      pg8::gemm_phase<pg8::EpiQM, pg8::StaticOrder, true, true>(ldsl, g, S, e); }
#if PROBE_DBL == 9
    { LOADP(p); unsigned char* ws = p.ws;
      pg8::Gemm g{(const bf16_t*)(ws + WS_XB), (const bf16_t*)(ws + WS_WQ_T), T, 2048, DM, 64, (size_t)T * 128}; pg8::StaticOrder S; S.init(T, 2048, gridDim.x, blockIdx.x); pg8::EpiQM e{(bf16_t*)(ws + WS_Q), 2048};
      pg8::gemm_phase<pg8::EpiQM, pg8::StaticOrder, true, true>(ldsl, g, S, e); }
#endif
    { LOADP(p); __builtin_amdgcn_s_waitcnt(0); __syncthreads(); topk_mfma(p, lds); }
    BAR(); STAMP(8);
#define LOAD_SL(p) Sl sl; { const unsigned* ctl = (const unsigned*)(p.ws + WS_CTL); const int myrank = (int)((volatile unsigned*)lds)[36860]; const unsigned xcc = ((volatile unsigned*)lds)[36861]; \
      bool good = (gridDim.x % 8u) == 0u; \
      for (int j = 0; j < 8; ++j) good = good && (__hip_atomic_load(&ctl[64 * j], __ATOMIC_RELAXED, __HIP_MEMORY_SCOPE_AGENT) == gridDim.x / 8u); \
      if (good) { sl.vx = (int)xcc; sl.rank = myrank; sl.nrank = (int)(gridDim.x / 8u); } \
      else { sl.vx = (int)(blockIdx.x & 7u); sl.rank = (int)(blockIdx.x >> 3); sl.nrank = (int)((gridDim.x - (blockIdx.x & 7u) + 7u) / 8u); } }
    { LOADP(p); LOAD_SL(p); REP(11) peer_u_phase(p, sl); }
    BAR(); STAMP(9);
    { LOADP(p); REP(12) peer_w_phase(p); }
    BAR(); STAMP(10);
    if (PROBE_DBL == 100) { for (int i = 0; i < 10; ++i) BAR(); }
    { LOADP(p); LOAD_SL(p); peer_v_phase(p, sl); }
#if PROBE_SPIN >= 0
    __syncthreads(); STAMP(11);
    if (blockIdx.x == 0 && threadIdx.x == 0) {
        volatile LAS unsigned* tsw = (volatile LAS unsigned*)(LAS unsigned char*)lds + 36800;
        const int ia_ = (PROBE_SPIN == 14) ? 13 : PROBE_SPIN, ib_ = (PROBE_SPIN == 13) ? 0 : ((PROBE_SPIN == 14) ? 11 : PROBE_SPIN + 1);
        const unsigned long long t0 = (unsigned long long)tsw[2 * ia_] | ((unsigned long long)tsw[2 * ia_ + 1] << 32);
        const unsigned long long t1 = (unsigned long long)tsw[2 * ib_] | ((unsigned long long)tsw[2 * ib_ + 1] << 32);
        const unsigned long long until = __builtin_amdgcn_s_memrealtime() + (t1 - t0);
        while (__builtin_amdgcn_s_memrealtime() < until) __builtin_amdgcn_s_sleep(8);
    }
#endif
}

extern "C" void kernel_launch(void* const* d_in, const int* in_sizes, int n_in, void* d_out, int out_size, void* d_ws, size_t ws_size, hipStream_t stream) {
    static int grid_blocks = 0;
    if (grid_blocks == 0) {
        if (n_in != 17 || out_size != T * DM || ws_size < WS_END) { fprintf(stderr, "kernel_launch: unexpected shapes n_in %d out %d ws %zu\n", n_in, out_size, ws_size); grid_blocks = -1; return; }
        int dev = 0, cus = 0, per_cu = 0;
        (void)hipGetDevice(&dev);
        (void)hipDeviceGetAttribute(&cus, hipDeviceAttributeMultiprocessorCount, dev);
        (void)hipFuncSetAttribute((const void*)fwd_kernel, hipFuncAttributeMaxDynamicSharedMemorySize, LDS_BYTES);
        (void)hipOccupancyMaxActiveBlocksPerMultiprocessor(&per_cu, (const void*)fwd_kernel, NTHR, LDS_BYTES);
        if (per_cu < 1) { fprintf(stderr, "kernel_launch: occupancy query says %d blocks/CU\n", per_cu); per_cu = 1; }
        grid_blocks = cus * 1;
        (void)hipGetLastError();
    }
    if (grid_blocks < 0) return;
    Params p{};
    p.x = (const float*)d_in[0]; p.mem = (const float*)d_in[1]; p.g_mix = (const float*)d_in[2]; p.w_in = (const float*)d_in[3]; p.gamma_lb = (const float*)d_in[4];
    p.sb_gain = (const float*)d_in[5]; p.hg_gain = (const float*)d_in[6]; p.mem_gain = (const float*)d_in[7]; p.w_mkv = (const float*)d_in[8]; p.mq_gain = (const float*)d_in[9];
    p.mk_gain = (const float*)d_in[10]; p.w_out = (const float*)d_in[11]; p.g_ffn = (const float*)d_in[12]; p.w_q = (const float*)d_in[13]; p.sub_keys = (const float*)d_in[14];
    p.pu = (const float*)d_in[15]; p.pv = (const float*)d_in[16];
    p.out = (float*)d_out; p.ws = (unsigned char*)d_ws;
    void* args[] = {&p};
    hipError_t e = hipLaunchCooperativeKernel((const void*)fwd_kernel, dim3(grid_blocks), dim3(NTHR), args, LDS_BYTES, stream);
    if (e != hipSuccess) fprintf(stderr, "cooperative launch failed: %s (grid %d)\n", hipGetErrorString(e), grid_blocks);
}
```
